# Optimizing an MI355X kernel written in HIP

```python
import jax, jax.numpy as jnp
from jax import lax
import numpy as np

D_MODEL = 1024
BATCH = 4
SEQ = 4096
DEPTH = 2

CHUNK = 64
N_META = 16
EPS = 1e-6
D_FF = 4 * D_MODEL

RET_HEADS = 4
RET_QK_DIM = D_MODEL // 8
RET_V_DIM = D_MODEL // 4
RET_QK = RET_HEADS * RET_QK_DIM
RET_V = RET_HEADS * RET_V_DIM
ROPE_BASE = 10000.0

LRU_WIDTH = D_MODEL
LRU_BLOCKS = 16
LRU_BLOCK_DIM = LRU_WIDTH // LRU_BLOCKS
LRU_C = 8.0
CONV_WIDTH = 4

S5_WIDTH = D_MODEL // 2
S5_GROUP = 16
S5_GROUPS = S5_WIDTH // S5_GROUP
S5_STATE = 64

HG_HEADS = 4
HG_DK = 128
HG_DV = 128
HG_WIDTH = HG_HEADS * HG_DK
HG_V = HG_HEADS * HG_DV

N_EVEN = (DEPTH + 1) // 2
N_ODD = DEPTH // 2
IN_AB = 2 * RET_QK + 2 * RET_V + 2 * LRU_WIDTH
OUT_AB = RET_V + LRU_WIDTH
IN_CD = S5_WIDTH + 3 * HG_WIDTH + HG_V
OUT_CD = S5_WIDTH + HG_V

kernel_name = "hybrid_retention_rglru_s5_hgrn2_block"

F32 = jnp.float32


def rms_norm(x, g):
    xf = x.astype(F32)
    y = xf * lax.rsqrt(jnp.mean(xf * xf, axis=-1, keepdims=True) + EPS)
    return (y * g.astype(F32)).astype(x.dtype)


def head_norm(o, g, center):
    if center:
        o = o - jnp.mean(o, axis=-1, keepdims=True)
    o = o * lax.rsqrt(jnp.mean(o * o, axis=-1, keepdims=True) + EPS)
    return o.reshape(o.shape[0], o.shape[1], -1) * g.astype(F32)


def split_cols(z, sizes):
    offs = np.cumsum([0] + list(sizes))
    return [z[..., int(offs[n]):int(offs[n + 1])] for n in range(len(sizes))]


def to_chunks(t):
    pad = CHUNK - N_META
    t = jnp.pad(t, [(0, 0), (pad, 0)] + [(0, 0)] * (t.ndim - 2))
    return t.reshape(t.shape[0], -1, CHUNK, *t.shape[2:])


def from_chunks(t):
    t = t.reshape(t.shape[0], -1, *t.shape[3:])
    return t[:, CHUNK - N_META:]


def rotary(x, pos):
    half = x.shape[-1] // 2
    inv = ROPE_BASE ** (-jnp.arange(half, dtype=F32) / half)
    ang = pos.astype(F32)[:, None] * inv[None, :]
    cos = jnp.cos(ang)[None, :, None, :]
    sin = jnp.sin(ang)[None, :, None, :]
    x1, x2 = x[..., :half], x[..., half:]
    return jnp.concatenate([x1 * cos - x2 * sin, x1 * sin + x2 * cos], axis=-1)


def retention(q, k, v, gate, gn_g):
    Bn, L, H, dk = q.shape
    pos = jnp.arange(L)
    q = rotary(q.astype(F32), pos) * (dk ** -0.5)
    k = rotary(k.astype(F32), pos)
    v = v.astype(F32).reshape(Bn, L, H, RET_V_DIM)
    log_g = jnp.log1p(-(2.0 ** (-5.0 - jnp.arange(H, dtype=F32))))
    qc, kc, vc = to_chunks(q), to_chunks(k), to_chunks(v)
    idx = jnp.arange(CHUNK, dtype=F32)
    intra_decay = jnp.exp(jnp.abs(idx[:, None] - idx[None, :])[None] * log_g[:, None, None])
    scores = jnp.einsum('bnihd,bnjhd->bnhij', qc, kc) * intra_decay
    o_intra = jnp.einsum('bnhij,bnjhe->bnihe', scores, vc)
    k_dec = kc * jnp.exp((CHUNK - 1 - idx)[:, None] * log_g[None, :])[..., None]
    kv = jnp.einsum('bnjhd,bnjhe->nbhde', k_dec, vc)
    chunk_decay = jnp.exp(CHUNK * log_g)[None, :, None, None]

    def step(state, kv_c):
        return chunk_decay * state + kv_c, state

    _, prev = lax.scan(step, jnp.zeros_like(kv[0]), kv)
    q_dec = qc * jnp.exp((idx + 1.0)[:, None] * log_g[None, :])[..., None]
    o_inter = jnp.einsum('bnihd,nbhde->bnihe', q_dec, prev)
    o = from_chunks(o_intra + o_inter)
    return head_norm(o, gn_g, True) * jax.nn.silu(gate.astype(F32))


def rg_lru(xb, w_a, b_a, w_i, b_i, lam, conv_w, conv_b):
    Bn, L, W = xb.shape
    xc = lax.conv_general_dilated(
        xb, conv_w[:, None, :].astype(xb.dtype), window_strides=(1,),
        padding=[(CONV_WIDTH - 1, 0)], dimension_numbers=('NWC', 'WIO', 'NWC'),
        feature_group_count=W).astype(F32) + conv_b.astype(F32)
    xg = xc.reshape(Bn, L, LRU_BLOCKS, LRU_BLOCK_DIM)
    r = jax.nn.sigmoid(jnp.einsum('blhi,hij->blhj', xg, w_a.astype(F32)).reshape(Bn, L, W) + b_a)
    i = jax.nn.sigmoid(jnp.einsum('blhi,hij->blhj', xg, w_i.astype(F32)).reshape(Bn, L, W) + b_i)
    log_a = -LRU_C * r * jax.nn.softplus(-lam.astype(F32))
    a = jnp.exp(log_a)
    b = jnp.sqrt(-jnp.expm1(2.0 * log_a)) * (i * xc)

    def comb(lhs, rhs):
        a1, b1 = lhs
        a2, b2 = rhs
        return a1 * a2, a2 * b1 + b2

    _, h = lax.associative_scan(comb, (a, b), axis=1)
    return h


def s5(u, a_re_log, a_im, b_re, b_im, c_re, c_im, d, log_dt, glu_w, glu_b):
    Bn, L, _ = u.shape
    ug = u.astype(F32).reshape(Bn, L, S5_GROUPS, S5_GROUP)
    dt = jnp.exp(log_dt.astype(F32))[:, None]
    a_re = -jnp.exp(a_re_log.astype(F32))
    a_im = a_im.astype(F32)
    mag = jnp.exp(dt * a_re)
    ab_re = mag * jnp.cos(dt * a_im)
    ab_im = mag * jnp.sin(dt * a_im)
    n_re, n_im = ab_re - 1.0, ab_im
    den = a_re * a_re + a_im * a_im
    z_re = (n_re * a_re + n_im * a_im) / den
    z_im = (n_im * a_re - n_re * a_im) / den
    b_re = b_re.astype(F32)
    b_im = b_im.astype(F32)
    bb_re = z_re[..., None] * b_re - z_im[..., None] * b_im
    bb_im = z_re[..., None] * b_im + z_im[..., None] * b_re
    bu_re = jnp.einsum('blgc,gpc->blgp', ug, bb_re)
    bu_im = jnp.einsum('blgc,gpc->blgp', ug, bb_im)
    ar = jnp.broadcast_to(ab_re, bu_re.shape)
    ai = jnp.broadcast_to(ab_im, bu_re.shape)

    def comb(lhs, rhs):
        ar1, ai1, br1, bi1 = lhs
        ar2, ai2, br2, bi2 = rhs
        return (ar1 * ar2 - ai1 * ai2, ar1 * ai2 + ai1 * ar2,
                ar2 * br1 - ai2 * bi1 + br2, ar2 * bi1 + ai2 * br1 + bi2)

    _, _, h_re, h_im = lax.associative_scan(comb, (ar, ai, bu_re, bu_im), axis=1)
    y = (jnp.einsum('blgp,gcp->blgc', h_re, c_re.astype(F32))
         - jnp.einsum('blgp,gcp->blgc', h_im, c_im.astype(F32))
         + d.astype(F32) * ug)
    y = jax.nn.gelu(y.reshape(Bn, L, S5_WIDTH))
    return y * jax.nn.sigmoid(y @ glu_w.astype(F32) + glu_b.astype(F32))


def hgrn2(q, f_pre, i, g, lb, gn_g):
    Bn, L, H, dk = q.shape
    lb = lb.astype(F32).reshape(H, dk)
    f = lb + (1.0 - lb) * jax.nn.sigmoid(f_pre.astype(F32))
    log_f = jnp.log(f)
    k = 1.0 - f
    qc = to_chunks(q.astype(F32))
    kc = to_chunks(k)
    ic = to_chunks(i.astype(F32))
    cum = jnp.cumsum(to_chunks(log_f), axis=2)
    xs = tuple(jnp.moveaxis(t, 1, 0) for t in (qc, kc, ic, cum))
    mask = jnp.tril(jnp.ones((CHUNK, CHUNK), dtype=bool))[None, :, :, None, None]

    def step(S, inp):
        qb, kb, ib, cb = inp
        diff = cb[:, :, None] - cb[:, None, :]
        w = jnp.exp(jnp.where(mask, diff, -jnp.inf))
        att = jnp.einsum('bthd,btshd->bhts', qb, w * kb[:, None])
        o_intra = jnp.einsum('bhts,bshe->bthe', att, ib)
        o_inter = jnp.einsum('bthd,bhde->bthe', qb * jnp.exp(cb), S)
        total = cb[:, -1]
        k_dec = kb * jnp.exp(total[:, None] - cb)
        S_new = jnp.exp(total)[..., None] * S + jnp.einsum('bshd,bshe->bhde', k_dec, ib)
        return S_new, o_intra + o_inter

    S0 = jnp.zeros((Bn, H, dk, HG_DV), F32)
    _, o = lax.scan(step, S0, xs)
    o = from_chunks(jnp.moveaxis(o, 0, 1))
    return head_norm(o, gn_g, False) * jax.nn.silu(g.astype(F32))


def mixer_ab(h, w_in, w_out, ret_gn, rg_wa, rg_ba, rg_wi, rg_bi, rg_lam, rg_conv_w, rg_conv_b):
    Bn, L, _ = h.shape
    z = h @ w_in
    q, k, v, gate, bx, bg = split_cols(z, [RET_QK, RET_QK, RET_V, RET_V, LRU_WIDTH, LRU_WIDTH])
    ya = retention(q.reshape(Bn, L, RET_HEADS, RET_QK_DIM), k.reshape(Bn, L, RET_HEADS, RET_QK_DIM),
                   v, gate, ret_gn)
    yb = jax.nn.gelu(bg.astype(F32)) * rg_lru(bx, rg_wa, rg_ba, rg_wi, rg_bi, rg_lam, rg_conv_w, rg_conv_b)
    return jnp.concatenate([ya, yb], axis=-1) @ w_out.astype(F32)


def mixer_cd(h, w_in, w_out, a_re_log, a_im, b_re, b_im, c_re, c_im, d, log_dt, glu_w, glu_b, hg_gn, lb):
    Bn, L, _ = h.shape
    z = h @ w_in
    u, q, f, i, g = split_cols(z, [S5_WIDTH, HG_WIDTH, HG_WIDTH, HG_V, HG_V])
    yc = s5(u, a_re_log, a_im, b_re, b_im, c_re, c_im, d, log_dt, glu_w, glu_b)
    yd = hgrn2(q.reshape(Bn, L, HG_HEADS, HG_DK), f.reshape(Bn, L, HG_HEADS, HG_DK),
               i.reshape(Bn, L, HG_HEADS, HG_DV), g, lb, hg_gn)
    return jnp.concatenate([yc, yd], axis=-1) @ w_out.astype(F32)


def sq_relu_mlp(h, w1, w2):
    a = jax.nn.relu(h @ w1)
    return (a * a) @ w2


def setup_inputs(seed: int = 0) -> dict:
    key = jax.random.key(seed)
    ks = iter(jax.random.split(key, 40))
    nrm = lambda shape, s: jax.random.normal(next(ks), shape, F32) * s
    u_lru = jax.random.uniform(next(ks), (N_EVEN, LRU_WIDTH), F32, 0.9, 0.999)
    a_lru = u_lru ** (1.0 / LRU_C)
    return {
        "x": nrm((BATCH, SEQ, D_MODEL), 1.0),
        "meta": nrm((N_META, D_MODEL), 1.0),
        "w_in_ab": nrm((N_EVEN, D_MODEL, IN_AB), D_MODEL ** -0.5),
        "w_out_ab": nrm((N_EVEN, OUT_AB, D_MODEL), OUT_AB ** -0.5),
        "ret_gn": 1.0 + nrm((N_EVEN, RET_V), 0.02),
        "rg_wa": nrm((N_EVEN, LRU_BLOCKS, LRU_BLOCK_DIM, LRU_BLOCK_DIM), LRU_BLOCK_DIM ** -0.5),
        "rg_ba": nrm((N_EVEN, LRU_WIDTH), 0.02),
        "rg_wi": nrm((N_EVEN, LRU_BLOCKS, LRU_BLOCK_DIM, LRU_BLOCK_DIM), LRU_BLOCK_DIM ** -0.5),
        "rg_bi": nrm((N_EVEN, LRU_WIDTH), 0.02),
        "rg_lam": jnp.log(a_lru) - jnp.log1p(-a_lru),
        "rg_conv_w": nrm((N_EVEN, CONV_WIDTH, LRU_WIDTH), CONV_WIDTH ** -0.5),
        "rg_conv_b": nrm((N_EVEN, LRU_WIDTH), 0.02),
        "w_in_cd": nrm((N_ODD, D_MODEL, IN_CD), D_MODEL ** -0.5),
        "w_out_cd": nrm((N_ODD, OUT_CD, D_MODEL), OUT_CD ** -0.5),
        "s5_a_re_log": jnp.log(0.5) + nrm((N_ODD, S5_GROUPS, S5_STATE), 0.02),
        "s5_a_im": jnp.broadcast_to(jnp.pi * jnp.arange(S5_STATE, dtype=F32), (N_ODD, S5_GROUPS, S5_STATE))
                   + nrm((N_ODD, S5_GROUPS, S5_STATE), 0.02),
        "s5_b_re": nrm((N_ODD, S5_GROUPS, S5_STATE, S5_GROUP), (2 * S5_GROUP) ** -0.5),
        "s5_b_im": nrm((N_ODD, S5_GROUPS, S5_STATE, S5_GROUP), (2 * S5_GROUP) ** -0.5),
        "s5_c_re": nrm((N_ODD, S5_GROUPS, S5_GROUP, S5_STATE), (2 * S5_STATE) ** -0.5),
        "s5_c_im": nrm((N_ODD, S5_GROUPS, S5_GROUP, S5_STATE), (2 * S5_STATE) ** -0.5),
        "s5_d": nrm((N_ODD, S5_GROUPS, S5_GROUP), 1.0),
        "s5_log_dt": jax.random.uniform(next(ks), (N_ODD, S5_GROUPS), F32, np.log(1e-3), np.log(1e-1)),
        "s5_glu_w": nrm((N_ODD, S5_WIDTH, S5_WIDTH), S5_WIDTH ** -0.5),
        "s5_glu_b": nrm((N_ODD, S5_WIDTH), 0.02),
        "hg_gn": 1.0 + nrm((N_ODD, HG_V), 0.02),
        "hg_lb_logits": nrm((DEPTH, HG_WIDTH), 0.5),
        "norm_g": 1.0 + nrm((DEPTH, 4, D_MODEL), 0.02),
        "mlp_w1": nrm((DEPTH, D_MODEL, D_FF), D_MODEL ** -0.5),
        "mlp_w2": nrm((DEPTH, D_FF, D_MODEL), D_FF ** -0.5),
    }


def reference(x, meta, w_in_ab, w_out_ab, ret_gn, rg_wa, rg_ba, rg_wi, rg_bi, rg_lam, rg_conv_w, rg_conv_b,
              w_in_cd, w_out_cd, s5_a_re_log, s5_a_im, s5_b_re, s5_b_im, s5_c_re, s5_c_im, s5_d, s5_log_dt,
              s5_glu_w, s5_glu_b, hg_gn, hg_lb_logits, norm_g, mlp_w1, mlp_w2):
    Bn = x.shape[0]
    h = jnp.concatenate([jnp.broadcast_to(meta[None].astype(x.dtype), (Bn, N_META, D_MODEL)), x], axis=1)
    p = jax.nn.softmax(hg_lb_logits.astype(F32), axis=0)
    lb_all = jnp.cumsum(p, axis=0) - p
    for l in range(DEPTH):
        j = l // 2
        hn = rms_norm(h, norm_g[l, 0])
        if l % 2 == 0:
            m = mixer_ab(hn, w_in_ab[j], w_out_ab[j], ret_gn[j], rg_wa[j], rg_ba[j], rg_wi[j], rg_bi[j],
                         rg_lam[j], rg_conv_w[j], rg_conv_b[j])
        else:
            m = mixer_cd(hn, w_in_cd[j], w_out_cd[j], s5_a_re_log[j], s5_a_im[j], s5_b_re[j], s5_b_im[j],
                         s5_c_re[j], s5_c_im[j], s5_d[j], s5_log_dt[j], s5_glu_w[j], s5_glu_b[j],
                         hg_gn[j], lb_all[l])
        h = h + rms_norm(m, norm_g[l, 1])
        hn = rms_norm(h, norm_g[l, 2])
        h = h + rms_norm(sq_relu_mlp(hn, mlp_w1[l], mlp_w2[l]), norm_g[l, 3])
    return h[:, N_META:]
```

```cpp
#include <hip/hip_runtime.h>
#include <hip/hip_cooperative_groups.h>
#include <cstdio>
#include <cstdint>
namespace cg = cooperative_groups;

#define LAS __attribute__((address_space(3)))
typedef unsigned short bf16_t;
typedef short bf16x8 __attribute__((ext_vector_type(8)));
typedef float f32x4 __attribute__((ext_vector_type(4)));
typedef float f32x2 __attribute__((ext_vector_type(2)));
typedef unsigned u32x4 __attribute__((ext_vector_type(4)));
typedef unsigned u32x2 __attribute__((ext_vector_type(2)));

constexpr int DM = 1024, NB = 4, SEQ = 4096, NMETA = 16, FF = 4096;
constexpr int RM = NB * SEQ;
constexpr int RMETA = RM;
constexpr int RVALID = RM + NB * NMETA;
constexpr int R = 16640;
constexpr int NCH = 65;
constexpr int IN_AB = 5120, IN_CD = 2560;
constexpr float EPS = 1e-6f;
constexpr int NTHREADS = 512;
constexpr int LDS_BYTES = 147456;

constexpr size_t W_INAB = 0;
constexpr size_t W_OUTAB = W_INAB + (size_t)5120 * 1024 * 2;
constexpr size_t W_W1_0 = W_OUTAB + (size_t)1024 * 2048 * 2;
constexpr size_t W_W2_0 = W_W1_0 + (size_t)4096 * 1024 * 2;
constexpr size_t W_INCD = W_W2_0 + (size_t)4096 * 1024 * 2;
constexpr size_t W_OUTCD = W_INCD + (size_t)2560 * 1024 * 2;
constexpr size_t W_GLU = W_OUTCD + (size_t)1024 * 1024 * 2;
constexpr size_t W_W1_1 = W_GLU + (size_t)512 * 512 * 2;
constexpr size_t W_W2_1 = W_W1_1 + (size_t)4096 * 1024 * 2;
constexpr size_t W_END = W_W2_1 + (size_t)4096 * 1024 * 2;
constexpr size_t Z_OFF = W_END;
constexpr size_t HN_OFF = Z_OFF + (size_t)R * 5120 * 2;
constexpr size_t SM_OFF = HN_OFF + (size_t)R * 1024 * 2;
constexpr size_t HMETA_OFF = SM_OFF;
constexpr size_t SSQ_OFF = HMETA_OFF + (size_t)64 * 1024 * 4;
constexpr size_t LRUW_OFF = SSQ_OFF + (size_t)R * 16 * 4;
constexpr size_t S5BB_OFF = LRUW_OFF + (size_t)16 * 128 * 64 * 2;
constexpr size_t S5CM_OFF = S5BB_OFF + (size_t)32 * 128 * 32 * 2;
constexpr size_t S5AB_OFF = S5CM_OFF + (size_t)32 * 16 * 128 * 2;
constexpr size_t WS_END = S5AB_OFF + (size_t)32 * 64 * 2 * 4;
static_assert(WS_END <= (size_t)268435456, "workspace map");

struct Args {
    const float* in[29];
    float* out;
    unsigned char* ws;
};

typedef __bf16 bf16x2_t __attribute__((ext_vector_type(2)));
__device__ __forceinline__ unsigned cvt_pk_bf16(float lo, float hi) { f32x2 v = {lo, hi}; bf16x2_t b = __builtin_convertvector(v, bf16x2_t); return __builtin_bit_cast(unsigned, b); }
__device__ __forceinline__ float bf_lo(unsigned u) { return __uint_as_float(u << 16); }
__device__ __forceinline__ float bf_hi(unsigned u) { return __uint_as_float(u & 0xffff0000u); }
__device__ __forceinline__ bf16_t f2bf(float f) { return (bf16_t)(cvt_pk_bf16(f, 0.f) & 0xffffu); }
__device__ __forceinline__ float wave_sum(float v) {
#pragma unroll
    for (int o = 1; o < 64; o <<= 1) v += __shfl_xor(v, o);
    return v;
}
__device__ __forceinline__ float sigmoidf_(float x) { return 1.f / (1.f + __expf(-x)); }
__device__ __forceinline__ float gelu_tanh(float x) {
    const float u = 0.7978845608028654f * (x + 0.044715f * x * x * x);
    const float e = __expf(2.f * u);
    const float t = 1.f - 2.f / (e + 1.f);
    return 0.5f * x * (1.f + t);
}
__device__ __forceinline__ float silu_(float x) { return x * sigmoidf_(x); }
__device__ __forceinline__ void sincos_big(float ang, float& s, float& c) {
    double t = (double)ang * 0.15915494309189535;
    t -= rint(t);
    const float fr = (float)t;
    s = __builtin_amdgcn_sinf(fr); c = __builtin_amdgcn_cosf(fr);
}
__device__ __forceinline__ float* hrow(const Args& a, int row) {
    return row < RM ? a.out + (size_t)row * DM : (float*)(a.ws + HMETA_OFF) + (size_t)(row - RM) * DM;
}
__device__ __forceinline__ int chunk_row(int b, int n, int j) {
    if (n == 0) return j >= 48 ? RMETA + b * NMETA + (j - 48) : -1;
    return b * SEQ + (n - 1) * 64 + j;
}

namespace pg8 {
constexpr int BM = 256, BK = 64, HALF = 128, HTB = HALF * BK * 2, NXCD = 8, WGM = 8;
__device__ __forceinline__ int lds_byte(int r, int c) { const int st = (r >> 4) * 2 + (c >> 5), rr = r & 15, cc = c & 31, ob = rr * 64 + cc * 2; return st * 1024 + (ob ^ (((ob >> 9) & 1) << 5)); }
__device__ __forceinline__ void stage_rc(int b, int& Rr, int& C) { const int st = b / 1024, sb = b % 1024, swz = sb ^ (((sb >> 9) & 1) << 5); Rr = (st >> 1) * 16 + swz / 64; C = (st & 1) * 32 + (swz % 64) / 2; }
__device__ __forceinline__ int perm32(int rho) { const int n = rho >> 4, i = rho & 15; return 8 * (i >> 2) + 4 * n + (i & 3); }
struct Unit { int pm, pn; };
struct Gemm { const bf16_t* A; const bf16_t* Bt; int M, N, K, lda; };
struct StaticOrder {
    int nM, nN, nwg, G, c;
    __device__ void init(int M, int N, int G_, int c_) { nM = M / BM; nN = N / BM; nwg = nM * nN; G = G_; c = c_; }
    __device__ bool next(int i, Unit& u) const {
        const long L = (long)i * G + c; if (L >= nwg) return false;
        int wgid = (int)L; { const int q = nwg / NXCD, r = nwg % NXCD, xcd = wgid % NXCD, off = wgid / NXCD; wgid = (xcd < r ? xcd * (q + 1) : r * (q + 1) + (xcd - r) * q) + off; }
        const int nig = WGM * nN, gid = wgid / nig, fm = gid * WGM, gsz = (nM - fm) < WGM ? (nM - fm) : WGM;
        u.pm = fm + ((wgid % nig) % gsz); u.pn = (wgid % nig) / gsz; return true;
    }
};
template <class Epi>
__device__ __forceinline__ void gemm_phase(LAS unsigned char* lds, const Gemm g, const StaticOrder& S, const Epi& E) {
    int tid_ = threadIdx.x; asm volatile("" : "+v"(tid_));
    const int tid = tid_, wid = __builtin_amdgcn_readfirstlane(tid >> 6), lane = tid & 63, wr = wid >> 2, wc = wid & 3, fr = lane & 15, fq = lane >> 4;
    const int K = g.K, nt = K / BK, lda = g.lda;
    unsigned voffA[2], voffB[2];
#pragma unroll
    for (int i = 0; i < 2; ++i) { int Rr, C; stage_rc(tid * 16 + i * 8192, Rr, C); const int Rb = (Rr & ~31) + perm32(Rr & 31);
        voffA[i] = (unsigned)(Rr * lda + C) * 2u; voffB[i] = (unsigned)(Rb * K + C) * 2u; }
    const size_t kstep = (size_t)(BK * 2);
    const size_t hstepA = (size_t)HALF * lda * 2, hstepB = (size_t)HALF * K * 2;
    const size_t tstepA = 2 * hstepA, tstepB = 2 * hstepB;
    const unsigned ldsw = (unsigned)wid * 1024u;
    const int aoff = lds_byte(wr * 64 + fr, fq * 8), boff = lds_byte(wc * 32 + fr, fq * 8);
#define PG8_SA(b, h) (((b) * 2 + (h)) * HTB)
#define PG8_SB(b, h) ((4 + (b) * 2 + (h)) * HTB)
#define PG8_STAGE(bufoff, gbase, voff) do { _Pragma("unroll") for (int _i = 0; _i < 2; ++_i) \
        __builtin_amdgcn_global_load_lds((const unsigned*)((const char*)(gbase) + (voff)[_i]), (LAS unsigned*)(lds + (bufoff) + ldsw + _i * 8192), 16, 0, 0); } while (0)
#define PG8_LDA(dst, b, h) do { _Pragma("unroll") for (int m = 0; m < 4; ++m) _Pragma("unroll") for (int k = 0; k < 2; ++k) dst[m][k] = *(const LAS bf16x8*)(lds + PG8_SA(b, h) + aoff + m * 2048 + k * 1024); } while (0)
#define PG8_LDB(dst, b, h) do { _Pragma("unroll") for (int n = 0; n < 2; ++n) _Pragma("unroll") for (int k = 0; k < 2; ++k) dst[n][k] = *(const LAS bf16x8*)(lds + PG8_SB(b, h) + boff + n * 2048 + k * 1024); } while (0)
#define PG8_MMA(ai, bj, At, Bt) do { __builtin_amdgcn_s_setprio(1); _Pragma("unroll") for (int m = 0; m < 4; ++m) _Pragma("unroll") for (int n = 0; n < 2; ++n) _Pragma("unroll") for (int k = 0; k < 2; ++k) \
        acc[ai][bj][m][n] = __builtin_amdgcn_mfma_f32_16x16x32_bf16(Bt[n][k], At[m][k], acc[ai][bj][m][n], 0, 0, 0); __builtin_amdgcn_s_setprio(0); } while (0)
#define PG8_WAIT_V(n) asm volatile("s_waitcnt vmcnt(" #n ")" ::: "memory")
#define PG8_WAIT_L(n) asm volatile("s_waitcnt lgkmcnt(" #n ")" ::: "memory")
#define PG8_BAR __builtin_amdgcn_s_barrier()
#define PG8_SCHED __builtin_amdgcn_sched_barrier(0)
    Unit cur, nxt; int ui = 0;
    if (!S.next(0, cur)) return;
    f32x4 acc[2][2][4][2];
#pragma unroll
    for (int a = 0; a < 2; ++a)
#pragma unroll
        for (int b = 0; b < 2; ++b)
#pragma unroll
            for (int m = 0; m < 4; ++m)
#pragma unroll
                for (int n = 0; n < 2; ++n) acc[a][b][m][n] = (f32x4){0.f, 0.f, 0.f, 0.f};
    bf16x8 At[4][2], B0[2][2], B1[2][2];
    const char* cA = (const char*)g.A + (size_t)cur.pm * tstepA; const char* cB = (const char*)g.Bt + (size_t)cur.pn * tstepB;
    PG8_STAGE(PG8_SB(0, 0), cB, voffB); PG8_STAGE(PG8_SB(0, 1), cB + hstepB, voffB); PG8_STAGE(PG8_SA(0, 0), cA, voffA); PG8_STAGE(PG8_SA(0, 1), cA + hstepA, voffA);
    if (wr == 1) PG8_BAR;
    PG8_WAIT_V(2); PG8_BAR;
    PG8_STAGE(PG8_SB(1, 0), cB + kstep, voffB); PG8_STAGE(PG8_SA(1, 0), cA + kstep, voffA); PG8_STAGE(PG8_SB(1, 1), cB + hstepB + kstep, voffB);
    PG8_WAIT_V(6); PG8_BAR;
    for (;;) {
        const bool has_next = S.next(ui + 1, nxt);
        const char* nA = has_next ? (const char*)g.A + (size_t)nxt.pm * tstepA : cA; const char* nB = has_next ? (const char*)g.Bt + (size_t)nxt.pn * tstepB : cB;
        for (int t = 0; t < nt; t += 2) {
            const bool last = (t == nt - 2);
            const char* a1 = cA + (size_t)(t + 1) * kstep;
            const char* a2 = last ? nA : cA + (size_t)(t + 2) * kstep; const char* b2 = last ? nB : cB + (size_t)(t + 2) * kstep;
            const char* a3 = a2 + kstep; const char* b3 = b2 + kstep;
            PG8_LDB(B0, 0, 0); PG8_LDB(B1, 0, 1); PG8_SCHED; PG8_LDA(At, 0, 0); PG8_STAGE(PG8_SA(1, 1), a1 + hstepA, voffA);
            PG8_WAIT_V(8); PG8_WAIT_L(0); PG8_BAR; PG8_MMA(0, 0, At, B0); PG8_MMA(0, 1, At, B1); PG8_BAR; PG8_SCHED;
            PG8_LDA(At, 0, 1); PG8_STAGE(PG8_SB(0, 0), b2, voffB); PG8_STAGE(PG8_SB(0, 1), b2 + hstepB, voffB); PG8_STAGE(PG8_SA(0, 0), a2, voffA);
            PG8_WAIT_V(8); PG8_WAIT_L(0); PG8_BAR; PG8_MMA(1, 0, At, B0); PG8_MMA(1, 1, At, B1); PG8_BAR; PG8_SCHED;
            PG8_LDB(B0, 1, 0); PG8_LDB(B1, 1, 1); PG8_SCHED; PG8_LDA(At, 1, 0); PG8_STAGE(PG8_SA(0, 1), a2 + hstepA, voffA);
            PG8_WAIT_V(8); PG8_WAIT_L(0); PG8_BAR; PG8_MMA(0, 0, At, B0); PG8_MMA(0, 1, At, B1); PG8_BAR; PG8_SCHED;
            PG8_LDA(At, 1, 1); PG8_STAGE(PG8_SB(1, 0), b3, voffB); PG8_STAGE(PG8_SB(1, 1), b3 + hstepB, voffB); PG8_STAGE(PG8_SA(1, 0), a3, voffA);
            PG8_WAIT_V(8); PG8_WAIT_L(0); PG8_BAR; PG8_MMA(1, 0, At, B0); PG8_MMA(1, 1, At, B1); PG8_BAR; PG8_SCHED;
        }
        if (wr == 0) PG8_BAR;
        E(acc, cur, wr, wc, fr, fq);
        if (!has_next) break;
#pragma unroll
        for (int a = 0; a < 2; ++a)
#pragma unroll
            for (int b = 0; b < 2; ++b)
#pragma unroll
                for (int m = 0; m < 4; ++m)
#pragma unroll
                    for (int n = 0; n < 2; ++n) acc[a][b][m][n] = (f32x4){0.f, 0.f, 0.f, 0.f};
        cur = nxt; cA = nA; cB = nB; ++ui;
        if (wr == 1) PG8_BAR;
    }
    PG8_WAIT_V(0);
    PG8_BAR;
#undef PG8_SA
#undef PG8_SB
#undef PG8_STAGE
#undef PG8_LDA
#undef PG8_LDB
#undef PG8_MMA
#undef PG8_WAIT_V
#undef PG8_WAIT_L
#undef PG8_BAR
#undef PG8_SCHED
}

template <int MODE> struct Epi {
    bf16_t* O; int ldo;
    float* ssq;
    const bf16_t* Y; int ldy;
    const float* bias;
    __device__ __forceinline__ void operator()(const f32x4 (&acc)[2][2][4][2], const Unit& u, int wr, int wc, int fr, int fq) const {
#pragma unroll
        for (int ai = 0; ai < 2; ++ai)
#pragma unroll
            for (int m = 0; m < 4; ++m) {
                const int row = u.pm * BM + ai * HALF + wr * 64 + m * 16 + fr;
                float ss = 0.f;
#pragma unroll
                for (int bj = 0; bj < 2; ++bj) {
                    const int col0 = u.pn * BM + bj * HALF + wc * 32 + 8 * fq;
                    f32x4 v0 = acc[ai][bj][m][0], v1 = acc[ai][bj][m][1];
                    if (MODE == 1) { ss += v0[0] * v0[0] + v0[1] * v0[1] + v0[2] * v0[2] + v0[3] * v0[3] + v1[0] * v1[0] + v1[1] * v1[1] + v1[2] * v1[2] + v1[3] * v1[3]; }
                    if (MODE == 2) {
#pragma unroll
                        for (int j = 0; j < 4; ++j) { float a = fmaxf(v0[j], 0.f); v0[j] = a * a; float b = fmaxf(v1[j], 0.f); v1[j] = b * b; }
                    }
                    if (MODE == 3) {
                        const u32x4 yv = *(const u32x4*)(Y + (size_t)row * ldy + col0);
                        const f32x4 b0 = *(const f32x4*)(bias + col0), b1 = *(const f32x4*)(bias + col0 + 4);
                        v0[0] = bf_lo(yv.x) * sigmoidf_(v0[0] + b0[0]); v0[1] = bf_hi(yv.x) * sigmoidf_(v0[1] + b0[1]);
                        v0[2] = bf_lo(yv.y) * sigmoidf_(v0[2] + b0[2]); v0[3] = bf_hi(yv.y) * sigmoidf_(v0[3] + b0[3]);
                        v1[0] = bf_lo(yv.z) * sigmoidf_(v1[0] + b1[0]); v1[1] = bf_hi(yv.z) * sigmoidf_(v1[1] + b1[1]);
                        v1[2] = bf_lo(yv.w) * sigmoidf_(v1[2] + b1[2]); v1[3] = bf_hi(yv.w) * sigmoidf_(v1[3] + b1[3]);
                    }
                    u32x4 w; w.x = cvt_pk_bf16(v0[0], v0[1]); w.y = cvt_pk_bf16(v0[2], v0[3]); w.z = cvt_pk_bf16(v1[0], v1[1]); w.w = cvt_pk_bf16(v1[2], v1[3]);
                    *(u32x4*)(O + (size_t)row * ldo + col0) = w;
                }
                if (MODE == 1) {
                    ss += __shfl_xor(ss, 16); ss += __shfl_xor(ss, 32);
                    if (fq == 0) ssq[(size_t)row * 16 + u.pn * 4 + wc] = ss;
                }
            }
    }
};
}

__device__ __forceinline__ bf16x8 ldsfrag(const LAS unsigned char* p) { return *(const LAS bf16x8*)p; }
#define MFMA16(X, Y, ACC) __builtin_amdgcn_mfma_f32_16x16x32_bf16((X), (Y), (ACC), 0, 0, 0)

__device__ __forceinline__ void transpose_item(const float* W, int K, int N, bf16_t* WT, int dst_row0, LAS float* scr, int k0, int n0, int lane) {
#pragma unroll 8
    for (int i = 0; i < 32; ++i) { const int kk = 2 * i + (lane >> 5); scr[kk * 33 + (lane & 31)] = W[(size_t)(k0 + kk) * N + n0 + (lane & 31)]; }
    asm volatile("s_waitcnt lgkmcnt(0)" ::: "memory");
    const int c = lane & 7;
#pragma unroll
    for (int j = 0; j < 4; ++j) { const int n = (lane >> 3) + 8 * j; const LAS float* s = scr + (8 * c) * 33 + n;
        u32x4 o; o.x = cvt_pk_bf16(s[0 * 33], s[1 * 33]); o.y = cvt_pk_bf16(s[2 * 33], s[3 * 33]); o.z = cvt_pk_bf16(s[4 * 33], s[5 * 33]); o.w = cvt_pk_bf16(s[6 * 33], s[7 * 33]);
        *(u32x4*)(WT + (size_t)(dst_row0 + n) * K + k0 + 8 * c) = o; }
    asm volatile("s_waitcnt lgkmcnt(0)" ::: "memory");
}

__device__ __forceinline__ void phase_prologue(const Args& a, LAS unsigned char* lds) {
    int tid_ = threadIdx.x; asm volatile("" : "+v"(tid_));
    const int tid = tid_, lane = tid & 63, wave = tid >> 6;
    const int gw = blockIdx.x * 8 + wave, NGW = gridDim.x * 8;
    unsigned char* ws = a.ws;
    LAS float* scr = (LAS float*)(lds + wave * 16384);
    {
        constexpr int I0 = 16 * 160, I1 = 32 * 32, I2 = 16 * 128, I3 = 64 * 32, I4 = 16 * 80, I5 = 16 * 32, I6 = 8 * 16, I7 = I2, I8 = I3;
        constexpr int NIT = I0 + I1 + I2 + I3 + I4 + I5 + I6 + I7 + I8;
        for (int it = gw; it < NIT; it += NGW) {
            int r = it; const float* W; int K, N; bf16_t* WT; bool perm = false;
            if (r < I0) { W = a.in[2]; K = 1024; N = 5120; WT = (bf16_t*)(ws + W_INAB); perm = true; }
            else if ((r -= I0) < I1) { W = a.in[3]; K = 2048; N = 1024; WT = (bf16_t*)(ws + W_OUTAB); }
            else if ((r -= I1) < I2) { W = a.in[27]; K = 1024; N = 4096; WT = (bf16_t*)(ws + W_W1_0); }
            else if ((r -= I2) < I3) { W = a.in[28]; K = 4096; N = 1024; WT = (bf16_t*)(ws + W_W2_0); }
            else if ((r -= I3) < I4) { W = a.in[12]; K = 1024; N = 2560; WT = (bf16_t*)(ws + W_INCD); }
            else if ((r -= I4) < I5) { W = a.in[13]; K = 1024; N = 1024; WT = (bf16_t*)(ws + W_OUTCD); }
            else if ((r -= I5) < I6) { W = a.in[22]; K = 512; N = 512; WT = (bf16_t*)(ws + W_GLU); }
            else if ((r -= I6) < I7) { W = a.in[27] + (size_t)1024 * 4096; K = 1024; N = 4096; WT = (bf16_t*)(ws + W_W1_1); }
            else { r -= I7; W = a.in[28] + (size_t)1024 * 4096; K = 4096; N = 1024; WT = (bf16_t*)(ws + W_W2_1); }
            const int nblk = N / 32, kb = r / nblk, nb = r % nblk, n0 = nb * 32;
            int d0 = n0;
            if (perm) { if (n0 >= 2048 && n0 < 3072) d0 = n0 + 1024; else if (n0 >= 3072 && n0 < 4096) d0 = n0 - 1024; }
            transpose_item(W, K, N, WT, d0, scr, kb * 64, n0, lane);
        }
    }
    {
        const float* x = a.in[0]; const float* meta = a.in[1]; const float* g = a.in[26];
        bf16_t* HN = (bf16_t*)(ws + HN_OFF);
        for (int row = gw; row < R; row += NGW) {
            if (row >= RVALID) {
#pragma unroll
                for (int j = 0; j < 4; ++j) *(u32x2*)(HN + (size_t)row * DM + 4 * lane + 256 * j) = (u32x2){0u, 0u};
                continue;
            }
            const float* src = row < RM ? x + (size_t)row * DM : meta + (size_t)((row - RM) & 15) * DM;
            float* hr = hrow(a, row);
            f32x4 v[4]; float s = 0.f;
#pragma unroll
            for (int j = 0; j < 4; ++j) { v[j] = *(const f32x4*)(src + 4 * lane + 256 * j); *(f32x4*)(hr + 4 * lane + 256 * j) = v[j];
                s += v[j][0] * v[j][0] + v[j][1] * v[j][1] + v[j][2] * v[j][2] + v[j][3] * v[j][3]; }
            const float inv = rsqrtf(wave_sum(s) * (1.f / DM) + EPS);
#pragma unroll
            for (int j = 0; j < 4; ++j) { const f32x4 gg = *(const f32x4*)(g + 4 * lane + 256 * j);
                u32x2 o; o.x = cvt_pk_bf16(v[j][0] * inv * gg[0], v[j][1] * inv * gg[1]); o.y = cvt_pk_bf16(v[j][2] * inv * gg[2], v[j][3] * inv * gg[3]);
                *(u32x2*)(HN + (size_t)row * DM + 4 * lane + 256 * j) = o; }
        }
    }
    const int gt = blockIdx.x * NTHREADS + tid, NGT = gridDim.x * NTHREADS;
    {
        bf16_t* WG = (bf16_t*)(ws + LRUW_OFF);
        for (int i = gt; i < 16 * 128 * 64; i += NGT) { const int k = i & 63, n = (i >> 6) & 127, blk = i >> 13;
            const float v = n < 64 ? a.in[5][(size_t)blk * 4096 + k * 64 + n] : a.in[7][(size_t)blk * 4096 + k * 64 + (n - 64)];
            WG[i] = f2bf(v); }
    }
    {
        bf16_t* BB = (bf16_t*)(ws + S5BB_OFF); bf16_t* CM = (bf16_t*)(ws + S5CM_OFF); float* AB = (float*)(ws + S5AB_OFF);
        const float* are_log = a.in[14]; const float* aim = a.in[15]; const float* bre = a.in[16]; const float* bim = a.in[17];
        const float* cre = a.in[18]; const float* cim = a.in[19]; const float* ldt = a.in[21];
        for (int i = gt; i < 32 * 64; i += NGT) {
            const int g = i >> 6, p = i & 63;
            const float dt = expf(ldt[g]); const float a_re = -expf(are_log[i]); const float a_im = aim[i];
            const float mag = expf(dt * a_re); float sn, cs; sincos_big(dt * a_im, sn, cs);
            const float ab_re = mag * cs, ab_im = mag * sn;
            AB[2 * i] = ab_re; AB[2 * i + 1] = ab_im;
            const float n_re = ab_re - 1.f, n_im = ab_im, den = a_re * a_re + a_im * a_im;
            const float z_re = (n_re * a_re + n_im * a_im) / den, z_im = (n_im * a_re - n_re * a_im) / den;
            for (int c = 0; c < 32; ++c) {
                float vr = 0.f, vi = 0.f;
                if (c < 16) { const float br = bre[(size_t)i * 16 + c], bi = bim[(size_t)i * 16 + c]; vr = z_re * br - z_im * bi; vi = z_re * bi + z_im * br; }
                BB[((size_t)g * 128 + p) * 32 + c] = f2bf(vr);
                BB[((size_t)g * 128 + 64 + p) * 32 + c] = f2bf(vi);
            }
            for (int c = 0; c < 16; ++c) {
                CM[((size_t)g * 16 + c) * 128 + p] = f2bf(cre[((size_t)g * 16 + c) * 64 + p]);
                CM[((size_t)g * 16 + c) * 128 + 64 + p] = f2bf(-cim[((size_t)g * 16 + c) * 64 + p]);
            }
        }
    }
}

__device__ __forceinline__ void phase_resnorm(const Args& a, const float* g1, const float* g2) {
    int tid_ = threadIdx.x; asm volatile("" : "+v"(tid_));
    const int tid = tid_, lane = tid & 63, wave = tid >> 6;
    const int gw = blockIdx.x * 8 + wave, NGW = gridDim.x * 8;
    bf16_t* HN = (bf16_t*)(a.ws + HN_OFF); const float* ssq = (const float*)(a.ws + SSQ_OFF);
    for (int row = gw; row < R; row += NGW) {
        bf16_t* mrow = HN + (size_t)row * DM;
        if (row >= RVALID) {
#pragma unroll
            for (int j = 0; j < 4; ++j) *(u32x2*)(mrow + 4 * lane + 256 * j) = (u32x2){0u, 0u};
            continue;
        }
        float s = 0.f;
        { const f32x4* sp = (const f32x4*)(ssq + (size_t)row * 16); const f32x4 s0 = sp[0], s1 = sp[1], s2 = sp[2], s3 = sp[3];
          s = ((s0[0] + s0[1]) + (s0[2] + s0[3])) + ((s1[0] + s1[1]) + (s1[2] + s1[3])) + ((s2[0] + s2[1]) + (s2[2] + s2[3])) + ((s3[0] + s3[1]) + (s3[2] + s3[3])); }
        const float inv = rsqrtf(s * (1.f / DM) + EPS);
        float* hr = hrow(a, row);
        f32x4 v[4]; float s2 = 0.f;
#pragma unroll
        for (int j = 0; j < 4; ++j) {
            const u32x2 mv = *(const u32x2*)(mrow + 4 * lane + 256 * j);
            const f32x4 gg = *(const f32x4*)(g1 + 4 * lane + 256 * j);
            v[j] = *(const f32x4*)(hr + 4 * lane + 256 * j);
            v[j][0] += bf_lo(mv.x) * inv * gg[0]; v[j][1] += bf_hi(mv.x) * inv * gg[1]; v[j][2] += bf_lo(mv.y) * inv * gg[2]; v[j][3] += bf_hi(mv.y) * inv * gg[3];
            *(f32x4*)(hr + 4 * lane + 256 * j) = v[j];
            s2 += v[j][0] * v[j][0] + v[j][1] * v[j][1] + v[j][2] * v[j][2] + v[j][3] * v[j][3];
        }
        if (g2) {
            const float inv2 = rsqrtf(wave_sum(s2) * (1.f / DM) + EPS);
#pragma unroll
            for (int j = 0; j < 4; ++j) { const f32x4 gg = *(const f32x4*)(g2 + 4 * lane + 256 * j);
                u32x2 o; o.x = cvt_pk_bf16(v[j][0] * inv2 * gg[0], v[j][1] * inv2 * gg[1]); o.y = cvt_pk_bf16(v[j][2] * inv2 * gg[2], v[j][3] * inv2 * gg[3]);
                *(u32x2*)(mrow + 4 * lane + 256 * j) = o; }
        }
    }
}

constexpr int LA_QS = 0, LA_KS = 17408, LA_QD = 34816, LA_KT = 52224, LA_VT = 70656, LA_PS = 75264, LA_ST = 84480, LA_CUM = 93184, LA_DEC = 125952, LA_END = 126464;
static_assert(LA_END <= LDS_BYTES, "LA lds");

template <bool HG>
__device__ __forceinline__ void la_core(LAS unsigned char* L, f32x4 (&st)[2], float l2g, bf16_t* obuf, int ldo, int ocol, int b, int n) {
    int tid_ = threadIdx.x; asm volatile("" : "+v"(tid_));
    const int tid = tid_, lane = tid & 63, w = __builtin_amdgcn_readfirstlane(tid >> 6), fr = lane & 15, fq = lane >> 4;
    const int mt = w >> 1, nh = w & 1;
    bf16x8 qf[4];
#pragma unroll
    for (int kk = 0; kk < 4; ++kk) qf[kk] = ldsfrag(L + LA_QS + (mt * 16 + fr) * 272 + kk * 64 + fq * 16);
    f32x4 s0 = {0.f, 0.f, 0.f, 0.f}, s1 = {0.f, 0.f, 0.f, 0.f};
#pragma unroll
    for (int kk = 0; kk < 4; ++kk) {
        const bf16x8 k0 = ldsfrag(L + LA_KS + ((nh * 2) * 16 + fr) * 272 + kk * 64 + fq * 16);
        const bf16x8 k1 = ldsfrag(L + LA_KS + ((nh * 2 + 1) * 16 + fr) * 272 + kk * 64 + fq * 16);
        s0 = MFMA16(k0, qf[kk], s0); s1 = MFMA16(k1, qf[kk], s1);
    }
    const int t = mt * 16 + fr;
    {
        float p0[4], p1[4];
#pragma unroll
        for (int jj = 0; jj < 4; ++jj) {
            const int sa = (nh * 2) * 16 + 4 * fq + jj, sb = sa + 16;
            if (HG) { p0[jj] = sa <= t ? s0[jj] : 0.f; p1[jj] = sb <= t ? s1[jj] : 0.f; }
            else { p0[jj] = s0[jj] * exp2f(l2g * fabsf((float)(t - sa))); p1[jj] = s1[jj] * exp2f(l2g * fabsf((float)(t - sb))); }
        }
        u32x2 o0, o1; o0.x = cvt_pk_bf16(p0[0], p0[1]); o0.y = cvt_pk_bf16(p0[2], p0[3]); o1.x = cvt_pk_bf16(p1[0], p1[1]); o1.y = cvt_pk_bf16(p1[2], p1[3]);
        *(LAS u32x2*)(L + LA_PS + t * 144 + ((nh * 2) * 16 + 4 * fq) * 2) = o0;
        *(LAS u32x2*)(L + LA_PS + t * 144 + ((nh * 2 + 1) * 16 + 4 * fq) * 2) = o1;
    }
    f32x4 o = {0.f, 0.f, 0.f, 0.f};
#pragma unroll
    for (int kk = 0; kk < 4; ++kk) {
        const bf16x8 sf = ldsfrag(L + LA_ST + (nh * 16 + fr) * 272 + kk * 64 + fq * 16);
        const bf16x8 qq = HG ? ldsfrag(L + LA_QD + (mt * 16 + fr) * 272 + kk * 64 + fq * 16) : qf[kk];
        o = MFMA16(sf, qq, o);
    }
    if (!HG) { const float sc = exp2f(l2g * (float)(t + 1)); o[0] *= sc; o[1] *= sc; o[2] *= sc; o[3] *= sc; }
    __syncthreads();
#pragma unroll
    for (int kk = 0; kk < 2; ++kk) {
        const bf16x8 vf = ldsfrag(L + LA_VT + (nh * 16 + fr) * 144 + kk * 64 + fq * 16);
        const bf16x8 pf = ldsfrag(L + LA_PS + (mt * 16 + fr) * 144 + kk * 64 + fq * 16);
        o = MFMA16(vf, pf, o);
    }
    {
        const int row = chunk_row(b, n, t);
        if (row >= 0) { u32x2 ov; ov.x = cvt_pk_bf16(o[0], o[1]); ov.y = cvt_pk_bf16(o[2], o[3]);
            *(u32x2*)(obuf + (size_t)row * ldo + ocol + nh * 16 + 4 * fq) = ov; }
    }
    float dc[4];
    if (HG) { const f32x4 dv = *(const LAS f32x4*)(L + LA_DEC + (w * 16 + 4 * fq) * 4); dc[0] = dv[0]; dc[1] = dv[1]; dc[2] = dv[2]; dc[3] = dv[3]; }
    else { const float g64 = exp2f(l2g * 64.f); dc[0] = dc[1] = dc[2] = dc[3] = g64; }
    const bf16x8 kt0 = ldsfrag(L + LA_KT + (w * 16 + fr) * 144 + fq * 16), kt1 = ldsfrag(L + LA_KT + (w * 16 + fr) * 144 + 64 + fq * 16);
#pragma unroll
    for (int et = 0; et < 2; ++et) {
#pragma unroll
        for (int jj = 0; jj < 4; ++jj) st[et][jj] *= dc[jj];
        const bf16x8 v0 = ldsfrag(L + LA_VT + (et * 16 + fr) * 144 + fq * 16), v1 = ldsfrag(L + LA_VT + (et * 16 + fr) * 144 + 64 + fq * 16);
        st[et] = MFMA16(kt0, v0, st[et]); st[et] = MFMA16(kt1, v1, st[et]);
        u32x2 sv; sv.x = cvt_pk_bf16(st[et][0], st[et][1]); sv.y = cvt_pk_bf16(st[et][2], st[et][3]);
        *(LAS u32x2*)(L + LA_ST + (et * 16 + fr) * 272 + (w * 16 + 4 * fq) * 2) = sv;
    }
}

#define UNPK8(dst, v) do { dst[0] = bf_lo((v).x); dst[1] = bf_hi((v).x); dst[2] = bf_lo((v).y); dst[3] = bf_hi((v).y); dst[4] = bf_lo((v).z); dst[5] = bf_hi((v).z); dst[6] = bf_lo((v).w); dst[7] = bf_hi((v).w); } while (0)
#define PK8(v, src) do { (v).x = cvt_pk_bf16(src[0], src[1]); (v).y = cvt_pk_bf16(src[2], src[3]); (v).z = cvt_pk_bf16(src[4], src[5]); (v).w = cvt_pk_bf16(src[6], src[7]); } while (0)

__device__ __forceinline__ void retention_unit(const Args& a, LAS unsigned char* L, int unit) {
    int tid_ = threadIdx.x; asm volatile("" : "+v"(tid_));
    const int tid = tid_, b = unit >> 5, h = (unit >> 3) & 3, sl = unit & 7;
    const bf16_t* Z = (const bf16_t*)(a.ws + Z_OFF); bf16_t* OB = (bf16_t*)(a.ws + HN_OFF);
    const float l2g = log2f(1.f - exp2f(-5.f - (float)h));
    const int row_l = tid >> 3, c8 = tid & 7;
    const int vrow = (tid >> 2) & 63, vp = tid & 3;
    float invf[8];
#pragma unroll
    for (int i = 0; i < 8; ++i) invf[i] = exp2f(-(float)(c8 * 8 + i) * (13.287712379549449f / 64.f));
    f32x4 st[2] = {{0.f, 0.f, 0.f, 0.f}, {0.f, 0.f, 0.f, 0.f}};
    for (int i = tid; i < 32 * 272 / 4; i += NTHREADS) ((LAS unsigned*)(L + LA_ST))[i] = 0u;
    u32x4 q1, q2, k1, k2, vv;
#define RET_LOAD(n_) do { const int r_ = chunk_row(b, (n_), row_l); \
        if (r_ >= 0) { const bf16_t* zr = Z + (size_t)r_ * IN_AB; \
            q1 = *(const u32x4*)(zr + h * 128 + c8 * 8); q2 = *(const u32x4*)(zr + h * 128 + 64 + c8 * 8); \
            k1 = *(const u32x4*)(zr + 512 + h * 128 + c8 * 8); k2 = *(const u32x4*)(zr + 512 + h * 128 + 64 + c8 * 8); \
        } else { q1 = q2 = k1 = k2 = (u32x4){0u, 0u, 0u, 0u}; } \
        vv = (u32x4){0u, 0u, 0u, 0u}; \
        if (tid < 256) { const int rv = chunk_row(b, (n_), vrow); if (rv >= 0) vv = *(const u32x4*)(Z + (size_t)rv * IN_AB + 1024 + h * 256 + sl * 32 + vp * 8); } } while (0)
    RET_LOAD(0);
    for (int n = 0; n < NCH; ++n) {
        {
            const float pos = (float)(n == 0 ? row_l - 48 : 16 + (n - 1) * 64 + row_l);
            const float kdec = exp2f(l2g * (float)(63 - row_l));
            float x1[8], x2[8], y1[8], y2[8], qo1[8], qo2[8], ko1[8], ko2[8];
            UNPK8(x1, q1); UNPK8(x2, q2); UNPK8(y1, k1); UNPK8(y2, k2);
#pragma unroll
            for (int i = 0; i < 8; ++i) {
                float sn, cs; sincos_big(pos * invf[i], sn, cs);
                qo1[i] = (x1[i] * cs - x2[i] * sn) * 0.08838834764831845f; qo2[i] = (x1[i] * sn + x2[i] * cs) * 0.08838834764831845f;
                ko1[i] = y1[i] * cs - y2[i] * sn; ko2[i] = y1[i] * sn + y2[i] * cs;
            }
            u32x4 w1, w2;
            PK8(w1, qo1); PK8(w2, qo2);
            *(LAS u32x4*)(L + LA_QS + row_l * 272 + c8 * 16) = w1; *(LAS u32x4*)(L + LA_QS + row_l * 272 + 128 + c8 * 16) = w2;
            PK8(w1, ko1); PK8(w2, ko2);
            *(LAS u32x4*)(L + LA_KS + row_l * 272 + c8 * 16) = w1; *(LAS u32x4*)(L + LA_KS + row_l * 272 + 128 + c8 * 16) = w2;
#pragma unroll
            for (int i = 0; i < 8; ++i) {
                *(LAS bf16_t*)(L + LA_KT + (c8 * 8 + i) * 144 + row_l * 2) = f2bf(ko1[i] * kdec);
                *(LAS bf16_t*)(L + LA_KT + (64 + c8 * 8 + i) * 144 + row_l * 2) = f2bf(ko2[i] * kdec);
            }
            if (tid < 256) {
                const unsigned va[4] = {vv.x, vv.y, vv.z, vv.w};
#pragma unroll
                for (int i = 0; i < 8; ++i) *(LAS bf16_t*)(L + LA_VT + (vp * 8 + i) * 144 + vrow * 2) = (bf16_t)((i & 1) ? (va[i >> 1] >> 16) : (va[i >> 1] & 0xffffu));
            }
        }
        if (n + 1 < NCH) RET_LOAD(n + 1);
        __syncthreads();
        la_core<false>(L, st, l2g, OB, DM, h * 256 + sl * 32, b, n);
        __syncthreads();
    }
#undef RET_LOAD
}

__device__ __forceinline__ void hgrn_unit(const Args& a, LAS unsigned char* L, int unit) {
    int tid_ = threadIdx.x; asm volatile("" : "+v"(tid_));
    const int tid = tid_, b = unit >> 4, h = (unit >> 2) & 3, sl = unit & 3;
    bf16_t* Z = (bf16_t*)(a.ws + Z_OFF); bf16_t* OB = (bf16_t*)(a.ws + HN_OFF);
    const int row_l = tid >> 3, c8 = tid & 7;
    const int vrow = (tid >> 2) & 63, vp = tid & 3;
    const float* lg = a.in[25];
    float lb1[8], lb2[8];
#pragma unroll
    for (int i = 0; i < 8; ++i) { const int d = h * 128 + c8 * 8 + i; lb1[i] = sigmoidf_(lg[d] - lg[512 + d]); lb2[i] = sigmoidf_(lg[d + 64] - lg[512 + d + 64]); }
    f32x4 st[2] = {{0.f, 0.f, 0.f, 0.f}, {0.f, 0.f, 0.f, 0.f}};
    for (int i = tid; i < 32 * 272 / 4; i += NTHREADS) ((LAS unsigned*)(L + LA_ST))[i] = 0u;
    u32x4 q1, q2, f1, f2, vv;
#define HG_LOAD(n_) do { const int r_ = chunk_row(b, (n_), row_l); \
        if (r_ >= 0) { const bf16_t* zr = Z + (size_t)r_ * IN_CD; \
            q1 = *(const u32x4*)(zr + 512 + h * 128 + c8 * 8); q2 = *(const u32x4*)(zr + 512 + h * 128 + 64 + c8 * 8); \
            f1 = *(const u32x4*)(zr + 1024 + h * 128 + c8 * 8); f2 = *(const u32x4*)(zr + 1024 + h * 128 + 64 + c8 * 8); \
        } else { q1 = q2 = f1 = f2 = (u32x4){0u, 0u, 0u, 0u}; } \
        vv = (u32x4){0u, 0u, 0u, 0u}; \
        if (tid < 256) { const int rv = chunk_row(b, (n_), vrow); if (rv >= 0) vv = *(const u32x4*)(Z + (size_t)rv * IN_CD + 1536 + h * 128 + sl * 32 + vp * 8); } } while (0)
    HG_LOAD(0);
    for (int n = 0; n < NCH; ++n) {
        const bool valid = chunk_row(b, n, row_l) >= 0;
        float qv1[8], qv2[8], kv1[8], kv2[8];
        {
            float fp1[8], fp2[8], lf1[8], lf2[8];
            UNPK8(qv1, q1); UNPK8(qv2, q2); UNPK8(fp1, f1); UNPK8(fp2, f2);
#pragma unroll
            for (int i = 0; i < 8; ++i) {
                const float ff1 = lb1[i] + (1.f - lb1[i]) * sigmoidf_(fp1[i]), ff2 = lb2[i] + (1.f - lb2[i]) * sigmoidf_(fp2[i]);
                if (valid) { lf1[i] = __logf(ff1); lf2[i] = __logf(ff2); kv1[i] = 1.f - ff1; kv2[i] = 1.f - ff2; }
                else { lf1[i] = 0.f; lf2[i] = 0.f; kv1[i] = 0.f; kv2[i] = 0.f; qv1[i] = 0.f; qv2[i] = 0.f; }
            }
            LAS float* cr = (LAS float*)(L + LA_CUM) + row_l * 128;
            *(LAS f32x4*)(cr + c8 * 8) = (f32x4){lf1[0], lf1[1], lf1[2], lf1[3]}; *(LAS f32x4*)(cr + c8 * 8 + 4) = (f32x4){lf1[4], lf1[5], lf1[6], lf1[7]};
            *(LAS f32x4*)(cr + 64 + c8 * 8) = (f32x4){lf2[0], lf2[1], lf2[2], lf2[3]}; *(LAS f32x4*)(cr + 64 + c8 * 8 + 4) = (f32x4){lf2[4], lf2[5], lf2[6], lf2[7]};
            if (tid < 256) {
                const unsigned va[4] = {vv.x, vv.y, vv.z, vv.w};
#pragma unroll
                for (int i = 0; i < 8; ++i) *(LAS bf16_t*)(L + LA_VT + (vp * 8 + i) * 144 + vrow * 2) = (bf16_t)((i & 1) ? (va[i >> 1] >> 16) : (va[i >> 1] & 0xffffu));
            }
        }
        if (n + 1 < NCH) HG_LOAD(n + 1);
        __syncthreads();
        {
            const int d = tid & 127, sg = tid >> 7; LAS float* c = (LAS float*)(L + LA_CUM) + (sg * 16) * 128 + d; float run = 0.f;
#pragma unroll
            for (int r = 0; r < 16; ++r) { run += c[r * 128]; c[r * 128] = run; }
        }
        __syncthreads();
        {
            const LAS float* C = (const LAS float*)(L + LA_CUM);
            const int sg = row_l >> 4;
            float qi[16], ki[16], qd[16], kd[16];
#pragma unroll
            for (int i = 0; i < 16; ++i) {
                const int d = (i < 8) ? c8 * 8 + i : 64 + c8 * 8 + (i - 8);
                const float t0 = C[15 * 128 + d], t1 = C[31 * 128 + d], t2 = C[47 * 128 + d], t3 = C[63 * 128 + d];
                float cum = C[row_l * 128 + d];
                cum += (sg > 0 ? t0 : 0.f) + (sg > 1 ? t1 : 0.f) + (sg > 2 ? t2 : 0.f);
                const float cmid = t0 + t1, total = (t0 + t1) + (t2 + t3);
                const float q = (i < 8) ? qv1[i & 7] : qv2[i & 7], k = (i < 8) ? kv1[i & 7] : kv2[i & 7];
                qi[i] = q * __expf(fminf(cum - cmid, 80.f)); ki[i] = k * __expf(fminf(cmid - cum, 80.f));
                qd[i] = q * __expf(cum); kd[i] = k * __expf(total - cum);
                if (row_l == 0) *(LAS float*)(L + LA_DEC + d * 4) = __expf(total);
            }
            u32x4 w1, w2;
            PK8(w1, qi); { const float* s = qi + 8; PK8(w2, s); }
            *(LAS u32x4*)(L + LA_QS + row_l * 272 + c8 * 16) = w1; *(LAS u32x4*)(L + LA_QS + row_l * 272 + 128 + c8 * 16) = w2;
            PK8(w1, ki); { const float* s = ki + 8; PK8(w2, s); }
            *(LAS u32x4*)(L + LA_KS + row_l * 272 + c8 * 16) = w1; *(LAS u32x4*)(L + LA_KS + row_l * 272 + 128 + c8 * 16) = w2;
            PK8(w1, qd); { const float* s = qd + 8; PK8(w2, s); }
            *(LAS u32x4*)(L + LA_QD + row_l * 272 + c8 * 16) = w1; *(LAS u32x4*)(L + LA_QD + row_l * 272 + 128 + c8 * 16) = w2;
#pragma unroll
            for (int i = 0; i < 8; ++i) {
                *(LAS bf16_t*)(L + LA_KT + (c8 * 8 + i) * 144 + row_l * 2) = f2bf(kd[i]);
                *(LAS bf16_t*)(L + LA_KT + (64 + c8 * 8 + i) * 144 + row_l * 2) = f2bf(kd[8 + i]);
            }
        }
        __syncthreads();
        la_core<true>(L, st, 0.f, OB, 512, h * 128 + sl * 32, b, n);
        __syncthreads();
    }
#undef HG_LOAD
}

constexpr int LR_XB = 0, LR_XC = 17152, LR_XA = 33536, LR_RG = 42752, LR_CW = 75520, LR_END = 77568;
__device__ __forceinline__ void lru_unit(const Args& a, LAS unsigned char* L, int unit) {
    int tid_ = threadIdx.x; asm volatile("" : "+v"(tid_));
    const int tid = tid_, lane = tid & 63, w = __builtin_amdgcn_readfirstlane(tid >> 6), fr = lane & 15, fq = lane >> 4;
    const int b = unit >> 4, cb = unit & 15;
    bf16_t* Z = (bf16_t*)(a.ws + Z_OFF);
    const int row_l = tid >> 3, c8 = tid & 7;
    LAS float* XB = (LAS float*)(L + LR_XB); LAS float* XC = (LAS float*)(L + LR_XC); LAS float* RG = (LAS float*)(L + LR_RG); LAS float* CW = (LAS float*)(L + LR_CW);
    if (tid < 64) {
        const int c = cb * 64 + tid;
#pragma unroll
        for (int ww = 0; ww < 4; ++ww) CW[ww * 64 + tid] = a.in[10][ww * 1024 + c];
        CW[4 * 64 + tid] = a.in[11][c];
        CW[5 * 64 + tid] = log1pf(expf(-a.in[9][c]));
        CW[6 * 64 + tid] = a.in[6][c]; CW[7 * 64 + tid] = a.in[8][c];
    }
    const bf16_t* WG = (const bf16_t*)(a.ws + LRUW_OFF) + (size_t)cb * 128 * 64;
    const bf16x8 wf0 = *(const bf16x8*)(WG + (w * 16 + fr) * 64 + fq * 8), wf1 = *(const bf16x8*)(WG + (w * 16 + fr) * 64 + 32 + fq * 8);
    float hstate = 0.f;
    u32x4 xbv, bgv;
#define LRU_LOAD(n_) do { const int r_ = chunk_row(b, (n_), row_l); \
        if (r_ >= 0) { const bf16_t* zr = Z + (size_t)r_ * IN_AB; xbv = *(const u32x4*)(zr + 2048 + cb * 64 + c8 * 8); bgv = *(const u32x4*)(zr + 4096 + cb * 64 + c8 * 8); } \
        else { xbv = bgv = (u32x4){0u, 0u, 0u, 0u}; } } while (0)
    LRU_LOAD(0);
    __syncthreads();
    for (int n = 0; n < NCH; ++n) {
        float hv = 0.f;
        if (tid < 192 && n > 0) hv = XB[64 * 64 + tid];
        __syncthreads();
        if (tid < 192) XB[tid] = hv;
        {
            float xf[8]; UNPK8(xf, xbv);
            *(LAS f32x4*)(XB + (3 + row_l) * 64 + c8 * 8) = (f32x4){xf[0], xf[1], xf[2], xf[3]}; *(LAS f32x4*)(XB + (3 + row_l) * 64 + c8 * 8 + 4) = (f32x4){xf[4], xf[5], xf[6], xf[7]};
        }
        const u32x4 bgc = bgv;
        const int grow = chunk_row(b, n, row_l);
        if (n + 1 < NCH) LRU_LOAD(n + 1);
        __syncthreads();
        {
            float xc[8];
#pragma unroll
            for (int i = 0; i < 8; ++i) { const int c = c8 * 8 + i; float s = CW[4 * 64 + c];
#pragma unroll
                for (int ww = 0; ww < 4; ++ww) s += CW[ww * 64 + c] * XB[(row_l + ww) * 64 + c];
                xc[i] = s; XC[row_l * 64 + c] = s; }
            u32x4 o; PK8(o, xc);
            *(LAS u32x4*)(L + LR_XA + row_l * 144 + c8 * 16) = o;
        }
        __syncthreads();
        {
            const f32x4 bias = *(const LAS f32x4*)(CW + (w < 4 ? 6 * 64 + w * 16 : 7 * 64 + (w - 4) * 16) + 4 * fq);
#pragma unroll
            for (int m = 0; m < 4; ++m) {
                f32x4 acc = {0.f, 0.f, 0.f, 0.f};
                const bf16x8 x0 = ldsfrag(L + LR_XA + (m * 16 + fr) * 144 + fq * 16), x1 = ldsfrag(L + LR_XA + (m * 16 + fr) * 144 + 64 + fq * 16);
                acc = MFMA16(wf0, x0, acc); acc = MFMA16(wf1, x1, acc);
                f32x4 gte; gte[0] = sigmoidf_(acc[0] + bias[0]); gte[1] = sigmoidf_(acc[1] + bias[1]); gte[2] = sigmoidf_(acc[2] + bias[2]); gte[3] = sigmoidf_(acc[3] + bias[3]);
                *(LAS f32x4*)(RG + (m * 16 + fr) * 128 + w * 16 + 4 * fq) = gte;
            }
        }
        __syncthreads();
        {
#pragma unroll
            for (int i = 0; i < 8; ++i) { const int c = c8 * 8 + i;
                const float r = RG[row_l * 128 + c], ig = RG[row_l * 128 + 64 + c], xc = XC[row_l * 64 + c];
                const float log_a = -8.f * r * CW[5 * 64 + c];
                float av = __expf(log_a), bv = sqrtf(fmaxf(-expm1f(2.f * log_a), 0.f)) * (ig * xc);
                if (grow < 0) { av = 1.f; bv = 0.f; }
                RG[row_l * 128 + c] = av; RG[row_l * 128 + 64 + c] = bv; }
        }
        __syncthreads();
        if (w == 0) {
#pragma unroll 16
            for (int j = 0; j < 64; ++j) { hstate = RG[j * 128 + lane] * hstate + RG[j * 128 + 64 + lane]; RG[j * 128 + 64 + lane] = hstate; }
        }
        __syncthreads();
        if (grow >= 0) {
            float gf[8], y[8]; UNPK8(gf, bgc);
#pragma unroll
            for (int i = 0; i < 8; ++i) y[i] = gelu_tanh(gf[i]) * RG[row_l * 128 + 64 + c8 * 8 + i];
            u32x4 o; PK8(o, y);
            *(u32x4*)(Z + (size_t)grow * IN_AB + 4096 + cb * 64 + c8 * 8) = o;
        }
    }
    __syncthreads();
#undef LRU_LOAD
}

constexpr int S5_BU = 0, S5_HS = 32768, S5_END = 32768 + 64 * 272;
__device__ __forceinline__ void s5_unit(const Args& a, LAS unsigned char* L, int unit) {
    int tid_ = threadIdx.x; asm volatile("" : "+v"(tid_));
    const int tid = tid_, lane = tid & 63, w = __builtin_amdgcn_readfirstlane(tid >> 6), fr = lane & 15, fq = lane >> 4;
    const int b = unit >> 5, g = unit & 31;
    bf16_t* Z = (bf16_t*)(a.ws + Z_OFF);
    const bf16_t* BB = (const bf16_t*)(a.ws + S5BB_OFF) + (size_t)g * 128 * 32;
    const bf16_t* CM = (const bf16_t*)(a.ws + S5CM_OFF) + (size_t)g * 16 * 128;
    const float* AB = (const float*)(a.ws + S5AB_OFF) + (size_t)g * 128;
    const bf16x8 bbf = *(const bf16x8*)(BB + (w * 16 + fr) * 32 + fq * 8);
    bf16x8 cmf[4];
#pragma unroll
    for (int kk = 0; kk < 4; ++kk) cmf[kk] = *(const bf16x8*)(CM + fr * 128 + kk * 32 + fq * 8);
    const float ar = AB[2 * lane], ai = AB[2 * lane + 1];
    const f32x4 dv = *(const f32x4*)(a.in[20] + g * 16 + 4 * fq);
    float hr = 0.f, hi = 0.f;
    LAS float* BU = (LAS float*)(L + S5_BU);
    bf16x8 uf[4];
#define S5_LOAD(n_) do { _Pragma("unroll") for (int m = 0; m < 4; ++m) { const int r_ = chunk_row(b, (n_), m * 16 + fr); \
            uf[m] = (bf16x8){0, 0, 0, 0, 0, 0, 0, 0}; \
            if (r_ >= 0 && fq < 2) uf[m] = *(const bf16x8*)(Z + (size_t)r_ * IN_CD + g * 16 + fq * 8); } } while (0)
    S5_LOAD(0);
    for (int n = 0; n < NCH; ++n) {
#pragma unroll
        for (int m = 0; m < 4; ++m) { f32x4 acc = {0.f, 0.f, 0.f, 0.f}; acc = MFMA16(bbf, uf[m], acc);
            *(LAS f32x4*)(BU + (m * 16 + fr) * 128 + w * 16 + 4 * fq) = acc; }
        if (n + 1 < NCH) S5_LOAD(n + 1);
        __syncthreads();
        if (w == 0) {
#pragma unroll 8
            for (int j = 0; j < 64; ++j) {
                const float br = BU[j * 128 + lane], bi = BU[j * 128 + 64 + lane];
                const float nr = ar * hr - ai * hi + br, ni = ar * hi + ai * hr + bi;
                hr = nr; hi = ni;
                *(LAS bf16_t*)(L + S5_HS + j * 272 + lane * 2) = f2bf(hr);
                *(LAS bf16_t*)(L + S5_HS + j * 272 + 128 + lane * 2) = f2bf(hi);
            }
        }
        __syncthreads();
        if (w < 4) {
            f32x4 acc = {0.f, 0.f, 0.f, 0.f};
#pragma unroll
            for (int kk = 0; kk < 4; ++kk) acc = MFMA16(cmf[kk], ldsfrag(L + S5_HS + (w * 16 + fr) * 272 + kk * 64 + fq * 16), acc);
            const int r = chunk_row(b, n, w * 16 + fr);
            if (r >= 0) {
                bf16_t* up = Z + (size_t)r * IN_CD + g * 16 + 4 * fq;
                const u32x2 uv = *(const u32x2*)up;
                const float y0 = gelu_tanh(acc[0] + dv[0] * bf_lo(uv.x)), y1 = gelu_tanh(acc[1] + dv[1] * bf_hi(uv.x));
                const float y2 = gelu_tanh(acc[2] + dv[2] * bf_lo(uv.y)), y3 = gelu_tanh(acc[3] + dv[3] * bf_hi(uv.y));
                u32x2 o; o.x = cvt_pk_bf16(y0, y1); o.y = cvt_pk_bf16(y2, y3);
                *(u32x2*)up = o;
            }
        }
    }
    __syncthreads();
#undef S5_LOAD
}

__device__ __forceinline__ void phase_ret_post(const Args& a) {
    int tid_ = threadIdx.x; asm volatile("" : "+v"(tid_));
    const int tid = tid_, lane = tid & 63, wave = tid >> 6;
    const int gw = blockIdx.x * 8 + wave, NGW = gridDim.x * 8;
    bf16_t* Z = (bf16_t*)(a.ws + Z_OFF); const bf16_t* OB = (const bf16_t*)(a.ws + HN_OFF); const float* gn = a.in[4];
    for (int it = gw; it < RVALID * 4; it += NGW) {
        const int row = it >> 2, h = it & 3;
        const u32x2 ov = *(const u32x2*)(OB + (size_t)row * DM + h * 256 + 4 * lane);
        bf16_t* gp = Z + (size_t)row * IN_AB + 3072 + h * 256 + 4 * lane;
        const u32x2 gv = *(const u32x2*)gp;
        const f32x4 gg = *(const f32x4*)(gn + h * 256 + 4 * lane);
        float o0 = bf_lo(ov.x), o1 = bf_hi(ov.x), o2 = bf_lo(ov.y), o3 = bf_hi(ov.y);
        const float mean = wave_sum((o0 + o1) + (o2 + o3)) * (1.f / 256.f);
        o0 -= mean; o1 -= mean; o2 -= mean; o3 -= mean;
        const float inv = rsqrtf(wave_sum(o0 * o0 + o1 * o1 + o2 * o2 + o3 * o3) * (1.f / 256.f) + EPS);
        u32x2 y; y.x = cvt_pk_bf16(o0 * inv * gg[0] * silu_(bf_lo(gv.x)), o1 * inv * gg[1] * silu_(bf_hi(gv.x)));
        y.y = cvt_pk_bf16(o2 * inv * gg[2] * silu_(bf_lo(gv.y)), o3 * inv * gg[3] * silu_(bf_hi(gv.y)));
        *(u32x2*)gp = y;
    }
}
__device__ __forceinline__ void phase_hg_post(const Args& a) {
    int tid_ = threadIdx.x; asm volatile("" : "+v"(tid_));
    const int tid = tid_, lane = tid & 63, wave = tid >> 6;
    const int gw = blockIdx.x * 8 + wave, NGW = gridDim.x * 8;
    bf16_t* Z = (bf16_t*)(a.ws + Z_OFF); const bf16_t* OB = (const bf16_t*)(a.ws + HN_OFF); const float* gn = a.in[24];
    for (int it = gw; it < RVALID * 4; it += NGW) {
        const int row = it >> 2, h = it & 3;
        const unsigned ov = *(const unsigned*)(OB + (size_t)row * 512 + h * 128 + 2 * lane);
        bf16_t* gp = Z + (size_t)row * IN_CD + 2048 + h * 128 + 2 * lane;
        const unsigned gv = *(const unsigned*)gp;
        const f32x2 gg = *(const f32x2*)(gn + h * 128 + 2 * lane);
        const float o0 = bf_lo(ov), o1 = bf_hi(ov);
        const float inv = rsqrtf(wave_sum(o0 * o0 + o1 * o1) * (1.f / 128.f) + EPS);
        *(unsigned*)gp = cvt_pk_bf16(o0 * inv * gg[0] * silu_(bf_lo(gv)), o1 * inv * gg[1] * silu_(bf_hi(gv)));
    }
}


#ifndef DBG_STOP
#define DBG_STOP 0
#endif
__device__ __forceinline__ void dbg_digest(const Args& a) {
    const size_t gt = (size_t)blockIdx.x * NTHREADS + threadIdx.x, NGT = (size_t)gridDim.x * NTHREADS;
    const bf16_t* zb = (const bf16_t*)(a.ws + Z_OFF);
    const size_t NE = ((size_t)R * 5120 + (size_t)R * 1024);
    const size_t ON = (size_t)RM * DM;
    for (size_t i = gt; i < ON; i += NGT) {
        float s = 0.f;
        for (size_t k = i; k < NE; k += ON) s += __uint_as_float((unsigned)zb[k] << 16);
        a.out[i] = a.out[i] * 1e-3f + s;
    }
}
#define DBG_CHECK(k) do { if (DBG_STOP == (k)) { grid.sync(); dbg_digest(a); return; } } while (0)
__global__ void __launch_bounds__(NTHREADS, 2) fwd_megakernel(Args a) {
    extern __shared__ __attribute__((aligned(16))) unsigned char lds_raw[];
    LAS unsigned char* L = (LAS unsigned char*)lds_raw;
    cg::grid_group grid = cg::this_grid();
    unsigned char* ws = a.ws;
    const int G = gridDim.x, bx = blockIdx.x;
    bf16_t* Zb = (bf16_t*)(ws + Z_OFF); bf16_t* HNb = (bf16_t*)(ws + HN_OFF); float* ssq = (float*)(ws + SSQ_OFF);
    const float* ng = a.in[26];

    phase_prologue(a, L);
    grid.sync();
    DBG_CHECK(1);

    {
        pg8::Gemm g{HNb, (const bf16_t*)(ws + W_INAB), R, IN_AB, DM, DM}; pg8::StaticOrder S; S.init(R, IN_AB, G, bx);
        pg8::Epi<0> E{Zb, IN_AB, nullptr, nullptr, 0, nullptr};
        pg8::gemm_phase(L, g, S, E);
    }
    grid.sync();
    DBG_CHECK(2);
    for (int u = bx; u < 128 + 64; u += G) { if (u < 128) retention_unit(a, L, u); else if (DBG_STOP != 3) lru_unit(a, L, u - 128); }
    grid.sync();
    DBG_CHECK(3);
    phase_ret_post(a);
    grid.sync();
    DBG_CHECK(4);
    {
        pg8::Gemm g{Zb + 3072, (const bf16_t*)(ws + W_OUTAB), R, DM, 2048, IN_AB}; pg8::StaticOrder S; S.init(R, DM, G, bx);
        pg8::Epi<1> E{HNb, DM, ssq, nullptr, 0, nullptr};
        pg8::gemm_phase(L, g, S, E);
    }
    grid.sync();
    DBG_CHECK(5);
    phase_resnorm(a, ng + 1 * DM, ng + 2 * DM);
    grid.sync();
    DBG_CHECK(6);
    {
        pg8::Gemm g{HNb, (const bf16_t*)(ws + W_W1_0), R, FF, DM, DM}; pg8::StaticOrder S; S.init(R, FF, G, bx);
        pg8::Epi<2> E{Zb, FF, nullptr, nullptr, 0, nullptr};
        pg8::gemm_phase(L, g, S, E);
    }
    grid.sync();
    DBG_CHECK(7);
    {
        pg8::Gemm g{Zb, (const bf16_t*)(ws + W_W2_0), R, DM, FF, FF}; pg8::StaticOrder S; S.init(R, DM, G, bx);
        pg8::Epi<1> E{HNb, DM, ssq, nullptr, 0, nullptr};
        pg8::gemm_phase(L, g, S, E);
    }
    grid.sync();
    DBG_CHECK(8);
    phase_resnorm(a, ng + 3 * DM, ng + 4 * DM);
    grid.sync();
    DBG_CHECK(9);

    {
        pg8::Gemm g{HNb, (const bf16_t*)(ws + W_INCD), R, IN_CD, DM, DM}; pg8::StaticOrder S; S.init(R, IN_CD, G, bx);
        pg8::Epi<0> E{Zb, IN_CD, nullptr, nullptr, 0, nullptr};
        pg8::gemm_phase(L, g, S, E);
    }
    grid.sync();
    DBG_CHECK(10);
    for (int u = bx; u < 64 + 128; u += G) { if (u < 64) hgrn_unit(a, L, u); else s5_unit(a, L, u - 64); }
    grid.sync();
    DBG_CHECK(11);
    phase_hg_post(a);
    {
        pg8::Gemm g{Zb, (const bf16_t*)(ws + W_GLU), R, 512, 512, IN_CD}; pg8::StaticOrder S; S.init(R, 512, G, bx);
        pg8::Epi<3> E{Zb + 1536, IN_CD, nullptr, Zb, IN_CD, a.in[23]};
        pg8::gemm_phase(L, g, S, E);
    }
    grid.sync();
    DBG_CHECK(12);
    {
        pg8::Gemm g{Zb + 1536, (const bf16_t*)(ws + W_OUTCD), R, DM, DM, IN_CD}; pg8::StaticOrder S; S.init(R, DM, G, bx);
        pg8::Epi<1> E{HNb, DM, ssq, nullptr, 0, nullptr};
        pg8::gemm_phase(L, g, S, E);
    }
    grid.sync();
    DBG_CHECK(13);
    phase_resnorm(a, ng + 5 * DM, ng + 6 * DM);
    grid.sync();
    DBG_CHECK(14);
    {
        pg8::Gemm g{HNb, (const bf16_t*)(ws + W_W1_1), R, FF, DM, DM}; pg8::StaticOrder S; S.init(R, FF, G, bx);
        pg8::Epi<2> E{Zb, FF, nullptr, nullptr, 0, nullptr};
        pg8::gemm_phase(L, g, S, E);
    }
    grid.sync();
    DBG_CHECK(15);
    {
        pg8::Gemm g{Zb, (const bf16_t*)(ws + W_W2_1), R, DM, FF, FF}; pg8::StaticOrder S; S.init(R, DM, G, bx);
        pg8::Epi<1> E{HNb, DM, ssq, nullptr, 0, nullptr};
        pg8::gemm_phase(L, g, S, E);
    }
    grid.sync();
    DBG_CHECK(16);
    phase_resnorm(a, ng + 7 * DM, nullptr);
}

extern "C" void kernel_launch(void* const* d_in, const int* in_sizes, int n_in, void* d_out, int out_size, void* d_ws, size_t ws_size, hipStream_t stream) {
    static int grid = 0;
    if (!grid) {
        int dev = 0, cus = 0, per_cu = 0;
        (void)hipGetDevice(&dev);
        (void)hipDeviceGetAttribute(&cus, hipDeviceAttributeMultiprocessorCount, dev);
        (void)hipFuncSetAttribute((const void*)fwd_megakernel, hipFuncAttributeMaxDynamicSharedMemorySize, LDS_BYTES);
        (void)hipOccupancyMaxActiveBlocksPerMultiprocessor(&per_cu, (const void*)fwd_megakernel, NTHREADS, LDS_BYTES);
        if (per_cu < 1) per_cu = 1;
        grid = cus * per_cu;
        if (n_in != 29 || ws_size < WS_END) fprintf(stderr, "kernel_launch: unexpected n_in %d / ws %zu (need %zu)\n", n_in, ws_size, (size_t)WS_END);
    }
    Args a{};
    for (int i = 0; i < 29; ++i) a.in[i] = (const float*)d_in[i];
    a.out = (float*)d_out; a.ws = (unsigned char*)d_ws;
    void* args[] = {&a};
    hipError_t e = hipLaunchCooperativeKernel((void*)fwd_megakernel, dim3(grid), dim3(NTHREADS), args, LDS_BYTES, stream);
    if (e != hipSuccess) fprintf(stderr, "cooperative launch failed: %s (grid %d)\n", hipGetErrorString(e), grid);
}
```

```cpp
#include <hip/hip_runtime.h>
#include <hip/hip_cooperative_groups.h>
#include <cstdio>
#include <cstdint>
namespace cg = cooperative_groups;

#define LAS __attribute__((address_space(3)))
typedef unsigned short bf16_t;
typedef short bf16x8 __attribute__((ext_vector_type(8)));
typedef float f32x4 __attribute__((ext_vector_type(4)));
typedef float f32x2 __attribute__((ext_vector_type(2)));
typedef unsigned u32x4 __attribute__((ext_vector_type(4)));
typedef unsigned u32x2 __attribute__((ext_vector_type(2)));

constexpr int DM = 1024, NB = 4, SEQ = 4096, NMETA = 16, FF = 4096;
constexpr int RM = NB * SEQ;
constexpr int RMETA = RM;
constexpr int RVALID = RM + NMETA;
constexpr int R = RVALID;
constexpr int NCH = 65;
constexpr int IN_AB = 5120, IN_CD = 2560;
constexpr float EPS = 1e-6f;
constexpr int NTHREADS = 512;
constexpr int LDS_BYTES = 147456;

constexpr size_t W_INAB = 0;
constexpr size_t W_OUTAB = W_INAB + (size_t)5120 * 1024 * 2;
constexpr size_t W_W1_0 = W_OUTAB + (size_t)1024 * 2048 * 2;
constexpr size_t W_W2_0 = W_W1_0 + (size_t)4096 * 1024 * 2;
constexpr size_t W_INCD = W_W2_0 + (size_t)4096 * 1024 * 2;
constexpr size_t W_OUTCD = W_INCD + (size_t)2560 * 1024 * 2;
constexpr size_t W_GLU = W_OUTCD + (size_t)1024 * 1024 * 2;
constexpr size_t W_W1_1 = W_GLU + (size_t)512 * 512 * 2;
constexpr size_t W_W2_1 = W_W1_1 + (size_t)4096 * 1024 * 2;
constexpr size_t W_END = W_W2_1 + (size_t)4096 * 1024 * 2;
constexpr size_t Z_OFF = W_END;
constexpr size_t HN_OFF = Z_OFF + (size_t)R * 5120 * 2;
constexpr size_t SM_OFF = HN_OFF + (size_t)R * 1024 * 2;
constexpr size_t HMETA_OFF = SM_OFF;
constexpr size_t YAB_OFF = HMETA_OFF + (size_t)16 * 1024 * 4;
constexpr size_t YCD_OFF = YAB_OFF + (size_t)16 * 2048 * 2;
constexpr size_t YM_OFF = YCD_OFF + (size_t)16 * 1024 * 2;
constexpr size_t SSQ_OFF = YM_OFF + (size_t)16 * 512 * 2;
constexpr size_t LRUW_OFF = SSQ_OFF + (size_t)R * 16 * 4;
constexpr size_t S5BB_OFF = LRUW_OFF + (size_t)16 * 128 * 64 * 2;
constexpr size_t S5CM_OFF = S5BB_OFF + (size_t)32 * 128 * 32 * 2;
constexpr size_t S5AB_OFF = S5CM_OFF + (size_t)32 * 16 * 128 * 2;
constexpr size_t WS_END = S5AB_OFF + (size_t)32 * 64 * 2 * 4;
static_assert(WS_END <= (size_t)268435456, "workspace map");

struct Args {
    const float* in[29];
    float* out;
    unsigned char* ws;
};

typedef __bf16 bf16x2_t __attribute__((ext_vector_type(2)));
__device__ __forceinline__ unsigned cvt_pk_bf16(float lo, float hi) { f32x2 v = {lo, hi}; bf16x2_t b = __builtin_convertvector(v, bf16x2_t); return __builtin_bit_cast(unsigned, b); }
__device__ __forceinline__ float bf_lo(unsigned u) { return __uint_as_float(u << 16); }
__device__ __forceinline__ float bf_hi(unsigned u) { return __uint_as_float(u & 0xffff0000u); }
__device__ __forceinline__ bf16_t f2bf(float f) { return (bf16_t)(cvt_pk_bf16(f, 0.f) & 0xffffu); }
__device__ __forceinline__ float wave_sum(float v) {
#pragma unroll
    for (int o = 1; o < 64; o <<= 1) v += __shfl_xor(v, o);
    return v;
}
__device__ __forceinline__ float sigmoidf_(float x) { return 1.f / (1.f + __expf(-x)); }
__device__ __forceinline__ float gelu_tanh(float x) {
    const float u = 0.7978845608028654f * (x + 0.044715f * x * x * x);
    const float e = __expf(2.f * u);
    const float t = 1.f - 2.f / (e + 1.f);
    return 0.5f * x * (1.f + t);
}
__device__ __forceinline__ float silu_(float x) { return x * sigmoidf_(x); }
__device__ __forceinline__ void sincos_big(float ang, float& s, float& c) {
    double t = (double)ang * 0.15915494309189535;
    t -= rint(t);
    const float fr = (float)t;
    s = __builtin_amdgcn_sinf(fr); c = __builtin_amdgcn_cosf(fr);
}
__device__ __forceinline__ float* hrow(const Args& a, int row) {
    return row < RM ? a.out + (size_t)row * DM : (float*)(a.ws + HMETA_OFF) + (size_t)(row - RM) * DM;
}
__device__ __forceinline__ int chunk_row(int b, int n, int j) {
    if (n == 0) return j >= 48 ? RMETA + (j - 48) : -1;
    return b * SEQ + (n - 1) * 64 + j;
}

namespace pg8 {
constexpr int BM = 256, BK = 64, HALF = 128, HTB = HALF * BK * 2, NXCD = 8, WGM = 8;
__device__ __forceinline__ int lds_byte(int r, int c) { const int st = (r >> 4) * 2 + (c >> 5), rr = r & 15, cc = c & 31, ob = rr * 64 + cc * 2; return st * 1024 + (ob ^ (((ob >> 9) & 1) << 5)); }
__device__ __forceinline__ void stage_rc(int b, int& Rr, int& C) { const int st = b / 1024, sb = b % 1024, swz = sb ^ (((sb >> 9) & 1) << 5); Rr = (st >> 1) * 16 + swz / 64; C = (st & 1) * 32 + (swz % 64) / 2; }
__device__ __forceinline__ int perm32(int rho) { const int n = rho >> 4, i = rho & 15; return 8 * (i >> 2) + 4 * n + (i & 3); }
struct Unit { int pm, pn; };
struct Gemm { const bf16_t* A; const bf16_t* Bt; int M, N, K, lda; };
struct StaticOrder {
    int nM, nN, nwg, G, c;
    __device__ void init(int M, int N, int G_, int c_) { nM = M / BM; nN = N / BM; nwg = nM * nN; G = G_; c = c_; }
    __device__ bool next(int i, Unit& u) const {
        const long L = (long)i * G + c; if (L >= nwg) return false;
        int wgid = (int)L; { const int q = nwg / NXCD, r = nwg % NXCD, xcd = wgid % NXCD, off = wgid / NXCD; wgid = (xcd < r ? xcd * (q + 1) : r * (q + 1) + (xcd - r) * q) + off; }
        const int nig = WGM * nN, gid = wgid / nig, fm = gid * WGM, gsz = (nM - fm) < WGM ? (nM - fm) : WGM;
        u.pm = fm + ((wgid % nig) % gsz); u.pn = (wgid % nig) / gsz; return true;
    }
};
template <class Epi>
__device__ __forceinline__ void gemm_phase(LAS unsigned char* lds, const Gemm g, const StaticOrder& S, const Epi& E) {
    int tid_ = threadIdx.x; asm volatile("" : "+v"(tid_));
    const int tid = tid_, wid = __builtin_amdgcn_readfirstlane(tid >> 6), lane = tid & 63, wr = wid >> 2, wc = wid & 3, fr = lane & 15, fq = lane >> 4;
    const int K = g.K, nt = K / BK, lda = g.lda;
    unsigned voffA[2], voffB[2];
#pragma unroll
    for (int i = 0; i < 2; ++i) { int Rr, C; stage_rc(tid * 16 + i * 8192, Rr, C); const int Rb = (Rr & ~31) + perm32(Rr & 31);
        voffA[i] = (unsigned)(Rr * lda + C) * 2u; voffB[i] = (unsigned)(Rb * K + C) * 2u; }
    const size_t kstep = (size_t)(BK * 2);
    const size_t hstepA = (size_t)HALF * lda * 2, hstepB = (size_t)HALF * K * 2;
    const size_t tstepA = 2 * hstepA, tstepB = 2 * hstepB;
    const unsigned ldsw = (unsigned)wid * 1024u;
    const int aoff = lds_byte(wr * 64 + fr, fq * 8), boff = lds_byte(wc * 32 + fr, fq * 8);
#define PG8_SA(b, h) (((b) * 2 + (h)) * HTB)
#define PG8_SB(b, h) ((4 + (b) * 2 + (h)) * HTB)
#define PG8_STAGE(bufoff, gbase, voff) do { _Pragma("unroll") for (int _i = 0; _i < 2; ++_i) \
        __builtin_amdgcn_global_load_lds((const unsigned*)((const char*)(gbase) + (voff)[_i]), (LAS unsigned*)(lds + (bufoff) + ldsw + _i * 8192), 16, 0, 0); } while (0)
#define PG8_LDA(dst, b, h) do { _Pragma("unroll") for (int m = 0; m < 4; ++m) _Pragma("unroll") for (int k = 0; k < 2; ++k) dst[m][k] = *(const LAS bf16x8*)(lds + PG8_SA(b, h) + aoff + m * 2048 + k * 1024); } while (0)
#define PG8_LDB(dst, b, h) do { _Pragma("unroll") for (int n = 0; n < 2; ++n) _Pragma("unroll") for (int k = 0; k < 2; ++k) dst[n][k] = *(const LAS bf16x8*)(lds + PG8_SB(b, h) + boff + n * 2048 + k * 1024); } while (0)
#define PG8_MMA(ai, bj, At, Bt) do { __builtin_amdgcn_s_setprio(1); _Pragma("unroll") for (int m = 0; m < 4; ++m) _Pragma("unroll") for (int n = 0; n < 2; ++n) _Pragma("unroll") for (int k = 0; k < 2; ++k) \
        acc[ai][bj][m][n] = __builtin_amdgcn_mfma_f32_16x16x32_bf16(Bt[n][k], At[m][k], acc[ai][bj][m][n], 0, 0, 0); __builtin_amdgcn_s_setprio(0); } while (0)
#define PG8_WAIT_V(n) asm volatile("s_waitcnt vmcnt(" #n ")" ::: "memory")
#define PG8_WAIT_L(n) asm volatile("s_waitcnt lgkmcnt(" #n ")" ::: "memory")
#define PG8_BAR __builtin_amdgcn_s_barrier()
#define PG8_SCHED __builtin_amdgcn_sched_barrier(0)
    Unit cur, nxt; int ui = 0;
    if (!S.next(0, cur)) return;
    f32x4 acc[2][2][4][2];
#pragma unroll
    for (int a = 0; a < 2; ++a)
#pragma unroll
        for (int b = 0; b < 2; ++b)
#pragma unroll
            for (int m = 0; m < 4; ++m)
#pragma unroll
                for (int n = 0; n < 2; ++n) acc[a][b][m][n] = (f32x4){0.f, 0.f, 0.f, 0.f};
    bf16x8 At[4][2], B0[2][2], B1[2][2];
    const char* cA = (const char*)g.A + (size_t)cur.pm * tstepA; const char* cB = (const char*)g.Bt + (size_t)cur.pn * tstepB;
    PG8_STAGE(PG8_SB(0, 0), cB, voffB); PG8_STAGE(PG8_SB(0, 1), cB + hstepB, voffB); PG8_STAGE(PG8_SA(0, 0), cA, voffA); PG8_STAGE(PG8_SA(0, 1), cA + hstepA, voffA);
    if (wr == 1) PG8_BAR;
    PG8_WAIT_V(2); PG8_BAR;
    PG8_STAGE(PG8_SB(1, 0), cB + kstep, voffB); PG8_STAGE(PG8_SA(1, 0), cA + kstep, voffA); PG8_STAGE(PG8_SB(1, 1), cB + hstepB + kstep, voffB);
    PG8_WAIT_V(6); PG8_BAR;
    for (;;) {
        const bool has_next = S.next(ui + 1, nxt);
        const char* nA = has_next ? (const char*)g.A + (size_t)nxt.pm * tstepA : cA; const char* nB = has_next ? (const char*)g.Bt + (size_t)nxt.pn * tstepB : cB;
        for (int t = 0; t < nt; t += 2) {
            const bool last = (t == nt - 2);
            const char* a1 = cA + (size_t)(t + 1) * kstep;
            const char* a2 = last ? nA : cA + (size_t)(t + 2) * kstep; const char* b2 = last ? nB : cB + (size_t)(t + 2) * kstep;
            const char* a3 = a2 + kstep; const char* b3 = b2 + kstep;
            PG8_LDB(B0, 0, 0); PG8_LDB(B1, 0, 1); PG8_SCHED; PG8_LDA(At, 0, 0); PG8_STAGE(PG8_SA(1, 1), a1 + hstepA, voffA);
            PG8_WAIT_V(8); PG8_WAIT_L(0); PG8_BAR; PG8_MMA(0, 0, At, B0); PG8_MMA(0, 1, At, B1); PG8_BAR; PG8_SCHED;
            PG8_LDA(At, 0, 1); PG8_STAGE(PG8_SB(0, 0), b2, voffB); PG8_STAGE(PG8_SB(0, 1), b2 + hstepB, voffB); PG8_STAGE(PG8_SA(0, 0), a2, voffA);
            PG8_WAIT_V(8); PG8_WAIT_L(0); PG8_BAR; PG8_MMA(1, 0, At, B0); PG8_MMA(1, 1, At, B1); PG8_BAR; PG8_SCHED;
            PG8_LDB(B0, 1, 0); PG8_LDB(B1, 1, 1); PG8_SCHED; PG8_LDA(At, 1, 0); PG8_STAGE(PG8_SA(0, 1), a2 + hstepA, voffA);
            PG8_WAIT_V(8); PG8_WAIT_L(0); PG8_BAR; PG8_MMA(0, 0, At, B0); PG8_MMA(0, 1, At, B1); PG8_BAR; PG8_SCHED;
            PG8_LDA(At, 1, 1); PG8_STAGE(PG8_SB(1, 0), b3, voffB); PG8_STAGE(PG8_SB(1, 1), b3 + hstepB, voffB); PG8_STAGE(PG8_SA(1, 0), a3, voffA);
            PG8_WAIT_V(8); PG8_WAIT_L(0); PG8_BAR; PG8_MMA(1, 0, At, B0); PG8_MMA(1, 1, At, B1); PG8_BAR; PG8_SCHED;
        }
        if (wr == 0) PG8_BAR;
        E(acc, cur, wr, wc, fr, fq);
        if (!has_next) break;
#pragma unroll
        for (int a = 0; a < 2; ++a)
#pragma unroll
            for (int b = 0; b < 2; ++b)
#pragma unroll
                for (int m = 0; m < 4; ++m)
#pragma unroll
                    for (int n = 0; n < 2; ++n) acc[a][b][m][n] = (f32x4){0.f, 0.f, 0.f, 0.f};
        cur = nxt; cA = nA; cB = nB; ++ui;
        if (wr == 1) PG8_BAR;
    }
    PG8_WAIT_V(0);
    PG8_BAR;
#undef PG8_SA
#undef PG8_SB
#undef PG8_STAGE
#undef PG8_LDA
#undef PG8_LDB
#undef PG8_MMA
#undef PG8_WAIT_V
#undef PG8_WAIT_L
#undef PG8_BAR
#undef PG8_SCHED
}

template <int MODE> struct Epi {
    bf16_t* O; int ldo;
    float* ssq;
    const bf16_t* Y; int ldy;
    const float* bias;
    __device__ __forceinline__ void operator()(const f32x4 (&acc)[2][2][4][2], const Unit& u, int wr, int wc, int fr, int fq) const {
#pragma unroll
        for (int ai = 0; ai < 2; ++ai)
#pragma unroll
            for (int m = 0; m < 4; ++m) {
                const int row = u.pm * BM + ai * HALF + wr * 64 + m * 16 + fr;
                float ss = 0.f;
#pragma unroll
                for (int bj = 0; bj < 2; ++bj) {
                    const int col0 = u.pn * BM + bj * HALF + wc * 32 + 8 * fq;
                    f32x4 v0 = acc[ai][bj][m][0], v1 = acc[ai][bj][m][1];
                    if (MODE == 1) { ss += v0[0] * v0[0] + v0[1] * v0[1] + v0[2] * v0[2] + v0[3] * v0[3] + v1[0] * v1[0] + v1[1] * v1[1] + v1[2] * v1[2] + v1[3] * v1[3]; }
                    if (MODE == 2) {
#pragma unroll
                        for (int j = 0; j < 4; ++j) { float a = fmaxf(v0[j], 0.f); v0[j] = a * a; float b = fmaxf(v1[j], 0.f); v1[j] = b * b; }
                    }
                    if (MODE == 3) {
                        const u32x4 yv = *(const u32x4*)(Y + (size_t)row * ldy + col0);
                        const f32x4 b0 = *(const f32x4*)(bias + col0), b1 = *(const f32x4*)(bias + col0 + 4);
                        v0[0] = bf_lo(yv.x) * sigmoidf_(v0[0] + b0[0]); v0[1] = bf_hi(yv.x) * sigmoidf_(v0[1] + b0[1]);
                        v0[2] = bf_lo(yv.y) * sigmoidf_(v0[2] + b0[2]); v0[3] = bf_hi(yv.y) * sigmoidf_(v0[3] + b0[3]);
                        v1[0] = bf_lo(yv.z) * sigmoidf_(v1[0] + b1[0]); v1[1] = bf_hi(yv.z) * sigmoidf_(v1[1] + b1[1]);
                        v1[2] = bf_lo(yv.w) * sigmoidf_(v1[2] + b1[2]); v1[3] = bf_hi(yv.w) * sigmoidf_(v1[3] + b1[3]);
                    }
                    u32x4 w; w.x = cvt_pk_bf16(v0[0], v0[1]); w.y = cvt_pk_bf16(v0[2], v0[3]); w.z = cvt_pk_bf16(v1[0], v1[1]); w.w = cvt_pk_bf16(v1[2], v1[3]);
                    *(u32x4*)(O + (size_t)row * ldo + col0) = w;
                }
                if (MODE == 1) {
                    ss += __shfl_xor(ss, 16); ss += __shfl_xor(ss, 32);
                    if (fq == 0) ssq[(size_t)row * 16 + u.pn * 4 + wc] = ss;
                }
            }
    }
};
}

__device__ __forceinline__ bf16x8 ldsfrag(const LAS unsigned char* p) { return *(const LAS bf16x8*)p; }
#define MFMA16(X, Y, ACC) __builtin_amdgcn_mfma_f32_16x16x32_bf16((X), (Y), (ACC), 0, 0, 0)


template <int MODE>
__device__ __forceinline__ void meta_gemm(LAS unsigned char* L, const bf16_t* A, int lda, const bf16_t* Bt, int N, int K,
                                          bf16_t* O, int ldo, float* ssq, const bf16_t* Y, int ldy, const float* bias) {
    int tid_ = threadIdx.x; asm volatile("" : "+v"(tid_));
    const int tid = tid_, lane = tid & 63, w = __builtin_amdgcn_readfirstlane(tid >> 6), fr = lane & 15, fq = lane >> 4;
    const int t = (int)gridDim.x - 1 - (int)blockIdx.x;
    if (t >= N / 64) return;
    const int n0 = t * 64, kw = K / 8, k0 = w * kw;
    f32x4 acc[4];
#pragma unroll
    for (int nt = 0; nt < 4; ++nt) acc[nt] = (f32x4){0.f, 0.f, 0.f, 0.f};
    const bf16_t* ap = A + (size_t)fr * lda + k0 + fq * 8;
    const bf16_t* bp = Bt + (size_t)(n0 + fr) * K + k0 + fq * 8;
#pragma unroll 2
    for (int k = 0; k < kw; k += 32) {
        const bf16x8 af = *(const bf16x8*)(ap + k);
#pragma unroll
        for (int nt = 0; nt < 4; ++nt) { const bf16x8 bf = *(const bf16x8*)(bp + (size_t)nt * 16 * K + k); acc[nt] = MFMA16(bf, af, acc[nt]); }
    }
    LAS f32x4* P = (LAS f32x4*)L;
#pragma unroll
    for (int nt = 0; nt < 4; ++nt) P[(w * 4 + nt) * 64 + lane] = acc[nt];
    __syncthreads();
    if (w == 0) {
        float ss = 0.f;
#pragma unroll
        for (int nt = 0; nt < 4; ++nt) {
            f32x4 v = P[nt * 64 + lane];
#pragma unroll
            for (int ww = 1; ww < 8; ++ww) v += P[(ww * 4 + nt) * 64 + lane];
            const int col = n0 + nt * 16 + 4 * fq;
            if (MODE == 1) ss += v[0] * v[0] + v[1] * v[1] + v[2] * v[2] + v[3] * v[3];
            if (MODE == 2) {
#pragma unroll
                for (int j = 0; j < 4; ++j) { const float r = fmaxf(v[j], 0.f); v[j] = r * r; }
            }
            if (MODE == 3) {
                const u32x2 yv = *(const u32x2*)(Y + (size_t)fr * ldy + col);
                const f32x4 bb = *(const f32x4*)(bias + col);
                v[0] = bf_lo(yv.x) * sigmoidf_(v[0] + bb[0]); v[1] = bf_hi(yv.x) * sigmoidf_(v[1] + bb[1]);
                v[2] = bf_lo(yv.y) * sigmoidf_(v[2] + bb[2]); v[3] = bf_hi(yv.y) * sigmoidf_(v[3] + bb[3]);
            }
            u32x2 o; o.x = cvt_pk_bf16(v[0], v[1]); o.y = cvt_pk_bf16(v[2], v[3]);
            *(u32x2*)(O + (size_t)fr * ldo + col) = o;
        }
        if (MODE == 1) {
            ss += __shfl_xor(ss, 16); ss += __shfl_xor(ss, 32);
            if (fq == 0) ssq[fr * 16 + t] = ss;
        }
    }
    __syncthreads();
}

__device__ __forceinline__ void transpose_item(const float* W, int K, int N, bf16_t* WT, int dst_row0, LAS float* scr, int k0, int n0, int lane) {
#pragma unroll 8
    for (int i = 0; i < 32; ++i) { const int kk = 2 * i + (lane >> 5); scr[kk * 33 + (lane & 31)] = W[(size_t)(k0 + kk) * N + n0 + (lane & 31)]; }
    asm volatile("s_waitcnt lgkmcnt(0)" ::: "memory");
    const int c = lane & 7;
#pragma unroll
    for (int j = 0; j < 4; ++j) { const int n = (lane >> 3) + 8 * j; const LAS float* s = scr + (8 * c) * 33 + n;
        u32x4 o; o.x = cvt_pk_bf16(s[0 * 33], s[1 * 33]); o.y = cvt_pk_bf16(s[2 * 33], s[3 * 33]); o.z = cvt_pk_bf16(s[4 * 33], s[5 * 33]); o.w = cvt_pk_bf16(s[6 * 33], s[7 * 33]);
        *(u32x4*)(WT + (size_t)(dst_row0 + n) * K + k0 + 8 * c) = o; }
    asm volatile("s_waitcnt lgkmcnt(0)" ::: "memory");
}

__device__ __forceinline__ void phase_prologue(const Args& a, LAS unsigned char* lds) {
    int tid_ = threadIdx.x; asm volatile("" : "+v"(tid_));
    const int tid = tid_, lane = tid & 63, wave = tid >> 6;
    const int gw = blockIdx.x * 8 + wave, NGW = gridDim.x * 8;
    unsigned char* ws = a.ws;
    LAS float* scr = (LAS float*)(lds + wave * 16384);
    {
        constexpr int I0 = 16 * 160, I1 = 32 * 32, I2 = 16 * 128, I3 = 64 * 32, I4 = 16 * 80, I5 = 16 * 32, I6 = 8 * 16, I7 = I2, I8 = I3;
        constexpr int NIT = I0 + I1 + I2 + I3 + I4 + I5 + I6 + I7 + I8;
        for (int it = gw; it < NIT; it += NGW) {
            int r = it; const float* W; int K, N; bf16_t* WT; bool perm = false;
            if (r < I0) { W = a.in[2]; K = 1024; N = 5120; WT = (bf16_t*)(ws + W_INAB); perm = true; }
            else if ((r -= I0) < I1) { W = a.in[3]; K = 2048; N = 1024; WT = (bf16_t*)(ws + W_OUTAB); }
            else if ((r -= I1) < I2) { W = a.in[27]; K = 1024; N = 4096; WT = (bf16_t*)(ws + W_W1_0); }
            else if ((r -= I2) < I3) { W = a.in[28]; K = 4096; N = 1024; WT = (bf16_t*)(ws + W_W2_0); }
            else if ((r -= I3) < I4) { W = a.in[12]; K = 1024; N = 2560; WT = (bf16_t*)(ws + W_INCD); }
            else if ((r -= I4) < I5) { W = a.in[13]; K = 1024; N = 1024; WT = (bf16_t*)(ws + W_OUTCD); }
            else if ((r -= I5) < I6) { W = a.in[22]; K = 512; N = 512; WT = (bf16_t*)(ws + W_GLU); }
            else if ((r -= I6) < I7) { W = a.in[27] + (size_t)1024 * 4096; K = 1024; N = 4096; WT = (bf16_t*)(ws + W_W1_1); }
            else { r -= I7; W = a.in[28] + (size_t)1024 * 4096; K = 4096; N = 1024; WT = (bf16_t*)(ws + W_W2_1); }
            const int nblk = N / 32, kb = r / nblk, nb = r % nblk, n0 = nb * 32;
            int d0 = n0;
            if (perm) { if (n0 >= 2048 && n0 < 3072) d0 = n0 + 1024; else if (n0 >= 3072 && n0 < 4096) d0 = n0 - 1024; }
            transpose_item(W, K, N, WT, d0, scr, kb * 64, n0, lane);
        }
    }
    {
        const float* x = a.in[0]; const float* meta = a.in[1]; const float* g = a.in[26];
        bf16_t* HN = (bf16_t*)(ws + HN_OFF);
        for (int row = gw; row < R; row += NGW) {
            const float* src = row < RM ? x + (size_t)row * DM : meta + (size_t)(row - RM) * DM;
            float* hr = hrow(a, row);
            f32x4 v[4]; float s = 0.f;
#pragma unroll
            for (int j = 0; j < 4; ++j) { v[j] = *(const f32x4*)(src + 4 * lane + 256 * j); *(f32x4*)(hr + 4 * lane + 256 * j) = v[j];
                s += v[j][0] * v[j][0] + v[j][1] * v[j][1] + v[j][2] * v[j][2] + v[j][3] * v[j][3]; }
            const float inv = rsqrtf(wave_sum(s) * (1.f / DM) + EPS);
#pragma unroll
            for (int j = 0; j < 4; ++j) { const f32x4 gg = *(const f32x4*)(g + 4 * lane + 256 * j);
                u32x2 o; o.x = cvt_pk_bf16(v[j][0] * inv * gg[0], v[j][1] * inv * gg[1]); o.y = cvt_pk_bf16(v[j][2] * inv * gg[2], v[j][3] * inv * gg[3]);
                *(u32x2*)(HN + (size_t)row * DM + 4 * lane + 256 * j) = o; }
        }
    }
    const int gt = blockIdx.x * NTHREADS + tid, NGT = gridDim.x * NTHREADS;
    {
        bf16_t* WG = (bf16_t*)(ws + LRUW_OFF);
        for (int i = gt; i < 16 * 128 * 64; i += NGT) { const int k = i & 63, n = (i >> 6) & 127, blk = i >> 13;
            const float v = n < 64 ? a.in[5][(size_t)blk * 4096 + k * 64 + n] : a.in[7][(size_t)blk * 4096 + k * 64 + (n - 64)];
            WG[i] = f2bf(v); }
    }
    {
        bf16_t* BB = (bf16_t*)(ws + S5BB_OFF); bf16_t* CM = (bf16_t*)(ws + S5CM_OFF); float* AB = (float*)(ws + S5AB_OFF);
        const float* are_log = a.in[14]; const float* aim = a.in[15]; const float* bre = a.in[16]; const float* bim = a.in[17];
        const float* cre = a.in[18]; const float* cim = a.in[19]; const float* ldt = a.in[21];
        for (int i = gt; i < 32 * 64; i += NGT) {
            const int g = i >> 6, p = i & 63;
            const float dt = expf(ldt[g]); const float a_re = -expf(are_log[i]); const float a_im = aim[i];
            const float mag = expf(dt * a_re); float sn, cs; sincos_big(dt * a_im, sn, cs);
            const float ab_re = mag * cs, ab_im = mag * sn;
            AB[2 * i] = ab_re; AB[2 * i + 1] = ab_im;
            const float n_re = ab_re - 1.f, n_im = ab_im, den = a_re * a_re + a_im * a_im;
            const float z_re = (n_re * a_re + n_im * a_im) / den, z_im = (n_im * a_re - n_re * a_im) / den;
            for (int c = 0; c < 32; ++c) {
                float vr = 0.f, vi = 0.f;
                if (c < 16) { const float br = bre[(size_t)i * 16 + c], bi = bim[(size_t)i * 16 + c]; vr = z_re * br - z_im * bi; vi = z_re * bi + z_im * br; }
                BB[((size_t)g * 128 + p) * 32 + c] = f2bf(vr);
                BB[((size_t)g * 128 + 64 + p) * 32 + c] = f2bf(vi);
            }
            for (int c = 0; c < 16; ++c) {
                CM[((size_t)g * 16 + c) * 128 + p] = f2bf(cre[((size_t)g * 16 + c) * 64 + p]);
                CM[((size_t)g * 16 + c) * 128 + 64 + p] = f2bf(-cim[((size_t)g * 16 + c) * 64 + p]);
            }
        }
    }
}

__device__ __forceinline__ void phase_resnorm(const Args& a, const float* g1, const float* g2) {
    int tid_ = threadIdx.x; asm volatile("" : "+v"(tid_));
    const int tid = tid_, lane = tid & 63, wave = tid >> 6;
    const int gw = blockIdx.x * 8 + wave, NGW = gridDim.x * 8;
    bf16_t* HN = (bf16_t*)(a.ws + HN_OFF); const float* ssq = (const float*)(a.ws + SSQ_OFF);
    for (int row = gw; row < R; row += NGW) {
        bf16_t* mrow = HN + (size_t)row * DM;
        float s = 0.f;
        { const f32x4* sp = (const f32x4*)(ssq + (size_t)row * 16); const f32x4 s0 = sp[0], s1 = sp[1], s2 = sp[2], s3 = sp[3];
          s = ((s0[0] + s0[1]) + (s0[2] + s0[3])) + ((s1[0] + s1[1]) + (s1[2] + s1[3])) + ((s2[0] + s2[1]) + (s2[2] + s2[3])) + ((s3[0] + s3[1]) + (s3[2] + s3[3])); }
        const float inv = rsqrtf(s * (1.f / DM) + EPS);
        float* hr = hrow(a, row);
        f32x4 v[4]; float s2 = 0.f;
#pragma unroll
        for (int j = 0; j < 4; ++j) {
            const u32x2 mv = *(const u32x2*)(mrow + 4 * lane + 256 * j);
            const f32x4 gg = *(const f32x4*)(g1 + 4 * lane + 256 * j);
            v[j] = *(const f32x4*)(hr + 4 * lane + 256 * j);
            v[j][0] += bf_lo(mv.x) * inv * gg[0]; v[j][1] += bf_hi(mv.x) * inv * gg[1]; v[j][2] += bf_lo(mv.y) * inv * gg[2]; v[j][3] += bf_hi(mv.y) * inv * gg[3];
            *(f32x4*)(hr + 4 * lane + 256 * j) = v[j];
            s2 += v[j][0] * v[j][0] + v[j][1] * v[j][1] + v[j][2] * v[j][2] + v[j][3] * v[j][3];
        }
        if (g2) {
            const float inv2 = rsqrtf(wave_sum(s2) * (1.f / DM) + EPS);
#pragma unroll
            for (int j = 0; j < 4; ++j) { const f32x4 gg = *(const f32x4*)(g2 + 4 * lane + 256 * j);
                u32x2 o; o.x = cvt_pk_bf16(v[j][0] * inv2 * gg[0], v[j][1] * inv2 * gg[1]); o.y = cvt_pk_bf16(v[j][2] * inv2 * gg[2], v[j][3] * inv2 * gg[3]);
                *(u32x2*)(mrow + 4 * lane + 256 * j) = o; }
        }
    }
}

constexpr int LA_QS = 0, LA_KS = 17408, LA_QD = 34816, LA_KT = 52224, LA_VT = 70656, LA_PS = 75264, LA_ST = 84480, LA_CUM = 93184, LA_DEC = 125952, LA_END = 126464;
static_assert(LA_END <= LDS_BYTES, "LA lds");

template <bool HG>
__device__ __forceinline__ void la_core(LAS unsigned char* L, f32x4 (&st)[2], float l2g, bf16_t* obuf, int ldo, int ocol, int b, int n) {
    int tid_ = threadIdx.x; asm volatile("" : "+v"(tid_));
    const int tid = tid_, lane = tid & 63, w = __builtin_amdgcn_readfirstlane(tid >> 6), fr = lane & 15, fq = lane >> 4;
    const int mt = w >> 1, nh = w & 1;
    bf16x8 qf[4];
#pragma unroll
    for (int kk = 0; kk < 4; ++kk) qf[kk] = ldsfrag(L + LA_QS + (mt * 16 + fr) * 272 + kk * 64 + fq * 16);
    f32x4 s0 = {0.f, 0.f, 0.f, 0.f}, s1 = {0.f, 0.f, 0.f, 0.f};
#pragma unroll
    for (int kk = 0; kk < 4; ++kk) {
        const bf16x8 k0 = ldsfrag(L + LA_KS + ((nh * 2) * 16 + fr) * 272 + kk * 64 + fq * 16);
        const bf16x8 k1 = ldsfrag(L + LA_KS + ((nh * 2 + 1) * 16 + fr) * 272 + kk * 64 + fq * 16);
        s0 = MFMA16(k0, qf[kk], s0); s1 = MFMA16(k1, qf[kk], s1);
    }
    const int t = mt * 16 + fr;
    {
        float p0[4], p1[4];
#pragma unroll
        for (int jj = 0; jj < 4; ++jj) {
            const int sa = (nh * 2) * 16 + 4 * fq + jj, sb = sa + 16;
            if (HG) { p0[jj] = sa <= t ? s0[jj] : 0.f; p1[jj] = sb <= t ? s1[jj] : 0.f; }
            else { p0[jj] = s0[jj] * exp2f(l2g * fabsf((float)(t - sa))); p1[jj] = s1[jj] * exp2f(l2g * fabsf((float)(t - sb))); }
        }
        u32x2 o0, o1; o0.x = cvt_pk_bf16(p0[0], p0[1]); o0.y = cvt_pk_bf16(p0[2], p0[3]); o1.x = cvt_pk_bf16(p1[0], p1[1]); o1.y = cvt_pk_bf16(p1[2], p1[3]);
        *(LAS u32x2*)(L + LA_PS + t * 144 + ((nh * 2) * 16 + 4 * fq) * 2) = o0;
        *(LAS u32x2*)(L + LA_PS + t * 144 + ((nh * 2 + 1) * 16 + 4 * fq) * 2) = o1;
    }
    f32x4 o = {0.f, 0.f, 0.f, 0.f};
#pragma unroll
    for (int kk = 0; kk < 4; ++kk) {
        const bf16x8 sf = ldsfrag(L + LA_ST + (nh * 16 + fr) * 272 + kk * 64 + fq * 16);
        const bf16x8 qq = HG ? ldsfrag(L + LA_QD + (mt * 16 + fr) * 272 + kk * 64 + fq * 16) : qf[kk];
        o = MFMA16(sf, qq, o);
    }
    if (!HG) { const float sc = exp2f(l2g * (float)(t + 1)); o[0] *= sc; o[1] *= sc; o[2] *= sc; o[3] *= sc; }
    __syncthreads();
#pragma unroll
    for (int kk = 0; kk < 2; ++kk) {
        const bf16x8 vf = ldsfrag(L + LA_VT + (nh * 16 + fr) * 144 + kk * 64 + fq * 16);
        const bf16x8 pf = ldsfrag(L + LA_PS + (mt * 16 + fr) * 144 + kk * 64 + fq * 16);
        o = MFMA16(vf, pf, o);
    }
    {
        const int row = chunk_row(b, n, t);
        if (row >= 0 && (row < RM || b == 0)) { u32x2 ov; ov.x = cvt_pk_bf16(o[0], o[1]); ov.y = cvt_pk_bf16(o[2], o[3]);
            *(u32x2*)(obuf + (size_t)row * ldo + ocol + nh * 16 + 4 * fq) = ov; }
    }
    float dc[4];
    if (HG) { const f32x4 dv = *(const LAS f32x4*)(L + LA_DEC + (w * 16 + 4 * fq) * 4); dc[0] = dv[0]; dc[1] = dv[1]; dc[2] = dv[2]; dc[3] = dv[3]; }
    else { const float g64 = exp2f(l2g * 64.f); dc[0] = dc[1] = dc[2] = dc[3] = g64; }
    const bf16x8 kt0 = ldsfrag(L + LA_KT + (w * 16 + fr) * 144 + fq * 16), kt1 = ldsfrag(L + LA_KT + (w * 16 + fr) * 144 + 64 + fq * 16);
#pragma unroll
    for (int et = 0; et < 2; ++et) {
#pragma unroll
        for (int jj = 0; jj < 4; ++jj) st[et][jj] *= dc[jj];
        const bf16x8 v0 = ldsfrag(L + LA_VT + (et * 16 + fr) * 144 + fq * 16), v1 = ldsfrag(L + LA_VT + (et * 16 + fr) * 144 + 64 + fq * 16);
        st[et] = MFMA16(kt0, v0, st[et]); st[et] = MFMA16(kt1, v1, st[et]);
        u32x2 sv; sv.x = cvt_pk_bf16(st[et][0], st[et][1]); sv.y = cvt_pk_bf16(st[et][2], st[et][3]);
        *(LAS u32x2*)(L + LA_ST + (et * 16 + fr) * 272 + (w * 16 + 4 * fq) * 2) = sv;
    }
}

#define UNPK8(dst, v) do { dst[0] = bf_lo((v).x); dst[1] = bf_hi((v).x); dst[2] = bf_lo((v).y); dst[3] = bf_hi((v).y); dst[4] = bf_lo((v).z); dst[5] = bf_hi((v).z); dst[6] = bf_lo((v).w); dst[7] = bf_hi((v).w); } while (0)
#define PK8(v, src) do { (v).x = cvt_pk_bf16(src[0], src[1]); (v).y = cvt_pk_bf16(src[2], src[3]); (v).z = cvt_pk_bf16(src[4], src[5]); (v).w = cvt_pk_bf16(src[6], src[7]); } while (0)

__device__ __forceinline__ void retention_unit(const Args& a, LAS unsigned char* L, int unit) {
    int tid_ = threadIdx.x; asm volatile("" : "+v"(tid_));
    const int tid = tid_, b = unit >> 5, h = (unit >> 3) & 3, sl = unit & 7;
    const bf16_t* Z = (const bf16_t*)(a.ws + Z_OFF); bf16_t* OB = (bf16_t*)(a.ws + HN_OFF);
    const float l2g = log2f(1.f - exp2f(-5.f - (float)h));
    const int row_l = tid >> 3, c8 = tid & 7;
    const int vrow = (tid >> 2) & 63, vp = tid & 3;
    float invf[8];
#pragma unroll
    for (int i = 0; i < 8; ++i) invf[i] = exp2f(-(float)(c8 * 8 + i) * (13.287712379549449f / 64.f));
    f32x4 st[2] = {{0.f, 0.f, 0.f, 0.f}, {0.f, 0.f, 0.f, 0.f}};
    for (int i = tid; i < 32 * 272 / 4; i += NTHREADS) ((LAS unsigned*)(L + LA_ST))[i] = 0u;
    u32x4 q1, q2, k1, k2, vv;
#define RET_LOAD(n_) do { const int r_ = chunk_row(b, (n_), row_l); \
        if (r_ >= 0) { const bf16_t* zr = Z + (size_t)r_ * IN_AB; \
            q1 = *(const u32x4*)(zr + h * 128 + c8 * 8); q2 = *(const u32x4*)(zr + h * 128 + 64 + c8 * 8); \
            k1 = *(const u32x4*)(zr + 512 + h * 128 + c8 * 8); k2 = *(const u32x4*)(zr + 512 + h * 128 + 64 + c8 * 8); \
        } else { q1 = q2 = k1 = k2 = (u32x4){0u, 0u, 0u, 0u}; } \
        vv = (u32x4){0u, 0u, 0u, 0u}; \
        if (tid < 256) { const int rv = chunk_row(b, (n_), vrow); if (rv >= 0) vv = *(const u32x4*)(Z + (size_t)rv * IN_AB + 1024 + h * 256 + sl * 32 + vp * 8); } } while (0)
    RET_LOAD(0);
    for (int n = 0; n < NCH; ++n) {
        {
            const float pos = (float)(n == 0 ? row_l - 48 : 16 + (n - 1) * 64 + row_l);
            const float kdec = exp2f(l2g * (float)(63 - row_l));
            float x1[8], x2[8], y1[8], y2[8], qo1[8], qo2[8], ko1[8], ko2[8];
            UNPK8(x1, q1); UNPK8(x2, q2); UNPK8(y1, k1); UNPK8(y2, k2);
#pragma unroll
            for (int i = 0; i < 8; ++i) {
                float sn, cs; sincos_big(pos * invf[i], sn, cs);
                qo1[i] = (x1[i] * cs - x2[i] * sn) * 0.08838834764831845f; qo2[i] = (x1[i] * sn + x2[i] * cs) * 0.08838834764831845f;
                ko1[i] = y1[i] * cs - y2[i] * sn; ko2[i] = y1[i] * sn + y2[i] * cs;
            }
            u32x4 w1, w2;
            PK8(w1, qo1); PK8(w2, qo2);
            *(LAS u32x4*)(L + LA_QS + row_l * 272 + c8 * 16) = w1; *(LAS u32x4*)(L + LA_QS + row_l * 272 + 128 + c8 * 16) = w2;
            PK8(w1, ko1); PK8(w2, ko2);
            *(LAS u32x4*)(L + LA_KS + row_l * 272 + c8 * 16) = w1; *(LAS u32x4*)(L + LA_KS + row_l * 272 + 128 + c8 * 16) = w2;
#pragma unroll
            for (int i = 0; i < 8; ++i) {
                *(LAS bf16_t*)(L + LA_KT + (c8 * 8 + i) * 144 + row_l * 2) = f2bf(ko1[i] * kdec);
                *(LAS bf16_t*)(L + LA_KT + (64 + c8 * 8 + i) * 144 + row_l * 2) = f2bf(ko2[i] * kdec);
            }
            if (tid < 256) {
                const unsigned va[4] = {vv.x, vv.y, vv.z, vv.w};
#pragma unroll
                for (int i = 0; i < 8; ++i) *(LAS bf16_t*)(L + LA_VT + (vp * 8 + i) * 144 + vrow * 2) = (bf16_t)((i & 1) ? (va[i >> 1] >> 16) : (va[i >> 1] & 0xffffu));
            }
        }
        if (n + 1 < NCH) RET_LOAD(n + 1);
        __syncthreads();
        la_core<false>(L, st, l2g, OB, DM, h * 256 + sl * 32, b, n);
        __syncthreads();
    }
#undef RET_LOAD
}

__device__ __forceinline__ void hgrn_unit(const Args& a, LAS unsigned char* L, int unit) {
    int tid_ = threadIdx.x; asm volatile("" : "+v"(tid_));
    const int tid = tid_, b = unit >> 4, h = (unit >> 2) & 3, sl = unit & 3;
    bf16_t* Z = (bf16_t*)(a.ws + Z_OFF); bf16_t* OB = (bf16_t*)(a.ws + HN_OFF);
    const int row_l = tid >> 3, c8 = tid & 7;
    const int vrow = (tid >> 2) & 63, vp = tid & 3;
    const float* lg = a.in[25];
    float lb1[8], lb2[8];
#pragma unroll
    for (int i = 0; i < 8; ++i) { const int d = h * 128 + c8 * 8 + i; lb1[i] = sigmoidf_(lg[d] - lg[512 + d]); lb2[i] = sigmoidf_(lg[d + 64] - lg[512 + d + 64]); }
    f32x4 st[2] = {{0.f, 0.f, 0.f, 0.f}, {0.f, 0.f, 0.f, 0.f}};
    for (int i = tid; i < 32 * 272 / 4; i += NTHREADS) ((LAS unsigned*)(L + LA_ST))[i] = 0u;
    u32x4 q1, q2, f1, f2, vv;
#define HG_LOAD(n_) do { const int r_ = chunk_row(b, (n_), row_l); \
        if (r_ >= 0) { const bf16_t* zr = Z + (size_t)r_ * IN_CD; \
            q1 = *(const u32x4*)(zr + 512 + h * 128 + c8 * 8); q2 = *(const u32x4*)(zr + 512 + h * 128 + 64 + c8 * 8); \
            f1 = *(const u32x4*)(zr + 1024 + h * 128 + c8 * 8); f2 = *(const u32x4*)(zr + 1024 + h * 128 + 64 + c8 * 8); \
        } else { q1 = q2 = f1 = f2 = (u32x4){0u, 0u, 0u, 0u}; } \
        vv = (u32x4){0u, 0u, 0u, 0u}; \
        if (tid < 256) { const int rv = chunk_row(b, (n_), vrow); if (rv >= 0) vv = *(const u32x4*)(Z + (size_t)rv * IN_CD + 1536 + h * 128 + sl * 32 + vp * 8); } } while (0)
    HG_LOAD(0);
    for (int n = 0; n < NCH; ++n) {
        const bool valid = chunk_row(b, n, row_l) >= 0;
        float qv1[8], qv2[8], kv1[8], kv2[8];
        {
            float fp1[8], fp2[8], lf1[8], lf2[8];
            UNPK8(qv1, q1); UNPK8(qv2, q2); UNPK8(fp1, f1); UNPK8(fp2, f2);
#pragma unroll
            for (int i = 0; i < 8; ++i) {
                const float ff1 = lb1[i] + (1.f - lb1[i]) * sigmoidf_(fp1[i]), ff2 = lb2[i] + (1.f - lb2[i]) * sigmoidf_(fp2[i]);
                if (valid) { lf1[i] = __logf(ff1); lf2[i] = __logf(ff2); kv1[i] = 1.f - ff1; kv2[i] = 1.f - ff2; }
                else { lf1[i] = 0.f; lf2[i] = 0.f; kv1[i] = 0.f; kv2[i] = 0.f; qv1[i] = 0.f; qv2[i] = 0.f; }
            }
            LAS float* cr = (LAS float*)(L + LA_CUM) + row_l * 128;
            *(LAS f32x4*)(cr + c8 * 8) = (f32x4){lf1[0], lf1[1], lf1[2], lf1[3]}; *(LAS f32x4*)(cr + c8 * 8 + 4) = (f32x4){lf1[4], lf1[5], lf1[6], lf1[7]};
            *(LAS f32x4*)(cr + 64 + c8 * 8) = (f32x4){lf2[0], lf2[1], lf2[2], lf2[3]}; *(LAS f32x4*)(cr + 64 + c8 * 8 + 4) = (f32x4){lf2[4], lf2[5], lf2[6], lf2[7]};
            if (tid < 256) {
                const unsigned va[4] = {vv.x, vv.y, vv.z, vv.w};
#pragma unroll
                for (int i = 0; i < 8; ++i) *(LAS bf16_t*)(L + LA_VT + (vp * 8 + i) * 144 + vrow * 2) = (bf16_t)((i & 1) ? (va[i >> 1] >> 16) : (va[i >> 1] & 0xffffu));
            }
        }
        if (n + 1 < NCH) HG_LOAD(n + 1);
        __syncthreads();
        {
            const int d = tid & 127, sg = tid >> 7; LAS float* c = (LAS float*)(L + LA_CUM) + (sg * 16) * 128 + d; float run = 0.f;
#pragma unroll
            for (int r = 0; r < 16; ++r) { run += c[r * 128]; c[r * 128] = run; }
        }
        __syncthreads();
        {
            const LAS float* C = (const LAS float*)(L + LA_CUM);
            const int sg = row_l >> 4;
            float qi[16], ki[16], qd[16], kd[16];
#pragma unroll
            for (int i = 0; i < 16; ++i) {
                const int d = (i < 8) ? c8 * 8 + i : 64 + c8 * 8 + (i - 8);
                const float t0 = C[15 * 128 + d], t1 = C[31 * 128 + d], t2 = C[47 * 128 + d], t3 = C[63 * 128 + d];
                float cum = C[row_l * 128 + d];
                cum += (sg > 0 ? t0 : 0.f) + (sg > 1 ? t1 : 0.f) + (sg > 2 ? t2 : 0.f);
                const float cmid = t0 + t1, total = (t0 + t1) + (t2 + t3);
                const float q = (i < 8) ? qv1[i & 7] : qv2[i & 7], k = (i < 8) ? kv1[i & 7] : kv2[i & 7];
                qi[i] = q * __expf(fminf(cum - cmid, 80.f)); ki[i] = k * __expf(fminf(cmid - cum, 80.f));
                qd[i] = q * __expf(cum); kd[i] = k * __expf(total - cum);
                if (row_l == 0) *(LAS float*)(L + LA_DEC + d * 4) = __expf(total);
            }
            u32x4 w1, w2;
            PK8(w1, qi); { const float* s = qi + 8; PK8(w2, s); }
            *(LAS u32x4*)(L + LA_QS + row_l * 272 + c8 * 16) = w1; *(LAS u32x4*)(L + LA_QS + row_l * 272 + 128 + c8 * 16) = w2;
            PK8(w1, ki); { const float* s = ki + 8; PK8(w2, s); }
            *(LAS u32x4*)(L + LA_KS + row_l * 272 + c8 * 16) = w1; *(LAS u32x4*)(L + LA_KS + row_l * 272 + 128 + c8 * 16) = w2;
            PK8(w1, qd); { const float* s = qd + 8; PK8(w2, s); }
            *(LAS u32x4*)(L + LA_QD + row_l * 272 + c8 * 16) = w1; *(LAS u32x4*)(L + LA_QD + row_l * 272 + 128 + c8 * 16) = w2;
#pragma unroll
            for (int i = 0; i < 8; ++i) {
                *(LAS bf16_t*)(L + LA_KT + (c8 * 8 + i) * 144 + row_l * 2) = f2bf(kd[i]);
                *(LAS bf16_t*)(L + LA_KT + (64 + c8 * 8 + i) * 144 + row_l * 2) = f2bf(kd[8 + i]);
            }
        }
        __syncthreads();
        la_core<true>(L, st, 0.f, OB, 512, h * 128 + sl * 32, b, n);
        __syncthreads();
    }
#undef HG_LOAD
}

constexpr int LR_XB = 0, LR_XC = 17152, LR_XA = 33536, LR_RG = 42752, LR_CW = 75520, LR_END = 77568;
__device__ __forceinline__ void lru_unit(const Args& a, LAS unsigned char* L, int unit) {
    int tid_ = threadIdx.x; asm volatile("" : "+v"(tid_));
    const int tid = tid_, lane = tid & 63, w = __builtin_amdgcn_readfirstlane(tid >> 6), fr = lane & 15, fq = lane >> 4;
    const int b = unit >> 4, cb = unit & 15;
    bf16_t* Z = (bf16_t*)(a.ws + Z_OFF);
    const int row_l = tid >> 3, c8 = tid & 7;
    LAS float* XB = (LAS float*)(L + LR_XB); LAS float* XC = (LAS float*)(L + LR_XC); LAS float* RG = (LAS float*)(L + LR_RG); LAS float* CW = (LAS float*)(L + LR_CW);
    if (tid < 64) {
        const int c = cb * 64 + tid;
#pragma unroll
        for (int ww = 0; ww < 4; ++ww) CW[ww * 64 + tid] = a.in[10][ww * 1024 + c];
        CW[4 * 64 + tid] = a.in[11][c];
        CW[5 * 64 + tid] = log1pf(expf(-a.in[9][c]));
        CW[6 * 64 + tid] = a.in[6][c]; CW[7 * 64 + tid] = a.in[8][c];
    }
    const bf16_t* WG = (const bf16_t*)(a.ws + LRUW_OFF) + (size_t)cb * 128 * 64;
    const bf16x8 wf0 = *(const bf16x8*)(WG + (w * 16 + fr) * 64 + fq * 8), wf1 = *(const bf16x8*)(WG + (w * 16 + fr) * 64 + 32 + fq * 8);
    float hstate = 0.f;
    u32x4 xbv, bgv;
#define LRU_LOAD(n_) do { const int r_ = chunk_row(b, (n_), row_l); \
        if (r_ >= 0) { const bf16_t* zr = Z + (size_t)r_ * IN_AB; xbv = *(const u32x4*)(zr + 2048 + cb * 64 + c8 * 8); bgv = *(const u32x4*)(zr + 4096 + cb * 64 + c8 * 8); } \
        else { xbv = bgv = (u32x4){0u, 0u, 0u, 0u}; } } while (0)
    LRU_LOAD(0);
    __syncthreads();
    for (int n = 0; n < NCH; ++n) {
        float hv = 0.f;
        if (tid < 192 && n > 0) hv = XB[64 * 64 + tid];
        __syncthreads();
        if (tid < 192) XB[tid] = hv;
        {
            float xf[8]; UNPK8(xf, xbv);
            *(LAS f32x4*)(XB + (3 + row_l) * 64 + c8 * 8) = (f32x4){xf[0], xf[1], xf[2], xf[3]}; *(LAS f32x4*)(XB + (3 + row_l) * 64 + c8 * 8 + 4) = (f32x4){xf[4], xf[5], xf[6], xf[7]};
        }
        const u32x4 bgc = bgv;
        const int grow = chunk_row(b, n, row_l);
        if (n + 1 < NCH) LRU_LOAD(n + 1);
        __syncthreads();
        {
            float xc[8];
#pragma unroll
            for (int i = 0; i < 8; ++i) { const int c = c8 * 8 + i; float s = CW[4 * 64 + c];
#pragma unroll
                for (int ww = 0; ww < 4; ++ww) s += CW[ww * 64 + c] * XB[(row_l + ww) * 64 + c];
                xc[i] = s; XC[row_l * 64 + c] = s; }
            u32x4 o; PK8(o, xc);
            *(LAS u32x4*)(L + LR_XA + row_l * 144 + c8 * 16) = o;
        }
        __syncthreads();
        {
            const f32x4 bias = *(const LAS f32x4*)(CW + (w < 4 ? 6 * 64 + w * 16 : 7 * 64 + (w - 4) * 16) + 4 * fq);
#pragma unroll
            for (int m = 0; m < 4; ++m) {
                f32x4 acc = {0.f, 0.f, 0.f, 0.f};
                const bf16x8 x0 = ldsfrag(L + LR_XA + (m * 16 + fr) * 144 + fq * 16), x1 = ldsfrag(L + LR_XA + (m * 16 + fr) * 144 + 64 + fq * 16);
                acc = MFMA16(wf0, x0, acc); acc = MFMA16(wf1, x1, acc);
                f32x4 gte; gte[0] = sigmoidf_(acc[0] + bias[0]); gte[1] = sigmoidf_(acc[1] + bias[1]); gte[2] = sigmoidf_(acc[2] + bias[2]); gte[3] = sigmoidf_(acc[3] + bias[3]);
                *(LAS f32x4*)(RG + (m * 16 + fr) * 128 + w * 16 + 4 * fq) = gte;
            }
        }
        __syncthreads();
        {
#pragma unroll
            for (int i = 0; i < 8; ++i) { const int c = c8 * 8 + i;
                const float r = RG[row_l * 128 + c], ig = RG[row_l * 128 + 64 + c], xc = XC[row_l * 64 + c];
                const float log_a = -8.f * r * CW[5 * 64 + c];
                float av = __expf(log_a), bv = sqrtf(fmaxf(-expm1f(2.f * log_a), 0.f)) * (ig * xc);
                if (grow < 0) { av = 1.f; bv = 0.f; }
                RG[row_l * 128 + c] = av; RG[row_l * 128 + 64 + c] = bv; }
        }
        __syncthreads();
        if (w == 0) {
#pragma unroll 16
            for (int j = 0; j < 64; ++j) { hstate = RG[j * 128 + lane] * hstate + RG[j * 128 + 64 + lane]; RG[j * 128 + 64 + lane] = hstate; }
        }
        __syncthreads();
        if (grow >= 0) {
            float gf[8], y[8]; UNPK8(gf, bgc);
#pragma unroll
            for (int i = 0; i < 8; ++i) y[i] = gelu_tanh(gf[i]) * RG[row_l * 128 + 64 + c8 * 8 + i];
            u32x4 o; PK8(o, y);
            if (grow < RM) *(u32x4*)(Z + (size_t)grow * IN_AB + 4096 + cb * 64 + c8 * 8) = o;
            else if (b == 0) *(u32x4*)((bf16_t*)(a.ws + YAB_OFF) + (size_t)(grow - RM) * 2048 + 1024 + cb * 64 + c8 * 8) = o;
        }
    }
    __syncthreads();
#undef LRU_LOAD
}

constexpr int S5_BU = 0, S5_HS = 32768, S5_END = 32768 + 64 * 272;
__device__ __forceinline__ void s5_unit(const Args& a, LAS unsigned char* L, int unit) {
    int tid_ = threadIdx.x; asm volatile("" : "+v"(tid_));
    const int tid = tid_, lane = tid & 63, w = __builtin_amdgcn_readfirstlane(tid >> 6), fr = lane & 15, fq = lane >> 4;
    const int b = unit >> 5, g = unit & 31;
    bf16_t* Z = (bf16_t*)(a.ws + Z_OFF);
    const bf16_t* BB = (const bf16_t*)(a.ws + S5BB_OFF) + (size_t)g * 128 * 32;
    const bf16_t* CM = (const bf16_t*)(a.ws + S5CM_OFF) + (size_t)g * 16 * 128;
    const float* AB = (const float*)(a.ws + S5AB_OFF) + (size_t)g * 128;
    const bf16x8 bbf = *(const bf16x8*)(BB + (w * 16 + fr) * 32 + fq * 8);
    bf16x8 cmf[4];
#pragma unroll
    for (int kk = 0; kk < 4; ++kk) cmf[kk] = *(const bf16x8*)(CM + fr * 128 + kk * 32 + fq * 8);
    const float ar = AB[2 * lane], ai = AB[2 * lane + 1];
    const f32x4 dv = *(const f32x4*)(a.in[20] + g * 16 + 4 * fq);
    float hr = 0.f, hi = 0.f;
    LAS float* BU = (LAS float*)(L + S5_BU);
    bf16x8 uf[4];
#define S5_LOAD(n_) do { _Pragma("unroll") for (int m = 0; m < 4; ++m) { const int r_ = chunk_row(b, (n_), m * 16 + fr); \
            uf[m] = (bf16x8){0, 0, 0, 0, 0, 0, 0, 0}; \
            if (r_ >= 0 && fq < 2) uf[m] = *(const bf16x8*)(Z + (size_t)r_ * IN_CD + g * 16 + fq * 8); } } while (0)
    S5_LOAD(0);
    for (int n = 0; n < NCH; ++n) {
#pragma unroll
        for (int m = 0; m < 4; ++m) { f32x4 acc = {0.f, 0.f, 0.f, 0.f}; acc = MFMA16(bbf, uf[m], acc);
            *(LAS f32x4*)(BU + (m * 16 + fr) * 128 + w * 16 + 4 * fq) = acc; }
        if (n + 1 < NCH) S5_LOAD(n + 1);
        __syncthreads();
        if (w == 0) {
#pragma unroll 8
            for (int j = 0; j < 64; ++j) {
                const float br = BU[j * 128 + lane], bi = BU[j * 128 + 64 + lane];
                const float nr = ar * hr - ai * hi + br, ni = ar * hi + ai * hr + bi;
                hr = nr; hi = ni;
                *(LAS bf16_t*)(L + S5_HS + j * 272 + lane * 2) = f2bf(hr);
                *(LAS bf16_t*)(L + S5_HS + j * 272 + 128 + lane * 2) = f2bf(hi);
            }
        }
        __syncthreads();
        if (w < 4) {
            f32x4 acc = {0.f, 0.f, 0.f, 0.f};
#pragma unroll
            for (int kk = 0; kk < 4; ++kk) acc = MFMA16(cmf[kk], ldsfrag(L + S5_HS + (w * 16 + fr) * 272 + kk * 64 + fq * 16), acc);
            const int r = chunk_row(b, n, w * 16 + fr);
            if (r >= 0) {
                bf16_t* up = Z + (size_t)r * IN_CD + g * 16 + 4 * fq;
                const u32x2 uv = *(const u32x2*)up;
                const float y0 = gelu_tanh(acc[0] + dv[0] * bf_lo(uv.x)), y1 = gelu_tanh(acc[1] + dv[1] * bf_hi(uv.x));
                const float y2 = gelu_tanh(acc[2] + dv[2] * bf_lo(uv.y)), y3 = gelu_tanh(acc[3] + dv[3] * bf_hi(uv.y));
                u32x2 o; o.x = cvt_pk_bf16(y0, y1); o.y = cvt_pk_bf16(y2, y3);
                if (r < RM) *(u32x2*)up = o; else if (b == 0) *(u32x2*)((bf16_t*)(a.ws + YM_OFF) + (size_t)(r - RM) * 512 + g * 16 + 4 * fq) = o;
            }
        }
    }
    __syncthreads();
#undef S5_LOAD
}

__device__ __forceinline__ void phase_ret_post(const Args& a) {
    int tid_ = threadIdx.x; asm volatile("" : "+v"(tid_));
    const int tid = tid_, lane = tid & 63, wave = tid >> 6;
    const int gw = blockIdx.x * 8 + wave, NGW = gridDim.x * 8;
    bf16_t* Z = (bf16_t*)(a.ws + Z_OFF); const bf16_t* OB = (const bf16_t*)(a.ws + HN_OFF); const float* gn = a.in[4];
    for (int it = gw; it < RVALID * 4; it += NGW) {
        const int row = it >> 2, h = it & 3;
        const u32x2 ov = *(const u32x2*)(OB + (size_t)row * DM + h * 256 + 4 * lane);
        bf16_t* gp = Z + (size_t)row * IN_AB + 3072 + h * 256 + 4 * lane;
        const u32x2 gv = *(const u32x2*)gp;
        const f32x4 gg = *(const f32x4*)(gn + h * 256 + 4 * lane);
        float o0 = bf_lo(ov.x), o1 = bf_hi(ov.x), o2 = bf_lo(ov.y), o3 = bf_hi(ov.y);
        const float mean = wave_sum((o0 + o1) + (o2 + o3)) * (1.f / 256.f);
        o0 -= mean; o1 -= mean; o2 -= mean; o3 -= mean;
        const float inv = rsqrtf(wave_sum(o0 * o0 + o1 * o1 + o2 * o2 + o3 * o3) * (1.f / 256.f) + EPS);
        u32x2 y; y.x = cvt_pk_bf16(o0 * inv * gg[0] * silu_(bf_lo(gv.x)), o1 * inv * gg[1] * silu_(bf_hi(gv.x)));
        y.y = cvt_pk_bf16(o2 * inv * gg[2] * silu_(bf_lo(gv.y)), o3 * inv * gg[3] * silu_(bf_hi(gv.y)));
        if (row < RM) *(u32x2*)gp = y; else *(u32x2*)((bf16_t*)(a.ws + YAB_OFF) + (size_t)(row - RM) * 2048 + h * 256 + 4 * lane) = y;
    }
}
__device__ __forceinline__ void phase_hg_post(const Args& a) {
    int tid_ = threadIdx.x; asm volatile("" : "+v"(tid_));
    const int tid = tid_, lane = tid & 63, wave = tid >> 6;
    const int gw = blockIdx.x * 8 + wave, NGW = gridDim.x * 8;
    bf16_t* Z = (bf16_t*)(a.ws + Z_OFF); const bf16_t* OB = (const bf16_t*)(a.ws + HN_OFF); const float* gn = a.in[24];
    for (int it = gw; it < RVALID * 4; it += NGW) {
        const int row = it >> 2, h = it & 3;
        const unsigned ov = *(const unsigned*)(OB + (size_t)row * 512 + h * 128 + 2 * lane);
        bf16_t* gp = Z + (size_t)row * IN_CD + 2048 + h * 128 + 2 * lane;
        const unsigned gv = *(const unsigned*)gp;
        const f32x2 gg = *(const f32x2*)(gn + h * 128 + 2 * lane);
        const float o0 = bf_lo(ov), o1 = bf_hi(ov);
        const float inv = rsqrtf(wave_sum(o0 * o0 + o1 * o1) * (1.f / 128.f) + EPS);
        const unsigned yv = cvt_pk_bf16(o0 * inv * gg[0] * silu_(bf_lo(gv)), o1 * inv * gg[1] * silu_(bf_hi(gv)));
        if (row < RM) *(unsigned*)gp = yv; else *(unsigned*)((bf16_t*)(a.ws + YCD_OFF) + (size_t)(row - RM) * 1024 + 512 + h * 128 + 2 * lane) = yv;
    }
}


#ifndef DBG_STOP
#define DBG_STOP 0
#endif
__device__ __forceinline__ void dbg_digest(const Args& a) {
    const size_t gt = (size_t)blockIdx.x * NTHREADS + threadIdx.x, NGT = (size_t)gridDim.x * NTHREADS;
    const bf16_t* zb = (const bf16_t*)(a.ws + Z_OFF);
    const size_t NE = ((size_t)R * 5120 + (size_t)R * 1024);
    const size_t ON = (size_t)RM * DM;
    for (size_t i = gt; i < ON; i += NGT) {
        float s = 0.f;
        for (size_t k = i; k < NE; k += ON) s += __uint_as_float((unsigned)zb[k] << 16);
        a.out[i] = a.out[i] * 1e-3f + s;
    }
}
#define DBG_CHECK(k) do { if (DBG_STOP == (k)) { grid.sync(); dbg_digest(a); return; } } while (0)
__global__ void __launch_bounds__(NTHREADS, 2) fwd_megakernel(Args a) {
    extern __shared__ __attribute__((aligned(16))) unsigned char lds_raw[];
    LAS unsigned char* L = (LAS unsigned char*)lds_raw;
    cg::grid_group grid = cg::this_grid();
    unsigned char* ws = a.ws;
    const int G = gridDim.x, bx = blockIdx.x;
    bf16_t* Zb = (bf16_t*)(ws + Z_OFF); bf16_t* HNb = (bf16_t*)(ws + HN_OFF); float* ssq = (float*)(ws + SSQ_OFF);
    const float* ng = a.in[26];

    phase_prologue(a, L);
    grid.sync();
    DBG_CHECK(1);

    bf16_t* YABb = (bf16_t*)(ws + YAB_OFF); bf16_t* YCDb = (bf16_t*)(ws + YCD_OFF); bf16_t* YMb = (bf16_t*)(ws + YM_OFF);
    {
        const bf16_t* W = (const bf16_t*)(ws + W_INAB);
        pg8::Gemm g{HNb, W, RM, IN_AB, DM, DM}; pg8::StaticOrder S; S.init(RM, IN_AB, G, bx);
        pg8::Epi<0> E{Zb, IN_AB, nullptr, nullptr, 0, nullptr};
        pg8::gemm_phase(L, g, S, E);
        meta_gemm<0>(L, HNb + (size_t)RM * DM, DM, W, IN_AB, DM, Zb + (size_t)RM * IN_AB, IN_AB, nullptr, nullptr, 0, nullptr);
    }
    grid.sync();
    DBG_CHECK(2);
    for (int u = bx; u < 128 + 64; u += G) { if (u < 128) retention_unit(a, L, u); else lru_unit(a, L, u - 128); }
    grid.sync();
    DBG_CHECK(3);
    phase_ret_post(a);
    grid.sync();
    DBG_CHECK(4);
    {
        const bf16_t* W = (const bf16_t*)(ws + W_OUTAB);
        pg8::Gemm g{Zb + 3072, W, RM, DM, 2048, IN_AB}; pg8::StaticOrder S; S.init(RM, DM, G, bx);
        pg8::Epi<1> E{HNb, DM, ssq, nullptr, 0, nullptr};
        pg8::gemm_phase(L, g, S, E);
        meta_gemm<1>(L, YABb, 2048, W, DM, 2048, HNb + (size_t)RM * DM, DM, ssq + (size_t)RM * 16, nullptr, 0, nullptr);
    }
    grid.sync();
    DBG_CHECK(5);
    phase_resnorm(a, ng + 1 * DM, ng + 2 * DM);
    grid.sync();
    DBG_CHECK(6);
    {
        const bf16_t* W = (const bf16_t*)(ws + W_W1_0);
        pg8::Gemm g{HNb, W, RM, FF, DM, DM}; pg8::StaticOrder S; S.init(RM, FF, G, bx);
        pg8::Epi<2> E{Zb, FF, nullptr, nullptr, 0, nullptr};
        pg8::gemm_phase(L, g, S, E);
        meta_gemm<2>(L, HNb + (size_t)RM * DM, DM, W, FF, DM, Zb + (size_t)RM * FF, FF, nullptr, nullptr, 0, nullptr);
    }
    grid.sync();
    DBG_CHECK(7);
    {
        const bf16_t* W = (const bf16_t*)(ws + W_W2_0);
        pg8::Gemm g{Zb, W, RM, DM, FF, FF}; pg8::StaticOrder S; S.init(RM, DM, G, bx);
        pg8::Epi<1> E{HNb, DM, ssq, nullptr, 0, nullptr};
        pg8::gemm_phase(L, g, S, E);
        meta_gemm<1>(L, Zb + (size_t)RM * FF, FF, W, DM, FF, HNb + (size_t)RM * DM, DM, ssq + (size_t)RM * 16, nullptr, 0, nullptr);
    }
    grid.sync();
    DBG_CHECK(8);
    phase_resnorm(a, ng + 3 * DM, ng + 4 * DM);
    grid.sync();
    DBG_CHECK(9);

    {
        const bf16_t* W = (const bf16_t*)(ws + W_INCD);
        pg8::Gemm g{HNb, W, RM, IN_CD, DM, DM}; pg8::StaticOrder S; S.init(RM, IN_CD, G, bx);
        pg8::Epi<0> E{Zb, IN_CD, nullptr, nullptr, 0, nullptr};
        pg8::gemm_phase(L, g, S, E);
        meta_gemm<0>(L, HNb + (size_t)RM * DM, DM, W, IN_CD, DM, Zb + (size_t)RM * IN_CD, IN_CD, nullptr, nullptr, 0, nullptr);
    }
    grid.sync();
    DBG_CHECK(10);
    for (int u = bx; u < 64 + 128; u += G) { if (u < 64) hgrn_unit(a, L, u); else s5_unit(a, L, u - 64); }
    grid.sync();
    DBG_CHECK(11);
    phase_hg_post(a);
    {
        const bf16_t* W = (const bf16_t*)(ws + W_GLU);
        pg8::Gemm g{Zb, W, RM, 512, 512, IN_CD}; pg8::StaticOrder S; S.init(RM, 512, G, bx);
        pg8::Epi<3> E{Zb + 1536, IN_CD, nullptr, Zb, IN_CD, a.in[23]};
        pg8::gemm_phase(L, g, S, E);
        meta_gemm<3>(L, YMb, 512, W, 512, 512, YCDb, 1024, nullptr, YMb, 512, a.in[23]);
    }
    grid.sync();
    DBG_CHECK(12);
    {
        const bf16_t* W = (const bf16_t*)(ws + W_OUTCD);
        pg8::Gemm g{Zb + 1536, W, RM, DM, DM, IN_CD}; pg8::StaticOrder S; S.init(RM, DM, G, bx);
        pg8::Epi<1> E{HNb, DM, ssq, nullptr, 0, nullptr};
        pg8::gemm_phase(L, g, S, E);
        meta_gemm<1>(L, YCDb, 1024, W, DM, DM, HNb + (size_t)RM * DM, DM, ssq + (size_t)RM * 16, nullptr, 0, nullptr);
    }
    grid.sync();
    DBG_CHECK(13);
    phase_resnorm(a, ng + 5 * DM, ng + 6 * DM);
    grid.sync();
    DBG_CHECK(14);
    {
        const bf16_t* W = (const bf16_t*)(ws + W_W1_1);
        pg8::Gemm g{HNb, W, RM, FF, DM, DM}; pg8::StaticOrder S; S.init(RM, FF, G, bx);
        pg8::Epi<2> E{Zb, FF, nullptr, nullptr, 0, nullptr};
        pg8::gemm_phase(L, g, S, E);
        meta_gemm<2>(L, HNb + (size_t)RM * DM, DM, W, FF, DM, Zb + (size_t)RM * FF, FF, nullptr, nullptr, 0, nullptr);
    }
    grid.sync();
    DBG_CHECK(15);
    {
        const bf16_t* W = (const bf16_t*)(ws + W_W2_1);
        pg8::Gemm g{Zb, W, RM, DM, FF, FF}; pg8::StaticOrder S; S.init(RM, DM, G, bx);
        pg8::Epi<1> E{HNb, DM, ssq, nullptr, 0, nullptr};
        pg8::gemm_phase(L, g, S, E);
        meta_gemm<1>(L, Zb + (size_t)RM * FF, FF, W, DM, FF, HNb + (size_t)RM * DM, DM, ssq + (size_t)RM * 16, nullptr, 0, nullptr);
    }
    grid.sync();
    DBG_CHECK(16);
    phase_resnorm(a, ng + 7 * DM, nullptr);
}

extern "C" void kernel_launch(void* const* d_in, const int* in_sizes, int n_in, void* d_out, int out_size, void* d_ws, size_t ws_size, hipStream_t stream) {
    static int grid = 0;
    if (!grid) {
        int dev = 0, cus = 0, per_cu = 0;
        (void)hipGetDevice(&dev);
        (void)hipDeviceGetAttribute(&cus, hipDeviceAttributeMultiprocessorCount, dev);
        (void)hipFuncSetAttribute((const void*)fwd_megakernel, hipFuncAttributeMaxDynamicSharedMemorySize, LDS_BYTES);
        (void)hipOccupancyMaxActiveBlocksPerMultiprocessor(&per_cu, (const void*)fwd_megakernel, NTHREADS, LDS_BYTES);
        if (per_cu < 1) per_cu = 1;
        grid = cus * per_cu;
        if (n_in != 29 || ws_size < WS_END) fprintf(stderr, "kernel_launch: unexpected n_in %d / ws %zu (need %zu)\n", n_in, ws_size, (size_t)WS_END);
    }
    Args a{};
    for (int i = 0; i < 29; ++i) a.in[i] = (const float*)d_in[i];
    a.out = (float*)d_out; a.ws = (unsigned char*)d_ws;
    void* args[] = {&a};
    hipError_t e = hipLaunchCooperativeKernel((void*)fwd_megakernel, dim3(grid), dim3(NTHREADS), args, LDS_BYTES, stream);
    if (e != hipSuccess) fprintf(stderr, "cooperative launch failed: %s (grid %d)\n", hipGetErrorString(e), grid);
}
```

```cpp
#include <hip/hip_runtime.h>
#include <hip/hip_cooperative_groups.h>
#include <cstdio>
#include <cstdint>
namespace cg = cooperative_groups;

#define LAS __attribute__((address_space(3)))
typedef unsigned short bf16_t;
typedef short bf16x8 __attribute__((ext_vector_type(8)));
typedef float f32x4 __attribute__((ext_vector_type(4)));
typedef float f32x2 __attribute__((ext_vector_type(2)));
typedef unsigned u32x4 __attribute__((ext_vector_type(4)));
typedef unsigned u32x2 __attribute__((ext_vector_type(2)));

constexpr int DM = 1024, NB = 4, SEQ = 4096, NMETA = 16, FF = 4096;
constexpr int RM = NB * SEQ;
constexpr int RMETA = RM;
constexpr int RVALID = RM + NMETA;
constexpr int R = RVALID;
constexpr int NCH = 65;
constexpr int IN_AB = 5120, IN_CD = 2560;
constexpr float EPS = 1e-6f;
constexpr int NTHREADS = 512;
constexpr int LDS_BYTES = 147456;

constexpr size_t W_INAB = 0;
constexpr size_t W_OUTAB = W_INAB + (size_t)5120 * 1024 * 2;
constexpr size_t W_W1_0 = W_OUTAB + (size_t)1024 * 2048 * 2;
constexpr size_t W_W2_0 = W_W1_0 + (size_t)4096 * 1024 * 2;
constexpr size_t W_INCD = W_W2_0 + (size_t)4096 * 1024 * 2;
constexpr size_t W_OUTCD = W_INCD + (size_t)2560 * 1024 * 2;
constexpr size_t W_GLU = W_OUTCD + (size_t)1024 * 1024 * 2;
constexpr size_t W_W1_1 = W_GLU + (size_t)512 * 512 * 2;
constexpr size_t W_W2_1 = W_W1_1 + (size_t)4096 * 1024 * 2;
constexpr size_t W_END = W_W2_1 + (size_t)4096 * 1024 * 2;
constexpr size_t Z_OFF = W_END;
constexpr size_t HN_OFF = Z_OFF + (size_t)R * 5120 * 2;
constexpr size_t SM_OFF = HN_OFF + (size_t)R * 1024 * 2;
constexpr size_t HMETA_OFF = SM_OFF;
constexpr size_t YAB_OFF = HMETA_OFF + (size_t)16 * 1024 * 4;
constexpr size_t YCD_OFF = YAB_OFF + (size_t)16 * 2048 * 2;
constexpr size_t YM_OFF = YCD_OFF + (size_t)16 * 1024 * 2;
constexpr size_t SSQ_OFF = YM_OFF + (size_t)16 * 512 * 2;
constexpr size_t LRUW_OFF = SSQ_OFF + (size_t)R * 16 * 4;
constexpr size_t S5BB_OFF = LRUW_OFF + (size_t)16 * 128 * 64 * 2;
constexpr size_t S5CM_OFF = S5BB_OFF + (size_t)32 * 128 * 32 * 2;
constexpr size_t S5AB_OFF = S5CM_OFF + (size_t)32 * 16 * 128 * 2;
constexpr size_t BAR_OFF = S5AB_OFF + (size_t)32 * 64 * 2 * 4;
constexpr size_t CNT_OFF = BAR_OFF + 16384;
constexpr size_t XB_OFF = CNT_OFF + (size_t)8 * 80 * 32 * 4;
constexpr size_t XB_STRIDE = (size_t)64 * 256 * 4 * 4 + 4096;
constexpr size_t WS_END = XB_OFF + 8 * XB_STRIDE;
static_assert(WS_END <= (size_t)268435456, "workspace map");

struct Args {
    const float* in[29];
    float* out;
    unsigned char* ws;
    long long never;
};

typedef __bf16 bf16x2_t __attribute__((ext_vector_type(2)));
__device__ __forceinline__ unsigned cvt_pk_bf16(float lo, float hi) { f32x2 v = {lo, hi}; bf16x2_t b = __builtin_convertvector(v, bf16x2_t); return __builtin_bit_cast(unsigned, b); }
__device__ __forceinline__ float bf_lo(unsigned u) { return __uint_as_float(u << 16); }
__device__ __forceinline__ float bf_hi(unsigned u) { return __uint_as_float(u & 0xffff0000u); }
__device__ __forceinline__ bf16_t f2bf(float f) { return (bf16_t)(cvt_pk_bf16(f, 0.f) & 0xffffu); }
__device__ __forceinline__ float wave_sum(float v) {
#pragma unroll
    for (int o = 1; o < 64; o <<= 1) v += __shfl_xor(v, o);
    return v;
}
__device__ __forceinline__ float sigmoidf_(float x) { return 1.f / (1.f + __expf(-x)); }
__device__ __forceinline__ float gelu_tanh(float x) {
    const float u = 0.7978845608028654f * (x + 0.044715f * x * x * x);
    const float e = __expf(2.f * u);
    const float t = 1.f - 2.f / (e + 1.f);
    return 0.5f * x * (1.f + t);
}
__device__ __forceinline__ float silu_(float x) { return x * sigmoidf_(x); }
__device__ __forceinline__ void sincos_big(float ang, float& s, float& c) {
    double t = (double)ang * 0.15915494309189535;
    t -= rint(t);
    const float fr = (float)t;
    s = __builtin_amdgcn_sinf(fr); c = __builtin_amdgcn_cosf(fr);
}
__device__ __forceinline__ void st_agent(float* p, float v) { __hip_atomic_store(p, v, __ATOMIC_RELAXED, __HIP_MEMORY_SCOPE_AGENT); }
__device__ __forceinline__ float ld_agent(const float* p) { return __hip_atomic_load(p, __ATOMIC_RELAXED, __HIP_MEMORY_SCOPE_AGENT); }
__device__ __forceinline__ void cnt_arrive_wait(unsigned* c, unsigned target) {
    __hip_atomic_fetch_add(c, 1u, __ATOMIC_RELAXED, __HIP_MEMORY_SCOPE_AGENT);
    unsigned sp = 0;
    while (__hip_atomic_load(c, __ATOMIC_RELAXED, __HIP_MEMORY_SCOPE_AGENT) < target) { __builtin_amdgcn_s_sleep(1); if (++sp > (1u << 22)) break; }
}
__device__ __forceinline__ float* hrow(const Args& a, int row) {
    return row < RM ? a.out + (size_t)row * DM : (float*)(a.ws + HMETA_OFF) + (size_t)(row - RM) * DM;
}
__device__ __forceinline__ int chunk_row(int b, int n, int j) {
    if (n == 0) return j >= 48 ? RMETA + (j - 48) : -1;
    return b * SEQ + (n - 1) * 64 + j;
}

namespace pg8 {
constexpr int BM = 256, BK = 64, HALF = 128, HTB = HALF * BK * 2, NXCD = 8, WGM = 8;
__device__ __forceinline__ int lds_byte(int r, int c) { const int st = (r >> 4) * 2 + (c >> 5), rr = r & 15, cc = c & 31, ob = rr * 64 + cc * 2; return st * 1024 + (ob ^ (((ob >> 9) & 1) << 5)); }
__device__ __forceinline__ void stage_rc(int b, int& Rr, int& C) { const int st = b / 1024, sb = b % 1024, swz = sb ^ (((sb >> 9) & 1) << 5); Rr = (st >> 1) * 16 + swz / 64; C = (st & 1) * 32 + (swz % 64) / 2; }
__device__ __forceinline__ int perm32(int rho) { const int n = rho >> 4, i = rho & 15; return 8 * (i >> 2) + 4 * n + (i & 3); }
struct Unit { int pm, pn; };
struct Gemm { const bf16_t* A; const bf16_t* Bt; int M, N, K, lda; };
struct StaticOrder {
    int nM, nN, nwg, G, c;
    __device__ void init(int M, int N, int G_, int c_) { nM = M / BM; nN = N / BM; nwg = nM * nN; G = G_; c = c_; }
    __device__ bool next(int i, Unit& u) const {
        const long L = (long)i * G + c; if (L >= nwg) return false;
        int wgid = (int)L; { const int q = nwg / NXCD, r = nwg % NXCD, xcd = wgid % NXCD, off = wgid / NXCD; wgid = (xcd < r ? xcd * (q + 1) : r * (q + 1) + (xcd - r) * q) + off; }
        const int nig = WGM * nN, gid = wgid / nig, fm = gid * WGM, gsz = (nM - fm) < WGM ? (nM - fm) : WGM;
        u.pm = fm + ((wgid % nig) % gsz); u.pn = (wgid % nig) / gsz; return true;
    }
};
template <class Epi>
__device__ __forceinline__ void gemm_phase(LAS unsigned char* lds, const Gemm g, const StaticOrder& S, const Epi& E) {
    int tid_ = threadIdx.x; asm volatile("" : "+v"(tid_));
    const int tid = tid_, wid = __builtin_amdgcn_readfirstlane(tid >> 6), lane = tid & 63, wr = wid >> 2, wc = wid & 3, fr = lane & 15, fq = lane >> 4;
    const int K = g.K, nt = K / BK, lda = g.lda;
    unsigned voffA[2], voffB[2];
#pragma unroll
    for (int i = 0; i < 2; ++i) { int Rr, C; stage_rc(tid * 16 + i * 8192, Rr, C); const int Rb = (Rr & ~31) + perm32(Rr & 31);
        voffA[i] = (unsigned)(Rr * lda + C) * 2u; voffB[i] = (unsigned)(Rb * K + C) * 2u; }
    const size_t kstep = (size_t)(BK * 2);
    const size_t hstepA = (size_t)HALF * lda * 2, hstepB = (size_t)HALF * K * 2;
    const size_t tstepA = 2 * hstepA, tstepB = 2 * hstepB;
    const unsigned ldsw = (unsigned)wid * 1024u;
    const int aoff = lds_byte(wr * 64 + fr, fq * 8), boff = lds_byte(wc * 32 + fr, fq * 8);
#define PG8_SA(b, h) (((b) * 2 + (h)) * HTB)
#define PG8_SB(b, h) ((4 + (b) * 2 + (h)) * HTB)
#define PG8_STAGE(bufoff, gbase, voff) do { _Pragma("unroll") for (int _i = 0; _i < 2; ++_i) \
        __builtin_amdgcn_global_load_lds((const unsigned*)((const char*)(gbase) + (voff)[_i]), (LAS unsigned*)(lds + (bufoff) + ldsw + _i * 8192), 16, 0, 0); } while (0)
#define PG8_LDA(dst, b, h) do { _Pragma("unroll") for (int m = 0; m < 4; ++m) _Pragma("unroll") for (int k = 0; k < 2; ++k) dst[m][k] = *(const LAS bf16x8*)(lds + PG8_SA(b, h) + aoff + m * 2048 + k * 1024); } while (0)
#define PG8_LDB(dst, b, h) do { _Pragma("unroll") for (int n = 0; n < 2; ++n) _Pragma("unroll") for (int k = 0; k < 2; ++k) dst[n][k] = *(const LAS bf16x8*)(lds + PG8_SB(b, h) + boff + n * 2048 + k * 1024); } while (0)
#define PG8_MMA(ai, bj, At, Bt) do { __builtin_amdgcn_s_setprio(1); _Pragma("unroll") for (int m = 0; m < 4; ++m) _Pragma("unroll") for (int n = 0; n < 2; ++n) _Pragma("unroll") for (int k = 0; k < 2; ++k) \
        acc[ai][bj][m][n] = __builtin_amdgcn_mfma_f32_16x16x32_bf16(Bt[n][k], At[m][k], acc[ai][bj][m][n], 0, 0, 0); __builtin_amdgcn_s_setprio(0); } while (0)
#define PG8_WAIT_V(n) asm volatile("s_waitcnt vmcnt(" #n ")" ::: "memory")
#define PG8_WAIT_L(n) asm volatile("s_waitcnt lgkmcnt(" #n ")" ::: "memory")
#define PG8_BAR __builtin_amdgcn_s_barrier()
#define PG8_SCHED __builtin_amdgcn_sched_barrier(0)
    Unit cur, nxt; int ui = 0;
    if (!S.next(0, cur)) return;
    f32x4 acc[2][2][4][2];
#pragma unroll
    for (int a = 0; a < 2; ++a)
#pragma unroll
        for (int b = 0; b < 2; ++b)
#pragma unroll
            for (int m = 0; m < 4; ++m)
#pragma unroll
                for (int n = 0; n < 2; ++n) acc[a][b][m][n] = (f32x4){0.f, 0.f, 0.f, 0.f};
    bf16x8 At[4][2], B0[2][2], B1[2][2];
    const char* cA = (const char*)g.A + (size_t)cur.pm * tstepA; const char* cB = (const char*)g.Bt + (size_t)cur.pn * tstepB;
    PG8_STAGE(PG8_SB(0, 0), cB, voffB); PG8_STAGE(PG8_SB(0, 1), cB + hstepB, voffB); PG8_STAGE(PG8_SA(0, 0), cA, voffA); PG8_STAGE(PG8_SA(0, 1), cA + hstepA, voffA);
    if (wr == 1) PG8_BAR;
    PG8_WAIT_V(2); PG8_BAR;
    PG8_STAGE(PG8_SB(1, 0), cB + kstep, voffB); PG8_STAGE(PG8_SA(1, 0), cA + kstep, voffA); PG8_STAGE(PG8_SB(1, 1), cB + hstepB + kstep, voffB);
    PG8_WAIT_V(6); PG8_BAR;
    for (;;) {
        const bool has_next = S.next(ui + 1, nxt);
        const char* nA = has_next ? (const char*)g.A + (size_t)nxt.pm * tstepA : cA; const char* nB = has_next ? (const char*)g.Bt + (size_t)nxt.pn * tstepB : cB;
        for (int t = 0; t < nt; t += 2) {
            const bool last = (t == nt - 2);
            const char* a1 = cA + (size_t)(t + 1) * kstep;
            const char* a2 = last ? nA : cA + (size_t)(t + 2) * kstep; const char* b2 = last ? nB : cB + (size_t)(t + 2) * kstep;
            const char* a3 = a2 + kstep; const char* b3 = b2 + kstep;
            PG8_LDB(B0, 0, 0); PG8_LDB(B1, 0, 1); PG8_SCHED; PG8_LDA(At, 0, 0); PG8_STAGE(PG8_SA(1, 1), a1 + hstepA, voffA);
            PG8_WAIT_V(8); PG8_WAIT_L(0); PG8_BAR; PG8_MMA(0, 0, At, B0); PG8_MMA(0, 1, At, B1); PG8_BAR; PG8_SCHED;
            PG8_LDA(At, 0, 1); PG8_STAGE(PG8_SB(0, 0), b2, voffB); PG8_STAGE(PG8_SB(0, 1), b2 + hstepB, voffB); PG8_STAGE(PG8_SA(0, 0), a2, voffA);
            PG8_WAIT_V(8); PG8_WAIT_L(0); PG8_BAR; PG8_MMA(1, 0, At, B0); PG8_MMA(1, 1, At, B1); PG8_BAR; PG8_SCHED;
            PG8_LDB(B0, 1, 0); PG8_LDB(B1, 1, 1); PG8_SCHED; PG8_LDA(At, 1, 0); PG8_STAGE(PG8_SA(0, 1), a2 + hstepA, voffA);
            PG8_WAIT_V(8); PG8_WAIT_L(0); PG8_BAR; PG8_MMA(0, 0, At, B0); PG8_MMA(0, 1, At, B1); PG8_BAR; PG8_SCHED;
            PG8_LDA(At, 1, 1); PG8_STAGE(PG8_SB(1, 0), b3, voffB); PG8_STAGE(PG8_SB(1, 1), b3 + hstepB, voffB); PG8_STAGE(PG8_SA(1, 0), a3, voffA);
            PG8_WAIT_V(8); PG8_WAIT_L(0); PG8_BAR; PG8_MMA(1, 0, At, B0); PG8_MMA(1, 1, At, B1); PG8_BAR; PG8_SCHED;
        }
        if (wr == 0) PG8_BAR;
        if constexpr (!Epi::AFTER_DRAIN) E(acc, cur, wr, wc, fr, fq);
        if (!has_next) break;
#pragma unroll
        for (int a = 0; a < 2; ++a)
#pragma unroll
            for (int b = 0; b < 2; ++b)
#pragma unroll
                for (int m = 0; m < 4; ++m)
#pragma unroll
                    for (int n = 0; n < 2; ++n) acc[a][b][m][n] = (f32x4){0.f, 0.f, 0.f, 0.f};
        cur = nxt; cA = nA; cB = nB; ++ui;
        if (wr == 1) PG8_BAR;
    }
    PG8_WAIT_V(0);
    PG8_BAR;
    if constexpr (Epi::AFTER_DRAIN) E.fused(acc, cur, wr, wc, fr, fq, lds);
#undef PG8_SA
#undef PG8_SB
#undef PG8_STAGE
#undef PG8_LDA
#undef PG8_LDB
#undef PG8_MMA
#undef PG8_WAIT_V
#undef PG8_WAIT_L
#undef PG8_BAR
#undef PG8_SCHED
}

template <int MODE> struct Epi {
    static constexpr bool AFTER_DRAIN = false;
    bf16_t* O; int ldo;
    float* ssq;
    const bf16_t* Y; int ldy;
    const float* bias;
    __device__ __forceinline__ void operator()(const f32x4 (&acc)[2][2][4][2], const Unit& u, int wr, int wc, int fr, int fq) const {
#pragma unroll
        for (int ai = 0; ai < 2; ++ai)
#pragma unroll
            for (int m = 0; m < 4; ++m) {
                const int row = u.pm * BM + ai * HALF + wr * 64 + m * 16 + fr;
                float ss = 0.f;
#pragma unroll
                for (int bj = 0; bj < 2; ++bj) {
                    const int col0 = u.pn * BM + bj * HALF + wc * 32 + 8 * fq;
                    f32x4 v0 = acc[ai][bj][m][0], v1 = acc[ai][bj][m][1];
                    if (MODE == 1) { ss += v0[0] * v0[0] + v0[1] * v0[1] + v0[2] * v0[2] + v0[3] * v0[3] + v1[0] * v1[0] + v1[1] * v1[1] + v1[2] * v1[2] + v1[3] * v1[3]; }
                    if (MODE == 2) {
#pragma unroll
                        for (int j = 0; j < 4; ++j) { float a = fmaxf(v0[j], 0.f); v0[j] = a * a; float b = fmaxf(v1[j], 0.f); v1[j] = b * b; }
                    }
                    if (MODE == 3) {
                        const u32x4 yv = *(const u32x4*)(Y + (size_t)row * ldy + col0);
                        const f32x4 b0 = *(const f32x4*)(bias + col0), b1 = *(const f32x4*)(bias + col0 + 4);
                        v0[0] = bf_lo(yv.x) * sigmoidf_(v0[0] + b0[0]); v0[1] = bf_hi(yv.x) * sigmoidf_(v0[1] + b0[1]);
                        v0[2] = bf_lo(yv.y) * sigmoidf_(v0[2] + b0[2]); v0[3] = bf_hi(yv.y) * sigmoidf_(v0[3] + b0[3]);
                        v1[0] = bf_lo(yv.z) * sigmoidf_(v1[0] + b1[0]); v1[1] = bf_hi(yv.z) * sigmoidf_(v1[1] + b1[1]);
                        v1[2] = bf_lo(yv.w) * sigmoidf_(v1[2] + b1[2]); v1[3] = bf_hi(yv.w) * sigmoidf_(v1[3] + b1[3]);
                    }
                    u32x4 w; w.x = cvt_pk_bf16(v0[0], v0[1]); w.y = cvt_pk_bf16(v0[2], v0[3]); w.z = cvt_pk_bf16(v1[0], v1[1]); w.w = cvt_pk_bf16(v1[2], v1[3]);
                    *(u32x4*)(O + (size_t)row * ldo + col0) = w;
                }
                if (MODE == 1) {
                    ss += __shfl_xor(ss, 16); ss += __shfl_xor(ss, 32);
                    if (fq == 0) ssq[(size_t)row * 16 + u.pn * 4 + wc] = ss;
                }
            }
    }
};

struct EpiRes {
    static constexpr bool AFTER_DRAIN = true;
    const float* hin; float* h;
    const float* g1; const float* g2;
    bf16_t* HN;
    float* xb1; float* xb2;
    unsigned* c1; unsigned* c2;
    __device__ __forceinline__ void exchange(const f32x4 (&acc)[2][2][4][2], const Unit& u, int wr, int wc, int fr, int fq, LAS unsigned char* lds, float* xb, unsigned* cnt) const {
        LAS float* P = (LAS float*)lds; LAS float* S = (LAS float*)(lds + 4096);
        const int tid = threadIdx.x;
#pragma unroll
        for (int ai = 0; ai < 2; ++ai)
#pragma unroll
            for (int m = 0; m < 4; ++m) {
                float ss = 0.f;
#pragma unroll
                for (int bj = 0; bj < 2; ++bj)
#pragma unroll
                    for (int n = 0; n < 2; ++n) { const f32x4 v = acc[ai][bj][m][n]; ss += v[0] * v[0] + v[1] * v[1] + v[2] * v[2] + v[3] * v[3]; }
                ss += __shfl_xor(ss, 16); ss += __shfl_xor(ss, 32);
                if (fq == 0) P[(ai * HALF + wr * 64 + m * 16 + fr) * 4 + wc] = ss;
            }
        __syncthreads();
        if (tid < 256) { const f32x4 p = *(const LAS f32x4*)(P + tid * 4); st_agent(xb + ((size_t)u.pm * 256 + tid) * 4 + u.pn, (p[0] + p[1]) + (p[2] + p[3])); }
        asm volatile("s_waitcnt vmcnt(0)" ::: "memory");
        __syncthreads();
        if (tid == 0) cnt_arrive_wait(cnt + u.pm * 32, 4u);
        __syncthreads();
        if (tid < 256) { const float* q = xb + ((size_t)u.pm * 256 + tid) * 4; const float t = (ld_agent(q) + ld_agent(q + 1)) + (ld_agent(q + 2) + ld_agent(q + 3));
            S[tid] = rsqrtf(t * (1.f / 1024.f) + EPS); }
        __syncthreads();
    }
    __device__ __forceinline__ void fused(f32x4 (&acc)[2][2][4][2], const Unit& u, int wr, int wc, int fr, int fq, LAS unsigned char* lds) const {
        const LAS float* S = (const LAS float*)(lds + 4096);
        exchange(acc, u, wr, wc, fr, fq, lds, xb1, c1);
#pragma unroll
        for (int bj = 0; bj < 2; ++bj) {
            const int col0 = u.pn * BM + bj * HALF + wc * 32 + 8 * fq;
            const f32x4 ga = *(const f32x4*)(g1 + col0), gb = *(const f32x4*)(g1 + col0 + 4);
#pragma unroll
            for (int ai = 0; ai < 2; ++ai)
#pragma unroll
                for (int m = 0; m < 4; ++m) {
                    const int rl = ai * HALF + wr * 64 + m * 16 + fr; const float inv = S[rl];
                    float* hp = h + (size_t)(u.pm * BM + rl) * 1024 + col0;
                    const float* hq = hin + (size_t)(u.pm * BM + rl) * 1024 + col0;
                    const f32x4 h0 = *(const f32x4*)hq, h1 = *(const f32x4*)(hq + 4);
                    f32x4 v0 = acc[ai][bj][m][0], v1 = acc[ai][bj][m][1];
                    v0 = h0 + v0 * inv * ga; v1 = h1 + v1 * inv * gb;
                    *(f32x4*)hp = v0; *(f32x4*)(hp + 4) = v1;
                    acc[ai][bj][m][0] = v0; acc[ai][bj][m][1] = v1;
                }
        }
        if (g2 == nullptr) return;
        __syncthreads();
        exchange(acc, u, wr, wc, fr, fq, lds, xb2, c2);
#pragma unroll
        for (int bj = 0; bj < 2; ++bj) {
            const int col0 = u.pn * BM + bj * HALF + wc * 32 + 8 * fq;
            const f32x4 ga = *(const f32x4*)(g2 + col0), gb = *(const f32x4*)(g2 + col0 + 4);
#pragma unroll
            for (int ai = 0; ai < 2; ++ai)
#pragma unroll
                for (int m = 0; m < 4; ++m) {
                    const int rl = ai * HALF + wr * 64 + m * 16 + fr; const float inv = S[rl];
                    const f32x4 v0 = acc[ai][bj][m][0] * inv * ga, v1 = acc[ai][bj][m][1] * inv * gb;
                    u32x4 w; w.x = cvt_pk_bf16(v0[0], v0[1]); w.y = cvt_pk_bf16(v0[2], v0[3]); w.z = cvt_pk_bf16(v1[0], v1[1]); w.w = cvt_pk_bf16(v1[2], v1[3]);
                    *(u32x4*)(HN + (size_t)(u.pm * BM + rl) * 1024 + col0) = w;
                }
        }
    }
};
}

__device__ __forceinline__ bf16x8 ldsfrag(const LAS unsigned char* p) { return *(const LAS bf16x8*)p; }
#define LBAR() do { asm volatile("s_waitcnt lgkmcnt(0)" ::: "memory"); __builtin_amdgcn_s_barrier(); asm volatile("" ::: "memory"); } while (0)
#define MFMA16(X, Y, ACC) __builtin_amdgcn_mfma_f32_16x16x32_bf16((X), (Y), (ACC), 0, 0, 0)


template <int MODE>
__device__ __forceinline__ void meta_gemm(LAS unsigned char* L, const bf16_t* A, int lda, const bf16_t* Bt, int N, int K,
                                          bf16_t* O, int ldo, float* ssq, const bf16_t* Y, int ldy, const float* bias,
                                          float* hm = nullptr, const float* g1 = nullptr, const float* g2 = nullptr, float* xm1 = nullptr, float* xm2 = nullptr, unsigned* cm1 = nullptr, unsigned* cm2 = nullptr) {
    int tid_ = threadIdx.x; asm volatile("" : "+v"(tid_));
    const int tid = tid_, lane = tid & 63, w = __builtin_amdgcn_readfirstlane(tid >> 6), fr = lane & 15, fq = lane >> 4;
    const int t = (int)gridDim.x - 1 - (int)blockIdx.x;
    if (t >= N / 64) return;
    const int n0 = t * 64, kw = K / 8, k0 = w * kw;
    f32x4 acc[4];
#pragma unroll
    for (int nt = 0; nt < 4; ++nt) acc[nt] = (f32x4){0.f, 0.f, 0.f, 0.f};
    const bf16_t* ap = A + (size_t)fr * lda + k0 + fq * 8;
    const bf16_t* bp = Bt + (size_t)(n0 + fr) * K + k0 + fq * 8;
#pragma unroll 2
    for (int k = 0; k < kw; k += 32) {
        const bf16x8 af = *(const bf16x8*)(ap + k);
#pragma unroll
        for (int nt = 0; nt < 4; ++nt) { const bf16x8 bf = *(const bf16x8*)(bp + (size_t)nt * 16 * K + k); acc[nt] = MFMA16(bf, af, acc[nt]); }
    }
    LAS f32x4* P = (LAS f32x4*)L;
#pragma unroll
    for (int nt = 0; nt < 4; ++nt) P[(w * 4 + nt) * 64 + lane] = acc[nt];
    __syncthreads();
    if (MODE == 4) {
        if (w == 0) {
            f32x4 v[4]; float ss = 0.f;
#pragma unroll
            for (int nt = 0; nt < 4; ++nt) { v[nt] = P[nt * 64 + lane];
#pragma unroll
                for (int ww = 1; ww < 8; ++ww) v[nt] += P[(ww * 4 + nt) * 64 + lane];
                ss += v[nt][0] * v[nt][0] + v[nt][1] * v[nt][1] + v[nt][2] * v[nt][2] + v[nt][3] * v[nt][3]; }
            ss += __shfl_xor(ss, 16); ss += __shfl_xor(ss, 32);
            if (fq == 0) st_agent(xm1 + fr * 16 + t, ss);
            asm volatile("s_waitcnt vmcnt(0)" ::: "memory");
            if (lane == 0) cnt_arrive_wait(cm1, 16u);
            __builtin_amdgcn_wave_barrier();
            float tot = 0.f;
#pragma unroll
            for (int q = 0; q < 16; ++q) tot += ld_agent(xm1 + fr * 16 + q);
            const float inv = rsqrtf(tot * (1.f / 1024.f) + EPS);
            float ss2 = 0.f;
#pragma unroll
            for (int nt = 0; nt < 4; ++nt) { const int col = n0 + nt * 16 + 4 * fq; float* hp = hm + fr * 1024 + col;
                const f32x4 gg = *(const f32x4*)(g1 + col); const f32x4 h0 = *(const f32x4*)hp;
                v[nt] = h0 + v[nt] * inv * gg; *(f32x4*)hp = v[nt];
                ss2 += v[nt][0] * v[nt][0] + v[nt][1] * v[nt][1] + v[nt][2] * v[nt][2] + v[nt][3] * v[nt][3]; }
            if (g2 != nullptr) {
                ss2 += __shfl_xor(ss2, 16); ss2 += __shfl_xor(ss2, 32);
                if (fq == 0) st_agent(xm2 + fr * 16 + t, ss2);
                asm volatile("s_waitcnt vmcnt(0)" ::: "memory");
                if (lane == 0) cnt_arrive_wait(cm2, 16u);
                __builtin_amdgcn_wave_barrier();
                float tot2 = 0.f;
#pragma unroll
                for (int q = 0; q < 16; ++q) tot2 += ld_agent(xm2 + fr * 16 + q);
                const float inv2 = rsqrtf(tot2 * (1.f / 1024.f) + EPS);
#pragma unroll
                for (int nt = 0; nt < 4; ++nt) { const int col = n0 + nt * 16 + 4 * fq; const f32x4 gg = *(const f32x4*)(g2 + col);
                    const f32x4 y = v[nt] * inv2 * gg; u32x2 o; o.x = cvt_pk_bf16(y[0], y[1]); o.y = cvt_pk_bf16(y[2], y[3]);
                    *(u32x2*)(O + (size_t)fr * ldo + col) = o; }
            }
        }
    } else if (w == 0) {
        float ss = 0.f;
#pragma unroll
        for (int nt = 0; nt < 4; ++nt) {
            f32x4 v = P[nt * 64 + lane];
#pragma unroll
            for (int ww = 1; ww < 8; ++ww) v += P[(ww * 4 + nt) * 64 + lane];
            const int col = n0 + nt * 16 + 4 * fq;
            if (MODE == 1) ss += v[0] * v[0] + v[1] * v[1] + v[2] * v[2] + v[3] * v[3];
            if (MODE == 2) {
#pragma unroll
                for (int j = 0; j < 4; ++j) { const float r = fmaxf(v[j], 0.f); v[j] = r * r; }
            }
            if (MODE == 3) {
                const u32x2 yv = *(const u32x2*)(Y + (size_t)fr * ldy + col);
                const f32x4 bb = *(const f32x4*)(bias + col);
                v[0] = bf_lo(yv.x) * sigmoidf_(v[0] + bb[0]); v[1] = bf_hi(yv.x) * sigmoidf_(v[1] + bb[1]);
                v[2] = bf_lo(yv.y) * sigmoidf_(v[2] + bb[2]); v[3] = bf_hi(yv.y) * sigmoidf_(v[3] + bb[3]);
            }
            u32x2 o; o.x = cvt_pk_bf16(v[0], v[1]); o.y = cvt_pk_bf16(v[2], v[3]);
            *(u32x2*)(O + (size_t)fr * ldo + col) = o;
        }
        if (MODE == 1) {
            ss += __shfl_xor(ss, 16); ss += __shfl_xor(ss, 32);
            if (fq == 0) ssq[fr * 16 + t] = ss;
        }
    }
    __syncthreads();
}

__device__ __forceinline__ void transpose_item(const float* W, int K, int N, bf16_t* WT, int dst_row0, LAS float* scr, int k0, int n0, int lane) {
#pragma unroll 8
    for (int i = 0; i < 32; ++i) { const int kk = 2 * i + (lane >> 5); scr[kk * 33 + (lane & 31)] = W[(size_t)(k0 + kk) * N + n0 + (lane & 31)]; }
    asm volatile("s_waitcnt lgkmcnt(0)" ::: "memory");
    const int c = lane & 7;
#pragma unroll
    for (int j = 0; j < 4; ++j) { const int n = (lane >> 3) + 8 * j; const LAS float* s = scr + (8 * c) * 33 + n;
        u32x4 o; o.x = cvt_pk_bf16(s[0 * 33], s[1 * 33]); o.y = cvt_pk_bf16(s[2 * 33], s[3 * 33]); o.z = cvt_pk_bf16(s[4 * 33], s[5 * 33]); o.w = cvt_pk_bf16(s[6 * 33], s[7 * 33]);
        *(u32x4*)(WT + (size_t)(dst_row0 + n) * K + k0 + 8 * c) = o; }
    asm volatile("s_waitcnt lgkmcnt(0)" ::: "memory");
}


constexpr int WC_I0 = 16 * 160, WC_I1 = 32 * 32, WC_I2 = 16 * 128, WC_I3 = 64 * 32, WC_I4 = 16 * 80, WC_I5 = 16 * 32, WC_I6 = 8 * 16, WC_I7 = WC_I2, WC_I8 = WC_I3;
constexpr int WC_C0 = 0, WC_C1 = WC_I0, WC_C5 = WC_I0 + WC_I1 + WC_I2 + WC_I3 + WC_I4, WC_C9 = WC_C5 + WC_I5 + WC_I6 + WC_I7 + WC_I8;
__device__ __forceinline__ void weight_convert(const Args& a, LAS unsigned char* lds, int it0, int it1, int vb, int nvb) {
    int tid_ = threadIdx.x; asm volatile("" : "+v"(tid_));
    const int tid = tid_, lane = tid & 63, wave = tid >> 6;
    unsigned char* ws = a.ws;
    LAS float* scr = (LAS float*)(lds + wave * 16384);
    constexpr int I0 = WC_I0, I1 = WC_I1, I2 = WC_I2, I3 = WC_I3, I4 = WC_I4, I5 = WC_I5, I6 = WC_I6, I7 = WC_I7;
    for (int it = it0 + vb * 8 + wave; it < it1; it += nvb * 8) {
        int r = it; const float* W; int K, N; bf16_t* WT; bool perm = false;
        if (r < I0) { W = a.in[2]; K = 1024; N = 5120; WT = (bf16_t*)(ws + W_INAB); perm = true; }
        else if ((r -= I0) < I1) { W = a.in[3]; K = 2048; N = 1024; WT = (bf16_t*)(ws + W_OUTAB); }
        else if ((r -= I1) < I2) { W = a.in[27]; K = 1024; N = 4096; WT = (bf16_t*)(ws + W_W1_0); }
        else if ((r -= I2) < I3) { W = a.in[28]; K = 4096; N = 1024; WT = (bf16_t*)(ws + W_W2_0); }
        else if ((r -= I3) < I4) { W = a.in[12]; K = 1024; N = 2560; WT = (bf16_t*)(ws + W_INCD); }
        else if ((r -= I4) < I5) { W = a.in[13]; K = 1024; N = 1024; WT = (bf16_t*)(ws + W_OUTCD); }
        else if ((r -= I5) < I6) { W = a.in[22]; K = 512; N = 512; WT = (bf16_t*)(ws + W_GLU); }
        else if ((r -= I6) < I7) { W = a.in[27] + (size_t)1024 * 4096; K = 1024; N = 4096; WT = (bf16_t*)(ws + W_W1_1); }
        else { r -= I7; W = a.in[28] + (size_t)1024 * 4096; K = 4096; N = 1024; WT = (bf16_t*)(ws + W_W2_1); }
        const int nblk = N / 32, kb = r / nblk, nb = r % nblk, n0 = nb * 32;
        int d0 = n0;
        if (perm) { if (n0 >= 2048 && n0 < 3072) d0 = n0 + 1024; else if (n0 >= 3072 && n0 < 4096) d0 = n0 - 1024; }
        transpose_item(W, K, N, WT, d0, scr, kb * 64, n0, lane);
    }
}

__device__ __forceinline__ void phase_prologue(const Args& a, LAS unsigned char* lds, bool copy_x) {
    int tid_ = threadIdx.x; asm volatile("" : "+v"(tid_));
    const int tid = tid_, lane = tid & 63, wave = tid >> 6;
    const int gw = blockIdx.x * 8 + wave, NGW = gridDim.x * 8;
    unsigned char* ws = a.ws;
    LAS float* scr = (LAS float*)(lds + wave * 16384);
    weight_convert(a, lds, WC_C0, WC_C1, blockIdx.x, gridDim.x);
    {
        const float* x = a.in[0]; const float* meta = a.in[1]; const float* g = a.in[26];
        bf16_t* HN = (bf16_t*)(ws + HN_OFF);
        for (int row = gw; row < R; row += NGW) {
            const float* src = row < RM ? x + (size_t)row * DM : meta + (size_t)(row - RM) * DM;
            float* hr = hrow(a, row);
            f32x4 v[4]; float s = 0.f;
#pragma unroll
            for (int j = 0; j < 4; ++j) { v[j] = *(const f32x4*)(src + 4 * lane + 256 * j); if (copy_x || row >= RM) *(f32x4*)(hr + 4 * lane + 256 * j) = v[j];
                s += v[j][0] * v[j][0] + v[j][1] * v[j][1] + v[j][2] * v[j][2] + v[j][3] * v[j][3]; }
            const float inv = rsqrtf(wave_sum(s) * (1.f / DM) + EPS);
#pragma unroll
            for (int j = 0; j < 4; ++j) { const f32x4 gg = *(const f32x4*)(g + 4 * lane + 256 * j);
                u32x2 o; o.x = cvt_pk_bf16(v[j][0] * inv * gg[0], v[j][1] * inv * gg[1]); o.y = cvt_pk_bf16(v[j][2] * inv * gg[2], v[j][3] * inv * gg[3]);
                *(u32x2*)(HN + (size_t)row * DM + 4 * lane + 256 * j) = o; }
        }
    }
    const int gt = blockIdx.x * NTHREADS + tid, NGT = gridDim.x * NTHREADS;
    {
        bf16_t* WG = (bf16_t*)(ws + LRUW_OFF);
        for (int i = gt; i < 16 * 128 * 64; i += NGT) { const int k = i & 63, n = (i >> 6) & 127, blk = i >> 13;
            const float v = n < 64 ? a.in[5][(size_t)blk * 4096 + k * 64 + n] : a.in[7][(size_t)blk * 4096 + k * 64 + (n - 64)];
            WG[i] = f2bf(v); }
    }
    {
        bf16_t* BB = (bf16_t*)(ws + S5BB_OFF); bf16_t* CM = (bf16_t*)(ws + S5CM_OFF); float* AB = (float*)(ws + S5AB_OFF);
        const float* are_log = a.in[14]; const float* aim = a.in[15]; const float* bre = a.in[16]; const float* bim = a.in[17];
        const float* cre = a.in[18]; const float* cim = a.in[19]; const float* ldt = a.in[21];
        for (int i = gt; i < 32 * 64; i += NGT) {
            const int g = i >> 6, p = i & 63;
            const float dt = expf(ldt[g]); const float a_re = -expf(are_log[i]); const float a_im = aim[i];
            const float mag = expf(dt * a_re); float sn, cs; sincos_big(dt * a_im, sn, cs);
            const float ab_re = mag * cs, ab_im = mag * sn;
            AB[2 * i] = ab_re; AB[2 * i + 1] = ab_im;
            const float n_re = ab_re - 1.f, n_im = ab_im, den = a_re * a_re + a_im * a_im;
            const float z_re = (n_re * a_re + n_im * a_im) / den, z_im = (n_im * a_re - n_re * a_im) / den;
            for (int c = 0; c < 32; ++c) {
                float vr = 0.f, vi = 0.f;
                if (c < 16) { const float br = bre[(size_t)i * 16 + c], bi = bim[(size_t)i * 16 + c]; vr = z_re * br - z_im * bi; vi = z_re * bi + z_im * br; }
                BB[((size_t)g * 128 + p) * 32 + c] = f2bf(vr);
                BB[((size_t)g * 128 + 64 + p) * 32 + c] = f2bf(vi);
            }
            for (int c = 0; c < 16; ++c) {
                CM[((size_t)g * 16 + c) * 128 + p] = f2bf(cre[((size_t)g * 16 + c) * 64 + p]);
                CM[((size_t)g * 16 + c) * 128 + 64 + p] = f2bf(-cim[((size_t)g * 16 + c) * 64 + p]);
            }
        }
    }
}

__device__ __forceinline__ void phase_resnorm(const Args& a, const float* g1, const float* g2) {
    int tid_ = threadIdx.x; asm volatile("" : "+v"(tid_));
    const int tid = tid_, lane = tid & 63, wave = tid >> 6;
    const int gw = blockIdx.x * 8 + wave, NGW = gridDim.x * 8;
    bf16_t* HN = (bf16_t*)(a.ws + HN_OFF); const float* ssq = (const float*)(a.ws + SSQ_OFF);
    for (int row = gw; row < R; row += NGW) {
        bf16_t* mrow = HN + (size_t)row * DM;
        float s = 0.f;
        { const f32x4* sp = (const f32x4*)(ssq + (size_t)row * 16); const f32x4 s0 = sp[0], s1 = sp[1], s2 = sp[2], s3 = sp[3];
          s = ((s0[0] + s0[1]) + (s0[2] + s0[3])) + ((s1[0] + s1[1]) + (s1[2] + s1[3])) + ((s2[0] + s2[1]) + (s2[2] + s2[3])) + ((s3[0] + s3[1]) + (s3[2] + s3[3])); }
        const float inv = rsqrtf(s * (1.f / DM) + EPS);
        float* hr = hrow(a, row);
        f32x4 v[4]; float s2 = 0.f;
#pragma unroll
        for (int j = 0; j < 4; ++j) {
            const u32x2 mv = *(const u32x2*)(mrow + 4 * lane + 256 * j);
            const f32x4 gg = *(const f32x4*)(g1 + 4 * lane + 256 * j);
            v[j] = *(const f32x4*)(hr + 4 * lane + 256 * j);
            v[j][0] += bf_lo(mv.x) * inv * gg[0]; v[j][1] += bf_hi(mv.x) * inv * gg[1]; v[j][2] += bf_lo(mv.y) * inv * gg[2]; v[j][3] += bf_hi(mv.y) * inv * gg[3];
            *(f32x4*)(hr + 4 * lane + 256 * j) = v[j];
            s2 += v[j][0] * v[j][0] + v[j][1] * v[j][1] + v[j][2] * v[j][2] + v[j][3] * v[j][3];
        }
        if (g2) {
            const float inv2 = rsqrtf(wave_sum(s2) * (1.f / DM) + EPS);
#pragma unroll
            for (int j = 0; j < 4; ++j) { const f32x4 gg = *(const f32x4*)(g2 + 4 * lane + 256 * j);
                u32x2 o; o.x = cvt_pk_bf16(v[j][0] * inv2 * gg[0], v[j][1] * inv2 * gg[1]); o.y = cvt_pk_bf16(v[j][2] * inv2 * gg[2], v[j][3] * inv2 * gg[3]);
                *(u32x2*)(mrow + 4 * lane + 256 * j) = o; }
        }
    }
}

constexpr int LA_QS = 0, LA_KS = 17408, LA_QD = 34816, LA_KT = 52224, LA_VT = 70656, LA_PS = 75264, LA_ST = 84480, LA_CUM = 93184, LA_DEC = 125952, LA_END = 126464;
static_assert(LA_END <= LDS_BYTES, "LA lds");

template <bool HG>
__device__ __forceinline__ void la_core(LAS unsigned char* L, f32x4 (&st)[2], float l2g, bf16_t* obuf, int ldo, int ocol, int b, int n, bool dry) {
    int tid_ = threadIdx.x; asm volatile("" : "+v"(tid_));
    const int tid = tid_, lane = tid & 63, w = __builtin_amdgcn_readfirstlane(tid >> 6), fr = lane & 15, fq = lane >> 4;
    const int mt = w >> 1, nh = w & 1;
    bf16x8 qf[4];
#pragma unroll
    for (int kk = 0; kk < 4; ++kk) qf[kk] = ldsfrag(L + LA_QS + (mt * 16 + fr) * 272 + kk * 64 + fq * 16);
    f32x4 s0 = {0.f, 0.f, 0.f, 0.f}, s1 = {0.f, 0.f, 0.f, 0.f};
#pragma unroll
    for (int kk = 0; kk < 4; ++kk) {
        const bf16x8 k0 = ldsfrag(L + LA_KS + ((nh * 2) * 16 + fr) * 272 + kk * 64 + fq * 16);
        const bf16x8 k1 = ldsfrag(L + LA_KS + ((nh * 2 + 1) * 16 + fr) * 272 + kk * 64 + fq * 16);
        s0 = MFMA16(k0, qf[kk], s0); s1 = MFMA16(k1, qf[kk], s1);
    }
    const int t = mt * 16 + fr;
    {
        float p0[4], p1[4];
#pragma unroll
        for (int jj = 0; jj < 4; ++jj) {
            const int sa = (nh * 2) * 16 + 4 * fq + jj, sb = sa + 16;
            if (HG) { p0[jj] = sa <= t ? s0[jj] : 0.f; p1[jj] = sb <= t ? s1[jj] : 0.f; }
            else { p0[jj] = s0[jj] * exp2f(l2g * fabsf((float)(t - sa))); p1[jj] = s1[jj] * exp2f(l2g * fabsf((float)(t - sb))); }
        }
        u32x2 o0, o1; o0.x = cvt_pk_bf16(p0[0], p0[1]); o0.y = cvt_pk_bf16(p0[2], p0[3]); o1.x = cvt_pk_bf16(p1[0], p1[1]); o1.y = cvt_pk_bf16(p1[2], p1[3]);
        *(LAS u32x2*)(L + LA_PS + t * 144 + ((nh * 2) * 16 + 4 * fq) * 2) = o0;
        *(LAS u32x2*)(L + LA_PS + t * 144 + ((nh * 2 + 1) * 16 + 4 * fq) * 2) = o1;
    }
    f32x4 o = {0.f, 0.f, 0.f, 0.f};
#pragma unroll
    for (int kk = 0; kk < 4; ++kk) {
        const bf16x8 sf = ldsfrag(L + LA_ST + (nh * 16 + fr) * 272 + kk * 64 + fq * 16);
        const bf16x8 qq = HG ? ldsfrag(L + LA_QD + (mt * 16 + fr) * 272 + kk * 64 + fq * 16) : qf[kk];
        o = MFMA16(sf, qq, o);
    }
    if (!HG) { const float sc = exp2f(l2g * (float)(t + 1)); o[0] *= sc; o[1] *= sc; o[2] *= sc; o[3] *= sc; }
    LBAR();
#pragma unroll
    for (int kk = 0; kk < 2; ++kk) {
        const bf16x8 vf = ldsfrag(L + LA_VT + (nh * 16 + fr) * 144 + kk * 64 + fq * 16);
        const bf16x8 pf = ldsfrag(L + LA_PS + (mt * 16 + fr) * 144 + kk * 64 + fq * 16);
        o = MFMA16(vf, pf, o);
    }
    {
        const int row = chunk_row(b, n, t);
        if (row >= 0 && (row < RM || b == 0) && !dry) { u32x2 ov; ov.x = cvt_pk_bf16(o[0], o[1]); ov.y = cvt_pk_bf16(o[2], o[3]);
            *(u32x2*)(obuf + (size_t)row * ldo + ocol + nh * 16 + 4 * fq) = ov; }
    }
    float dc[4];
    if (HG) { const f32x4 dv = *(const LAS f32x4*)(L + LA_DEC + (w * 16 + 4 * fq) * 4); dc[0] = dv[0]; dc[1] = dv[1]; dc[2] = dv[2]; dc[3] = dv[3]; }
    else { const float g64 = exp2f(l2g * 64.f); dc[0] = dc[1] = dc[2] = dc[3] = g64; }
    const bf16x8 kt0 = ldsfrag(L + LA_KT + (w * 16 + fr) * 144 + fq * 16), kt1 = ldsfrag(L + LA_KT + (w * 16 + fr) * 144 + 64 + fq * 16);
#pragma unroll
    for (int et = 0; et < 2; ++et) {
#pragma unroll
        for (int jj = 0; jj < 4; ++jj) st[et][jj] *= dc[jj];
        const bf16x8 v0 = ldsfrag(L + LA_VT + (et * 16 + fr) * 144 + fq * 16), v1 = ldsfrag(L + LA_VT + (et * 16 + fr) * 144 + 64 + fq * 16);
        st[et] = MFMA16(kt0, v0, st[et]); st[et] = MFMA16(kt1, v1, st[et]);
        u32x2 sv; sv.x = cvt_pk_bf16(st[et][0], st[et][1]); sv.y = cvt_pk_bf16(st[et][2], st[et][3]);
        *(LAS u32x2*)(L + LA_ST + (et * 16 + fr) * 272 + (w * 16 + 4 * fq) * 2) = sv;
    }
}

#define UNPK8(dst, v) do { dst[0] = bf_lo((v).x); dst[1] = bf_hi((v).x); dst[2] = bf_lo((v).y); dst[3] = bf_hi((v).y); dst[4] = bf_lo((v).z); dst[5] = bf_hi((v).z); dst[6] = bf_lo((v).w); dst[7] = bf_hi((v).w); } while (0)
#define PK8(v, src) do { (v).x = cvt_pk_bf16(src[0], src[1]); (v).y = cvt_pk_bf16(src[2], src[3]); (v).z = cvt_pk_bf16(src[4], src[5]); (v).w = cvt_pk_bf16(src[6], src[7]); } while (0)

__device__ __forceinline__ void retention_unit(const Args& a, LAS unsigned char* L, int unit, bool dry) {
    int tid_ = threadIdx.x; asm volatile("" : "+v"(tid_));
    const int tid = tid_, b = unit >> 5, h = (unit >> 3) & 3, sl = unit & 7;
    const bf16_t* Z = (const bf16_t*)(a.ws + Z_OFF); bf16_t* OB = (bf16_t*)(a.ws + HN_OFF);
    const float l2g = log2f(1.f - exp2f(-5.f - (float)h));
    const int row_l = tid >> 3, c8 = tid & 7;
    const int vrow = (tid >> 2) & 63, vp = tid & 3;
    float rc[8], rs[8], stc[8], sts[8];
#pragma unroll
    for (int i = 0; i < 8; ++i) { const float invf = exp2f(-(float)(c8 * 8 + i) * (13.287712379549449f / 64.f));
        sincos_big((float)(row_l - 48) * invf, rs[i], rc[i]); sincos_big(64.f * invf, sts[i], stc[i]); }
    f32x4 st[2] = {{0.f, 0.f, 0.f, 0.f}, {0.f, 0.f, 0.f, 0.f}};
    for (int i = tid; i < 32 * 272 / 4; i += NTHREADS) ((LAS unsigned*)(L + LA_ST))[i] = 0u;
    u32x4 q1, q2, k1, k2, vv;
#define RET_LOAD(n_) do { const int r_ = chunk_row(b, (n_), row_l); \
        if (r_ >= 0) { const bf16_t* zr = Z + (size_t)r_ * IN_AB; \
            q1 = *(const u32x4*)(zr + h * 128 + c8 * 8); q2 = *(const u32x4*)(zr + h * 128 + 64 + c8 * 8); \
            k1 = *(const u32x4*)(zr + 512 + h * 128 + c8 * 8); k2 = *(const u32x4*)(zr + 512 + h * 128 + 64 + c8 * 8); \
        } else { q1 = q2 = k1 = k2 = (u32x4){0u, 0u, 0u, 0u}; } \
        vv = (u32x4){0u, 0u, 0u, 0u}; \
        if (tid < 256) { const int rv = chunk_row(b, (n_), vrow); if (rv >= 0) vv = *(const u32x4*)(Z + (size_t)rv * IN_AB + 1024 + h * 256 + sl * 32 + vp * 8); } } while (0)
    RET_LOAD(0);
    for (int n = 0; n < NCH; ++n) {
        {
            const float kdec = exp2f(l2g * (float)(63 - row_l));
            float x1[8], x2[8], y1[8], y2[8], qo1[8], qo2[8], ko1[8], ko2[8];
            UNPK8(x1, q1); UNPK8(x2, q2); UNPK8(y1, k1); UNPK8(y2, k2);
#pragma unroll
            for (int i = 0; i < 8; ++i) {
                const float sn = rs[i], cs = rc[i];
                rc[i] = cs * stc[i] - sn * sts[i]; rs[i] = sn * stc[i] + cs * sts[i];
                qo1[i] = (x1[i] * cs - x2[i] * sn) * 0.08838834764831845f; qo2[i] = (x1[i] * sn + x2[i] * cs) * 0.08838834764831845f;
                ko1[i] = y1[i] * cs - y2[i] * sn; ko2[i] = y1[i] * sn + y2[i] * cs;
            }
            u32x4 w1, w2;
            PK8(w1, qo1); PK8(w2, qo2);
            *(LAS u32x4*)(L + LA_QS + row_l * 272 + c8 * 16) = w1; *(LAS u32x4*)(L + LA_QS + row_l * 272 + 128 + c8 * 16) = w2;
            PK8(w1, ko1); PK8(w2, ko2);
            *(LAS u32x4*)(L + LA_KS + row_l * 272 + c8 * 16) = w1; *(LAS u32x4*)(L + LA_KS + row_l * 272 + 128 + c8 * 16) = w2;
#pragma unroll
            for (int i = 0; i < 8; ++i) {
                *(LAS bf16_t*)(L + LA_KT + (c8 * 8 + i) * 144 + row_l * 2) = f2bf(ko1[i] * kdec);
                *(LAS bf16_t*)(L + LA_KT + (64 + c8 * 8 + i) * 144 + row_l * 2) = f2bf(ko2[i] * kdec);
            }
            if (tid < 256) {
                const unsigned va[4] = {vv.x, vv.y, vv.z, vv.w};
#pragma unroll
                for (int i = 0; i < 8; ++i) *(LAS bf16_t*)(L + LA_VT + (vp * 8 + i) * 144 + vrow * 2) = (bf16_t)((i & 1) ? (va[i >> 1] >> 16) : (va[i >> 1] & 0xffffu));
            }
        }
        if (n + 1 < NCH) RET_LOAD(n + 1);
        LBAR();
        la_core<false>(L, st, l2g, OB, DM, h * 256 + sl * 32, b, n, dry);
        LBAR();
    }
#undef RET_LOAD
}

constexpr size_t HGT_OFF = Z_OFF + (size_t)R * IN_CD * 2;
constexpr size_t HGT_ITEM = 71680;
static_assert(HGT_OFF + (size_t)NB * NCH * 4 * HGT_ITEM <= HN_OFF, "HGRN tile images fit behind z_cd");
__device__ __forceinline__ void hgrn_prepass(const Args& a, LAS unsigned char* L) {
    int tid_ = threadIdx.x; asm volatile("" : "+v"(tid_));
    const int tid = tid_;
    const bf16_t* Z = (const bf16_t*)(a.ws + Z_OFF);
    const int row_l = tid >> 3, c8 = tid & 7;
    const float* lg = a.in[25];
    for (int it = blockIdx.x; it < NB * NCH * 4; it += gridDim.x) {
        const int h = it & 3, bn = it >> 2, b = bn / NCH, n = bn % NCH;
        float lb1[8], lb2[8];
#pragma unroll
        for (int i = 0; i < 8; ++i) { const int d = h * 128 + c8 * 8 + i; lb1[i] = sigmoidf_(lg[d] - lg[512 + d]); lb2[i] = sigmoidf_(lg[d + 64] - lg[512 + d + 64]); }
        const int r = chunk_row(b, n, row_l);
        const bool valid = r >= 0;
        u32x4 q1, q2, f1, f2;
        if (valid) { const bf16_t* zr = Z + (size_t)r * IN_CD;
            q1 = *(const u32x4*)(zr + 512 + h * 128 + c8 * 8); q2 = *(const u32x4*)(zr + 512 + h * 128 + 64 + c8 * 8);
            f1 = *(const u32x4*)(zr + 1024 + h * 128 + c8 * 8); f2 = *(const u32x4*)(zr + 1024 + h * 128 + 64 + c8 * 8);
        } else { q1 = q2 = f1 = f2 = (u32x4){0u, 0u, 0u, 0u}; }
        float qv1[8], qv2[8], kv1[8], kv2[8];
        {
            float fp1[8], fp2[8], lf1[8], lf2[8];
            UNPK8(qv1, q1); UNPK8(qv2, q2); UNPK8(fp1, f1); UNPK8(fp2, f2);
#pragma unroll
            for (int i = 0; i < 8; ++i) {
                const float ff1 = lb1[i] + (1.f - lb1[i]) * sigmoidf_(fp1[i]), ff2 = lb2[i] + (1.f - lb2[i]) * sigmoidf_(fp2[i]);
                if (valid) { lf1[i] = __logf(ff1); lf2[i] = __logf(ff2); kv1[i] = 1.f - ff1; kv2[i] = 1.f - ff2; }
                else { lf1[i] = 0.f; lf2[i] = 0.f; kv1[i] = 0.f; kv2[i] = 0.f; qv1[i] = 0.f; qv2[i] = 0.f; }
            }
            LAS float* cr = (LAS float*)(L + LA_CUM) + row_l * 128;
            *(LAS f32x4*)(cr + c8 * 8) = (f32x4){lf1[0], lf1[1], lf1[2], lf1[3]}; *(LAS f32x4*)(cr + c8 * 8 + 4) = (f32x4){lf1[4], lf1[5], lf1[6], lf1[7]};
            *(LAS f32x4*)(cr + 64 + c8 * 8) = (f32x4){lf2[0], lf2[1], lf2[2], lf2[3]}; *(LAS f32x4*)(cr + 64 + c8 * 8 + 4) = (f32x4){lf2[4], lf2[5], lf2[6], lf2[7]};
        }
        __syncthreads();
        {
            const int d = tid & 127, sg = tid >> 7; LAS float* c = (LAS float*)(L + LA_CUM) + (sg * 16) * 128 + d; float run = 0.f;
#pragma unroll
            for (int rr = 0; rr < 16; ++rr) { run += c[rr * 128]; c[rr * 128] = run; }
        }
        __syncthreads();
        {
            const LAS float* C = (const LAS float*)(L + LA_CUM);
            const int sg = row_l >> 4;
            float qi[16], ki[16], qd[16], kd[16];
#pragma unroll
            for (int i = 0; i < 16; ++i) {
                const int d = (i < 8) ? c8 * 8 + i : 64 + c8 * 8 + (i - 8);
                const float t0 = C[15 * 128 + d], t1 = C[31 * 128 + d], t2 = C[47 * 128 + d], t3 = C[63 * 128 + d];
                float cum = C[row_l * 128 + d];
                cum += (sg > 0 ? t0 : 0.f) + (sg > 1 ? t1 : 0.f) + (sg > 2 ? t2 : 0.f);
                const float cmid = t0 + t1, total = (t0 + t1) + (t2 + t3);
                const float q = (i < 8) ? qv1[i & 7] : qv2[i & 7], k = (i < 8) ? kv1[i & 7] : kv2[i & 7];
                qi[i] = q * __expf(fminf(cum - cmid, 80.f)); ki[i] = k * __expf(fminf(cmid - cum, 80.f));
                qd[i] = q * __expf(cum); kd[i] = k * __expf(total - cum);
                if (row_l == 0) *(LAS float*)(L + 70656 + d * 4) = __expf(total);
            }
            u32x4 w1, w2;
            PK8(w1, qi); { const float* sp = qi + 8; PK8(w2, sp); }
            *(LAS u32x4*)(L + LA_QS + row_l * 272 + c8 * 16) = w1; *(LAS u32x4*)(L + LA_QS + row_l * 272 + 128 + c8 * 16) = w2;
            PK8(w1, ki); { const float* sp = ki + 8; PK8(w2, sp); }
            *(LAS u32x4*)(L + LA_KS + row_l * 272 + c8 * 16) = w1; *(LAS u32x4*)(L + LA_KS + row_l * 272 + 128 + c8 * 16) = w2;
            PK8(w1, qd); { const float* sp = qd + 8; PK8(w2, sp); }
            *(LAS u32x4*)(L + LA_QD + row_l * 272 + c8 * 16) = w1; *(LAS u32x4*)(L + LA_QD + row_l * 272 + 128 + c8 * 16) = w2;
#pragma unroll
            for (int i = 0; i < 8; ++i) {
                *(LAS bf16_t*)(L + LA_KT + (c8 * 8 + i) * 144 + row_l * 2) = f2bf(kd[i]);
                *(LAS bf16_t*)(L + LA_KT + (64 + c8 * 8 + i) * 144 + row_l * 2) = f2bf(kd[8 + i]);
            }
        }
        __syncthreads();
        {
            unsigned char* dst = a.ws + HGT_OFF + (size_t)it * HGT_ITEM;
#pragma unroll
            for (int k = 0; k < 9; ++k) { const int idx = tid + k * NTHREADS; if (idx < 4448) *(u32x4*)(dst + (size_t)idx * 16) = *(const LAS u32x4*)(L + idx * 16); }
        }
        __syncthreads();
    }
}

__device__ __forceinline__ void hgrn_unit(const Args& a, LAS unsigned char* L, int unit, bool dry) {
    int tid_ = threadIdx.x; asm volatile("" : "+v"(tid_));
    const int tid = tid_, b = unit >> 4, h = (unit >> 2) & 3, sl = unit & 3;
    const bf16_t* Z = (const bf16_t*)(a.ws + Z_OFF); bf16_t* OB = (bf16_t*)(a.ws + HN_OFF);
    const int vrow = (tid >> 2) & 63, vp = tid & 3;
    f32x4 st[2] = {{0.f, 0.f, 0.f, 0.f}, {0.f, 0.f, 0.f, 0.f}};
    for (int i = tid; i < 32 * 272 / 4; i += NTHREADS) ((LAS unsigned*)(L + LA_ST))[i] = 0u;
    u32x4 pfA[9], pfB[9], vvA, vvB;
#define HG_LOAD(PF, VV, n_) do { const unsigned char* src_ = a.ws + HGT_OFF + (size_t)(((b * NCH + (n_)) * 4) + h) * HGT_ITEM; \
        _Pragma("unroll") for (int k = 0; k < 9; ++k) { const int idx = tid + k * NTHREADS; PF[k] = (u32x4){0u, 0u, 0u, 0u}; if (idx < 4448) PF[k] = *(const u32x4*)(src_ + (size_t)idx * 16); } \
        VV = (u32x4){0u, 0u, 0u, 0u}; \
        if (tid < 256) { const int rv = chunk_row(b, (n_), vrow); if (rv >= 0) VV = *(const u32x4*)(Z + (size_t)rv * IN_CD + 1536 + h * 128 + sl * 32 + vp * 8); } } while (0)
#define HG_STEP(PF, VV, n_) do { \
        _Pragma("unroll") for (int k = 0; k < 9; ++k) { const int idx = tid + k * NTHREADS; \
            if (idx < 4416) *(LAS u32x4*)(L + idx * 16) = PF[k]; \
            else if (idx < 4448) *(LAS u32x4*)(L + LA_DEC + (idx - 4416) * 16) = PF[k]; } \
        if (tid < 256) { const unsigned va[4] = {VV.x, VV.y, VV.z, VV.w}; \
            _Pragma("unroll") for (int i = 0; i < 8; ++i) *(LAS bf16_t*)(L + LA_VT + (vp * 8 + i) * 144 + vrow * 2) = (bf16_t)((i & 1) ? (va[i >> 1] >> 16) : (va[i >> 1] & 0xffffu)); } \
        if ((n_) + 2 < NCH) HG_LOAD(PF, VV, (n_) + 2); \
        LBAR(); \
        la_core<true>(L, st, 0.f, OB, 512, h * 128 + sl * 32, b, (n_), dry); \
        LBAR(); } while (0)
    HG_LOAD(pfA, vvA, 0);
    HG_LOAD(pfB, vvB, 1);
    for (int n = 0; n < NCH; n += 2) {
        HG_STEP(pfA, vvA, n);
        if (n + 1 < NCH) HG_STEP(pfB, vvB, n + 1);
    }
#undef HG_STEP
#undef HG_LOAD
}

constexpr int LR_XB = 0, LR_XC = 32768, LR_XA = 49152, LR_RG = 58368, RGS = 68  , LR_SEG = LR_RG + 64 * RGS * 4  , LR_END = LR_SEG + 16 * 64 * 4;
__device__ __forceinline__ void lru_unit(const Args& a, LAS unsigned char* L, int unit, bool dry) {
    int tid_ = threadIdx.x; asm volatile("" : "+v"(tid_));
    const int tid = tid_, lane = tid & 63, w = __builtin_amdgcn_readfirstlane(tid >> 6), fr = lane & 15, fq = lane >> 4;
    const int b = unit >> 5, cb = (unit >> 1) & 15, hf = unit & 1;
    bf16_t* Z = (bf16_t*)(a.ws + Z_OFF);
    const int row_l = tid >> 3, c8 = tid & 7;
    const int oc = cb * 64 + hf * 32 + c8 * 4;
    LAS float* XB = (LAS float*)(L + LR_XB); LAS float* XC = (LAS float*)(L + LR_XC); LAS float* RG = (LAS float*)(L + LR_RG);
    float cw[4][8], cbs[8];
#pragma unroll
    for (int i = 0; i < 8; ++i) { const int c = cb * 64 + c8 * 8 + i; cbs[i] = a.in[11][c];
#pragma unroll
        for (int ww = 0; ww < 4; ++ww) cw[ww][i] = a.in[10][ww * 1024 + c]; }
    const int mg = w >> 1, ct = w & 1;
    const int gch = cb * 64 + hf * 32 + ct * 16 + 4 * fq;
    const bf16_t* WG = (const bf16_t*)(a.ws + LRUW_OFF) + (size_t)cb * 128 * 64;
    const int nr_ = hf * 32 + ct * 16 + fr;
    const bf16x8 wr0 = *(const bf16x8*)(WG + nr_ * 64 + fq * 8), wr1 = *(const bf16x8*)(WG + nr_ * 64 + 32 + fq * 8);
    const bf16x8 wi0 = *(const bf16x8*)(WG + (64 + nr_) * 64 + fq * 8), wi1 = *(const bf16x8*)(WG + (64 + nr_) * 64 + 32 + fq * 8);
    const f32x4 bra = *(const f32x4*)(a.in[6] + gch), bia = *(const f32x4*)(a.in[8] + gch);
    float sp[4];
#pragma unroll
    for (int i = 0; i < 4; ++i) sp[i] = log1pf(expf(-a.in[9][gch + i]));
    float hstate = 0.f;
    for (int i = tid; i < 64 * 64; i += NTHREADS) XB[64 * 64 + i] = 0.f;
    u32x4 xbv; u32x2 bgv;
#define LRU_LOAD(n_) do { const int r_ = chunk_row(b, (n_), row_l); \
        if (r_ >= 0) { const bf16_t* zr = Z + (size_t)r_ * IN_AB; xbv = *(const u32x4*)(zr + 2048 + cb * 64 + c8 * 8); bgv = *(const u32x2*)(zr + 4096 + oc); } \
        else { xbv = (u32x4){0u, 0u, 0u, 0u}; bgv = (u32x2){0u, 0u}; } } while (0)
    LRU_LOAD(0);
    for (int n = 0; n < NCH; ++n) {
        const int cur = (n & 1) * 4096, prv = 4096 - cur;
        {
            float xf[8]; UNPK8(xf, xbv);
            *(LAS f32x4*)(XB + cur + row_l * 64 + c8 * 8) = (f32x4){xf[0], xf[1], xf[2], xf[3]}; *(LAS f32x4*)(XB + cur + row_l * 64 + c8 * 8 + 4) = (f32x4){xf[4], xf[5], xf[6], xf[7]};
        }
        const u32x2 bgc = bgv;
        const int grow = chunk_row(b, n, row_l);
        if (n + 1 < NCH) LRU_LOAD(n + 1);
        LBAR();
        {
            float xc[8];
#pragma unroll
            for (int i = 0; i < 8; ++i) xc[i] = cbs[i];
#pragma unroll
            for (int ww = 0; ww < 4; ++ww) {
                const int rr = row_l + ww - 3;
                const LAS float* src = rr >= 0 ? XB + cur + rr * 64 + c8 * 8 : XB + prv + (64 + rr) * 64 + c8 * 8;
                const f32x4 x0 = *(const LAS f32x4*)src, x1 = *(const LAS f32x4*)(src + 4);
                xc[0] += cw[ww][0] * x0[0]; xc[1] += cw[ww][1] * x0[1]; xc[2] += cw[ww][2] * x0[2]; xc[3] += cw[ww][3] * x0[3];
                xc[4] += cw[ww][4] * x1[0]; xc[5] += cw[ww][5] * x1[1]; xc[6] += cw[ww][6] * x1[2]; xc[7] += cw[ww][7] * x1[3];
            }
            *(LAS f32x4*)(XC + row_l * 64 + c8 * 8) = (f32x4){xc[0], xc[1], xc[2], xc[3]}; *(LAS f32x4*)(XC + row_l * 64 + c8 * 8 + 4) = (f32x4){xc[4], xc[5], xc[6], xc[7]};
            u32x4 o; PK8(o, xc);
            *(LAS u32x4*)(L + LR_XA + row_l * 144 + c8 * 16) = o;
        }
        LBAR();
        {
            const bf16x8 x0 = ldsfrag(L + LR_XA + (mg * 16 + fr) * 144 + fq * 16), x1 = ldsfrag(L + LR_XA + (mg * 16 + fr) * 144 + 64 + fq * 16);
            f32x4 ra = {0.f, 0.f, 0.f, 0.f}, ia = {0.f, 0.f, 0.f, 0.f};
            ra = MFMA16(wr0, x0, ra); ia = MFMA16(wi0, x0, ia); ra = MFMA16(wr1, x1, ra); ia = MFMA16(wi1, x1, ia);
            const int jr = mg * 16 + fr;
            const f32x4 x4 = *(const LAS f32x4*)(XC + jr * 64 + hf * 32 + ct * 16 + 4 * fq);
            const bool rvalid = (n > 0) || (jr >= 48);
            f32x4 a4, b4;
#pragma unroll
            for (int i = 0; i < 4; ++i) {
                const float r = sigmoidf_(ra[i] + bra[i]), ig = sigmoidf_(ia[i] + bia[i]);
                const float log_a = -8.f * r * sp[i], x2 = 2.f * log_a, e2 = __expf(x2);
                const float ser = -x2 * (1.f + x2 * (0.5f + x2 * (0.16666667f + x2 * (0.041666668f + x2 * 0.0083333338f))));
                const float om = x2 > -0.25f ? ser : 1.f - e2;
                a4[i] = rvalid ? __expf(log_a) : 1.f; b4[i] = rvalid ? sqrtf(fmaxf(om, 0.f)) * (ig * x4[i]) : 0.f;
            }
            *(LAS f32x4*)(RG + jr * RGS + ct * 16 + 4 * fq) = a4; *(LAS f32x4*)(RG + jr * RGS + 32 + ct * 16 + 4 * fq) = b4;
        }
        LBAR();
        {
            LAS float* SEG = (LAS float*)(L + LR_SEG);
            const int sg = w * 2 + (lane >> 5), ch = lane & 31;
            float sa[4], sb[4];
            {
                float P = 1.f, hh = 0.f;
#pragma unroll
                for (int i = 0; i < 4; ++i) { sa[i] = RG[(sg * 4 + i) * RGS + ch]; sb[i] = RG[(sg * 4 + i) * RGS + 32 + ch]; hh = sa[i] * hh + sb[i]; P *= sa[i]; }
                SEG[sg * 64 + ch] = P; SEG[sg * 64 + 32 + ch] = hh;
            }
            LBAR();
            float c = hstate, mine = 0.f;
#pragma unroll
            for (int s2 = 0; s2 < 16; ++s2) { mine = (s2 == sg) ? c : mine; c = SEG[s2 * 64 + ch] * c + SEG[s2 * 64 + 32 + ch]; }
            hstate = c;
            float hh = mine;
#pragma unroll
            for (int i = 0; i < 4; ++i) { hh = sa[i] * hh + sb[i]; RG[(sg * 4 + i) * RGS + 32 + ch] = hh; }
        }
        LBAR();
        if (grow >= 0 && !dry) {
            const f32x4 h4 = *(const LAS f32x4*)(RG + row_l * RGS + 32 + c8 * 4);
            u32x2 o; o.x = cvt_pk_bf16(gelu_tanh(bf_lo(bgc.x)) * h4[0], gelu_tanh(bf_hi(bgc.x)) * h4[1]); o.y = cvt_pk_bf16(gelu_tanh(bf_lo(bgc.y)) * h4[2], gelu_tanh(bf_hi(bgc.y)) * h4[3]);
            if (grow < RM) *(u32x2*)(Z + (size_t)grow * IN_AB + 4096 + oc) = o;
            else if (b == 0) *(u32x2*)((bf16_t*)(a.ws + YAB_OFF) + (size_t)(grow - RM) * 2048 + 1024 + oc) = o;
        }
    }
    LBAR();
#undef LRU_LOAD
}

constexpr int S5_BU = 0, BUS = 132  , S5_HS = 64 * BUS * 4, S5_EX = S5_HS + 64 * 272  , S5_END = S5_EX + 8 * 128 * 4;
__device__ __forceinline__ void s5_unit(const Args& a, LAS unsigned char* L, int unit, bool dry) {
    int tid_ = threadIdx.x; asm volatile("" : "+v"(tid_));
    const int tid = tid_, lane = tid & 63, w = __builtin_amdgcn_readfirstlane(tid >> 6), fr = lane & 15, fq = lane >> 4;
    const int b = unit >> 5, g = unit & 31;
    bf16_t* Z = (bf16_t*)(a.ws + Z_OFF);
    const bf16_t* BB = (const bf16_t*)(a.ws + S5BB_OFF) + (size_t)g * 128 * 32;
    const bf16_t* CM = (const bf16_t*)(a.ws + S5CM_OFF) + (size_t)g * 16 * 128;
    const float* AB = (const float*)(a.ws + S5AB_OFF) + (size_t)g * 128;
    const bf16x8 bbf = *(const bf16x8*)(BB + (w * 16 + fr) * 32 + fq * 8);
    bf16x8 cmf[4];
#pragma unroll
    for (int kk = 0; kk < 4; ++kk) cmf[kk] = *(const bf16x8*)(CM + fr * 128 + kk * 32 + fq * 8);
    const float ar = AB[2 * lane], ai = AB[2 * lane + 1];
    const f32x4 dv = *(const f32x4*)(a.in[20] + g * 16 + 4 * fq);
    float hr = 0.f, hi = 0.f;
    LAS float* BU = (LAS float*)(L + S5_BU); LAS float* EX = (LAS float*)(L + S5_EX);
    float pwr[8], pwi[8];
    pwr[0] = ar; pwi[0] = ai;
#pragma unroll
    for (int i = 1; i < 8; ++i) { pwr[i] = pwr[i - 1] * ar - pwi[i - 1] * ai; pwi[i] = pwr[i - 1] * ai + pwi[i - 1] * ar; }
    bf16x8 uf[4]; u32x2 uvn = {0u, 0u};
#define S5_LOAD(n_) do { _Pragma("unroll") for (int m = 0; m < 4; ++m) { const int r_ = chunk_row(b, (n_), m * 16 + fr); \
            uf[m] = (bf16x8){0, 0, 0, 0, 0, 0, 0, 0}; \
            if (r_ >= 0 && fq < 2) uf[m] = *(const bf16x8*)(Z + (size_t)r_ * IN_CD + g * 16 + fq * 8); } \
        if (w < 4) { const int r2_ = chunk_row(b, (n_), w * 16 + fr); uvn = (u32x2){0u, 0u}; if (r2_ >= 0) uvn = *(const u32x2*)(Z + (size_t)r2_ * IN_CD + g * 16 + 4 * fq); } } while (0)
    S5_LOAD(0);
    for (int n = 0; n < NCH; ++n) {
#pragma unroll
        for (int m = 0; m < 4; ++m) { f32x4 acc = {0.f, 0.f, 0.f, 0.f}; acc = MFMA16(bbf, uf[m], acc);
            *(LAS f32x4*)(BU + (m * 16 + fr) * BUS + w * 16 + 4 * fq) = acc; }
        const u32x2 uv = uvn;
        if (n + 1 < NCH) S5_LOAD(n + 1);
        LBAR();
        float lr[8], li[8];
        {
            float cr = 0.f, ci = 0.f;
#pragma unroll
            for (int i = 0; i < 8; ++i) {
                const float br = BU[(8 * w + i) * BUS + lane], bi = BU[(8 * w + i) * BUS + 64 + lane];
                const float nr = ar * cr - ai * ci + br, ni = ar * ci + ai * cr + bi;
                cr = nr; ci = ni; lr[i] = cr; li[i] = ci;
            }
            EX[w * 128 + lane] = cr; EX[w * 128 + 64 + lane] = ci;
        }
        LBAR();
        {
            float cr = hr, ci = hi, mr = 0.f, mi = 0.f;
#pragma unroll
            for (int ww = 0; ww < 8; ++ww) {
                if (ww == w) { mr = cr; mi = ci; }
                const float er = EX[ww * 128 + lane], ei = EX[ww * 128 + 64 + lane];
                const float nr = pwr[7] * cr - pwi[7] * ci + er, ni = pwr[7] * ci + pwi[7] * cr + ei;
                cr = nr; ci = ni;
            }
            hr = cr; hi = ci;
#pragma unroll
            for (int i = 0; i < 8; ++i) {
                const float xr = lr[i] + pwr[i] * mr - pwi[i] * mi, xi = li[i] + pwr[i] * mi + pwi[i] * mr;
                *(LAS bf16_t*)(L + S5_HS + (8 * w + i) * 272 + lane * 2) = f2bf(xr);
                *(LAS bf16_t*)(L + S5_HS + (8 * w + i) * 272 + 128 + lane * 2) = f2bf(xi);
            }
        }
        LBAR();
        if (w < 4) {
            f32x4 acc = {0.f, 0.f, 0.f, 0.f};
#pragma unroll
            for (int kk = 0; kk < 4; ++kk) acc = MFMA16(cmf[kk], ldsfrag(L + S5_HS + (w * 16 + fr) * 272 + kk * 64 + fq * 16), acc);
            const int r = chunk_row(b, n, w * 16 + fr);
            if (r >= 0 && !dry) {
                bf16_t* up = Z + (size_t)r * IN_CD + g * 16 + 4 * fq;
                const float y0 = gelu_tanh(acc[0] + dv[0] * bf_lo(uv.x)), y1 = gelu_tanh(acc[1] + dv[1] * bf_hi(uv.x));
                const float y2 = gelu_tanh(acc[2] + dv[2] * bf_lo(uv.y)), y3 = gelu_tanh(acc[3] + dv[3] * bf_hi(uv.y));
                u32x2 o; o.x = cvt_pk_bf16(y0, y1); o.y = cvt_pk_bf16(y2, y3);
                if (r < RM) *(u32x2*)up = o; else if (b == 0) *(u32x2*)((bf16_t*)(a.ws + YM_OFF) + (size_t)(r - RM) * 512 + g * 16 + 4 * fq) = o;
            }
        }
    }
    LBAR();
#undef S5_LOAD
}

__device__ __forceinline__ void phase_ret_post(const Args& a) {
    int tid_ = threadIdx.x; asm volatile("" : "+v"(tid_));
    const int tid = tid_, lane = tid & 63, wave = tid >> 6;
    const int gw = blockIdx.x * 8 + wave, NGW = gridDim.x * 8;
    bf16_t* Z = (bf16_t*)(a.ws + Z_OFF); const bf16_t* OB = (const bf16_t*)(a.ws + HN_OFF); const float* gn = a.in[4];
    for (int it = gw; it < RVALID * 4; it += NGW) {
        const int row = it >> 2, h = it & 3;
        const u32x2 ov = *(const u32x2*)(OB + (size_t)row * DM + h * 256 + 4 * lane);
        bf16_t* gp = Z + (size_t)row * IN_AB + 3072 + h * 256 + 4 * lane;
        const u32x2 gv = *(const u32x2*)gp;
        const f32x4 gg = *(const f32x4*)(gn + h * 256 + 4 * lane);
        float o0 = bf_lo(ov.x), o1 = bf_hi(ov.x), o2 = bf_lo(ov.y), o3 = bf_hi(ov.y);
        const float mean = wave_sum((o0 + o1) + (o2 + o3)) * (1.f / 256.f);
        o0 -= mean; o1 -= mean; o2 -= mean; o3 -= mean;
        const float inv = rsqrtf(wave_sum(o0 * o0 + o1 * o1 + o2 * o2 + o3 * o3) * (1.f / 256.f) + EPS);
        u32x2 y; y.x = cvt_pk_bf16(o0 * inv * gg[0] * silu_(bf_lo(gv.x)), o1 * inv * gg[1] * silu_(bf_hi(gv.x)));
        y.y = cvt_pk_bf16(o2 * inv * gg[2] * silu_(bf_lo(gv.y)), o3 * inv * gg[3] * silu_(bf_hi(gv.y)));
        if (row < RM) *(u32x2*)gp = y; else *(u32x2*)((bf16_t*)(a.ws + YAB_OFF) + (size_t)(row - RM) * 2048 + h * 256 + 4 * lane) = y;
    }
}
__device__ __forceinline__ void phase_hg_post(const Args& a) {
    int tid_ = threadIdx.x; asm volatile("" : "+v"(tid_));
    const int tid = tid_, lane = tid & 63, wave = tid >> 6;
    const int gw = blockIdx.x * 8 + wave, NGW = gridDim.x * 8;
    bf16_t* Z = (bf16_t*)(a.ws + Z_OFF); const bf16_t* OB = (const bf16_t*)(a.ws + HN_OFF); const float* gn = a.in[24];
    for (int it = gw; it < RVALID * 4; it += NGW) {
        const int row = it >> 2, h = it & 3;
        const unsigned ov = *(const unsigned*)(OB + (size_t)row * 512 + h * 128 + 2 * lane);
        bf16_t* gp = Z + (size_t)row * IN_CD + 2048 + h * 128 + 2 * lane;
        const unsigned gv = *(const unsigned*)gp;
        const f32x2 gg = *(const f32x2*)(gn + h * 128 + 2 * lane);
        const float o0 = bf_lo(ov), o1 = bf_hi(ov);
        const float inv = rsqrtf(wave_sum(o0 * o0 + o1 * o1) * (1.f / 128.f) + EPS);
        const unsigned yv = cvt_pk_bf16(o0 * inv * gg[0] * silu_(bf_lo(gv)), o1 * inv * gg[1] * silu_(bf_hi(gv)));
        if (row < RM) *(unsigned*)gp = yv; else *(unsigned*)((bf16_t*)(a.ws + YCD_OFF) + (size_t)(row - RM) * 1024 + 512 + h * 128 + 2 * lane) = yv;
    }
}


#define XB_TMO      128
#define XB_XCNT(j)  (256  + 64 * (j))
#define XB_XSUB(j)  (1280 + 64 * (j))
#define XB_XGEN(j)  (2304 + 64 * (j))
#define XB_TOP      3328
#define XB_TOPGEN   3392
#define XCD_BAR_WORDS 3456
#define XB_SPIN_CAP (1u << 18)

__device__ __forceinline__ unsigned xb_ld(unsigned* p)              { return __hip_atomic_load(p, __ATOMIC_RELAXED, __HIP_MEMORY_SCOPE_AGENT); }
__device__ __forceinline__ unsigned xb_add(unsigned* p, unsigned v) { return __hip_atomic_fetch_add(p, v, __ATOMIC_RELAXED, __HIP_MEMORY_SCOPE_AGENT); }
__device__ __forceinline__ unsigned xb_xcc_id() { return (unsigned)__builtin_amdgcn_s_getreg((3 << 11) | 20) & 0xFu; }
#define XB_SPIN(cond, bar) do { unsigned _sp = 0; while (cond) { __builtin_amdgcn_s_sleep(1); \
    if ((++_sp & 255u) == 0u) { if (xb_ld(&(bar)[XB_TMO])) break; if (_sp > XB_SPIN_CAP) { atomicAdd(&(bar)[XB_TMO], 1u); break; } } } } while (0)

struct XcdBarrier {
    unsigned* bar; unsigned x;
    volatile LAS unsigned* st;
};

__device__ __forceinline__ XcdBarrier xcd_barrier_post(unsigned* bar, volatile LAS unsigned* st) {
    XcdBarrier b; b.bar = bar; b.x = xb_xcc_id(); b.st = st;
    if (threadIdx.x == 0) (void)xb_add(&bar[XB_XCNT(b.x)], 1u);
    return b;
}
__device__ __forceinline__ void xcd_barrier_complete(unsigned* bar, unsigned x, unsigned& nloc, unsigned& nx) {
    const unsigned G = gridDim.x * gridDim.y * gridDim.z;
    unsigned sum, cnt, mine, sp = 0u;
    for (;;) {
        sum = 0u; cnt = 0u; mine = 0u;
#pragma unroll
        for (unsigned j = 0; j < 16; ++j) { const unsigned c = xb_ld(&bar[XB_XCNT(j)]); sum += c; cnt += (c > 0u) ? 1u : 0u; mine = (j == x) ? c : mine; }
        if (sum == G) break;
        __builtin_amdgcn_s_sleep(1);
        if ((++sp & 255u) == 0u) { if (xb_ld(&bar[XB_TMO])) break; if (sp > XB_SPIN_CAP) { atomicAdd(&bar[XB_TMO], 1u); break; } }
    }
    nloc = mine > 0u ? mine : 1u; nx = cnt > 0u ? cnt : 1u;
}

__device__ __forceinline__ void xcd_barrier(const XcdBarrier& b) {
    asm volatile("s_waitcnt vmcnt(0)" ::: "memory");
    __syncthreads();
    if (threadIdx.x == 0) {
        unsigned* bar = b.bar;
        __builtin_amdgcn_s_waitcnt(0);
        unsigned nloc = b.st[0], nx = b.st[1];
        if (nloc == 0u) { xcd_barrier_complete(bar, b.x, nloc, nx); b.st[0] = nloc; b.st[1] = nx; }
        const unsigned old = xb_add(&bar[XB_XSUB(b.x)], 1u);
        const unsigned gen = old / nloc;
        if (old + 1u == (gen + 1u) * nloc) {
            __builtin_amdgcn_fence(__ATOMIC_RELEASE, "agent");
            asm volatile("s_waitcnt vmcnt(0)" ::: "memory");
            const unsigned og = xb_add(&bar[XB_TOP], 1u);
            const unsigned tg = og / nx;
            if (og + 1u == (tg + 1u) * nx) xb_add(&bar[XB_TOPGEN], 1u);
            else XB_SPIN(xb_ld(&bar[XB_TOPGEN]) == tg, bar);
            __builtin_amdgcn_fence(__ATOMIC_ACQUIRE, "agent");
            xb_add(&bar[XB_XGEN(b.x)], 1u);
            asm volatile("s_waitcnt vmcnt(0)" ::: "memory");
        } else {
            XB_SPIN(xb_ld(&bar[XB_XGEN(b.x)]) == gen, bar);
            __builtin_amdgcn_fence(__ATOMIC_ACQUIRE, "agent");
            asm volatile("s_waitcnt vmcnt(0)" ::: "memory");
        }
    }
    __syncthreads();
}


#ifndef DBG_STOP
#define DBG_STOP 0
#endif
__device__ __forceinline__ void dbg_digest(const Args& a) {
    const size_t gt = (size_t)blockIdx.x * NTHREADS + threadIdx.x, NGT = (size_t)gridDim.x * NTHREADS;
    const bf16_t* zb = (const bf16_t*)(a.ws + Z_OFF);
    const size_t NE = ((size_t)R * 5120 + (size_t)R * 1024);
    const size_t ON = (size_t)RM * DM;
    for (size_t i = gt; i < ON; i += NGT) {
        float s = 0.f;
        for (size_t k = i; k < NE; k += ON) s += __uint_as_float((unsigned)zb[k] << 16);
        a.out[i] = a.out[i] * 1e-3f + s;
    }
}
#ifndef DBG_REP34
#define DBG_REP34 0
#endif
#ifndef DBG_REPG
#define DBG_REPG 0
#endif
#ifndef DBG_SYNC2
#define DBG_SYNC2 0
#endif
#ifndef DBG_TIME
#define DBG_TIME 0
#endif
#define GSYNC() xcd_barrier(xbar)
#define DBG_CHECK(k) do { if (DBG_STOP == (k)) { grid.sync(); dbg_digest(a); return; } \
    if (DBG_TIME) { if ((k) == DBG_TIME - 1) dbg_t0 = __builtin_amdgcn_s_memrealtime(); if ((k) == DBG_TIME) dbg_t1 = __builtin_amdgcn_s_memrealtime(); } } while (0)
__global__ void __launch_bounds__(NTHREADS, 2) fwd_megakernel(Args a) {
    extern __shared__ __attribute__((aligned(16))) unsigned char lds_raw[];
    LAS unsigned char* L = (LAS unsigned char*)lds_raw;
    cg::grid_group grid = cg::this_grid();
    unsigned char* ws = a.ws;
    const int G = gridDim.x, bx = blockIdx.x;
    bf16_t* Zb = (bf16_t*)(ws + Z_OFF); bf16_t* HNb = (bf16_t*)(ws + HN_OFF); float* ssq = (float*)(ws + SSQ_OFF);
    bf16_t* YABb = (bf16_t*)(ws + YAB_OFF); bf16_t* YCDb = (bf16_t*)(ws + YCD_OFF); bf16_t* YMb = (bf16_t*)(ws + YM_OFF);
    float* hmeta = (float*)(ws + HMETA_OFF);
    const float* ng = a.in[26];
    const bool fusedres = (G == 256);

    if (threadIdx.x < 4) ((LAS unsigned*)(L + LDS_BYTES - 16))[threadIdx.x] = 0u;
    __syncthreads();
    const XcdBarrier xbar = xcd_barrier_post((unsigned*)(ws + BAR_OFF), (volatile LAS unsigned*)(L + LDS_BYTES - 16));
    if (a.never) grid.sync();
    phase_prologue(a, L, !fusedres);
    GSYNC();

#define GEMM_PHASE(MODE, Ap, lda_, Wp, N_, K_, Op, ldo_, Yp, ldy_, biasp, AMp, ldam_, OMp, ldom_, YMp, ldym_) do { \
        pg8::Gemm g{(Ap), (Wp), RM, (N_), (K_), (lda_)}; pg8::StaticOrder S; S.init(RM, (N_), G, bx); \
        pg8::Epi<MODE> E{(Op), (ldo_), nullptr, (Yp), (ldy_), (biasp)}; \
        pg8::gemm_phase(L, g, S, E); \
        meta_gemm<MODE>(L, (AMp), (ldam_), (Wp), (N_), (K_), (OMp), (ldom_), nullptr, (YMp), (ldym_), (biasp)); } while (0)
#define RES_PHASE(P, HIN, Ap, lda_, Wp, K_, AMp, ldam_, g1_, g2_) do { \
        pg8::Gemm g{(Ap), (Wp), RM, DM, (K_), (lda_)}; pg8::StaticOrder S; S.init(RM, DM, G, bx); \
        if (fusedres) { \
            float* x1 = (float*)(ws + XB_OFF + (size_t)((P) * 2) * XB_STRIDE); float* x2 = (float*)(ws + XB_OFF + (size_t)((P) * 2 + 1) * XB_STRIDE); \
            unsigned* c1 = (unsigned*)(ws + CNT_OFF) + ((P) * 2) * 80 * 32; unsigned* c2 = (unsigned*)(ws + CNT_OFF) + ((P) * 2 + 1) * 80 * 32; \
            pg8::EpiRes E{(HIN), a.out, (g1_), (g2_), HNb, x1, x2, c1, c2}; \
            pg8::gemm_phase(L, g, S, E); \
            meta_gemm<4>(L, (AMp), (ldam_), (Wp), DM, (K_), HNb + (size_t)RM * DM, DM, nullptr, nullptr, 0, nullptr, hmeta, (g1_), (g2_), x1 + 64 * 256 * 4, x2 + 64 * 256 * 4, c1 + 64 * 32, c2 + 64 * 32); \
            GSYNC(); \
        } else { \
            pg8::Epi<1> E{HNb, DM, ssq, nullptr, 0, nullptr}; \
            pg8::gemm_phase(L, g, S, E); \
            meta_gemm<1>(L, (AMp), (ldam_), (Wp), DM, (K_), HNb + (size_t)RM * DM, DM, ssq + (size_t)RM * 16, nullptr, 0, nullptr); \
            GSYNC(); \
            phase_resnorm(a, (g1_), (g2_)); \
            GSYNC(); \
        } } while (0)

    {
        const bf16_t* W = (const bf16_t*)(ws + W_INAB);
        GEMM_PHASE(0, HNb, DM, W, IN_AB, DM, Zb, IN_AB, nullptr, 0, nullptr, HNb + (size_t)RM * DM, DM, Zb + (size_t)RM * IN_AB, IN_AB, nullptr, 0);
    }
    GSYNC();
    for (int u = bx; u < 128 + 128; u += G) { if (u < 128) retention_unit(a, L, u, false); else lru_unit(a, L, u - 128, false); }
    if (G == 256) { if (bx < 128) weight_convert(a, L, WC_C1, WC_C5, bx, 128); }
    else weight_convert(a, L, WC_C1, WC_C5, bx, G);
    GSYNC();
    phase_ret_post(a);
    GSYNC();
    {
        const bf16_t* W = (const bf16_t*)(ws + W_OUTAB);
        RES_PHASE(0, (fusedres ? a.in[0] : (const float*)a.out), Zb + 3072, IN_AB, W, 2048, YABb, 2048, ng + 1 * DM, ng + 2 * DM);
    }
    {
        const bf16_t* W = (const bf16_t*)(ws + W_W1_0);
        GEMM_PHASE(2, HNb, DM, W, FF, DM, Zb, FF, nullptr, 0, nullptr, HNb + (size_t)RM * DM, DM, Zb + (size_t)RM * FF, FF, nullptr, 0);
    }
    GSYNC();
    {
        const bf16_t* W = (const bf16_t*)(ws + W_W2_0);
        RES_PHASE(1, (const float*)a.out, Zb, FF, W, FF, Zb + (size_t)RM * FF, FF, ng + 3 * DM, ng + 4 * DM);
    }

    {
        const bf16_t* W = (const bf16_t*)(ws + W_INCD);
        GEMM_PHASE(0, HNb, DM, W, IN_CD, DM, Zb, IN_CD, nullptr, 0, nullptr, HNb + (size_t)RM * DM, DM, Zb + (size_t)RM * IN_CD, IN_CD, nullptr, 0);
    }
    GSYNC();
    hgrn_prepass(a, L);
    GSYNC();
    for (int u = bx; u < 64 + 128; u += G) { if (u < 64) hgrn_unit(a, L, u, false); else s5_unit(a, L, u - 64, false); }
    if (G == 256) { if (bx < 64 || bx >= 192) weight_convert(a, L, WC_C5, WC_C9, bx < 64 ? bx : bx - 128, 128); }
    else weight_convert(a, L, WC_C5, WC_C9, bx, G);
    GSYNC();
    phase_hg_post(a);
    {
        const bf16_t* W = (const bf16_t*)(ws + W_GLU);
        GEMM_PHASE(3, Zb, IN_CD, W, 512, 512, Zb + 1536, IN_CD, Zb, IN_CD, a.in[23], YMb, 512, YCDb, 1024, YMb, 512);
    }
    GSYNC();
    {
        const bf16_t* W = (const bf16_t*)(ws + W_OUTCD);
        RES_PHASE(2, (const float*)a.out, Zb + 1536, IN_CD, W, DM, YCDb, 1024, ng + 5 * DM, ng + 6 * DM);
    }
    {
        const bf16_t* W = (const bf16_t*)(ws + W_W1_1);
        GEMM_PHASE(2, HNb, DM, W, FF, DM, Zb, FF, nullptr, 0, nullptr, HNb + (size_t)RM * DM, DM, Zb + (size_t)RM * FF, FF, nullptr, 0);
    }
    GSYNC();
    {
        const bf16_t* W = (const bf16_t*)(ws + W_W2_1);
        pg8::Gemm g{Zb, W, RM, DM, FF, FF}; pg8::StaticOrder S; S.init(RM, DM, G, bx);
        if (fusedres) {
            float* x1 = (float*)(ws + XB_OFF + (size_t)6 * XB_STRIDE); unsigned* c1 = (unsigned*)(ws + CNT_OFF) + 6 * 80 * 32;
            pg8::EpiRes E{(const float*)a.out, a.out, ng + 7 * DM, nullptr, HNb, x1, x1, c1, c1};
            pg8::gemm_phase(L, g, S, E);
            meta_gemm<4>(L, Zb + (size_t)RM * FF, FF, W, DM, FF, HNb + (size_t)RM * DM, DM, nullptr, nullptr, 0, nullptr, hmeta, ng + 7 * DM, nullptr, x1 + 64 * 256 * 4, x1 + 64 * 256 * 4, c1 + 64 * 32, c1 + 64 * 32);
        } else {
            pg8::Epi<1> E{HNb, DM, ssq, nullptr, 0, nullptr};
            pg8::gemm_phase(L, g, S, E);
            meta_gemm<1>(L, Zb + (size_t)RM * FF, FF, W, DM, FF, HNb + (size_t)RM * DM, DM, ssq + (size_t)RM * 16, nullptr, 0, nullptr);
            GSYNC();
            phase_resnorm(a, ng + 7 * DM, nullptr);
        }
    }
#undef GEMM_PHASE
#undef RES_PHASE
}

extern "C" void kernel_launch(void* const* d_in, const int* in_sizes, int n_in, void* d_out, int out_size, void* d_ws, size_t ws_size, hipStream_t stream) {
    static int grid = 0;
    if (!grid) {
        int dev = 0, cus = 0, per_cu = 0;
        (void)hipGetDevice(&dev);
        (void)hipDeviceGetAttribute(&cus, hipDeviceAttributeMultiprocessorCount, dev);
        (void)hipFuncSetAttribute((const void*)fwd_megakernel, hipFuncAttributeMaxDynamicSharedMemorySize, LDS_BYTES);
        (void)hipOccupancyMaxActiveBlocksPerMultiprocessor(&per_cu, (const void*)fwd_megakernel, NTHREADS, LDS_BYTES);
        if (per_cu < 1) per_cu = 1;
        grid = cus * per_cu;
        if (n_in != 29 || ws_size < WS_END) fprintf(stderr, "kernel_launch: unexpected n_in %d / ws %zu (need %zu)\n", n_in, ws_size, (size_t)WS_END);
    }
    Args a{};
    for (int i = 0; i < 29; ++i) a.in[i] = (const float*)d_in[i];
    a.out = (float*)d_out; a.ws = (unsigned char*)d_ws; a.never = 0;
    (void)hipMemsetAsync((unsigned char*)d_ws + BAR_OFF, 0, (size_t)(XB_OFF - BAR_OFF), stream);
    void* args[] = {&a};
    hipError_t e = hipLaunchCooperativeKernel((void*)fwd_megakernel, dim3(grid), dim3(NTHREADS), args, LDS_BYTES, stream);
    if (e != hipSuccess) fprintf(stderr, "cooperative launch failed: %s (grid %d)\n", hipGetErrorString(e), grid);
}
```

```cpp
#include <hip/hip_runtime.h>
#include <hip/hip_cooperative_groups.h>
#include <cstdio>
#include <cstdint>
namespace cg = cooperative_groups;

#define LAS __attribute__((address_space(3)))
typedef unsigned short bf16_t;
typedef short bf16x8 __attribute__((ext_vector_type(8)));
typedef float f32x4 __attribute__((ext_vector_type(4)));
typedef float f32x2 __attribute__((ext_vector_type(2)));
typedef unsigned u32x4 __attribute__((ext_vector_type(4)));
typedef unsigned u32x2 __attribute__((ext_vector_type(2)));

constexpr int DM = 1024, NB = 4, SEQ = 4096, NMETA = 16, FF = 4096;
constexpr int RM = NB * SEQ;
constexpr int RMETA = RM;
constexpr int RVALID = RM + NMETA;
constexpr int R = RVALID;
constexpr int NCH = 65;
constexpr int IN_AB = 5120, IN_CD = 2560;
constexpr float EPS = 1e-6f;
constexpr int NTHREADS = 512;
constexpr int LDS_BYTES = 147456;

constexpr size_t W_INAB = 0;
constexpr size_t W_OUTAB = W_INAB + (size_t)5120 * 1024 * 2;
constexpr size_t W_W1_0 = W_OUTAB + (size_t)1024 * 2048 * 2;
constexpr size_t W_W2_0 = W_W1_0 + (size_t)4096 * 1024 * 2;
constexpr size_t W_INCD = W_W2_0 + (size_t)4096 * 1024 * 2;
constexpr size_t W_OUTCD = W_INCD + (size_t)2560 * 1024 * 2;
constexpr size_t W_GLU = W_OUTCD + (size_t)1024 * 1024 * 2;
constexpr size_t W_W1_1 = W_GLU + (size_t)512 * 512 * 2;
constexpr size_t W_W2_1 = W_W1_1 + (size_t)4096 * 1024 * 2;
constexpr size_t W_END = W_W2_1 + (size_t)4096 * 1024 * 2;
constexpr size_t Z_OFF = W_END;
constexpr size_t HN_OFF = Z_OFF + (size_t)R * 5120 * 2;
constexpr size_t SM_OFF = HN_OFF + (size_t)R * 1024 * 2;
constexpr size_t HMETA_OFF = SM_OFF;
constexpr size_t YAB_OFF = HMETA_OFF + (size_t)16 * 1024 * 4;
constexpr size_t YCD_OFF = YAB_OFF + (size_t)16 * 2048 * 2;
constexpr size_t YM_OFF = YCD_OFF + (size_t)16 * 1024 * 2;
constexpr size_t SSQ_OFF = YM_OFF + (size_t)16 * 512 * 2;
constexpr size_t LRUW_OFF = SSQ_OFF + (size_t)R * 16 * 4;
constexpr size_t S5BB_OFF = LRUW_OFF + (size_t)16 * 128 * 64 * 2;
constexpr size_t S5CM_OFF = S5BB_OFF + (size_t)32 * 128 * 32 * 2;
constexpr size_t S5AB_OFF = S5CM_OFF + (size_t)32 * 16 * 128 * 2;
constexpr size_t BAR_OFF = S5AB_OFF + (size_t)32 * 64 * 2 * 4;
constexpr size_t CNT_OFF = BAR_OFF + 16384;
constexpr size_t XB_OFF = CNT_OFF + (size_t)8 * 80 * 32 * 4;
constexpr size_t XB_STRIDE = (size_t)64 * 256 * 4 * 4 + 4096;
constexpr size_t WS_END = XB_OFF + 8 * XB_STRIDE;
static_assert(WS_END <= (size_t)268435456, "workspace map");

struct Args {
    const float* in[29];
    float* out;
    unsigned char* ws;
    long long never;
};

typedef __bf16 bf16x2_t __attribute__((ext_vector_type(2)));
__device__ __forceinline__ unsigned cvt_pk_bf16(float lo, float hi) { f32x2 v = {lo, hi}; bf16x2_t b = __builtin_convertvector(v, bf16x2_t); return __builtin_bit_cast(unsigned, b); }
__device__ __forceinline__ float bf_lo(unsigned u) { return __uint_as_float(u << 16); }
__device__ __forceinline__ float bf_hi(unsigned u) { return __uint_as_float(u & 0xffff0000u); }
__device__ __forceinline__ bf16_t f2bf(float f) { return (bf16_t)(cvt_pk_bf16(f, 0.f) & 0xffffu); }
__device__ __forceinline__ float wave_sum(float v) {
#pragma unroll
    for (int o = 1; o < 64; o <<= 1) v += __shfl_xor(v, o);
    return v;
}
__device__ __forceinline__ float sigmoidf_(float x) { return 1.f / (1.f + __expf(-x)); }
__device__ __forceinline__ float gelu_tanh(float x) {
    const float u = 0.7978845608028654f * (x + 0.044715f * x * x * x);
    const float e = __expf(2.f * u);
    const float t = 1.f - 2.f / (e + 1.f);
    return 0.5f * x * (1.f + t);
}
__device__ __forceinline__ float silu_(float x) { return x * sigmoidf_(x); }
__device__ __forceinline__ void sincos_big(float ang, float& s, float& c) {
    double t = (double)ang * 0.15915494309189535;
    t -= rint(t);
    const float fr = (float)t;
    s = __builtin_amdgcn_sinf(fr); c = __builtin_amdgcn_cosf(fr);
}
__device__ __forceinline__ void st_agent(float* p, float v) { __hip_atomic_store(p, v, __ATOMIC_RELAXED, __HIP_MEMORY_SCOPE_AGENT); }
__device__ __forceinline__ float ld_agent(const float* p) { return __hip_atomic_load(p, __ATOMIC_RELAXED, __HIP_MEMORY_SCOPE_AGENT); }
__device__ __forceinline__ void cnt_arrive_wait(unsigned* c, unsigned target) {
    __hip_atomic_fetch_add(c, 1u, __ATOMIC_RELAXED, __HIP_MEMORY_SCOPE_AGENT);
    unsigned sp = 0;
    while (__hip_atomic_load(c, __ATOMIC_RELAXED, __HIP_MEMORY_SCOPE_AGENT) < target) { __builtin_amdgcn_s_sleep(1); if (++sp > (1u << 22)) break; }
}
__device__ __forceinline__ float* hrow(const Args& a, int row) {
    return row < RM ? a.out + (size_t)row * DM : (float*)(a.ws + HMETA_OFF) + (size_t)(row - RM) * DM;
}
__device__ __forceinline__ int chunk_row(int b, int n, int j) {
    if (n == 0) return j >= 48 ? RMETA + (j - 48) : -1;
    return b * SEQ + (n - 1) * 64 + j;
}

namespace pg8 {
constexpr int BM = 256, BK = 64, HALF = 128, HTB = HALF * BK * 2, NXCD = 8, WGM = 8;
__device__ __forceinline__ int lds_byte(int r, int c) { const int st = (r >> 4) * 2 + (c >> 5), rr = r & 15, cc = c & 31, ob = rr * 64 + cc * 2; return st * 1024 + (ob ^ (((ob >> 9) & 1) << 5)); }
__device__ __forceinline__ void stage_rc(int b, int& Rr, int& C) { const int st = b / 1024, sb = b % 1024, swz = sb ^ (((sb >> 9) & 1) << 5); Rr = (st >> 1) * 16 + swz / 64; C = (st & 1) * 32 + (swz % 64) / 2; }
__device__ __forceinline__ int perm32(int rho) { const int n = rho >> 4, i = rho & 15; return 8 * (i >> 2) + 4 * n + (i & 3); }
struct Unit { int pm, pn; };
struct Gemm { const bf16_t* A; const bf16_t* Bt; int M, N, K, lda; };
struct StaticOrder {
    int nM, nN, nwg, G, c;
    __device__ void init(int M, int N, int G_, int c_) { nM = M / BM; nN = N / BM; nwg = nM * nN; G = G_; c = c_; }
    __device__ bool next(int i, Unit& u) const {
        const long L = (long)i * G + c; if (L >= nwg) return false;
        int wgid = (int)L; { const int q = nwg / NXCD, r = nwg % NXCD, xcd = wgid % NXCD, off = wgid / NXCD; wgid = (xcd < r ? xcd * (q + 1) : r * (q + 1) + (xcd - r) * q) + off; }
        const int nig = WGM * nN, gid = wgid / nig, fm = gid * WGM, gsz = (nM - fm) < WGM ? (nM - fm) : WGM;
        u.pm = fm + ((wgid % nig) % gsz); u.pn = (wgid % nig) / gsz; return true;
    }
};
template <class Epi>
__device__ __forceinline__ void gemm_phase(LAS unsigned char* lds, const Gemm g, const StaticOrder& S, const Epi& E) {
    int tid_ = threadIdx.x; asm volatile("" : "+v"(tid_));
    const int tid = tid_, wid = __builtin_amdgcn_readfirstlane(tid >> 6), lane = tid & 63, wr = wid >> 2, wc = wid & 3, fr = lane & 15, fq = lane >> 4;
    const int K = g.K, nt = K / BK, lda = g.lda;
    unsigned voffA[2], voffB[2];
#pragma unroll
    for (int i = 0; i < 2; ++i) { int Rr, C; stage_rc(tid * 16 + i * 8192, Rr, C); const int Rb = (Rr & ~31) + perm32(Rr & 31);
        voffA[i] = (unsigned)(Rr * lda + C) * 2u; voffB[i] = (unsigned)(Rb * K + C) * 2u; }
    const size_t kstep = (size_t)(BK * 2);
    const size_t hstepA = (size_t)HALF * lda * 2, hstepB = (size_t)HALF * K * 2;
    const size_t tstepA = 2 * hstepA, tstepB = 2 * hstepB;
    const unsigned ldsw = (unsigned)wid * 1024u;
    const int aoff = lds_byte(wr * 64 + fr, fq * 8), boff = lds_byte(wc * 32 + fr, fq * 8);
#define PG8_SA(b, h) (((b) * 2 + (h)) * HTB)
#define PG8_SB(b, h) ((4 + (b) * 2 + (h)) * HTB)
#define PG8_STAGE(bufoff, gbase, voff) do { _Pragma("unroll") for (int _i = 0; _i < 2; ++_i) \
        __builtin_amdgcn_global_load_lds((const unsigned*)((const char*)(gbase) + (voff)[_i]), (LAS unsigned*)(lds + (bufoff) + ldsw + _i * 8192), 16, 0, 0); } while (0)
#define PG8_LDA(dst, b, h) do { _Pragma("unroll") for (int m = 0; m < 4; ++m) _Pragma("unroll") for (int k = 0; k < 2; ++k) dst[m][k] = *(const LAS bf16x8*)(lds + PG8_SA(b, h) + aoff + m * 2048 + k * 1024); } while (0)
#define PG8_LDB(dst, b, h) do { _Pragma("unroll") for (int n = 0; n < 2; ++n) _Pragma("unroll") for (int k = 0; k < 2; ++k) dst[n][k] = *(const LAS bf16x8*)(lds + PG8_SB(b, h) + boff + n * 2048 + k * 1024); } while (0)
#define PG8_MMA(ai, bj, At, Bt) do { __builtin_amdgcn_s_setprio(1); _Pragma("unroll") for (int m = 0; m < 4; ++m) _Pragma("unroll") for (int n = 0; n < 2; ++n) _Pragma("unroll") for (int k = 0; k < 2; ++k) \
        acc[ai][bj][m][n] = __builtin_amdgcn_mfma_f32_16x16x32_bf16(Bt[n][k], At[m][k], acc[ai][bj][m][n], 0, 0, 0); __builtin_amdgcn_s_setprio(0); } while (0)
#define PG8_WAIT_V(n) asm volatile("s_waitcnt vmcnt(" #n ")" ::: "memory")
#define PG8_WAIT_L(n) asm volatile("s_waitcnt lgkmcnt(" #n ")" ::: "memory")
#define PG8_BAR __builtin_amdgcn_s_barrier()
#define PG8_SCHED __builtin_amdgcn_sched_barrier(0)
    Unit cur, nxt; int ui = 0;
    if (!S.next(0, cur)) return;
    f32x4 acc[2][2][4][2];
#pragma unroll
    for (int a = 0; a < 2; ++a)
#pragma unroll
        for (int b = 0; b < 2; ++b)
#pragma unroll
            for (int m = 0; m < 4; ++m)
#pragma unroll
                for (int n = 0; n < 2; ++n) acc[a][b][m][n] = (f32x4){0.f, 0.f, 0.f, 0.f};
    bf16x8 At[4][2], B0[2][2], B1[2][2];
    const char* cA = (const char*)g.A + (size_t)cur.pm * tstepA; const char* cB = (const char*)g.Bt + (size_t)cur.pn * tstepB;
    PG8_STAGE(PG8_SB(0, 0), cB, voffB); PG8_STAGE(PG8_SB(0, 1), cB + hstepB, voffB); PG8_STAGE(PG8_SA(0, 0), cA, voffA); PG8_STAGE(PG8_SA(0, 1), cA + hstepA, voffA);
    if (wr == 1) PG8_BAR;
    PG8_WAIT_V(2); PG8_BAR;
    PG8_STAGE(PG8_SB(1, 0), cB + kstep, voffB); PG8_STAGE(PG8_SA(1, 0), cA + kstep, voffA); PG8_STAGE(PG8_SB(1, 1), cB + hstepB + kstep, voffB);
    PG8_WAIT_V(6); PG8_BAR;
    for (;;) {
        const bool has_next = S.next(ui + 1, nxt);
        const char* nA = has_next ? (const char*)g.A + (size_t)nxt.pm * tstepA : cA; const char* nB = has_next ? (const char*)g.Bt + (size_t)nxt.pn * tstepB : cB;
        for (int t = 0; t < nt; t += 2) {
            const bool last = (t == nt - 2);
            const char* a1 = cA + (size_t)(t + 1) * kstep;
            const char* a2 = last ? nA : cA + (size_t)(t + 2) * kstep; const char* b2 = last ? nB : cB + (size_t)(t + 2) * kstep;
            const char* a3 = a2 + kstep; const char* b3 = b2 + kstep;
            PG8_LDB(B0, 0, 0); PG8_LDB(B1, 0, 1); PG8_SCHED; PG8_LDA(At, 0, 0); PG8_STAGE(PG8_SA(1, 1), a1 + hstepA, voffA);
            PG8_WAIT_V(8); PG8_WAIT_L(0); PG8_BAR; PG8_MMA(0, 0, At, B0); PG8_MMA(0, 1, At, B1); PG8_BAR; PG8_SCHED;
            PG8_LDA(At, 0, 1); PG8_STAGE(PG8_SB(0, 0), b2, voffB); PG8_STAGE(PG8_SB(0, 1), b2 + hstepB, voffB); PG8_STAGE(PG8_SA(0, 0), a2, voffA);
            PG8_WAIT_V(8); PG8_WAIT_L(0); PG8_BAR; PG8_MMA(1, 0, At, B0); PG8_MMA(1, 1, At, B1); PG8_BAR; PG8_SCHED;
            PG8_LDB(B0, 1, 0); PG8_LDB(B1, 1, 1); PG8_SCHED; PG8_LDA(At, 1, 0); PG8_STAGE(PG8_SA(0, 1), a2 + hstepA, voffA);
            PG8_WAIT_V(8); PG8_WAIT_L(0); PG8_BAR; PG8_MMA(0, 0, At, B0); PG8_MMA(0, 1, At, B1); PG8_BAR; PG8_SCHED;
            PG8_LDA(At, 1, 1); PG8_STAGE(PG8_SB(1, 0), b3, voffB); PG8_STAGE(PG8_SB(1, 1), b3 + hstepB, voffB); PG8_STAGE(PG8_SA(1, 0), a3, voffA);
            PG8_WAIT_V(8); PG8_WAIT_L(0); PG8_BAR; PG8_MMA(1, 0, At, B0); PG8_MMA(1, 1, At, B1); PG8_BAR; PG8_SCHED;
        }
        if (wr == 0) PG8_BAR;
        if constexpr (!Epi::AFTER_DRAIN) E(acc, cur, wr, wc, fr, fq);
        if (!has_next) break;
#pragma unroll
        for (int a = 0; a < 2; ++a)
#pragma unroll
            for (int b = 0; b < 2; ++b)
#pragma unroll
                for (int m = 0; m < 4; ++m)
#pragma unroll
                    for (int n = 0; n < 2; ++n) acc[a][b][m][n] = (f32x4){0.f, 0.f, 0.f, 0.f};
        cur = nxt; cA = nA; cB = nB; ++ui;
        if (wr == 1) PG8_BAR;
    }
    PG8_WAIT_V(0);
    PG8_BAR;
    if constexpr (Epi::AFTER_DRAIN) E.fused(acc, cur, wr, wc, fr, fq, lds);
#undef PG8_SA
#undef PG8_SB
#undef PG8_STAGE
#undef PG8_LDA
#undef PG8_LDB
#undef PG8_MMA
#undef PG8_WAIT_V
#undef PG8_WAIT_L
#undef PG8_BAR
#undef PG8_SCHED
}

template <int MODE> struct Epi {
    static constexpr bool AFTER_DRAIN = false;
    bf16_t* O; int ldo;
    float* ssq;
    const bf16_t* Y; int ldy;
    const float* bias;
    __device__ __forceinline__ void operator()(const f32x4 (&acc)[2][2][4][2], const Unit& u, int wr, int wc, int fr, int fq) const {
#pragma unroll
        for (int ai = 0; ai < 2; ++ai)
#pragma unroll
            for (int m = 0; m < 4; ++m) {
                const int row = u.pm * BM + ai * HALF + wr * 64 + m * 16 + fr;
                float ss = 0.f;
#pragma unroll
                for (int bj = 0; bj < 2; ++bj) {
                    const int col0 = u.pn * BM + bj * HALF + wc * 32 + 8 * fq;
                    f32x4 v0 = acc[ai][bj][m][0], v1 = acc[ai][bj][m][1];
                    if (MODE == 1) { ss += v0[0] * v0[0] + v0[1] * v0[1] + v0[2] * v0[2] + v0[3] * v0[3] + v1[0] * v1[0] + v1[1] * v1[1] + v1[2] * v1[2] + v1[3] * v1[3]; }
                    if (MODE == 2) {
#pragma unroll
                        for (int j = 0; j < 4; ++j) { float a = fmaxf(v0[j], 0.f); v0[j] = a * a; float b = fmaxf(v1[j], 0.f); v1[j] = b * b; }
                    }
                    if (MODE == 3) {
                        const u32x4 yv = *(const u32x4*)(Y + (size_t)row * ldy + col0);
                        const f32x4 b0 = *(const f32x4*)(bias + col0), b1 = *(const f32x4*)(bias + col0 + 4);
                        v0[0] = bf_lo(yv.x) * sigmoidf_(v0[0] + b0[0]); v0[1] = bf_hi(yv.x) * sigmoidf_(v0[1] + b0[1]);
                        v0[2] = bf_lo(yv.y) * sigmoidf_(v0[2] + b0[2]); v0[3] = bf_hi(yv.y) * sigmoidf_(v0[3] + b0[3]);
                        v1[0] = bf_lo(yv.z) * sigmoidf_(v1[0] + b1[0]); v1[1] = bf_hi(yv.z) * sigmoidf_(v1[1] + b1[1]);
                        v1[2] = bf_lo(yv.w) * sigmoidf_(v1[2] + b1[2]); v1[3] = bf_hi(yv.w) * sigmoidf_(v1[3] + b1[3]);
                    }
                    u32x4 w; w.x = cvt_pk_bf16(v0[0], v0[1]); w.y = cvt_pk_bf16(v0[2], v0[3]); w.z = cvt_pk_bf16(v1[0], v1[1]); w.w = cvt_pk_bf16(v1[2], v1[3]);
                    *(u32x4*)(O + (size_t)row * ldo + col0) = w;
                }
                if (MODE == 1) {
                    ss += __shfl_xor(ss, 16); ss += __shfl_xor(ss, 32);
                    if (fq == 0) ssq[(size_t)row * 16 + u.pn * 4 + wc] = ss;
                }
            }
    }
};

struct EpiRes {
    static constexpr bool AFTER_DRAIN = true;
    const float* hin; float* h;
    const float* g1; const float* g2;
    bf16_t* HN;
    float* xb1; float* xb2;
    unsigned* c1; unsigned* c2;
    __device__ __forceinline__ void exchange(const f32x4 (&acc)[2][2][4][2], const Unit& u, int wr, int wc, int fr, int fq, LAS unsigned char* lds, float* xb, unsigned* cnt) const {
        LAS float* P = (LAS float*)lds; LAS float* S = (LAS float*)(lds + 4096);
        const int tid = threadIdx.x;
#pragma unroll
        for (int ai = 0; ai < 2; ++ai)
#pragma unroll
            for (int m = 0; m < 4; ++m) {
                float ss = 0.f;
#pragma unroll
                for (int bj = 0; bj < 2; ++bj)
#pragma unroll
                    for (int n = 0; n < 2; ++n) { const f32x4 v = acc[ai][bj][m][n]; ss += v[0] * v[0] + v[1] * v[1] + v[2] * v[2] + v[3] * v[3]; }
                ss += __shfl_xor(ss, 16); ss += __shfl_xor(ss, 32);
                if (fq == 0) P[(ai * HALF + wr * 64 + m * 16 + fr) * 4 + wc] = ss;
            }
        __syncthreads();
        if (tid < 256) { const f32x4 p = *(const LAS f32x4*)(P + tid * 4); st_agent(xb + ((size_t)u.pm * 256 + tid) * 4 + u.pn, (p[0] + p[1]) + (p[2] + p[3])); }
        asm volatile("s_waitcnt vmcnt(0)" ::: "memory");
        __syncthreads();
        if (tid == 0) cnt_arrive_wait(cnt + u.pm * 32, 4u);
        __syncthreads();
        if (tid < 256) { const float* q = xb + ((size_t)u.pm * 256 + tid) * 4; const float t = (ld_agent(q) + ld_agent(q + 1)) + (ld_agent(q + 2) + ld_agent(q + 3));
            S[tid] = rsqrtf(t * (1.f / 1024.f) + EPS); }
        __syncthreads();
    }
    __device__ __forceinline__ void fused(f32x4 (&acc)[2][2][4][2], const Unit& u, int wr, int wc, int fr, int fq, LAS unsigned char* lds) const {
        const LAS float* S = (const LAS float*)(lds + 4096);
        exchange(acc, u, wr, wc, fr, fq, lds, xb1, c1);
#pragma unroll
        for (int bj = 0; bj < 2; ++bj) {
            const int col0 = u.pn * BM + bj * HALF + wc * 32 + 8 * fq;
            const f32x4 ga = *(const f32x4*)(g1 + col0), gb = *(const f32x4*)(g1 + col0 + 4);
#pragma unroll
            for (int ai = 0; ai < 2; ++ai)
#pragma unroll
                for (int m = 0; m < 4; ++m) {
                    const int rl = ai * HALF + wr * 64 + m * 16 + fr; const float inv = S[rl];
                    float* hp = h + (size_t)(u.pm * BM + rl) * 1024 + col0;
                    const float* hq = hin + (size_t)(u.pm * BM + rl) * 1024 + col0;
                    const f32x4 h0 = *(const f32x4*)hq, h1 = *(const f32x4*)(hq + 4);
                    f32x4 v0 = acc[ai][bj][m][0], v1 = acc[ai][bj][m][1];
                    v0 = h0 + v0 * inv * ga; v1 = h1 + v1 * inv * gb;
                    *(f32x4*)hp = v0; *(f32x4*)(hp + 4) = v1;
                    acc[ai][bj][m][0] = v0; acc[ai][bj][m][1] = v1;
                }
        }
        if (g2 == nullptr) return;
        __syncthreads();
        exchange(acc, u, wr, wc, fr, fq, lds, xb2, c2);
#pragma unroll
        for (int bj = 0; bj < 2; ++bj) {
            const int col0 = u.pn * BM + bj * HALF + wc * 32 + 8 * fq;
            const f32x4 ga = *(const f32x4*)(g2 + col0), gb = *(const f32x4*)(g2 + col0 + 4);
#pragma unroll
            for (int ai = 0; ai < 2; ++ai)
#pragma unroll
                for (int m = 0; m < 4; ++m) {
                    const int rl = ai * HALF + wr * 64 + m * 16 + fr; const float inv = S[rl];
                    const f32x4 v0 = acc[ai][bj][m][0] * inv * ga, v1 = acc[ai][bj][m][1] * inv * gb;
                    u32x4 w; w.x = cvt_pk_bf16(v0[0], v0[1]); w.y = cvt_pk_bf16(v0[2], v0[3]); w.z = cvt_pk_bf16(v1[0], v1[1]); w.w = cvt_pk_bf16(v1[2], v1[3]);
                    *(u32x4*)(HN + (size_t)(u.pm * BM + rl) * 1024 + col0) = w;
                }
        }
    }
};
}

__device__ __forceinline__ bf16x8 ldsfrag(const LAS unsigned char* p) { return *(const LAS bf16x8*)p; }
#define LBAR() do { asm volatile("s_waitcnt lgkmcnt(0)" ::: "memory"); __builtin_amdgcn_s_barrier(); asm volatile("" ::: "memory"); } while (0)
#define MFMA16(X, Y, ACC) __builtin_amdgcn_mfma_f32_16x16x32_bf16((X), (Y), (ACC), 0, 0, 0)


template <int MODE>
__device__ __forceinline__ void meta_gemm(LAS unsigned char* L, const bf16_t* A, int lda, const bf16_t* Bt, int N, int K,
                                          bf16_t* O, int ldo, float* ssq, const bf16_t* Y, int ldy, const float* bias,
                                          float* hm = nullptr, const float* g1 = nullptr, const float* g2 = nullptr, float* xm1 = nullptr, float* xm2 = nullptr, unsigned* cm1 = nullptr, unsigned* cm2 = nullptr) {
    int tid_ = threadIdx.x; asm volatile("" : "+v"(tid_));
    const int tid = tid_, lane = tid & 63, w = __builtin_amdgcn_readfirstlane(tid >> 6), fr = lane & 15, fq = lane >> 4;
    const int t = (int)gridDim.x - 1 - (int)blockIdx.x;
    if (t >= N / 64) return;
    const int n0 = t * 64, kw = K / 8, k0 = w * kw;
    f32x4 acc[4];
#pragma unroll
    for (int nt = 0; nt < 4; ++nt) acc[nt] = (f32x4){0.f, 0.f, 0.f, 0.f};
    const bf16_t* ap = A + (size_t)fr * lda + k0 + fq * 8;
    const bf16_t* bp = Bt + (size_t)(n0 + fr) * K + k0 + fq * 8;
#pragma unroll 2
    for (int k = 0; k < kw; k += 32) {
        const bf16x8 af = *(const bf16x8*)(ap + k);
#pragma unroll
        for (int nt = 0; nt < 4; ++nt) { const bf16x8 bf = *(const bf16x8*)(bp + (size_t)nt * 16 * K + k); acc[nt] = MFMA16(bf, af, acc[nt]); }
    }
    LAS f32x4* P = (LAS f32x4*)L;
#pragma unroll
    for (int nt = 0; nt < 4; ++nt) P[(w * 4 + nt) * 64 + lane] = acc[nt];
    __syncthreads();
    if (MODE == 4) {
        if (w == 0) {
            f32x4 v[4]; float ss = 0.f;
#pragma unroll
            for (int nt = 0; nt < 4; ++nt) { v[nt] = P[nt * 64 + lane];
#pragma unroll
                for (int ww = 1; ww < 8; ++ww) v[nt] += P[(ww * 4 + nt) * 64 + lane];
                ss += v[nt][0] * v[nt][0] + v[nt][1] * v[nt][1] + v[nt][2] * v[nt][2] + v[nt][3] * v[nt][3]; }
            ss += __shfl_xor(ss, 16); ss += __shfl_xor(ss, 32);
            if (fq == 0) st_agent(xm1 + fr * 16 + t, ss);
            asm volatile("s_waitcnt vmcnt(0)" ::: "memory");
            if (lane == 0) cnt_arrive_wait(cm1, 16u);
            __builtin_amdgcn_wave_barrier();
            float tot = 0.f;
#pragma unroll
            for (int q = 0; q < 16; ++q) tot += ld_agent(xm1 + fr * 16 + q);
            const float inv = rsqrtf(tot * (1.f / 1024.f) + EPS);
            float ss2 = 0.f;
#pragma unroll
            for (int nt = 0; nt < 4; ++nt) { const int col = n0 + nt * 16 + 4 * fq; float* hp = hm + fr * 1024 + col;
                const f32x4 gg = *(const f32x4*)(g1 + col); const f32x4 h0 = *(const f32x4*)hp;
                v[nt] = h0 + v[nt] * inv * gg; *(f32x4*)hp = v[nt];
                ss2 += v[nt][0] * v[nt][0] + v[nt][1] * v[nt][1] + v[nt][2] * v[nt][2] + v[nt][3] * v[nt][3]; }
            if (g2 != nullptr) {
                ss2 += __shfl_xor(ss2, 16); ss2 += __shfl_xor(ss2, 32);
                if (fq == 0) st_agent(xm2 + fr * 16 + t, ss2);
                asm volatile("s_waitcnt vmcnt(0)" ::: "memory");
                if (lane == 0) cnt_arrive_wait(cm2, 16u);
                __builtin_amdgcn_wave_barrier();
                float tot2 = 0.f;
#pragma unroll
                for (int q = 0; q < 16; ++q) tot2 += ld_agent(xm2 + fr * 16 + q);
                const float inv2 = rsqrtf(tot2 * (1.f / 1024.f) + EPS);
#pragma unroll
                for (int nt = 0; nt < 4; ++nt) { const int col = n0 + nt * 16 + 4 * fq; const f32x4 gg = *(const f32x4*)(g2 + col);
                    const f32x4 y = v[nt] * inv2 * gg; u32x2 o; o.x = cvt_pk_bf16(y[0], y[1]); o.y = cvt_pk_bf16(y[2], y[3]);
                    *(u32x2*)(O + (size_t)fr * ldo + col) = o; }
            }
        }
    } else if (w == 0) {
        float ss = 0.f;
#pragma unroll
        for (int nt = 0; nt < 4; ++nt) {
            f32x4 v = P[nt * 64 + lane];
#pragma unroll
            for (int ww = 1; ww < 8; ++ww) v += P[(ww * 4 + nt) * 64 + lane];
            const int col = n0 + nt * 16 + 4 * fq;
            if (MODE == 1) ss += v[0] * v[0] + v[1] * v[1] + v[2] * v[2] + v[3] * v[3];
            if (MODE == 2) {
#pragma unroll
                for (int j = 0; j < 4; ++j) { const float r = fmaxf(v[j], 0.f); v[j] = r * r; }
            }
            if (MODE == 3) {
                const u32x2 yv = *(const u32x2*)(Y + (size_t)fr * ldy + col);
                const f32x4 bb = *(const f32x4*)(bias + col);
                v[0] = bf_lo(yv.x) * sigmoidf_(v[0] + bb[0]); v[1] = bf_hi(yv.x) * sigmoidf_(v[1] + bb[1]);
                v[2] = bf_lo(yv.y) * sigmoidf_(v[2] + bb[2]); v[3] = bf_hi(yv.y) * sigmoidf_(v[3] + bb[3]);
            }
            u32x2 o; o.x = cvt_pk_bf16(v[0], v[1]); o.y = cvt_pk_bf16(v[2], v[3]);
            *(u32x2*)(O + (size_t)fr * ldo + col) = o;
        }
        if (MODE == 1) {
            ss += __shfl_xor(ss, 16); ss += __shfl_xor(ss, 32);
            if (fq == 0) ssq[fr * 16 + t] = ss;
        }
    }
    __syncthreads();
}

__device__ __forceinline__ void transpose_item(const float* W, int K, int N, bf16_t* WT, int dst_row0, LAS float* scr, int k0, int n0, int lane) {
#pragma unroll 8
    for (int i = 0; i < 32; ++i) { const int kk = 2 * i + (lane >> 5); scr[kk * 33 + (lane & 31)] = W[(size_t)(k0 + kk) * N + n0 + (lane & 31)]; }
    asm volatile("s_waitcnt lgkmcnt(0)" ::: "memory");
    const int c = lane & 7;
#pragma unroll
    for (int j = 0; j < 4; ++j) { const int n = (lane >> 3) + 8 * j; const LAS float* s = scr + (8 * c) * 33 + n;
        u32x4 o; o.x = cvt_pk_bf16(s[0 * 33], s[1 * 33]); o.y = cvt_pk_bf16(s[2 * 33], s[3 * 33]); o.z = cvt_pk_bf16(s[4 * 33], s[5 * 33]); o.w = cvt_pk_bf16(s[6 * 33], s[7 * 33]);
        *(u32x4*)(WT + (size_t)(dst_row0 + n) * K + k0 + 8 * c) = o; }
    asm volatile("s_waitcnt lgkmcnt(0)" ::: "memory");
}


constexpr int WC_I0 = 16 * 160, WC_I1 = 32 * 32, WC_I2 = 16 * 128, WC_I3 = 64 * 32, WC_I4 = 16 * 80, WC_I5 = 16 * 32, WC_I6 = 8 * 16, WC_I7 = WC_I2, WC_I8 = WC_I3;
constexpr int WC_C0 = 0, WC_C1 = WC_I0, WC_C5 = WC_I0 + WC_I1 + WC_I2 + WC_I3 + WC_I4, WC_C9 = WC_C5 + WC_I5 + WC_I6 + WC_I7 + WC_I8;
__device__ __forceinline__ void weight_convert(const Args& a, LAS unsigned char* lds, int it0, int it1, int vb, int nvb) {
    int tid_ = threadIdx.x; asm volatile("" : "+v"(tid_));
    const int tid = tid_, lane = tid & 63, wave = tid >> 6;
    unsigned char* ws = a.ws;
    LAS float* scr = (LAS float*)(lds + wave * 16384);
    constexpr int I0 = WC_I0, I1 = WC_I1, I2 = WC_I2, I3 = WC_I3, I4 = WC_I4, I5 = WC_I5, I6 = WC_I6, I7 = WC_I7;
    for (int it = it0 + vb * 8 + wave; it < it1; it += nvb * 8) {
        int r = it; const float* W; int K, N; bf16_t* WT; bool perm = false;
        if (r < I0) { W = a.in[2]; K = 1024; N = 5120; WT = (bf16_t*)(ws + W_INAB); perm = true; }
        else if ((r -= I0) < I1) { W = a.in[3]; K = 2048; N = 1024; WT = (bf16_t*)(ws + W_OUTAB); }
        else if ((r -= I1) < I2) { W = a.in[27]; K = 1024; N = 4096; WT = (bf16_t*)(ws + W_W1_0); }
        else if ((r -= I2) < I3) { W = a.in[28]; K = 4096; N = 1024; WT = (bf16_t*)(ws + W_W2_0); }
        else if ((r -= I3) < I4) { W = a.in[12]; K = 1024; N = 2560; WT = (bf16_t*)(ws + W_INCD); }
        else if ((r -= I4) < I5) { W = a.in[13]; K = 1024; N = 1024; WT = (bf16_t*)(ws + W_OUTCD); }
        else if ((r -= I5) < I6) { W = a.in[22]; K = 512; N = 512; WT = (bf16_t*)(ws + W_GLU); }
        else if ((r -= I6) < I7) { W = a.in[27] + (size_t)1024 * 4096; K = 1024; N = 4096; WT = (bf16_t*)(ws + W_W1_1); }
        else { r -= I7; W = a.in[28] + (size_t)1024 * 4096; K = 4096; N = 1024; WT = (bf16_t*)(ws + W_W2_1); }
        const int nblk = N / 32, kb = r / nblk, nb = r % nblk, n0 = nb * 32;
        int d0 = n0;
        if (perm) { if (n0 >= 2048 && n0 < 3072) d0 = n0 + 1024; else if (n0 >= 3072 && n0 < 4096) d0 = n0 - 1024; }
        transpose_item(W, K, N, WT, d0, scr, kb * 64, n0, lane);
    }
}

__device__ __forceinline__ void phase_prologue(const Args& a, LAS unsigned char* lds, bool copy_x) {
    int tid_ = threadIdx.x; asm volatile("" : "+v"(tid_));
    const int tid = tid_, lane = tid & 63, wave = tid >> 6;
    const int gw = blockIdx.x * 8 + wave, NGW = gridDim.x * 8;
    unsigned char* ws = a.ws;
    LAS float* scr = (LAS float*)(lds + wave * 16384);
    weight_convert(a, lds, WC_C0, WC_C1, blockIdx.x, gridDim.x);
    {
        const float* x = a.in[0]; const float* meta = a.in[1]; const float* g = a.in[26];
        bf16_t* HN = (bf16_t*)(ws + HN_OFF);
        f32x4 gg[4];
#pragma unroll
        for (int j = 0; j < 4; ++j) gg[j] = *(const f32x4*)(g + 4 * lane + 256 * j);
        for (int row0 = gw; row0 < R; row0 += 4 * NGW) {
            f32x4 v[4][4];
#pragma unroll
            for (int q = 0; q < 4; ++q) { const int row = row0 + q * NGW;
                if (row < R) { const float* src = row < RM ? x + (size_t)row * DM : meta + (size_t)(row - RM) * DM;
#pragma unroll
                    for (int j = 0; j < 4; ++j) v[q][j] = *(const f32x4*)(src + 4 * lane + 256 * j); }
                else {
#pragma unroll
                    for (int j = 0; j < 4; ++j) v[q][j] = (f32x4){0.f, 0.f, 0.f, 0.f}; } }
#pragma unroll
            for (int q = 0; q < 4; ++q) { const int row = row0 + q * NGW;
                if (row < R) {
                    float s = 0.f;
#pragma unroll
                    for (int j = 0; j < 4; ++j) s += v[q][j][0] * v[q][j][0] + v[q][j][1] * v[q][j][1] + v[q][j][2] * v[q][j][2] + v[q][j][3] * v[q][j][3];
                    const float inv = rsqrtf(wave_sum(s) * (1.f / DM) + EPS);
                    if (copy_x || row >= RM) { float* hr = hrow(a, row);
#pragma unroll
                        for (int j = 0; j < 4; ++j) *(f32x4*)(hr + 4 * lane + 256 * j) = v[q][j]; }
#pragma unroll
                    for (int j = 0; j < 4; ++j) { u32x2 o; o.x = cvt_pk_bf16(v[q][j][0] * inv * gg[j][0], v[q][j][1] * inv * gg[j][1]); o.y = cvt_pk_bf16(v[q][j][2] * inv * gg[j][2], v[q][j][3] * inv * gg[j][3]);
                        *(u32x2*)(HN + (size_t)row * DM + 4 * lane + 256 * j) = o; }
                } }
        }
    }
    const int gt = blockIdx.x * NTHREADS + tid, NGT = gridDim.x * NTHREADS;
    {
        bf16_t* WG = (bf16_t*)(ws + LRUW_OFF);
        for (int i = gt; i < 16 * 128 * 64; i += NGT) { const int k = i & 63, n = (i >> 6) & 127, blk = i >> 13;
            const float v = n < 64 ? a.in[5][(size_t)blk * 4096 + k * 64 + n] : a.in[7][(size_t)blk * 4096 + k * 64 + (n - 64)];
            WG[i] = f2bf(v); }
    }
    {
        bf16_t* BB = (bf16_t*)(ws + S5BB_OFF); bf16_t* CM = (bf16_t*)(ws + S5CM_OFF); float* AB = (float*)(ws + S5AB_OFF);
        const float* are_log = a.in[14]; const float* aim = a.in[15]; const float* bre = a.in[16]; const float* bim = a.in[17];
        const float* cre = a.in[18]; const float* cim = a.in[19]; const float* ldt = a.in[21];
        for (int i = gt; i < 32 * 64; i += NGT) {
            const int g = i >> 6, p = i & 63;
            const float dt = expf(ldt[g]); const float a_re = -expf(are_log[i]); const float a_im = aim[i];
            const float mag = expf(dt * a_re); float sn, cs; sincos_big(dt * a_im, sn, cs);
            const float ab_re = mag * cs, ab_im = mag * sn;
            AB[2 * i] = ab_re; AB[2 * i + 1] = ab_im;
            const float n_re = ab_re - 1.f, n_im = ab_im, den = a_re * a_re + a_im * a_im;
            const float z_re = (n_re * a_re + n_im * a_im) / den, z_im = (n_im * a_re - n_re * a_im) / den;
            for (int c = 0; c < 32; ++c) {
                float vr = 0.f, vi = 0.f;
                if (c < 16) { const float br = bre[(size_t)i * 16 + c], bi = bim[(size_t)i * 16 + c]; vr = z_re * br - z_im * bi; vi = z_re * bi + z_im * br; }
                BB[((size_t)g * 128 + p) * 32 + c] = f2bf(vr);
                BB[((size_t)g * 128 + 64 + p) * 32 + c] = f2bf(vi);
            }
            for (int c = 0; c < 16; ++c) {
                CM[((size_t)g * 16 + c) * 128 + p] = f2bf(cre[((size_t)g * 16 + c) * 64 + p]);
                CM[((size_t)g * 16 + c) * 128 + 64 + p] = f2bf(-cim[((size_t)g * 16 + c) * 64 + p]);
            }
        }
    }
}

__device__ __forceinline__ void phase_resnorm(const Args& a, const float* g1, const float* g2) {
    int tid_ = threadIdx.x; asm volatile("" : "+v"(tid_));
    const int tid = tid_, lane = tid & 63, wave = tid >> 6;
    const int gw = blockIdx.x * 8 + wave, NGW = gridDim.x * 8;
    bf16_t* HN = (bf16_t*)(a.ws + HN_OFF); const float* ssq = (const float*)(a.ws + SSQ_OFF);
    for (int row = gw; row < R; row += NGW) {
        bf16_t* mrow = HN + (size_t)row * DM;
        float s = 0.f;
        { const f32x4* sp = (const f32x4*)(ssq + (size_t)row * 16); const f32x4 s0 = sp[0], s1 = sp[1], s2 = sp[2], s3 = sp[3];
          s = ((s0[0] + s0[1]) + (s0[2] + s0[3])) + ((s1[0] + s1[1]) + (s1[2] + s1[3])) + ((s2[0] + s2[1]) + (s2[2] + s2[3])) + ((s3[0] + s3[1]) + (s3[2] + s3[3])); }
        const float inv = rsqrtf(s * (1.f / DM) + EPS);
        float* hr = hrow(a, row);
        f32x4 v[4]; float s2 = 0.f;
#pragma unroll
        for (int j = 0; j < 4; ++j) {
            const u32x2 mv = *(const u32x2*)(mrow + 4 * lane + 256 * j);
            const f32x4 gg = *(const f32x4*)(g1 + 4 * lane + 256 * j);
            v[j] = *(const f32x4*)(hr + 4 * lane + 256 * j);
            v[j][0] += bf_lo(mv.x) * inv * gg[0]; v[j][1] += bf_hi(mv.x) * inv * gg[1]; v[j][2] += bf_lo(mv.y) * inv * gg[2]; v[j][3] += bf_hi(mv.y) * inv * gg[3];
            *(f32x4*)(hr + 4 * lane + 256 * j) = v[j];
            s2 += v[j][0] * v[j][0] + v[j][1] * v[j][1] + v[j][2] * v[j][2] + v[j][3] * v[j][3];
        }
        if (g2) {
            const float inv2 = rsqrtf(wave_sum(s2) * (1.f / DM) + EPS);
#pragma unroll
            for (int j = 0; j < 4; ++j) { const f32x4 gg = *(const f32x4*)(g2 + 4 * lane + 256 * j);
                u32x2 o; o.x = cvt_pk_bf16(v[j][0] * inv2 * gg[0], v[j][1] * inv2 * gg[1]); o.y = cvt_pk_bf16(v[j][2] * inv2 * gg[2], v[j][3] * inv2 * gg[3]);
                *(u32x2*)(mrow + 4 * lane + 256 * j) = o; }
        }
    }
}

constexpr int LA_QS = 0, LA_KS = 17408, LA_QD = 34816, LA_KT = 52224, LA_VT = 70656, LA_PS = 75264, LA_ST = 84480, LA_CUM = 93184, LA_DEC = 125952, LA_END = 126464;
static_assert(LA_END <= LDS_BYTES, "LA lds");

template <bool HG>
__device__ __forceinline__ void la_core(LAS unsigned char* L, f32x4 (&st)[2], float l2g, bf16_t* obuf, int ldo, int ocol, int b, int n, bool dry) {
    int tid_ = threadIdx.x; asm volatile("" : "+v"(tid_));
    const int tid = tid_, lane = tid & 63, w = __builtin_amdgcn_readfirstlane(tid >> 6), fr = lane & 15, fq = lane >> 4;
    const int mt = w >> 1, nh = w & 1;
    bf16x8 qf[4];
#pragma unroll
    for (int kk = 0; kk < 4; ++kk) qf[kk] = ldsfrag(L + LA_QS + (mt * 16 + fr) * 272 + kk * 64 + fq * 16);
    f32x4 s0 = {0.f, 0.f, 0.f, 0.f}, s1 = {0.f, 0.f, 0.f, 0.f};
#pragma unroll
    for (int kk = 0; kk < 4; ++kk) {
        const bf16x8 k0 = ldsfrag(L + LA_KS + ((nh * 2) * 16 + fr) * 272 + kk * 64 + fq * 16);
        const bf16x8 k1 = ldsfrag(L + LA_KS + ((nh * 2 + 1) * 16 + fr) * 272 + kk * 64 + fq * 16);
        s0 = MFMA16(k0, qf[kk], s0); s1 = MFMA16(k1, qf[kk], s1);
    }
    const int t = mt * 16 + fr;
    {
        float p0[4], p1[4];
#pragma unroll
        for (int jj = 0; jj < 4; ++jj) {
            const int sa = (nh * 2) * 16 + 4 * fq + jj, sb = sa + 16;
            if (HG) { p0[jj] = sa <= t ? s0[jj] : 0.f; p1[jj] = sb <= t ? s1[jj] : 0.f; }
            else { p0[jj] = s0[jj] * exp2f(l2g * fabsf((float)(t - sa))); p1[jj] = s1[jj] * exp2f(l2g * fabsf((float)(t - sb))); }
        }
        u32x2 o0, o1; o0.x = cvt_pk_bf16(p0[0], p0[1]); o0.y = cvt_pk_bf16(p0[2], p0[3]); o1.x = cvt_pk_bf16(p1[0], p1[1]); o1.y = cvt_pk_bf16(p1[2], p1[3]);
        *(LAS u32x2*)(L + LA_PS + t * 144 + ((nh * 2) * 16 + 4 * fq) * 2) = o0;
        *(LAS u32x2*)(L + LA_PS + t * 144 + ((nh * 2 + 1) * 16 + 4 * fq) * 2) = o1;
    }
    f32x4 o = {0.f, 0.f, 0.f, 0.f};
#pragma unroll
    for (int kk = 0; kk < 4; ++kk) {
        const bf16x8 sf = ldsfrag(L + LA_ST + (nh * 16 + fr) * 272 + kk * 64 + fq * 16);
        const bf16x8 qq = HG ? ldsfrag(L + LA_QD + (mt * 16 + fr) * 272 + kk * 64 + fq * 16) : qf[kk];
        o = MFMA16(sf, qq, o);
    }
    if (!HG) { const float sc = exp2f(l2g * (float)(t + 1)); o[0] *= sc; o[1] *= sc; o[2] *= sc; o[3] *= sc; }
    LBAR();
#pragma unroll
    for (int kk = 0; kk < 2; ++kk) {
        const bf16x8 vf = ldsfrag(L + LA_VT + (nh * 16 + fr) * 144 + kk * 64 + fq * 16);
        const bf16x8 pf = ldsfrag(L + LA_PS + (mt * 16 + fr) * 144 + kk * 64 + fq * 16);
        o = MFMA16(vf, pf, o);
    }
    {
        const int row = chunk_row(b, n, t);
        if (row >= 0 && (row < RM || b == 0) && !dry) { u32x2 ov; ov.x = cvt_pk_bf16(o[0], o[1]); ov.y = cvt_pk_bf16(o[2], o[3]);
            *(u32x2*)(obuf + (size_t)row * ldo + ocol + nh * 16 + 4 * fq) = ov; }
    }
    float dc[4];
    if (HG) { const f32x4 dv = *(const LAS f32x4*)(L + LA_DEC + (w * 16 + 4 * fq) * 4); dc[0] = dv[0]; dc[1] = dv[1]; dc[2] = dv[2]; dc[3] = dv[3]; }
    else { const float g64 = exp2f(l2g * 64.f); dc[0] = dc[1] = dc[2] = dc[3] = g64; }
    const bf16x8 kt0 = ldsfrag(L + LA_KT + (w * 16 + fr) * 144 + fq * 16), kt1 = ldsfrag(L + LA_KT + (w * 16 + fr) * 144 + 64 + fq * 16);
#pragma unroll
    for (int et = 0; et < 2; ++et) {
#pragma unroll
        for (int jj = 0; jj < 4; ++jj) st[et][jj] *= dc[jj];
        const bf16x8 v0 = ldsfrag(L + LA_VT + (et * 16 + fr) * 144 + fq * 16), v1 = ldsfrag(L + LA_VT + (et * 16 + fr) * 144 + 64 + fq * 16);
        st[et] = MFMA16(kt0, v0, st[et]); st[et] = MFMA16(kt1, v1, st[et]);
        u32x2 sv; sv.x = cvt_pk_bf16(st[et][0], st[et][1]); sv.y = cvt_pk_bf16(st[et][2], st[et][3]);
        *(LAS u32x2*)(L + LA_ST + (et * 16 + fr) * 272 + (w * 16 + 4 * fq) * 2) = sv;
    }
}

#define UNPK8(dst, v) do { dst[0] = bf_lo((v).x); dst[1] = bf_hi((v).x); dst[2] = bf_lo((v).y); dst[3] = bf_hi((v).y); dst[4] = bf_lo((v).z); dst[5] = bf_hi((v).z); dst[6] = bf_lo((v).w); dst[7] = bf_hi((v).w); } while (0)
#define PK8(v, src) do { (v).x = cvt_pk_bf16(src[0], src[1]); (v).y = cvt_pk_bf16(src[2], src[3]); (v).z = cvt_pk_bf16(src[4], src[5]); (v).w = cvt_pk_bf16(src[6], src[7]); } while (0)

__device__ __forceinline__ void retention_unit(const Args& a, LAS unsigned char* L, int unit, bool dry) {
    int tid_ = threadIdx.x; asm volatile("" : "+v"(tid_));
    const int tid = tid_, b = unit >> 5, h = (unit >> 3) & 3, sl = unit & 7;
    const bf16_t* Z = (const bf16_t*)(a.ws + Z_OFF); bf16_t* OB = (bf16_t*)(a.ws + HN_OFF);
    const float l2g = log2f(1.f - exp2f(-5.f - (float)h));
    const int row_l = tid >> 3, c8 = tid & 7;
    const int vrow = (tid >> 2) & 63, vp = tid & 3;
    float rc[8], rs[8], stc[8], sts[8];
#pragma unroll
    for (int i = 0; i < 8; ++i) { const float invf = exp2f(-(float)(c8 * 8 + i) * (13.287712379549449f / 64.f));
        sincos_big((float)(row_l - 48) * invf, rs[i], rc[i]); sincos_big(64.f * invf, sts[i], stc[i]); }
    f32x4 st[2] = {{0.f, 0.f, 0.f, 0.f}, {0.f, 0.f, 0.f, 0.f}};
    for (int i = tid; i < 32 * 272 / 4; i += NTHREADS) ((LAS unsigned*)(L + LA_ST))[i] = 0u;
    u32x4 q1, q2, k1, k2, vv;
#define RET_LOAD(n_) do { const int r_ = chunk_row(b, (n_), row_l); \
        if (r_ >= 0) { const bf16_t* zr = Z + (size_t)r_ * IN_AB; \
            q1 = *(const u32x4*)(zr + h * 128 + c8 * 8); q2 = *(const u32x4*)(zr + h * 128 + 64 + c8 * 8); \
            k1 = *(const u32x4*)(zr + 512 + h * 128 + c8 * 8); k2 = *(const u32x4*)(zr + 512 + h * 128 + 64 + c8 * 8); \
        } else { q1 = q2 = k1 = k2 = (u32x4){0u, 0u, 0u, 0u}; } \
        vv = (u32x4){0u, 0u, 0u, 0u}; \
        if (tid < 256) { const int rv = chunk_row(b, (n_), vrow); if (rv >= 0) vv = *(const u32x4*)(Z + (size_t)rv * IN_AB + 1024 + h * 256 + sl * 32 + vp * 8); } } while (0)
    RET_LOAD(0);
    for (int n = 0; n < NCH; ++n) {
        {
            const float kdec = exp2f(l2g * (float)(63 - row_l));
            float x1[8], x2[8], y1[8], y2[8], qo1[8], qo2[8], ko1[8], ko2[8];
            UNPK8(x1, q1); UNPK8(x2, q2); UNPK8(y1, k1); UNPK8(y2, k2);
#pragma unroll
            for (int i = 0; i < 8; ++i) {
                const float sn = rs[i], cs = rc[i];
                rc[i] = cs * stc[i] - sn * sts[i]; rs[i] = sn * stc[i] + cs * sts[i];
                qo1[i] = (x1[i] * cs - x2[i] * sn) * 0.08838834764831845f; qo2[i] = (x1[i] * sn + x2[i] * cs) * 0.08838834764831845f;
                ko1[i] = y1[i] * cs - y2[i] * sn; ko2[i] = y1[i] * sn + y2[i] * cs;
            }
            u32x4 w1, w2;
            PK8(w1, qo1); PK8(w2, qo2);
            *(LAS u32x4*)(L + LA_QS + row_l * 272 + c8 * 16) = w1; *(LAS u32x4*)(L + LA_QS + row_l * 272 + 128 + c8 * 16) = w2;
            PK8(w1, ko1); PK8(w2, ko2);
            *(LAS u32x4*)(L + LA_KS + row_l * 272 + c8 * 16) = w1; *(LAS u32x4*)(L + LA_KS + row_l * 272 + 128 + c8 * 16) = w2;
#pragma unroll
            for (int i = 0; i < 8; ++i) {
                *(LAS bf16_t*)(L + LA_KT + (c8 * 8 + i) * 144 + row_l * 2) = f2bf(ko1[i] * kdec);
                *(LAS bf16_t*)(L + LA_KT + (64 + c8 * 8 + i) * 144 + row_l * 2) = f2bf(ko2[i] * kdec);
            }
            if (tid < 256) {
                const unsigned va[4] = {vv.x, vv.y, vv.z, vv.w};
#pragma unroll
                for (int i = 0; i < 8; ++i) *(LAS bf16_t*)(L + LA_VT + (vp * 8 + i) * 144 + vrow * 2) = (bf16_t)((i & 1) ? (va[i >> 1] >> 16) : (va[i >> 1] & 0xffffu));
            }
        }
        if (n + 1 < NCH) RET_LOAD(n + 1);
        LBAR();
        la_core<false>(L, st, l2g, OB, DM, h * 256 + sl * 32, b, n, dry);
        LBAR();
    }
#undef RET_LOAD
}

constexpr size_t HGT_OFF = Z_OFF + (size_t)R * IN_CD * 2;
constexpr size_t HGT_ITEM = 71680;
static_assert(HGT_OFF + (size_t)NB * NCH * 4 * HGT_ITEM <= HN_OFF, "HGRN tile images fit behind z_cd");
__device__ __forceinline__ void hgrn_prepass(const Args& a, LAS unsigned char* L) {
    int tid_ = threadIdx.x; asm volatile("" : "+v"(tid_));
    const int tid = tid_;
    const bf16_t* Z = (const bf16_t*)(a.ws + Z_OFF);
    const int row_l = tid >> 3, c8 = tid & 7;
    const float* lg = a.in[25];
    for (int it = blockIdx.x; it < NB * NCH * 4; it += gridDim.x) {
        const int h = it & 3, bn = it >> 2, b = bn / NCH, n = bn % NCH;
        float lb1[8], lb2[8];
#pragma unroll
        for (int i = 0; i < 8; ++i) { const int d = h * 128 + c8 * 8 + i; lb1[i] = sigmoidf_(lg[d] - lg[512 + d]); lb2[i] = sigmoidf_(lg[d + 64] - lg[512 + d + 64]); }
        const int r = chunk_row(b, n, row_l);
        const bool valid = r >= 0;
        u32x4 q1, q2, f1, f2;
        if (valid) { const bf16_t* zr = Z + (size_t)r * IN_CD;
            q1 = *(const u32x4*)(zr + 512 + h * 128 + c8 * 8); q2 = *(const u32x4*)(zr + 512 + h * 128 + 64 + c8 * 8);
            f1 = *(const u32x4*)(zr + 1024 + h * 128 + c8 * 8); f2 = *(const u32x4*)(zr + 1024 + h * 128 + 64 + c8 * 8);
        } else { q1 = q2 = f1 = f2 = (u32x4){0u, 0u, 0u, 0u}; }
        float qv1[8], qv2[8], kv1[8], kv2[8];
        {
            float fp1[8], fp2[8], lf1[8], lf2[8];
            UNPK8(qv1, q1); UNPK8(qv2, q2); UNPK8(fp1, f1); UNPK8(fp2, f2);
#pragma unroll
            for (int i = 0; i < 8; ++i) {
                const float ff1 = lb1[i] + (1.f - lb1[i]) * sigmoidf_(fp1[i]), ff2 = lb2[i] + (1.f - lb2[i]) * sigmoidf_(fp2[i]);
                if (valid) { lf1[i] = __logf(ff1); lf2[i] = __logf(ff2); kv1[i] = 1.f - ff1; kv2[i] = 1.f - ff2; }
                else { lf1[i] = 0.f; lf2[i] = 0.f; kv1[i] = 0.f; kv2[i] = 0.f; qv1[i] = 0.f; qv2[i] = 0.f; }
            }
            LAS float* cr = (LAS float*)(L + LA_CUM) + row_l * 128;
            *(LAS f32x4*)(cr + c8 * 8) = (f32x4){lf1[0], lf1[1], lf1[2], lf1[3]}; *(LAS f32x4*)(cr + c8 * 8 + 4) = (f32x4){lf1[4], lf1[5], lf1[6], lf1[7]};
            *(LAS f32x4*)(cr + 64 + c8 * 8) = (f32x4){lf2[0], lf2[1], lf2[2], lf2[3]}; *(LAS f32x4*)(cr + 64 + c8 * 8 + 4) = (f32x4){lf2[4], lf2[5], lf2[6], lf2[7]};
        }
        __syncthreads();
        {
            const int d = tid & 127, sg = tid >> 7; LAS float* c = (LAS float*)(L + LA_CUM) + (sg * 16) * 128 + d; float run = 0.f;
#pragma unroll
            for (int rr = 0; rr < 16; ++rr) { run += c[rr * 128]; c[rr * 128] = run; }
        }
        __syncthreads();
        {
            const LAS float* C = (const LAS float*)(L + LA_CUM);
            const int sg = row_l >> 4;
            float qi[16], ki[16], qd[16], kd[16];
#pragma unroll
            for (int i = 0; i < 16; ++i) {
                const int d = (i < 8) ? c8 * 8 + i : 64 + c8 * 8 + (i - 8);
                const float t0 = C[15 * 128 + d], t1 = C[31 * 128 + d], t2 = C[47 * 128 + d], t3 = C[63 * 128 + d];
                float cum = C[row_l * 128 + d];
                cum += (sg > 0 ? t0 : 0.f) + (sg > 1 ? t1 : 0.f) + (sg > 2 ? t2 : 0.f);
                const float cmid = t0 + t1, total = (t0 + t1) + (t2 + t3);
                const float q = (i < 8) ? qv1[i & 7] : qv2[i & 7], k = (i < 8) ? kv1[i & 7] : kv2[i & 7];
                qi[i] = q * __expf(fminf(cum - cmid, 80.f)); ki[i] = k * __expf(fminf(cmid - cum, 80.f));
                qd[i] = q * __expf(cum); kd[i] = k * __expf(total - cum);
                if (row_l == 0) *(LAS float*)(L + 70656 + d * 4) = __expf(total);
            }
            u32x4 w1, w2;
            PK8(w1, qi); { const float* sp = qi + 8; PK8(w2, sp); }
            *(LAS u32x4*)(L + LA_QS + row_l * 272 + c8 * 16) = w1; *(LAS u32x4*)(L + LA_QS + row_l * 272 + 128 + c8 * 16) = w2;
            PK8(w1, ki); { const float* sp = ki + 8; PK8(w2, sp); }
            *(LAS u32x4*)(L + LA_KS + row_l * 272 + c8 * 16) = w1; *(LAS u32x4*)(L + LA_KS + row_l * 272 + 128 + c8 * 16) = w2;
            PK8(w1, qd); { const float* sp = qd + 8; PK8(w2, sp); }
            *(LAS u32x4*)(L + LA_QD + row_l * 272 + c8 * 16) = w1; *(LAS u32x4*)(L + LA_QD + row_l * 272 + 128 + c8 * 16) = w2;
#pragma unroll
            for (int i = 0; i < 8; ++i) {
                *(LAS bf16_t*)(L + LA_KT + (c8 * 8 + i) * 144 + row_l * 2) = f2bf(kd[i]);
                *(LAS bf16_t*)(L + LA_KT + (64 + c8 * 8 + i) * 144 + row_l * 2) = f2bf(kd[8 + i]);
            }
        }
        __syncthreads();
        {
            unsigned char* dst = a.ws + HGT_OFF + (size_t)it * HGT_ITEM;
#pragma unroll
            for (int k = 0; k < 9; ++k) { const int idx = tid + k * NTHREADS; if (idx < 4448) *(u32x4*)(dst + (size_t)idx * 16) = *(const LAS u32x4*)(L + idx * 16); }
        }
        __syncthreads();
    }
}

__device__ __forceinline__ void hgrn_unit(const Args& a, LAS unsigned char* L, int unit, bool dry) {
    int tid_ = threadIdx.x; asm volatile("" : "+v"(tid_));
    const int tid = tid_, b = unit >> 4, h = (unit >> 2) & 3, sl = unit & 3;
    const bf16_t* Z = (const bf16_t*)(a.ws + Z_OFF); bf16_t* OB = (bf16_t*)(a.ws + HN_OFF);
    const int vrow = (tid >> 2) & 63, vp = tid & 3;
    f32x4 st[2] = {{0.f, 0.f, 0.f, 0.f}, {0.f, 0.f, 0.f, 0.f}};
    for (int i = tid; i < 32 * 272 / 4; i += NTHREADS) ((LAS unsigned*)(L + LA_ST))[i] = 0u;
    u32x4 pfA[9], pfB[9], vvA, vvB;
#define HG_LOAD(PF, VV, n_) do { const unsigned char* src_ = a.ws + HGT_OFF + (size_t)(((b * NCH + (n_)) * 4) + h) * HGT_ITEM; \
        _Pragma("unroll") for (int k = 0; k < 9; ++k) { const int idx = tid + k * NTHREADS; PF[k] = (u32x4){0u, 0u, 0u, 0u}; if (idx < 4448) PF[k] = *(const u32x4*)(src_ + (size_t)idx * 16); } \
        VV = (u32x4){0u, 0u, 0u, 0u}; \
        if (tid < 256) { const int rv = chunk_row(b, (n_), vrow); if (rv >= 0) VV = *(const u32x4*)(Z + (size_t)rv * IN_CD + 1536 + h * 128 + sl * 32 + vp * 8); } } while (0)
#define HG_STEP(PF, VV, n_) do { \
        _Pragma("unroll") for (int k = 0; k < 9; ++k) { const int idx = tid + k * NTHREADS; \
            if (idx < 4416) *(LAS u32x4*)(L + idx * 16) = PF[k]; \
            else if (idx < 4448) *(LAS u32x4*)(L + LA_DEC + (idx - 4416) * 16) = PF[k]; } \
        if (tid < 256) { const unsigned va[4] = {VV.x, VV.y, VV.z, VV.w}; \
            _Pragma("unroll") for (int i = 0; i < 8; ++i) *(LAS bf16_t*)(L + LA_VT + (vp * 8 + i) * 144 + vrow * 2) = (bf16_t)((i & 1) ? (va[i >> 1] >> 16) : (va[i >> 1] & 0xffffu)); } \
        if ((n_) + 2 < NCH) HG_LOAD(PF, VV, (n_) + 2); \
        LBAR(); \
        la_core<true>(L, st, 0.f, OB, 512, h * 128 + sl * 32, b, (n_), dry); \
        LBAR(); } while (0)
    HG_LOAD(pfA, vvA, 0);
    HG_LOAD(pfB, vvB, 1);
    for (int n = 0; n < NCH; n += 2) {
        HG_STEP(pfA, vvA, n);
        if (n + 1 < NCH) HG_STEP(pfB, vvB, n + 1);
    }
#undef HG_STEP
#undef HG_LOAD
}

constexpr int LR_XB = 0, LR_XC = 32768, LR_XA = 49152, LR_RG = 58368, RGS = 68  , LR_SEG = LR_RG + 64 * RGS * 4  , LR_END = LR_SEG + 16 * 64 * 4;
__device__ __forceinline__ void lru_unit(const Args& a, LAS unsigned char* L, int unit, bool dry) {
    int tid_ = threadIdx.x; asm volatile("" : "+v"(tid_));
    const int tid = tid_, lane = tid & 63, w = __builtin_amdgcn_readfirstlane(tid >> 6), fr = lane & 15, fq = lane >> 4;
    const int b = unit >> 5, cb = (unit >> 1) & 15, hf = unit & 1;
    bf16_t* Z = (bf16_t*)(a.ws + Z_OFF);
    const int row_l = tid >> 3, c8 = tid & 7;
    const int oc = cb * 64 + hf * 32 + c8 * 4;
    LAS float* XB = (LAS float*)(L + LR_XB); LAS float* XC = (LAS float*)(L + LR_XC); LAS float* RG = (LAS float*)(L + LR_RG);
    float cw[4][8], cbs[8];
#pragma unroll
    for (int i = 0; i < 8; ++i) { const int c = cb * 64 + c8 * 8 + i; cbs[i] = a.in[11][c];
#pragma unroll
        for (int ww = 0; ww < 4; ++ww) cw[ww][i] = a.in[10][ww * 1024 + c]; }
    const int mg = w >> 1, ct = w & 1;
    const int gch = cb * 64 + hf * 32 + ct * 16 + 4 * fq;
    const bf16_t* WG = (const bf16_t*)(a.ws + LRUW_OFF) + (size_t)cb * 128 * 64;
    const int nr_ = hf * 32 + ct * 16 + fr;
    const bf16x8 wr0 = *(const bf16x8*)(WG + nr_ * 64 + fq * 8), wr1 = *(const bf16x8*)(WG + nr_ * 64 + 32 + fq * 8);
    const bf16x8 wi0 = *(const bf16x8*)(WG + (64 + nr_) * 64 + fq * 8), wi1 = *(const bf16x8*)(WG + (64 + nr_) * 64 + 32 + fq * 8);
    const f32x4 bra = *(const f32x4*)(a.in[6] + gch), bia = *(const f32x4*)(a.in[8] + gch);
    float sp[4];
#pragma unroll
    for (int i = 0; i < 4; ++i) sp[i] = log1pf(expf(-a.in[9][gch + i]));
    float hstate = 0.f;
    for (int i = tid; i < 64 * 64; i += NTHREADS) XB[64 * 64 + i] = 0.f;
    u32x4 xbv; u32x2 bgv;
#define LRU_LOAD(n_) do { const int r_ = chunk_row(b, (n_), row_l); \
        if (r_ >= 0) { const bf16_t* zr = Z + (size_t)r_ * IN_AB; xbv = *(const u32x4*)(zr + 2048 + cb * 64 + c8 * 8); bgv = *(const u32x2*)(zr + 4096 + oc); } \
        else { xbv = (u32x4){0u, 0u, 0u, 0u}; bgv = (u32x2){0u, 0u}; } } while (0)
    LRU_LOAD(0);
    for (int n = 0; n < NCH; ++n) {
        const int cur = (n & 1) * 4096, prv = 4096 - cur;
        {
            float xf[8]; UNPK8(xf, xbv);
            *(LAS f32x4*)(XB + cur + row_l * 64 + c8 * 8) = (f32x4){xf[0], xf[1], xf[2], xf[3]}; *(LAS f32x4*)(XB + cur + row_l * 64 + c8 * 8 + 4) = (f32x4){xf[4], xf[5], xf[6], xf[7]};
        }
        const u32x2 bgc = bgv;
        const int grow = chunk_row(b, n, row_l);
        if (n + 1 < NCH) LRU_LOAD(n + 1);
        LBAR();
        {
            float xc[8];
#pragma unroll
            for (int i = 0; i < 8; ++i) xc[i] = cbs[i];
#pragma unroll
            for (int ww = 0; ww < 4; ++ww) {
                const int rr = row_l + ww - 3;
                const LAS float* src = rr >= 0 ? XB + cur + rr * 64 + c8 * 8 : XB + prv + (64 + rr) * 64 + c8 * 8;
                const f32x4 x0 = *(const LAS f32x4*)src, x1 = *(const LAS f32x4*)(src + 4);
                xc[0] += cw[ww][0] * x0[0]; xc[1] += cw[ww][1] * x0[1]; xc[2] += cw[ww][2] * x0[2]; xc[3] += cw[ww][3] * x0[3];
                xc[4] += cw[ww][4] * x1[0]; xc[5] += cw[ww][5] * x1[1]; xc[6] += cw[ww][6] * x1[2]; xc[7] += cw[ww][7] * x1[3];
            }
            *(LAS f32x4*)(XC + row_l * 64 + c8 * 8) = (f32x4){xc[0], xc[1], xc[2], xc[3]}; *(LAS f32x4*)(XC + row_l * 64 + c8 * 8 + 4) = (f32x4){xc[4], xc[5], xc[6], xc[7]};
            u32x4 o; PK8(o, xc);
            *(LAS u32x4*)(L + LR_XA + row_l * 144 + c8 * 16) = o;
        }
        LBAR();
        {
            const bf16x8 x0 = ldsfrag(L + LR_XA + (mg * 16 + fr) * 144 + fq * 16), x1 = ldsfrag(L + LR_XA + (mg * 16 + fr) * 144 + 64 + fq * 16);
            f32x4 ra = {0.f, 0.f, 0.f, 0.f}, ia = {0.f, 0.f, 0.f, 0.f};
            ra = MFMA16(wr0, x0, ra); ia = MFMA16(wi0, x0, ia); ra = MFMA16(wr1, x1, ra); ia = MFMA16(wi1, x1, ia);
            const int jr = mg * 16 + fr;
            const f32x4 x4 = *(const LAS f32x4*)(XC + jr * 64 + hf * 32 + ct * 16 + 4 * fq);
            const bool rvalid = (n > 0) || (jr >= 48);
            f32x4 a4, b4;
#pragma unroll
            for (int i = 0; i < 4; ++i) {
                const float r = sigmoidf_(ra[i] + bra[i]), ig = sigmoidf_(ia[i] + bia[i]);
                const float log_a = -8.f * r * sp[i], x2 = 2.f * log_a, e2 = __expf(x2);
                const float ser = -x2 * (1.f + x2 * (0.5f + x2 * (0.16666667f + x2 * (0.041666668f + x2 * 0.0083333338f))));
                const float om = x2 > -0.25f ? ser : 1.f - e2;
                a4[i] = rvalid ? __expf(log_a) : 1.f; b4[i] = rvalid ? sqrtf(fmaxf(om, 0.f)) * (ig * x4[i]) : 0.f;
            }
            *(LAS f32x4*)(RG + jr * RGS + ct * 16 + 4 * fq) = a4; *(LAS f32x4*)(RG + jr * RGS + 32 + ct * 16 + 4 * fq) = b4;
        }
        LBAR();
        {
            LAS float* SEG = (LAS float*)(L + LR_SEG);
            const int sg = w * 2 + (lane >> 5), ch = lane & 31;
            float sa[4], sb[4];
            {
                float P = 1.f, hh = 0.f;
#pragma unroll
                for (int i = 0; i < 4; ++i) { sa[i] = RG[(sg * 4 + i) * RGS + ch]; sb[i] = RG[(sg * 4 + i) * RGS + 32 + ch]; hh = sa[i] * hh + sb[i]; P *= sa[i]; }
                SEG[sg * 64 + ch] = P; SEG[sg * 64 + 32 + ch] = hh;
            }
            LBAR();
            float c = hstate, mine = 0.f;
#pragma unroll
            for (int s2 = 0; s2 < 16; ++s2) { mine = (s2 == sg) ? c : mine; c = SEG[s2 * 64 + ch] * c + SEG[s2 * 64 + 32 + ch]; }
            hstate = c;
            float hh = mine;
#pragma unroll
            for (int i = 0; i < 4; ++i) { hh = sa[i] * hh + sb[i]; RG[(sg * 4 + i) * RGS + 32 + ch] = hh; }
        }
        LBAR();
        if (grow >= 0 && !dry) {
            const f32x4 h4 = *(const LAS f32x4*)(RG + row_l * RGS + 32 + c8 * 4);
            u32x2 o; o.x = cvt_pk_bf16(gelu_tanh(bf_lo(bgc.x)) * h4[0], gelu_tanh(bf_hi(bgc.x)) * h4[1]); o.y = cvt_pk_bf16(gelu_tanh(bf_lo(bgc.y)) * h4[2], gelu_tanh(bf_hi(bgc.y)) * h4[3]);
            if (grow < RM) *(u32x2*)(Z + (size_t)grow * IN_AB + 4096 + oc) = o;
            else if (b == 0) *(u32x2*)((bf16_t*)(a.ws + YAB_OFF) + (size_t)(grow - RM) * 2048 + 1024 + oc) = o;
        }
    }
    LBAR();
#undef LRU_LOAD
}

constexpr int S5_BU = 0, BUS = 132  , S5_HS = 64 * BUS * 4, S5_EX = S5_HS + 64 * 272  , S5_END = S5_EX + 8 * 128 * 4;
__device__ __forceinline__ void s5_unit(const Args& a, LAS unsigned char* L, int unit, bool dry) {
    int tid_ = threadIdx.x; asm volatile("" : "+v"(tid_));
    const int tid = tid_, lane = tid & 63, w = __builtin_amdgcn_readfirstlane(tid >> 6), fr = lane & 15, fq = lane >> 4;
    const int b = unit >> 5, g = unit & 31;
    bf16_t* Z = (bf16_t*)(a.ws + Z_OFF);
    const bf16_t* BB = (const bf16_t*)(a.ws + S5BB_OFF) + (size_t)g * 128 * 32;
    const bf16_t* CM = (const bf16_t*)(a.ws + S5CM_OFF) + (size_t)g * 16 * 128;
    const float* AB = (const float*)(a.ws + S5AB_OFF) + (size_t)g * 128;
    const bf16x8 bbf = *(const bf16x8*)(BB + (w * 16 + fr) * 32 + fq * 8);
    bf16x8 cmf[4];
#pragma unroll
    for (int kk = 0; kk < 4; ++kk) cmf[kk] = *(const bf16x8*)(CM + fr * 128 + kk * 32 + fq * 8);
    const float ar = AB[2 * lane], ai = AB[2 * lane + 1];
    const f32x4 dv = *(const f32x4*)(a.in[20] + g * 16 + 4 * fq);
    float hr = 0.f, hi = 0.f;
    LAS float* BU = (LAS float*)(L + S5_BU); LAS float* EX = (LAS float*)(L + S5_EX);
    float pwr[8], pwi[8];
    pwr[0] = ar; pwi[0] = ai;
#pragma unroll
    for (int i = 1; i < 8; ++i) { pwr[i] = pwr[i - 1] * ar - pwi[i - 1] * ai; pwi[i] = pwr[i - 1] * ai + pwi[i - 1] * ar; }
    bf16x8 uf[4]; u32x2 uvn = {0u, 0u};
#define S5_LOAD(n_) do { _Pragma("unroll") for (int m = 0; m < 4; ++m) { const int r_ = chunk_row(b, (n_), m * 16 + fr); \
            uf[m] = (bf16x8){0, 0, 0, 0, 0, 0, 0, 0}; \
            if (r_ >= 0 && fq < 2) uf[m] = *(const bf16x8*)(Z + (size_t)r_ * IN_CD + g * 16 + fq * 8); } \
        if (w < 4) { const int r2_ = chunk_row(b, (n_), w * 16 + fr); uvn = (u32x2){0u, 0u}; if (r2_ >= 0) uvn = *(const u32x2*)(Z + (size_t)r2_ * IN_CD + g * 16 + 4 * fq); } } while (0)
    S5_LOAD(0);
    for (int n = 0; n < NCH; ++n) {
#pragma unroll
        for (int m = 0; m < 4; ++m) { f32x4 acc = {0.f, 0.f, 0.f, 0.f}; acc = MFMA16(bbf, uf[m], acc);
            *(LAS f32x4*)(BU + (m * 16 + fr) * BUS + w * 16 + 4 * fq) = acc; }
        const u32x2 uv = uvn;
        if (n + 1 < NCH) S5_LOAD(n + 1);
        LBAR();
        float lr[8], li[8];
        {
            float cr = 0.f, ci = 0.f;
#pragma unroll
            for (int i = 0; i < 8; ++i) {
                const float br = BU[(8 * w + i) * BUS + lane], bi = BU[(8 * w + i) * BUS + 64 + lane];
                const float nr = ar * cr - ai * ci + br, ni = ar * ci + ai * cr + bi;
                cr = nr; ci = ni; lr[i] = cr; li[i] = ci;
            }
            EX[w * 128 + lane] = cr; EX[w * 128 + 64 + lane] = ci;
        }
        LBAR();
        {
            float cr = hr, ci = hi, mr = 0.f, mi = 0.f;
#pragma unroll
            for (int ww = 0; ww < 8; ++ww) {
                if (ww == w) { mr = cr; mi = ci; }
                const float er = EX[ww * 128 + lane], ei = EX[ww * 128 + 64 + lane];
                const float nr = pwr[7] * cr - pwi[7] * ci + er, ni = pwr[7] * ci + pwi[7] * cr + ei;
                cr = nr; ci = ni;
            }
            hr = cr; hi = ci;
#pragma unroll
            for (int i = 0; i < 8; ++i) {
                const float xr = lr[i] + pwr[i] * mr - pwi[i] * mi, xi = li[i] + pwr[i] * mi + pwi[i] * mr;
                *(LAS bf16_t*)(L + S5_HS + (8 * w + i) * 272 + lane * 2) = f2bf(xr);
                *(LAS bf16_t*)(L + S5_HS + (8 * w + i) * 272 + 128 + lane * 2) = f2bf(xi);
            }
        }
        LBAR();
        if (w < 4) {
            f32x4 acc = {0.f, 0.f, 0.f, 0.f};
#pragma unroll
            for (int kk = 0; kk < 4; ++kk) acc = MFMA16(cmf[kk], ldsfrag(L + S5_HS + (w * 16 + fr) * 272 + kk * 64 + fq * 16), acc);
            const int r = chunk_row(b, n, w * 16 + fr);
            if (r >= 0 && !dry) {
                bf16_t* up = Z + (size_t)r * IN_CD + g * 16 + 4 * fq;
                const float y0 = gelu_tanh(acc[0] + dv[0] * bf_lo(uv.x)), y1 = gelu_tanh(acc[1] + dv[1] * bf_hi(uv.x));
                const float y2 = gelu_tanh(acc[2] + dv[2] * bf_lo(uv.y)), y3 = gelu_tanh(acc[3] + dv[3] * bf_hi(uv.y));
                u32x2 o; o.x = cvt_pk_bf16(y0, y1); o.y = cvt_pk_bf16(y2, y3);
                if (r < RM) *(u32x2*)up = o; else if (b == 0) *(u32x2*)((bf16_t*)(a.ws + YM_OFF) + (size_t)(r - RM) * 512 + g * 16 + 4 * fq) = o;
            }
        }
    }
    LBAR();
#undef S5_LOAD
}

__device__ __forceinline__ void phase_ret_post(const Args& a) {
    int tid_ = threadIdx.x; asm volatile("" : "+v"(tid_));
    const int tid = tid_, lane = tid & 63, wave = tid >> 6;
    const int gw = blockIdx.x * 8 + wave, NGW = gridDim.x * 8;
    bf16_t* Z = (bf16_t*)(a.ws + Z_OFF); const bf16_t* OB = (const bf16_t*)(a.ws + HN_OFF); const float* gn = a.in[4];
    for (int row = gw; row < RVALID; row += NGW) {
        u32x2 ov[4], gv[4]; f32x4 gg[4];
#pragma unroll
        for (int h = 0; h < 4; ++h) {
            ov[h] = *(const u32x2*)(OB + (size_t)row * DM + h * 256 + 4 * lane);
            gv[h] = *(const u32x2*)(Z + (size_t)row * IN_AB + 3072 + h * 256 + 4 * lane);
            gg[h] = *(const f32x4*)(gn + h * 256 + 4 * lane);
        }
#pragma unroll
        for (int h = 0; h < 4; ++h) {
            float o0 = bf_lo(ov[h].x), o1 = bf_hi(ov[h].x), o2 = bf_lo(ov[h].y), o3 = bf_hi(ov[h].y);
            const float mean = wave_sum((o0 + o1) + (o2 + o3)) * (1.f / 256.f);
            o0 -= mean; o1 -= mean; o2 -= mean; o3 -= mean;
            const float inv = rsqrtf(wave_sum(o0 * o0 + o1 * o1 + o2 * o2 + o3 * o3) * (1.f / 256.f) + EPS);
            u32x2 y; y.x = cvt_pk_bf16(o0 * inv * gg[h][0] * silu_(bf_lo(gv[h].x)), o1 * inv * gg[h][1] * silu_(bf_hi(gv[h].x)));
            y.y = cvt_pk_bf16(o2 * inv * gg[h][2] * silu_(bf_lo(gv[h].y)), o3 * inv * gg[h][3] * silu_(bf_hi(gv[h].y)));
            if (row < RM) *(u32x2*)(Z + (size_t)row * IN_AB + 3072 + h * 256 + 4 * lane) = y;
            else *(u32x2*)((bf16_t*)(a.ws + YAB_OFF) + (size_t)(row - RM) * 2048 + h * 256 + 4 * lane) = y;
        }
    }
}
__device__ __forceinline__ void phase_hg_post(const Args& a) {
    int tid_ = threadIdx.x; asm volatile("" : "+v"(tid_));
    const int tid = tid_, lane = tid & 63, wave = tid >> 6;
    const int gw = blockIdx.x * 8 + wave, NGW = gridDim.x * 8;
    bf16_t* Z = (bf16_t*)(a.ws + Z_OFF); const bf16_t* OB = (const bf16_t*)(a.ws + HN_OFF); const float* gn = a.in[24];
    for (int row = gw; row < RVALID; row += NGW) {
        unsigned ov[4], gv[4]; f32x2 gg[4];
#pragma unroll
        for (int h = 0; h < 4; ++h) {
            ov[h] = *(const unsigned*)(OB + (size_t)row * 512 + h * 128 + 2 * lane);
            gv[h] = *(const unsigned*)(Z + (size_t)row * IN_CD + 2048 + h * 128 + 2 * lane);
            gg[h] = *(const f32x2*)(gn + h * 128 + 2 * lane);
        }
#pragma unroll
        for (int h = 0; h < 4; ++h) {
            const float o0 = bf_lo(ov[h]), o1 = bf_hi(ov[h]);
            const float inv = rsqrtf(wave_sum(o0 * o0 + o1 * o1) * (1.f / 128.f) + EPS);
            const unsigned yv = cvt_pk_bf16(o0 * inv * gg[h][0] * silu_(bf_lo(gv[h])), o1 * inv * gg[h][1] * silu_(bf_hi(gv[h])));
            if (row < RM) *(unsigned*)(Z + (size_t)row * IN_CD + 2048 + h * 128 + 2 * lane) = yv;
            else *(unsigned*)((bf16_t*)(a.ws + YCD_OFF) + (size_t)(row - RM) * 1024 + 512 + h * 128 + 2 * lane) = yv;
        }
    }
}

#define XB_TMO      128
#define XB_XCNT(j)  (256  + 64 * (j))
#define XB_XSUB(j)  (1280 + 64 * (j))
#define XB_XGEN(j)  (2304 + 64 * (j))
#define XB_TOP      3328
#define XB_TOPGEN   3392
#define XCD_BAR_WORDS 3456
#define XB_SPIN_CAP (1u << 18)

__device__ __forceinline__ unsigned xb_ld(unsigned* p)              { return __hip_atomic_load(p, __ATOMIC_RELAXED, __HIP_MEMORY_SCOPE_AGENT); }
__device__ __forceinline__ unsigned xb_add(unsigned* p, unsigned v) { return __hip_atomic_fetch_add(p, v, __ATOMIC_RELAXED, __HIP_MEMORY_SCOPE_AGENT); }
__device__ __forceinline__ unsigned xb_xcc_id() { return (unsigned)__builtin_amdgcn_s_getreg((3 << 11) | 20) & 0xFu; }
#define XB_SPIN(cond, bar) do { unsigned _sp = 0; while (cond) { __builtin_amdgcn_s_sleep(1); \
    if ((++_sp & 255u) == 0u) { if (xb_ld(&(bar)[XB_TMO])) break; if (_sp > XB_SPIN_CAP) { atomicAdd(&(bar)[XB_TMO], 1u); break; } } } } while (0)

struct XcdBarrier {
    unsigned* bar; unsigned x;
    volatile LAS unsigned* st;
};

__device__ __forceinline__ XcdBarrier xcd_barrier_post(unsigned* bar, volatile LAS unsigned* st) {
    XcdBarrier b; b.bar = bar; b.x = xb_xcc_id(); b.st = st;
    if (threadIdx.x == 0) (void)xb_add(&bar[XB_XCNT(b.x)], 1u);
    return b;
}
__device__ __forceinline__ void xcd_barrier_complete(unsigned* bar, unsigned x, unsigned& nloc, unsigned& nx) {
    const unsigned G = gridDim.x * gridDim.y * gridDim.z;
    unsigned sum, cnt, mine, sp = 0u;
    for (;;) {
        sum = 0u; cnt = 0u; mine = 0u;
#pragma unroll
        for (unsigned j = 0; j < 16; ++j) { const unsigned c = xb_ld(&bar[XB_XCNT(j)]); sum += c; cnt += (c > 0u) ? 1u : 0u; mine = (j == x) ? c : mine; }
        if (sum == G) break;
        __builtin_amdgcn_s_sleep(1);
        if ((++sp & 255u) == 0u) { if (xb_ld(&bar[XB_TMO])) break; if (sp > XB_SPIN_CAP) { atomicAdd(&bar[XB_TMO], 1u); break; } }
    }
    nloc = mine > 0u ? mine : 1u; nx = cnt > 0u ? cnt : 1u;
}

__device__ __forceinline__ void xcd_barrier(const XcdBarrier& b) {
    asm volatile("s_waitcnt vmcnt(0)" ::: "memory");
    __syncthreads();
    if (threadIdx.x == 0) {
        unsigned* bar = b.bar;
        __builtin_amdgcn_s_waitcnt(0);
        unsigned nloc = b.st[0], nx = b.st[1];
        if (nloc == 0u) { xcd_barrier_complete(bar, b.x, nloc, nx); b.st[0] = nloc; b.st[1] = nx; }
        const unsigned old = xb_add(&bar[XB_XSUB(b.x)], 1u);
        const unsigned gen = old / nloc;
        if (old + 1u == (gen + 1u) * nloc) {
            __builtin_amdgcn_fence(__ATOMIC_RELEASE, "agent");
            asm volatile("s_waitcnt vmcnt(0)" ::: "memory");
            const unsigned og = xb_add(&bar[XB_TOP], 1u);
            const unsigned tg = og / nx;
            if (og + 1u == (tg + 1u) * nx) xb_add(&bar[XB_TOPGEN], 1u);
            else XB_SPIN(xb_ld(&bar[XB_TOPGEN]) == tg, bar);
            __builtin_amdgcn_fence(__ATOMIC_ACQUIRE, "agent");
            xb_add(&bar[XB_XGEN(b.x)], 1u);
            asm volatile("s_waitcnt vmcnt(0)" ::: "memory");
        } else {
            XB_SPIN(xb_ld(&bar[XB_XGEN(b.x)]) == gen, bar);
            __builtin_amdgcn_fence(__ATOMIC_ACQUIRE, "agent");
            asm volatile("s_waitcnt vmcnt(0)" ::: "memory");
        }
    }
    __syncthreads();
}


#ifndef DBG_STOP
#define DBG_STOP 0
#endif
__device__ __forceinline__ void dbg_digest(const Args& a) {
    const size_t gt = (size_t)blockIdx.x * NTHREADS + threadIdx.x, NGT = (size_t)gridDim.x * NTHREADS;
    const bf16_t* zb = (const bf16_t*)(a.ws + Z_OFF);
    const size_t NE = ((size_t)R * 5120 + (size_t)R * 1024);
    const size_t ON = (size_t)RM * DM;
    for (size_t i = gt; i < ON; i += NGT) {
        float s = 0.f;
        for (size_t k = i; k < NE; k += ON) s += __uint_as_float((unsigned)zb[k] << 16);
        a.out[i] = a.out[i] * 1e-3f + s;
    }
}
#ifndef DBG_REP34
#define DBG_REP34 0
#endif
#ifndef DBG_REPG
#define DBG_REPG 0
#endif
#ifndef DBG_SYNC2
#define DBG_SYNC2 0
#endif
#ifndef DBG_TIME
#define DBG_TIME 0
#endif
#define GSYNC() xcd_barrier(xbar)
#define DBG_CHECK(k) do { if (DBG_STOP == (k)) { grid.sync(); dbg_digest(a); return; } \
    if (DBG_TIME) { if ((k) == DBG_TIME - 1) dbg_t0 = __builtin_amdgcn_s_memrealtime(); if ((k) == DBG_TIME) dbg_t1 = __builtin_amdgcn_s_memrealtime(); } } while (0)
__global__ void __launch_bounds__(NTHREADS, 2) fwd_megakernel(Args a) {
    extern __shared__ __attribute__((aligned(16))) unsigned char lds_raw[];
    LAS unsigned char* L = (LAS unsigned char*)lds_raw;
    cg::grid_group grid = cg::this_grid();
    unsigned char* ws = a.ws;
    const int G = gridDim.x, bx = blockIdx.x;
    bf16_t* Zb = (bf16_t*)(ws + Z_OFF); bf16_t* HNb = (bf16_t*)(ws + HN_OFF); float* ssq = (float*)(ws + SSQ_OFF);
    bf16_t* YABb = (bf16_t*)(ws + YAB_OFF); bf16_t* YCDb = (bf16_t*)(ws + YCD_OFF); bf16_t* YMb = (bf16_t*)(ws + YM_OFF);
    float* hmeta = (float*)(ws + HMETA_OFF);
    const float* ng = a.in[26];
    const bool fusedres = (G == 256);

    if (threadIdx.x < 4) ((LAS unsigned*)(L + LDS_BYTES - 16))[threadIdx.x] = 0u;
    __syncthreads();
    const XcdBarrier xbar = xcd_barrier_post((unsigned*)(ws + BAR_OFF), (volatile LAS unsigned*)(L + LDS_BYTES - 16));
    if (a.never) grid.sync();
    phase_prologue(a, L, !fusedres);
    GSYNC();

#define GEMM_PHASE(MODE, Ap, lda_, Wp, N_, K_, Op, ldo_, Yp, ldy_, biasp, AMp, ldam_, OMp, ldom_, YMp, ldym_) do { \
        pg8::Gemm g{(Ap), (Wp), RM, (N_), (K_), (lda_)}; pg8::StaticOrder S; S.init(RM, (N_), G, bx); \
        pg8::Epi<MODE> E{(Op), (ldo_), nullptr, (Yp), (ldy_), (biasp)}; \
        pg8::gemm_phase(L, g, S, E); \
        meta_gemm<MODE>(L, (AMp), (ldam_), (Wp), (N_), (K_), (OMp), (ldom_), nullptr, (YMp), (ldym_), (biasp)); } while (0)
#define RES_PHASE(P, HIN, Ap, lda_, Wp, K_, AMp, ldam_, g1_, g2_) do { \
        pg8::Gemm g{(Ap), (Wp), RM, DM, (K_), (lda_)}; pg8::StaticOrder S; S.init(RM, DM, G, bx); \
        if (fusedres) { \
            float* x1 = (float*)(ws + XB_OFF + (size_t)((P) * 2) * XB_STRIDE); float* x2 = (float*)(ws + XB_OFF + (size_t)((P) * 2 + 1) * XB_STRIDE); \
            unsigned* c1 = (unsigned*)(ws + CNT_OFF) + ((P) * 2) * 80 * 32; unsigned* c2 = (unsigned*)(ws + CNT_OFF) + ((P) * 2 + 1) * 80 * 32; \
            pg8::EpiRes E{(HIN), a.out, (g1_), (g2_), HNb, x1, x2, c1, c2}; \
            pg8::gemm_phase(L, g, S, E); \
            meta_gemm<4>(L, (AMp), (ldam_), (Wp), DM, (K_), HNb + (size_t)RM * DM, DM, nullptr, nullptr, 0, nullptr, hmeta, (g1_), (g2_), x1 + 64 * 256 * 4, x2 + 64 * 256 * 4, c1 + 64 * 32, c2 + 64 * 32); \
            GSYNC(); \
        } else { \
            pg8::Epi<1> E{HNb, DM, ssq, nullptr, 0, nullptr}; \
            pg8::gemm_phase(L, g, S, E); \
            meta_gemm<1>(L, (AMp), (ldam_), (Wp), DM, (K_), HNb + (size_t)RM * DM, DM, ssq + (size_t)RM * 16, nullptr, 0, nullptr); \
            GSYNC(); \
            phase_resnorm(a, (g1_), (g2_)); \
            GSYNC(); \
        } } while (0)

    {
        const bf16_t* W = (const bf16_t*)(ws + W_INAB);
        GEMM_PHASE(0, HNb, DM, W, IN_AB, DM, Zb, IN_AB, nullptr, 0, nullptr, HNb + (size_t)RM * DM, DM, Zb + (size_t)RM * IN_AB, IN_AB, nullptr, 0);
    }
    GSYNC();
    for (int u = bx; u < 128 + 128; u += G) { if (u < 128) retention_unit(a, L, u, false); else lru_unit(a, L, u - 128, false); }
    if (G == 256) { if (bx < 128) weight_convert(a, L, WC_C1, WC_C5, bx, 128); }
    else weight_convert(a, L, WC_C1, WC_C5, bx, G);
    GSYNC();
    phase_ret_post(a);
    GSYNC();
    {
        const bf16_t* W = (const bf16_t*)(ws + W_OUTAB);
        RES_PHASE(0, (fusedres ? a.in[0] : (const float*)a.out), Zb + 3072, IN_AB, W, 2048, YABb, 2048, ng + 1 * DM, ng + 2 * DM);
    }
    {
        const bf16_t* W = (const bf16_t*)(ws + W_W1_0);
        GEMM_PHASE(2, HNb, DM, W, FF, DM, Zb, FF, nullptr, 0, nullptr, HNb + (size_t)RM * DM, DM, Zb + (size_t)RM * FF, FF, nullptr, 0);
    }
    GSYNC();
    {
        const bf16_t* W = (const bf16_t*)(ws + W_W2_0);
        RES_PHASE(1, (const float*)a.out, Zb, FF, W, FF, Zb + (size_t)RM * FF, FF, ng + 3 * DM, ng + 4 * DM);
    }

    {
        const bf16_t* W = (const bf16_t*)(ws + W_INCD);
        GEMM_PHASE(0, HNb, DM, W, IN_CD, DM, Zb, IN_CD, nullptr, 0, nullptr, HNb + (size_t)RM * DM, DM, Zb + (size_t)RM * IN_CD, IN_CD, nullptr, 0);
    }
    GSYNC();
    hgrn_prepass(a, L);
    GSYNC();
    for (int u = bx; u < 64 + 128; u += G) { if (u < 64) hgrn_unit(a, L, u, false); else s5_unit(a, L, u - 64, false); }
    if (G == 256) { if (bx < 64 || bx >= 192) weight_convert(a, L, WC_C5, WC_C9, bx < 64 ? bx : bx - 128, 128); }
    else weight_convert(a, L, WC_C5, WC_C9, bx, G);
    GSYNC();
    phase_hg_post(a);
    {
        const bf16_t* W = (const bf16_t*)(ws + W_GLU);
        GEMM_PHASE(3, Zb, IN_CD, W, 512, 512, Zb + 1536, IN_CD, Zb, IN_CD, a.in[23], YMb, 512, YCDb, 1024, YMb, 512);
    }
    GSYNC();
    {
        const bf16_t* W = (const bf16_t*)(ws + W_OUTCD);
        RES_PHASE(2, (const float*)a.out, Zb + 1536, IN_CD, W, DM, YCDb, 1024, ng + 5 * DM, ng + 6 * DM);
    }
    {
        const bf16_t* W = (const bf16_t*)(ws + W_W1_1);
        GEMM_PHASE(2, HNb, DM, W, FF, DM, Zb, FF, nullptr, 0, nullptr, HNb + (size_t)RM * DM, DM, Zb + (size_t)RM * FF, FF, nullptr, 0);
    }
    GSYNC();
    {
        const bf16_t* W = (const bf16_t*)(ws + W_W2_1);
        pg8::Gemm g{Zb, W, RM, DM, FF, FF}; pg8::StaticOrder S; S.init(RM, DM, G, bx);
        if (fusedres) {
            float* x1 = (float*)(ws + XB_OFF + (size_t)6 * XB_STRIDE); unsigned* c1 = (unsigned*)(ws + CNT_OFF) + 6 * 80 * 32;
            pg8::EpiRes E{(const float*)a.out, a.out, ng + 7 * DM, nullptr, HNb, x1, x1, c1, c1};
            pg8::gemm_phase(L, g, S, E);
            meta_gemm<4>(L, Zb + (size_t)RM * FF, FF, W, DM, FF, HNb + (size_t)RM * DM, DM, nullptr, nullptr, 0, nullptr, hmeta, ng + 7 * DM, nullptr, x1 + 64 * 256 * 4, x1 + 64 * 256 * 4, c1 + 64 * 32, c1 + 64 * 32);
        } else {
            pg8::Epi<1> E{HNb, DM, ssq, nullptr, 0, nullptr};
            pg8::gemm_phase(L, g, S, E);
            meta_gemm<1>(L, Zb + (size_t)RM * FF, FF, W, DM, FF, HNb + (size_t)RM * DM, DM, ssq + (size_t)RM * 16, nullptr, 0, nullptr);
            GSYNC();
            phase_resnorm(a, ng + 7 * DM, nullptr);
        }
    }
#undef GEMM_PHASE
#undef RES_PHASE
}

extern "C" void kernel_launch(void* const* d_in, const int* in_sizes, int n_in, void* d_out, int out_size, void* d_ws, size_t ws_size, hipStream_t stream) {
    static int grid = 0;
    if (!grid) {
        int dev = 0, cus = 0, per_cu = 0;
        (void)hipGetDevice(&dev);
        (void)hipDeviceGetAttribute(&cus, hipDeviceAttributeMultiprocessorCount, dev);
        (void)hipFuncSetAttribute((const void*)fwd_megakernel, hipFuncAttributeMaxDynamicSharedMemorySize, LDS_BYTES);
        (void)hipOccupancyMaxActiveBlocksPerMultiprocessor(&per_cu, (const void*)fwd_megakernel, NTHREADS, LDS_BYTES);
        if (per_cu < 1) per_cu = 1;
        grid = cus * per_cu;
        if (n_in != 29 || ws_size < WS_END) fprintf(stderr, "kernel_launch: unexpected n_in %d / ws %zu (need %zu)\n", n_in, ws_size, (size_t)WS_END);
    }
    Args a{};
    for (int i = 0; i < 29; ++i) a.in[i] = (const float*)d_in[i];
    a.out = (float*)d_out; a.ws = (unsigned char*)d_ws; a.never = 0;
    (void)hipMemsetAsync((unsigned char*)d_ws + BAR_OFF, 0, (size_t)(XB_OFF - BAR_OFF), stream);
    void* args[] = {&a};
    hipError_t e = hipLaunchCooperativeKernel((void*)fwd_megakernel, dim3(grid), dim3(NTHREADS), args, LDS_BYTES, stream);
    if (e != hipSuccess) fprintf(stderr, "cooperative launch failed: %s (grid %d)\n", hipGetErrorString(e), grid);
}
```

```cpp
#include <hip/hip_runtime.h>
#include <hip/hip_cooperative_groups.h>
#include <cstdio>
#include <cstdint>
namespace cg = cooperative_groups;

#define LAS __attribute__((address_space(3)))
typedef unsigned short bf16_t;
typedef short bf16x8 __attribute__((ext_vector_type(8)));
typedef float f32x4 __attribute__((ext_vector_type(4)));
typedef float f32x2 __attribute__((ext_vector_type(2)));
typedef unsigned u32x4 __attribute__((ext_vector_type(4)));
typedef unsigned u32x2 __attribute__((ext_vector_type(2)));

constexpr int DM = 1024, NB = 4, SEQ = 4096, NMETA = 16, FF = 4096;
constexpr int RM = NB * SEQ;
constexpr int RMETA = RM;
constexpr int RVALID = RM + NMETA;
constexpr int R = RVALID;
constexpr int NCH = 65;
constexpr int IN_AB = 5120, IN_CD = 2560;
constexpr float EPS = 1e-6f;
constexpr int NTHREADS = 512;
constexpr int LDS_BYTES = 147456;

constexpr size_t W_INAB = 0;
constexpr size_t W_OUTAB = W_INAB + (size_t)5120 * 1024 * 2;
constexpr size_t W_W1_0 = W_OUTAB + (size_t)1024 * 2048 * 2;
constexpr size_t W_W2_0 = W_W1_0 + (size_t)4096 * 1024 * 2;
constexpr size_t W_INCD = W_W2_0 + (size_t)4096 * 1024 * 2;
constexpr size_t W_OUTCD = W_INCD + (size_t)2560 * 1024 * 2;
constexpr size_t W_GLU = W_OUTCD + (size_t)1024 * 1024 * 2;
constexpr size_t W_W1_1 = W_GLU + (size_t)512 * 512 * 2;
constexpr size_t W_W2_1 = W_W1_1 + (size_t)4096 * 1024 * 2;
constexpr size_t W_END = W_W2_1 + (size_t)4096 * 1024 * 2;
constexpr size_t Z_OFF = W_END;
constexpr size_t HN_OFF = Z_OFF + (size_t)R * 5120 * 2;
constexpr size_t SM_OFF = HN_OFF + (size_t)R * 1024 * 2;
constexpr size_t HMETA_OFF = SM_OFF;
constexpr size_t YAB_OFF = HMETA_OFF + (size_t)16 * 1024 * 4;
constexpr size_t YCD_OFF = YAB_OFF + (size_t)16 * 2048 * 2;
constexpr size_t YM_OFF = YCD_OFF + (size_t)16 * 1024 * 2;
constexpr size_t SSQ_OFF = YM_OFF + (size_t)16 * 512 * 2;
constexpr size_t LRUW_OFF = SSQ_OFF + (size_t)R * 16 * 4;
constexpr size_t S5BB_OFF = LRUW_OFF + (size_t)16 * 128 * 64 * 2;
constexpr size_t S5CM_OFF = S5BB_OFF + (size_t)32 * 128 * 32 * 2;
constexpr size_t S5AB_OFF = S5CM_OFF + (size_t)32 * 16 * 128 * 2;
constexpr size_t BAR_OFF = S5AB_OFF + (size_t)32 * 64 * 2 * 4;
constexpr size_t CNT_OFF = BAR_OFF + 16384;
constexpr size_t XB_OFF = CNT_OFF + (size_t)8 * 80 * 32 * 4;
constexpr size_t XB_STRIDE = (size_t)64 * 256 * 4 * 4 + 4096;
constexpr size_t WS_END = XB_OFF + 8 * XB_STRIDE;
static_assert(WS_END <= (size_t)268435456, "workspace map");

struct Args {
    const float* in[29];
    float* out;
    unsigned char* ws;
    long long never;
};

typedef __bf16 bf16x2_t __attribute__((ext_vector_type(2)));
__device__ __forceinline__ unsigned cvt_pk_bf16(float lo, float hi) { f32x2 v = {lo, hi}; bf16x2_t b = __builtin_convertvector(v, bf16x2_t); return __builtin_bit_cast(unsigned, b); }
__device__ __forceinline__ float bf_lo(unsigned u) { return __uint_as_float(u << 16); }
__device__ __forceinline__ float bf_hi(unsigned u) { return __uint_as_float(u & 0xffff0000u); }
__device__ __forceinline__ bf16_t f2bf(float f) { return (bf16_t)(cvt_pk_bf16(f, 0.f) & 0xffffu); }
__device__ __forceinline__ float wave_sum(float v) {
#pragma unroll
    for (int o = 1; o < 64; o <<= 1) v += __shfl_xor(v, o);
    return v;
}
__device__ __forceinline__ float sigmoidf_(float x) { return 1.f / (1.f + __expf(-x)); }
__device__ __forceinline__ float gelu_tanh(float x) {
    const float u = 0.7978845608028654f * (x + 0.044715f * x * x * x);
    const float e = __expf(2.f * u);
    const float t = 1.f - 2.f / (e + 1.f);
    return 0.5f * x * (1.f + t);
}
__device__ __forceinline__ float silu_(float x) { return x * sigmoidf_(x); }
__device__ __forceinline__ void sincos_big(float ang, float& s, float& c) {
    double t = (double)ang * 0.15915494309189535;
    t -= rint(t);
    const float fr = (float)t;
    s = __builtin_amdgcn_sinf(fr); c = __builtin_amdgcn_cosf(fr);
}
__device__ __forceinline__ void st_agent(float* p, float v) { __hip_atomic_store(p, v, __ATOMIC_RELAXED, __HIP_MEMORY_SCOPE_AGENT); }
__device__ __forceinline__ float ld_agent(const float* p) { return __hip_atomic_load(p, __ATOMIC_RELAXED, __HIP_MEMORY_SCOPE_AGENT); }
__device__ __forceinline__ void cnt_arrive_wait(unsigned* c, unsigned target) {
    __hip_atomic_fetch_add(c, 1u, __ATOMIC_RELAXED, __HIP_MEMORY_SCOPE_AGENT);
    unsigned sp = 0;
    while (__hip_atomic_load(c, __ATOMIC_RELAXED, __HIP_MEMORY_SCOPE_AGENT) < target) { __builtin_amdgcn_s_sleep(1); if (++sp > (1u << 22)) break; }
}
__device__ __forceinline__ float* hrow(const Args& a, int row) {
    return row < RM ? a.out + (size_t)row * DM : (float*)(a.ws + HMETA_OFF) + (size_t)(row - RM) * DM;
}
__device__ __forceinline__ int chunk_row(int b, int n, int j) {
    if (n == 0) return j >= 48 ? RMETA + (j - 48) : -1;
    return b * SEQ + (n - 1) * 64 + j;
}

namespace pg8 {
constexpr int BM = 256, BK = 64, HALF = 128, HTB = HALF * BK * 2, NXCD = 8, WGM = 8;
__device__ __forceinline__ int lds_byte(int r, int c) { const int st = (r >> 4) * 2 + (c >> 5), rr = r & 15, cc = c & 31, ob = rr * 64 + cc * 2; return st * 1024 + (ob ^ (((ob >> 9) & 1) << 5)); }
__device__ __forceinline__ void stage_rc(int b, int& Rr, int& C) { const int st = b / 1024, sb = b % 1024, swz = sb ^ (((sb >> 9) & 1) << 5); Rr = (st >> 1) * 16 + swz / 64; C = (st & 1) * 32 + (swz % 64) / 2; }
__device__ __forceinline__ int perm32(int rho) { const int n = rho >> 4, i = rho & 15; return 8 * (i >> 2) + 4 * n + (i & 3); }
struct Unit { int pm, pn; };
struct Gemm { const bf16_t* A; const bf16_t* Bt; int M, N, K, lda; };
struct StaticOrder {
    int nM, nN, nwg, G, c;
    __device__ void init(int M, int N, int G_, int c_) { nM = M / BM; nN = N / BM; nwg = nM * nN; G = G_; c = c_; }
    __device__ bool next(int i, Unit& u) const {
        const long L = (long)i * G + c; if (L >= nwg) return false;
        int wgid = (int)L; { const int q = nwg / NXCD, r = nwg % NXCD, xcd = wgid % NXCD, off = wgid / NXCD; wgid = (xcd < r ? xcd * (q + 1) : r * (q + 1) + (xcd - r) * q) + off; }
        const int nig = WGM * nN, gid = wgid / nig, fm = gid * WGM, gsz = (nM - fm) < WGM ? (nM - fm) : WGM;
        u.pm = fm + ((wgid % nig) % gsz); u.pn = (wgid % nig) / gsz; return true;
    }
};
template <class Epi>
__device__ __forceinline__ void gemm_phase(LAS unsigned char* lds, const Gemm g, const StaticOrder& S, const Epi& E) {
    int tid_ = threadIdx.x; asm volatile("" : "+v"(tid_));
    const int tid = tid_, wid = __builtin_amdgcn_readfirstlane(tid >> 6), lane = tid & 63, wr = wid >> 2, wc = wid & 3, fr = lane & 15, fq = lane >> 4;
    const int K = g.K, nt = K / BK, lda = g.lda;
    unsigned voffA[2], voffB[2];
#pragma unroll
    for (int i = 0; i < 2; ++i) { int Rr, C; stage_rc(tid * 16 + i * 8192, Rr, C); const int Rb = (Rr & ~31) + perm32(Rr & 31);
        voffA[i] = (unsigned)(Rr * lda + C) * 2u; voffB[i] = (unsigned)(Rb * K + C) * 2u; }
    const size_t kstep = (size_t)(BK * 2);
    const size_t hstepA = (size_t)HALF * lda * 2, hstepB = (size_t)HALF * K * 2;
    const size_t tstepA = 2 * hstepA, tstepB = 2 * hstepB;
    const unsigned ldsw = (unsigned)wid * 1024u;
    const int aoff = lds_byte(wr * 64 + fr, fq * 8), boff = lds_byte(wc * 32 + fr, fq * 8);
#define PG8_SA(b, h) (((b) * 2 + (h)) * HTB)
#define PG8_SB(b, h) ((4 + (b) * 2 + (h)) * HTB)
#define PG8_STAGE(bufoff, gbase, voff) do { _Pragma("unroll") for (int _i = 0; _i < 2; ++_i) \
        __builtin_amdgcn_global_load_lds((const unsigned*)((const char*)(gbase) + (voff)[_i]), (LAS unsigned*)(lds + (bufoff) + ldsw + _i * 8192), 16, 0, 0); } while (0)
#define PG8_LDA(dst, b, h) do { _Pragma("unroll") for (int m = 0; m < 4; ++m) _Pragma("unroll") for (int k = 0; k < 2; ++k) dst[m][k] = *(const LAS bf16x8*)(lds + PG8_SA(b, h) + aoff + m * 2048 + k * 1024); } while (0)
#define PG8_LDB(dst, b, h) do { _Pragma("unroll") for (int n = 0; n < 2; ++n) _Pragma("unroll") for (int k = 0; k < 2; ++k) dst[n][k] = *(const LAS bf16x8*)(lds + PG8_SB(b, h) + boff + n * 2048 + k * 1024); } while (0)
#define PG8_MMA(ai, bj, At, Bt) do { __builtin_amdgcn_s_setprio(1); _Pragma("unroll") for (int m = 0; m < 4; ++m) _Pragma("unroll") for (int n = 0; n < 2; ++n) _Pragma("unroll") for (int k = 0; k < 2; ++k) \
        acc[ai][bj][m][n] = __builtin_amdgcn_mfma_f32_16x16x32_bf16(Bt[n][k], At[m][k], acc[ai][bj][m][n], 0, 0, 0); __builtin_amdgcn_s_setprio(0); } while (0)
#define PG8_WAIT_V(n) asm volatile("s_waitcnt vmcnt(" #n ")" ::: "memory")
#define PG8_WAIT_L(n) asm volatile("s_waitcnt lgkmcnt(" #n ")" ::: "memory")
#define PG8_BAR __builtin_amdgcn_s_barrier()
#define PG8_SCHED __builtin_amdgcn_sched_barrier(0)
    Unit cur, nxt; int ui = 0;
    if (!S.next(0, cur)) return;
    f32x4 acc[2][2][4][2];
#pragma unroll
    for (int a = 0; a < 2; ++a)
#pragma unroll
        for (int b = 0; b < 2; ++b)
#pragma unroll
            for (int m = 0; m < 4; ++m)
#pragma unroll
                for (int n = 0; n < 2; ++n) acc[a][b][m][n] = (f32x4){0.f, 0.f, 0.f, 0.f};
    bf16x8 At[4][2], B0[2][2], B1[2][2];
    const char* cA = (const char*)g.A + (size_t)cur.pm * tstepA; const char* cB = (const char*)g.Bt + (size_t)cur.pn * tstepB;
    PG8_STAGE(PG8_SB(0, 0), cB, voffB); PG8_STAGE(PG8_SB(0, 1), cB + hstepB, voffB); PG8_STAGE(PG8_SA(0, 0), cA, voffA); PG8_STAGE(PG8_SA(0, 1), cA + hstepA, voffA);
    if (wr == 1) PG8_BAR;
    PG8_WAIT_V(2); PG8_BAR;
    PG8_STAGE(PG8_SB(1, 0), cB + kstep, voffB); PG8_STAGE(PG8_SA(1, 0), cA + kstep, voffA); PG8_STAGE(PG8_SB(1, 1), cB + hstepB + kstep, voffB);
    PG8_WAIT_V(6); PG8_BAR;
    for (;;) {
        const bool has_next = S.next(ui + 1, nxt);
        const char* nA = has_next ? (const char*)g.A + (size_t)nxt.pm * tstepA : cA; const char* nB = has_next ? (const char*)g.Bt + (size_t)nxt.pn * tstepB : cB;
        for (int t = 0; t < nt; t += 2) {
            const bool last = (t == nt - 2);
            const char* a1 = cA + (size_t)(t + 1) * kstep;
            const char* a2 = last ? nA : cA + (size_t)(t + 2) * kstep; const char* b2 = last ? nB : cB + (size_t)(t + 2) * kstep;
            const char* a3 = a2 + kstep; const char* b3 = b2 + kstep;
            PG8_LDB(B0, 0, 0); PG8_LDB(B1, 0, 1); PG8_SCHED; PG8_LDA(At, 0, 0); PG8_STAGE(PG8_SA(1, 1), a1 + hstepA, voffA);
            PG8_WAIT_V(8); PG8_WAIT_L(0); PG8_BAR; PG8_MMA(0, 0, At, B0); PG8_MMA(0, 1, At, B1); PG8_BAR; PG8_SCHED;
            PG8_LDA(At, 0, 1); PG8_STAGE(PG8_SB(0, 0), b2, voffB); PG8_STAGE(PG8_SB(0, 1), b2 + hstepB, voffB); PG8_STAGE(PG8_SA(0, 0), a2, voffA);
            PG8_WAIT_V(8); PG8_WAIT_L(0); PG8_BAR; PG8_MMA(1, 0, At, B0); PG8_MMA(1, 1, At, B1); PG8_BAR; PG8_SCHED;
            PG8_LDB(B0, 1, 0); PG8_LDB(B1, 1, 1); PG8_SCHED; PG8_LDA(At, 1, 0); PG8_STAGE(PG8_SA(0, 1), a2 + hstepA, voffA);
            PG8_WAIT_V(8); PG8_WAIT_L(0); PG8_BAR; PG8_MMA(0, 0, At, B0); PG8_MMA(0, 1, At, B1); PG8_BAR; PG8_SCHED;
            PG8_LDA(At, 1, 1); PG8_STAGE(PG8_SB(1, 0), b3, voffB); PG8_STAGE(PG8_SB(1, 1), b3 + hstepB, voffB); PG8_STAGE(PG8_SA(1, 0), a3, voffA);
            PG8_WAIT_V(8); PG8_WAIT_L(0); PG8_BAR; PG8_MMA(1, 0, At, B0); PG8_MMA(1, 1, At, B1); PG8_BAR; PG8_SCHED;
        }
        if (wr == 0) PG8_BAR;
        if constexpr (!Epi::AFTER_DRAIN) E(acc, cur, wr, wc, fr, fq);
        if (!has_next) break;
#pragma unroll
        for (int a = 0; a < 2; ++a)
#pragma unroll
            for (int b = 0; b < 2; ++b)
#pragma unroll
                for (int m = 0; m < 4; ++m)
#pragma unroll
                    for (int n = 0; n < 2; ++n) acc[a][b][m][n] = (f32x4){0.f, 0.f, 0.f, 0.f};
        cur = nxt; cA = nA; cB = nB; ++ui;
        if (wr == 1) PG8_BAR;
    }
    PG8_WAIT_V(0);
    PG8_BAR;
    if constexpr (Epi::AFTER_DRAIN) E.fused(acc, cur, wr, wc, fr, fq, lds);
#undef PG8_SA
#undef PG8_SB
#undef PG8_STAGE
#undef PG8_LDA
#undef PG8_LDB
#undef PG8_MMA
#undef PG8_WAIT_V
#undef PG8_WAIT_L
#undef PG8_BAR
#undef PG8_SCHED
}

template <int MODE> struct Epi {
    static constexpr bool AFTER_DRAIN = false;
    bf16_t* O; int ldo;
    float* ssq;
    const bf16_t* Y; int ldy;
    const float* bias;
    __device__ __forceinline__ void operator()(const f32x4 (&acc)[2][2][4][2], const Unit& u, int wr, int wc, int fr, int fq) const {
#pragma unroll
        for (int ai = 0; ai < 2; ++ai)
#pragma unroll
            for (int m = 0; m < 4; ++m) {
                const int row = u.pm * BM + ai * HALF + wr * 64 + m * 16 + fr;
                float ss = 0.f;
#pragma unroll
                for (int bj = 0; bj < 2; ++bj) {
                    const int col0 = u.pn * BM + bj * HALF + wc * 32 + 8 * fq;
                    f32x4 v0 = acc[ai][bj][m][0], v1 = acc[ai][bj][m][1];
                    if (MODE == 1) { ss += v0[0] * v0[0] + v0[1] * v0[1] + v0[2] * v0[2] + v0[3] * v0[3] + v1[0] * v1[0] + v1[1] * v1[1] + v1[2] * v1[2] + v1[3] * v1[3]; }
                    if (MODE == 2) {
#pragma unroll
                        for (int j = 0; j < 4; ++j) { float a = fmaxf(v0[j], 0.f); v0[j] = a * a; float b = fmaxf(v1[j], 0.f); v1[j] = b * b; }
                    }
                    if (MODE == 3) {
                        const u32x4 yv = *(const u32x4*)(Y + (size_t)row * ldy + col0);
                        const f32x4 b0 = *(const f32x4*)(bias + col0), b1 = *(const f32x4*)(bias + col0 + 4);
                        v0[0] = bf_lo(yv.x) * sigmoidf_(v0[0] + b0[0]); v0[1] = bf_hi(yv.x) * sigmoidf_(v0[1] + b0[1]);
                        v0[2] = bf_lo(yv.y) * sigmoidf_(v0[2] + b0[2]); v0[3] = bf_hi(yv.y) * sigmoidf_(v0[3] + b0[3]);
                        v1[0] = bf_lo(yv.z) * sigmoidf_(v1[0] + b1[0]); v1[1] = bf_hi(yv.z) * sigmoidf_(v1[1] + b1[1]);
                        v1[2] = bf_lo(yv.w) * sigmoidf_(v1[2] + b1[2]); v1[3] = bf_hi(yv.w) * sigmoidf_(v1[3] + b1[3]);
                    }
                    u32x4 w; w.x = cvt_pk_bf16(v0[0], v0[1]); w.y = cvt_pk_bf16(v0[2], v0[3]); w.z = cvt_pk_bf16(v1[0], v1[1]); w.w = cvt_pk_bf16(v1[2], v1[3]);
                    *(u32x4*)(O + (size_t)row * ldo + col0) = w;
                }
                if (MODE == 1) {
                    ss += __shfl_xor(ss, 16); ss += __shfl_xor(ss, 32);
                    if (fq == 0) ssq[(size_t)row * 16 + u.pn * 4 + wc] = ss;
                }
            }
    }
};

struct EpiRes {
    static constexpr bool AFTER_DRAIN = true;
    const float* hin; float* h;
    const float* g1; const float* g2;
    bf16_t* HN;
    float* xb1; float* xb2;
    unsigned* c1; unsigned* c2;
    __device__ __forceinline__ void exchange(const f32x4 (&acc)[2][2][4][2], const Unit& u, int wr, int wc, int fr, int fq, LAS unsigned char* lds, float* xb, unsigned* cnt) const {
        LAS float* P = (LAS float*)lds; LAS float* S = (LAS float*)(lds + 4096);
        const int tid = threadIdx.x;
#pragma unroll
        for (int ai = 0; ai < 2; ++ai)
#pragma unroll
            for (int m = 0; m < 4; ++m) {
                float ss = 0.f;
#pragma unroll
                for (int bj = 0; bj < 2; ++bj)
#pragma unroll
                    for (int n = 0; n < 2; ++n) { const f32x4 v = acc[ai][bj][m][n]; ss += v[0] * v[0] + v[1] * v[1] + v[2] * v[2] + v[3] * v[3]; }
                ss += __shfl_xor(ss, 16); ss += __shfl_xor(ss, 32);
                if (fq == 0) P[(ai * HALF + wr * 64 + m * 16 + fr) * 4 + wc] = ss;
            }
        __syncthreads();
        if (tid < 256) { const f32x4 p = *(const LAS f32x4*)(P + tid * 4); st_agent(xb + ((size_t)u.pm * 256 + tid) * 4 + u.pn, (p[0] + p[1]) + (p[2] + p[3])); }
        asm volatile("s_waitcnt vmcnt(0)" ::: "memory");
        __syncthreads();
        if (tid == 0) cnt_arrive_wait(cnt + u.pm * 32, 4u);
        __syncthreads();
        if (tid < 256) { const float* q = xb + ((size_t)u.pm * 256 + tid) * 4; const float t = (ld_agent(q) + ld_agent(q + 1)) + (ld_agent(q + 2) + ld_agent(q + 3));
            S[tid] = rsqrtf(t * (1.f / 1024.f) + EPS); }
        __syncthreads();
    }
    __device__ __forceinline__ void fused(f32x4 (&acc)[2][2][4][2], const Unit& u, int wr, int wc, int fr, int fq, LAS unsigned char* lds) const {
        const LAS float* S = (const LAS float*)(lds + 4096);
        exchange(acc, u, wr, wc, fr, fq, lds, xb1, c1);
#pragma unroll
        for (int bj = 0; bj < 2; ++bj) {
            const int col0 = u.pn * BM + bj * HALF + wc * 32 + 8 * fq;
            const f32x4 ga = *(const f32x4*)(g1 + col0), gb = *(const f32x4*)(g1 + col0 + 4);
#pragma unroll
            for (int ai = 0; ai < 2; ++ai)
#pragma unroll
                for (int m = 0; m < 4; ++m) {
                    const int rl = ai * HALF + wr * 64 + m * 16 + fr; const float inv = S[rl];
                    float* hp = h + (size_t)(u.pm * BM + rl) * 1024 + col0;
                    const float* hq = hin + (size_t)(u.pm * BM + rl) * 1024 + col0;
                    const f32x4 h0 = *(const f32x4*)hq, h1 = *(const f32x4*)(hq + 4);
                    f32x4 v0 = acc[ai][bj][m][0], v1 = acc[ai][bj][m][1];
                    v0 = h0 + v0 * inv * ga; v1 = h1 + v1 * inv * gb;
                    *(f32x4*)hp = v0; *(f32x4*)(hp + 4) = v1;
                    acc[ai][bj][m][0] = v0; acc[ai][bj][m][1] = v1;
                }
        }
        if (g2 == nullptr) return;
        __syncthreads();
        exchange(acc, u, wr, wc, fr, fq, lds, xb2, c2);
#pragma unroll
        for (int bj = 0; bj < 2; ++bj) {
            const int col0 = u.pn * BM + bj * HALF + wc * 32 + 8 * fq;
            const f32x4 ga = *(const f32x4*)(g2 + col0), gb = *(const f32x4*)(g2 + col0 + 4);
#pragma unroll
            for (int ai = 0; ai < 2; ++ai)
#pragma unroll
                for (int m = 0; m < 4; ++m) {
                    const int rl = ai * HALF + wr * 64 + m * 16 + fr; const float inv = S[rl];
                    const f32x4 v0 = acc[ai][bj][m][0] * inv * ga, v1 = acc[ai][bj][m][1] * inv * gb;
                    u32x4 w; w.x = cvt_pk_bf16(v0[0], v0[1]); w.y = cvt_pk_bf16(v0[2], v0[3]); w.z = cvt_pk_bf16(v1[0], v1[1]); w.w = cvt_pk_bf16(v1[2], v1[3]);
                    *(u32x4*)(HN + (size_t)(u.pm * BM + rl) * 1024 + col0) = w;
                }
        }
    }
};
}

__device__ __forceinline__ bf16x8 ldsfrag(const LAS unsigned char* p) { return *(const LAS bf16x8*)p; }
#define LBAR() do { asm volatile("s_waitcnt lgkmcnt(0)" ::: "memory"); __builtin_amdgcn_s_barrier(); asm volatile("" ::: "memory"); } while (0)
#define MFMA16(X, Y, ACC) __builtin_amdgcn_mfma_f32_16x16x32_bf16((X), (Y), (ACC), 0, 0, 0)


template <int MODE, int NT, int STEPS>
__device__ __forceinline__ void meta_gemm(LAS unsigned char* L, const bf16_t* A, int lda, const bf16_t* Bt, int N, int K,
                                          bf16_t* O, int ldo, float* ssq, const bf16_t* Y, int ldy, const float* bias,
                                          float* hm = nullptr, const float* g1 = nullptr, const float* g2 = nullptr, float* xm1 = nullptr, float* xm2 = nullptr, unsigned* cm1 = nullptr, unsigned* cm2 = nullptr) {
    int tid_ = threadIdx.x; asm volatile("" : "+v"(tid_));
    const int tid = tid_, lane = tid & 63, w = __builtin_amdgcn_readfirstlane(tid >> 6), fr = lane & 15, fq = lane >> 4;
    const int t = (int)gridDim.x - 1 - (int)blockIdx.x;
    if (t >= N / (16 * NT)) return;
    const int n0 = t * 16 * NT, kw = K / 8, k0 = w * kw;
    f32x4 acc[NT];
#pragma unroll
    for (int nt = 0; nt < NT; ++nt) acc[nt] = (f32x4){0.f, 0.f, 0.f, 0.f};
    const bf16_t* ap = A + (size_t)fr * lda + k0 + fq * 8;
    const bf16_t* bp = Bt + (size_t)(n0 + fr) * K + k0 + fq * 8;
    for (int k = 0; k < kw; k += 32 * STEPS) {
        bf16x8 af[STEPS], bfr[STEPS][NT];
#pragma unroll
        for (int st = 0; st < STEPS; ++st) { af[st] = *(const bf16x8*)(ap + k + 32 * st);
#pragma unroll
            for (int nt = 0; nt < NT; ++nt) bfr[st][nt] = *(const bf16x8*)(bp + (size_t)nt * 16 * K + k + 32 * st); }
#pragma unroll
        for (int st = 0; st < STEPS; ++st)
#pragma unroll
            for (int nt = 0; nt < NT; ++nt) acc[nt] = MFMA16(bfr[st][nt], af[st], acc[nt]);
    }
    LAS f32x4* P = (LAS f32x4*)L;
#pragma unroll
    for (int nt = 0; nt < NT; ++nt) P[(w * NT + nt) * 64 + lane] = acc[nt];
    __syncthreads();
    if (MODE == 4) {
        if (w == 0) {
            const int np = N / 16;
            f32x4 v = P[lane];
#pragma unroll
            for (int ww = 1; ww < 8; ++ww) v += P[ww * NT * 64 + lane];
            float ss = v[0] * v[0] + v[1] * v[1] + v[2] * v[2] + v[3] * v[3];
            ss += __shfl_xor(ss, 16); ss += __shfl_xor(ss, 32);
            if (fq == 0) st_agent(xm1 + fr * np + t, ss);
            asm volatile("s_waitcnt vmcnt(0)" ::: "memory");
            if (lane == 0) cnt_arrive_wait(cm1, (unsigned)np);
            __builtin_amdgcn_wave_barrier();
            float tot = 0.f;
#pragma unroll
            for (int q = 0; q < 16; ++q) tot += ld_agent(xm1 + fr * np + fq * 16 + q);
            tot += __shfl_xor(tot, 16); tot += __shfl_xor(tot, 32);
            const float inv = rsqrtf(tot * (1.f / 1024.f) + EPS);
            const int col = n0 + 4 * fq; float* hp = hm + fr * 1024 + col;
            { const f32x4 gg = *(const f32x4*)(g1 + col); const f32x4 h0 = *(const f32x4*)hp; v = h0 + v * inv * gg; *(f32x4*)hp = v; }
            if (g2 != nullptr) {
                float ss2 = v[0] * v[0] + v[1] * v[1] + v[2] * v[2] + v[3] * v[3];
                ss2 += __shfl_xor(ss2, 16); ss2 += __shfl_xor(ss2, 32);
                if (fq == 0) st_agent(xm2 + fr * np + t, ss2);
                asm volatile("s_waitcnt vmcnt(0)" ::: "memory");
                if (lane == 0) cnt_arrive_wait(cm2, (unsigned)np);
                __builtin_amdgcn_wave_barrier();
                float tot2 = 0.f;
#pragma unroll
                for (int q = 0; q < 16; ++q) tot2 += ld_agent(xm2 + fr * np + fq * 16 + q);
                tot2 += __shfl_xor(tot2, 16); tot2 += __shfl_xor(tot2, 32);
                const float inv2 = rsqrtf(tot2 * (1.f / 1024.f) + EPS);
                const f32x4 gg = *(const f32x4*)(g2 + col); const f32x4 y = v * inv2 * gg;
                u32x2 o; o.x = cvt_pk_bf16(y[0], y[1]); o.y = cvt_pk_bf16(y[2], y[3]);
                *(u32x2*)(O + (size_t)fr * ldo + col) = o;
            }
        }
    } else if (w == 0) {
        float ss = 0.f;
#pragma unroll
        for (int nt = 0; nt < NT; ++nt) {
            f32x4 v = P[nt * 64 + lane];
#pragma unroll
            for (int ww = 1; ww < 8; ++ww) v += P[(ww * NT + nt) * 64 + lane];
            const int col = n0 + nt * 16 + 4 * fq;
            if (MODE == 1) ss += v[0] * v[0] + v[1] * v[1] + v[2] * v[2] + v[3] * v[3];
            if (MODE == 2) {
#pragma unroll
                for (int j = 0; j < 4; ++j) { const float r = fmaxf(v[j], 0.f); v[j] = r * r; }
            }
            if (MODE == 3) {
                const u32x2 yv = *(const u32x2*)(Y + (size_t)fr * ldy + col);
                const f32x4 bb = *(const f32x4*)(bias + col);
                v[0] = bf_lo(yv.x) * sigmoidf_(v[0] + bb[0]); v[1] = bf_hi(yv.x) * sigmoidf_(v[1] + bb[1]);
                v[2] = bf_lo(yv.y) * sigmoidf_(v[2] + bb[2]); v[3] = bf_hi(yv.y) * sigmoidf_(v[3] + bb[3]);
            }
            u32x2 o; o.x = cvt_pk_bf16(v[0], v[1]); o.y = cvt_pk_bf16(v[2], v[3]);
            *(u32x2*)(O + (size_t)fr * ldo + col) = o;
        }
        if (MODE == 1) {
            ss += __shfl_xor(ss, 16); ss += __shfl_xor(ss, 32);
            if (fq == 0) ssq[fr * 16 + t] = ss;
        }
    }
    __syncthreads();
}

__device__ __forceinline__ void transpose_item(const float* W, int K, int N, bf16_t* WT, int dst_row0, LAS float* scr, int k0, int n0, int lane) {
#pragma unroll 8
    for (int i = 0; i < 32; ++i) { const int kk = 2 * i + (lane >> 5); scr[kk * 33 + (lane & 31)] = W[(size_t)(k0 + kk) * N + n0 + (lane & 31)]; }
    asm volatile("s_waitcnt lgkmcnt(0)" ::: "memory");
    const int c = lane & 7;
#pragma unroll
    for (int j = 0; j < 4; ++j) { const int n = (lane >> 3) + 8 * j; const LAS float* s = scr + (8 * c) * 33 + n;
        u32x4 o; o.x = cvt_pk_bf16(s[0 * 33], s[1 * 33]); o.y = cvt_pk_bf16(s[2 * 33], s[3 * 33]); o.z = cvt_pk_bf16(s[4 * 33], s[5 * 33]); o.w = cvt_pk_bf16(s[6 * 33], s[7 * 33]);
        *(u32x4*)(WT + (size_t)(dst_row0 + n) * K + k0 + 8 * c) = o; }
    asm volatile("s_waitcnt lgkmcnt(0)" ::: "memory");
}


constexpr int WC_I0 = 16 * 160, WC_I1 = 32 * 32, WC_I2 = 16 * 128, WC_I3 = 64 * 32, WC_I4 = 16 * 80, WC_I5 = 16 * 32, WC_I6 = 8 * 16, WC_I7 = WC_I2, WC_I8 = WC_I3;
constexpr int WC_C0 = 0, WC_C1 = WC_I0, WC_C5 = WC_I0 + WC_I1 + WC_I2 + WC_I3 + WC_I4, WC_C9 = WC_C5 + WC_I5 + WC_I6 + WC_I7 + WC_I8;
__device__ __forceinline__ void weight_convert(const Args& a, LAS unsigned char* lds, int it0, int it1, int vb, int nvb) {
    int tid_ = threadIdx.x; asm volatile("" : "+v"(tid_));
    const int tid = tid_, lane = tid & 63, wave = tid >> 6;
    unsigned char* ws = a.ws;
    LAS float* scr = (LAS float*)(lds + wave * 16384);
    constexpr int I0 = WC_I0, I1 = WC_I1, I2 = WC_I2, I3 = WC_I3, I4 = WC_I4, I5 = WC_I5, I6 = WC_I6, I7 = WC_I7;
    for (int it = it0 + vb * 8 + wave; it < it1; it += nvb * 8) {
        int r = it; const float* W; int K, N; bf16_t* WT; bool perm = false;
        if (r < I0) { W = a.in[2]; K = 1024; N = 5120; WT = (bf16_t*)(ws + W_INAB); perm = true; }
        else if ((r -= I0) < I1) { W = a.in[3]; K = 2048; N = 1024; WT = (bf16_t*)(ws + W_OUTAB); }
        else if ((r -= I1) < I2) { W = a.in[27]; K = 1024; N = 4096; WT = (bf16_t*)(ws + W_W1_0); }
        else if ((r -= I2) < I3) { W = a.in[28]; K = 4096; N = 1024; WT = (bf16_t*)(ws + W_W2_0); }
        else if ((r -= I3) < I4) { W = a.in[12]; K = 1024; N = 2560; WT = (bf16_t*)(ws + W_INCD); }
        else if ((r -= I4) < I5) { W = a.in[13]; K = 1024; N = 1024; WT = (bf16_t*)(ws + W_OUTCD); }
        else if ((r -= I5) < I6) { W = a.in[22]; K = 512; N = 512; WT = (bf16_t*)(ws + W_GLU); }
        else if ((r -= I6) < I7) { W = a.in[27] + (size_t)1024 * 4096; K = 1024; N = 4096; WT = (bf16_t*)(ws + W_W1_1); }
        else { r -= I7; W = a.in[28] + (size_t)1024 * 4096; K = 4096; N = 1024; WT = (bf16_t*)(ws + W_W2_1); }
        const int nblk = N / 32, kb = r / nblk, nb = r % nblk, n0 = nb * 32;
        int d0 = n0;
        if (perm) { if (n0 >= 2048 && n0 < 3072) d0 = n0 + 1024; else if (n0 >= 3072 && n0 < 4096) d0 = n0 - 1024; }
        transpose_item(W, K, N, WT, d0, scr, kb * 64, n0, lane);
    }
}

__device__ __forceinline__ void phase_prologue(const Args& a, LAS unsigned char* lds, bool copy_x) {
    int tid_ = threadIdx.x; asm volatile("" : "+v"(tid_));
    const int tid = tid_, lane = tid & 63, wave = tid >> 6;
    const int gw = blockIdx.x * 8 + wave, NGW = gridDim.x * 8;
    unsigned char* ws = a.ws;
    LAS float* scr = (LAS float*)(lds + wave * 16384);
    weight_convert(a, lds, WC_C0, WC_C5, blockIdx.x, gridDim.x);
    {
        const float* x = a.in[0]; const float* meta = a.in[1]; const float* g = a.in[26];
        bf16_t* HN = (bf16_t*)(ws + HN_OFF);
        f32x4 gg[4];
#pragma unroll
        for (int j = 0; j < 4; ++j) gg[j] = *(const f32x4*)(g + 4 * lane + 256 * j);
        for (int row0 = gw; row0 < R; row0 += 4 * NGW) {
            f32x4 v[4][4];
#pragma unroll
            for (int q = 0; q < 4; ++q) { const int row = row0 + q * NGW;
                if (row < R) { const float* src = row < RM ? x + (size_t)row * DM : meta + (size_t)(row - RM) * DM;
#pragma unroll
                    for (int j = 0; j < 4; ++j) v[q][j] = *(const f32x4*)(src + 4 * lane + 256 * j); }
                else {
#pragma unroll
                    for (int j = 0; j < 4; ++j) v[q][j] = (f32x4){0.f, 0.f, 0.f, 0.f}; } }
#pragma unroll
            for (int q = 0; q < 4; ++q) { const int row = row0 + q * NGW;
                if (row < R) {
                    float s = 0.f;
#pragma unroll
                    for (int j = 0; j < 4; ++j) s += v[q][j][0] * v[q][j][0] + v[q][j][1] * v[q][j][1] + v[q][j][2] * v[q][j][2] + v[q][j][3] * v[q][j][3];
                    const float inv = rsqrtf(wave_sum(s) * (1.f / DM) + EPS);
                    if (copy_x || row >= RM) { float* hr = hrow(a, row);
#pragma unroll
                        for (int j = 0; j < 4; ++j) *(f32x4*)(hr + 4 * lane + 256 * j) = v[q][j]; }
#pragma unroll
                    for (int j = 0; j < 4; ++j) { u32x2 o; o.x = cvt_pk_bf16(v[q][j][0] * inv * gg[j][0], v[q][j][1] * inv * gg[j][1]); o.y = cvt_pk_bf16(v[q][j][2] * inv * gg[j][2], v[q][j][3] * inv * gg[j][3]);
                        *(u32x2*)(HN + (size_t)row * DM + 4 * lane + 256 * j) = o; }
                } }
        }
    }
    const int gt = blockIdx.x * NTHREADS + tid, NGT = gridDim.x * NTHREADS;
    {
        bf16_t* WG = (bf16_t*)(ws + LRUW_OFF);
        for (int i = gt; i < 16 * 128 * 64; i += NGT) { const int k = i & 63, n = (i >> 6) & 127, blk = i >> 13;
            const float v = n < 64 ? a.in[5][(size_t)blk * 4096 + k * 64 + n] : a.in[7][(size_t)blk * 4096 + k * 64 + (n - 64)];
            WG[i] = f2bf(v); }
    }
    {
        bf16_t* BB = (bf16_t*)(ws + S5BB_OFF); bf16_t* CM = (bf16_t*)(ws + S5CM_OFF); float* AB = (float*)(ws + S5AB_OFF);
        const float* are_log = a.in[14]; const float* aim = a.in[15]; const float* bre = a.in[16]; const float* bim = a.in[17];
        const float* cre = a.in[18]; const float* cim = a.in[19]; const float* ldt = a.in[21];
        for (int i = gt; i < 32 * 64; i += NGT) {
            const int g = i >> 6, p = i & 63;
            const float dt = expf(ldt[g]); const float a_re = -expf(are_log[i]); const float a_im = aim[i];
            const float mag = expf(dt * a_re); float sn, cs; sincos_big(dt * a_im, sn, cs);
            const float ab_re = mag * cs, ab_im = mag * sn;
            AB[2 * i] = ab_re; AB[2 * i + 1] = ab_im;
            const float n_re = ab_re - 1.f, n_im = ab_im, den = a_re * a_re + a_im * a_im;
            const float z_re = (n_re * a_re + n_im * a_im) / den, z_im = (n_im * a_re - n_re * a_im) / den;
            for (int c = 0; c < 32; ++c) {
                float vr = 0.f, vi = 0.f;
                if (c < 16) { const float br = bre[(size_t)i * 16 + c], bi = bim[(size_t)i * 16 + c]; vr = z_re * br - z_im * bi; vi = z_re * bi + z_im * br; }
                BB[((size_t)g * 128 + p) * 32 + c] = f2bf(vr);
                BB[((size_t)g * 128 + 64 + p) * 32 + c] = f2bf(vi);
            }
            for (int c = 0; c < 16; ++c) {
                CM[((size_t)g * 16 + c) * 128 + p] = f2bf(cre[((size_t)g * 16 + c) * 64 + p]);
                CM[((size_t)g * 16 + c) * 128 + 64 + p] = f2bf(-cim[((size_t)g * 16 + c) * 64 + p]);
            }
        }
    }
}

__device__ __forceinline__ void phase_resnorm(const Args& a, const float* g1, const float* g2) {
    int tid_ = threadIdx.x; asm volatile("" : "+v"(tid_));
    const int tid = tid_, lane = tid & 63, wave = tid >> 6;
    const int gw = blockIdx.x * 8 + wave, NGW = gridDim.x * 8;
    bf16_t* HN = (bf16_t*)(a.ws + HN_OFF); const float* ssq = (const float*)(a.ws + SSQ_OFF);
    for (int row = gw; row < R; row += NGW) {
        bf16_t* mrow = HN + (size_t)row * DM;
        float s = 0.f;
        { const f32x4* sp = (const f32x4*)(ssq + (size_t)row * 16); const f32x4 s0 = sp[0], s1 = sp[1], s2 = sp[2], s3 = sp[3];
          s = ((s0[0] + s0[1]) + (s0[2] + s0[3])) + ((s1[0] + s1[1]) + (s1[2] + s1[3])) + ((s2[0] + s2[1]) + (s2[2] + s2[3])) + ((s3[0] + s3[1]) + (s3[2] + s3[3])); }
        const float inv = rsqrtf(s * (1.f / DM) + EPS);
        float* hr = hrow(a, row);
        f32x4 v[4]; float s2 = 0.f;
#pragma unroll
        for (int j = 0; j < 4; ++j) {
            const u32x2 mv = *(const u32x2*)(mrow + 4 * lane + 256 * j);
            const f32x4 gg = *(const f32x4*)(g1 + 4 * lane + 256 * j);
            v[j] = *(const f32x4*)(hr + 4 * lane + 256 * j);
            v[j][0] += bf_lo(mv.x) * inv * gg[0]; v[j][1] += bf_hi(mv.x) * inv * gg[1]; v[j][2] += bf_lo(mv.y) * inv * gg[2]; v[j][3] += bf_hi(mv.y) * inv * gg[3];
            *(f32x4*)(hr + 4 * lane + 256 * j) = v[j];
            s2 += v[j][0] * v[j][0] + v[j][1] * v[j][1] + v[j][2] * v[j][2] + v[j][3] * v[j][3];
        }
        if (g2) {
            const float inv2 = rsqrtf(wave_sum(s2) * (1.f / DM) + EPS);
#pragma unroll
            for (int j = 0; j < 4; ++j) { const f32x4 gg = *(const f32x4*)(g2 + 4 * lane + 256 * j);
                u32x2 o; o.x = cvt_pk_bf16(v[j][0] * inv2 * gg[0], v[j][1] * inv2 * gg[1]); o.y = cvt_pk_bf16(v[j][2] * inv2 * gg[2], v[j][3] * inv2 * gg[3]);
                *(u32x2*)(mrow + 4 * lane + 256 * j) = o; }
        }
    }
}

constexpr int LA_QS = 0, LA_KS = 17408, LA_QD = 34816, LA_KT = 52224, LA_VT = 70656, LA_PS = 75264, LA_ST = 84480, LA_CUM = 93184, LA_DEC = 125952, LA_END = 126464;
static_assert(LA_END <= LDS_BYTES, "LA lds");
__device__ __forceinline__ int kt_off(int d, int s) { return d * 144 + ((((s >> 3) ^ (d >> 3)) & 7) << 4) + (s & 7) * 2; }

template <bool HG>
__device__ __forceinline__ void la_core(LAS unsigned char* L, f32x4 (&st)[2], float l2g, bf16_t* obuf, int ldo, int ocol, int b, int n, bool dry) {
    int tid_ = threadIdx.x; asm volatile("" : "+v"(tid_));
    const int tid = tid_, lane = tid & 63, w = __builtin_amdgcn_readfirstlane(tid >> 6), fr = lane & 15, fq = lane >> 4;
    const int mt = w >> 1, nh = w & 1;
    bf16x8 qf[4];
#pragma unroll
    for (int kk = 0; kk < 4; ++kk) qf[kk] = ldsfrag(L + LA_QS + (mt * 16 + fr) * 272 + kk * 64 + fq * 16);
    f32x4 s0 = {0.f, 0.f, 0.f, 0.f}, s1 = {0.f, 0.f, 0.f, 0.f};
#pragma unroll
    for (int kk = 0; kk < 4; ++kk) {
        const bf16x8 k0 = ldsfrag(L + LA_KS + ((nh * 2) * 16 + fr) * 272 + kk * 64 + fq * 16);
        const bf16x8 k1 = ldsfrag(L + LA_KS + ((nh * 2 + 1) * 16 + fr) * 272 + kk * 64 + fq * 16);
        s0 = MFMA16(k0, qf[kk], s0); s1 = MFMA16(k1, qf[kk], s1);
    }
    const int t = mt * 16 + fr;
    {
        float p0[4], p1[4];
#pragma unroll
        for (int jj = 0; jj < 4; ++jj) {
            const int sa = (nh * 2) * 16 + 4 * fq + jj, sb = sa + 16;
            if (HG) { p0[jj] = sa <= t ? s0[jj] : 0.f; p1[jj] = sb <= t ? s1[jj] : 0.f; }
            else { p0[jj] = s0[jj] * exp2f(l2g * fabsf((float)(t - sa))); p1[jj] = s1[jj] * exp2f(l2g * fabsf((float)(t - sb))); }
        }
        u32x2 o0, o1; o0.x = cvt_pk_bf16(p0[0], p0[1]); o0.y = cvt_pk_bf16(p0[2], p0[3]); o1.x = cvt_pk_bf16(p1[0], p1[1]); o1.y = cvt_pk_bf16(p1[2], p1[3]);
        *(LAS u32x2*)(L + LA_PS + t * 144 + ((nh * 2) * 16 + 4 * fq) * 2) = o0;
        *(LAS u32x2*)(L + LA_PS + t * 144 + ((nh * 2 + 1) * 16 + 4 * fq) * 2) = o1;
    }
    f32x4 o = {0.f, 0.f, 0.f, 0.f};
#pragma unroll
    for (int kk = 0; kk < 4; ++kk) {
        const bf16x8 sf = ldsfrag(L + LA_ST + (nh * 16 + fr) * 272 + kk * 64 + fq * 16);
        const bf16x8 qq = HG ? ldsfrag(L + LA_QD + (mt * 16 + fr) * 272 + kk * 64 + fq * 16) : qf[kk];
        o = MFMA16(sf, qq, o);
    }
    if (!HG) { const float sc = exp2f(l2g * (float)(t + 1)); o[0] *= sc; o[1] *= sc; o[2] *= sc; o[3] *= sc; }
    LBAR();
#pragma unroll
    for (int kk = 0; kk < 2; ++kk) {
        const bf16x8 vf = ldsfrag(L + LA_VT + (nh * 16 + fr) * 144 + kk * 64 + fq * 16);
        const bf16x8 pf = ldsfrag(L + LA_PS + (mt * 16 + fr) * 144 + kk * 64 + fq * 16);
        o = MFMA16(vf, pf, o);
    }
    {
        const int row = chunk_row(b, n, t);
        if (row >= 0 && (row < RM || b == 0) && !dry) { u32x2 ov; ov.x = cvt_pk_bf16(o[0], o[1]); ov.y = cvt_pk_bf16(o[2], o[3]);
            *(u32x2*)(obuf + (size_t)row * ldo + ocol + nh * 16 + 4 * fq) = ov; }
    }
    float dc[4];
    if (HG) { const f32x4 dv = *(const LAS f32x4*)(L + LA_DEC + (w * 16 + 4 * fq) * 4); dc[0] = dv[0]; dc[1] = dv[1]; dc[2] = dv[2]; dc[3] = dv[3]; }
    else { const float g64 = exp2f(l2g * 64.f); dc[0] = dc[1] = dc[2] = dc[3] = g64; }
    const int ktd = w * 16 + fr, ktx = (ktd >> 3) & 7;
    const bf16x8 kt0 = ldsfrag(L + LA_KT + ktd * 144 + ((fq ^ ktx) << 4)), kt1 = ldsfrag(L + LA_KT + ktd * 144 + (((4 + fq) ^ ktx) << 4));
#pragma unroll
    for (int et = 0; et < 2; ++et) {
#pragma unroll
        for (int jj = 0; jj < 4; ++jj) st[et][jj] *= dc[jj];
        const bf16x8 v0 = ldsfrag(L + LA_VT + (et * 16 + fr) * 144 + fq * 16), v1 = ldsfrag(L + LA_VT + (et * 16 + fr) * 144 + 64 + fq * 16);
        st[et] = MFMA16(kt0, v0, st[et]); st[et] = MFMA16(kt1, v1, st[et]);
        u32x2 sv; sv.x = cvt_pk_bf16(st[et][0], st[et][1]); sv.y = cvt_pk_bf16(st[et][2], st[et][3]);
        *(LAS u32x2*)(L + LA_ST + (et * 16 + fr) * 272 + (w * 16 + 4 * fq) * 2) = sv;
    }
}

#define UNPK8(dst, v) do { dst[0] = bf_lo((v).x); dst[1] = bf_hi((v).x); dst[2] = bf_lo((v).y); dst[3] = bf_hi((v).y); dst[4] = bf_lo((v).z); dst[5] = bf_hi((v).z); dst[6] = bf_lo((v).w); dst[7] = bf_hi((v).w); } while (0)
#define PK8(v, src) do { (v).x = cvt_pk_bf16(src[0], src[1]); (v).y = cvt_pk_bf16(src[2], src[3]); (v).z = cvt_pk_bf16(src[4], src[5]); (v).w = cvt_pk_bf16(src[6], src[7]); } while (0)

__device__ __forceinline__ void retention_unit(const Args& a, LAS unsigned char* L, int unit, bool dry) {
    int tid_ = threadIdx.x; asm volatile("" : "+v"(tid_));
    const int tid = tid_, b = unit >> 5, h = (unit >> 3) & 3, sl = unit & 7;
    const bf16_t* Z = (const bf16_t*)(a.ws + Z_OFF); bf16_t* OB = (bf16_t*)(a.ws + HN_OFF);
    const float l2g = log2f(1.f - exp2f(-5.f - (float)h));
    const int row_l = tid >> 3, c8 = tid & 7;
    const int vrow = (tid >> 2) & 63, vp = tid & 3;
    float rc[8], rs[8], stc[8], sts[8];
#pragma unroll
    for (int i = 0; i < 8; ++i) { const float invf = exp2f(-(float)(c8 * 8 + i) * (13.287712379549449f / 64.f));
        sincos_big((float)(row_l - 48) * invf, rs[i], rc[i]); sincos_big(64.f * invf, sts[i], stc[i]); }
    f32x4 st[2] = {{0.f, 0.f, 0.f, 0.f}, {0.f, 0.f, 0.f, 0.f}};
    for (int i = tid; i < 32 * 272 / 4; i += NTHREADS) ((LAS unsigned*)(L + LA_ST))[i] = 0u;
    u32x4 q1, q2, k1, k2, vv;
#define RET_LOAD(n_) do { const int r_ = chunk_row(b, (n_), row_l); \
        if (r_ >= 0) { const bf16_t* zr = Z + (size_t)r_ * IN_AB; \
            q1 = *(const u32x4*)(zr + h * 128 + c8 * 8); q2 = *(const u32x4*)(zr + h * 128 + 64 + c8 * 8); \
            k1 = *(const u32x4*)(zr + 512 + h * 128 + c8 * 8); k2 = *(const u32x4*)(zr + 512 + h * 128 + 64 + c8 * 8); \
        } else { q1 = q2 = k1 = k2 = (u32x4){0u, 0u, 0u, 0u}; } \
        vv = (u32x4){0u, 0u, 0u, 0u}; \
        if (tid < 256) { const int rv = chunk_row(b, (n_), vrow); if (rv >= 0) vv = *(const u32x4*)(Z + (size_t)rv * IN_AB + 1024 + h * 256 + sl * 32 + vp * 8); } } while (0)
    RET_LOAD(0);
    for (int n = 0; n < NCH; ++n) {
        {
            const float kdec = exp2f(l2g * (float)(63 - row_l));
            float x1[8], x2[8], y1[8], y2[8], qo1[8], qo2[8], ko1[8], ko2[8];
            UNPK8(x1, q1); UNPK8(x2, q2); UNPK8(y1, k1); UNPK8(y2, k2);
#pragma unroll
            for (int i = 0; i < 8; ++i) {
                const float sn = rs[i], cs = rc[i];
                rc[i] = cs * stc[i] - sn * sts[i]; rs[i] = sn * stc[i] + cs * sts[i];
                qo1[i] = (x1[i] * cs - x2[i] * sn) * 0.08838834764831845f; qo2[i] = (x1[i] * sn + x2[i] * cs) * 0.08838834764831845f;
                ko1[i] = y1[i] * cs - y2[i] * sn; ko2[i] = y1[i] * sn + y2[i] * cs;
            }
            u32x4 w1, w2;
            PK8(w1, qo1); PK8(w2, qo2);
            *(LAS u32x4*)(L + LA_QS + row_l * 272 + c8 * 16) = w1; *(LAS u32x4*)(L + LA_QS + row_l * 272 + 128 + c8 * 16) = w2;
            PK8(w1, ko1); PK8(w2, ko2);
            *(LAS u32x4*)(L + LA_KS + row_l * 272 + c8 * 16) = w1; *(LAS u32x4*)(L + LA_KS + row_l * 272 + 128 + c8 * 16) = w2;
#pragma unroll
            for (int i = 0; i < 8; ++i) {
                *(LAS bf16_t*)(L + LA_KT + kt_off(c8 * 8 + i, row_l)) = f2bf(ko1[i] * kdec);
                *(LAS bf16_t*)(L + LA_KT + kt_off(64 + c8 * 8 + i, row_l)) = f2bf(ko2[i] * kdec);
            }
            if (tid < 256) {
                const unsigned va[4] = {vv.x, vv.y, vv.z, vv.w};
#pragma unroll
                for (int i = 0; i < 8; ++i) *(LAS bf16_t*)(L + LA_VT + (vp * 8 + i) * 144 + vrow * 2) = (bf16_t)((i & 1) ? (va[i >> 1] >> 16) : (va[i >> 1] & 0xffffu));
            }
        }
        if (n + 1 < NCH) RET_LOAD(n + 1);
        LBAR();
        la_core<false>(L, st, l2g, OB, DM, h * 256 + sl * 32, b, n, dry);
        LBAR();
    }
#undef RET_LOAD
}

constexpr size_t HGT_OFF = Z_OFF + (size_t)R * IN_CD * 2;
constexpr size_t HGT_ITEM = 71680;
static_assert(HGT_OFF + (size_t)NB * NCH * 4 * HGT_ITEM <= HN_OFF, "HGRN tile images fit behind z_cd");
__device__ __forceinline__ void hgrn_prepass(const Args& a, LAS unsigned char* L) {
    int tid_ = threadIdx.x; asm volatile("" : "+v"(tid_));
    const int tid = tid_;
    const bf16_t* Z = (const bf16_t*)(a.ws + Z_OFF);
    const int row_l = tid >> 3, c8 = tid & 7;
    const float* lg = a.in[25];
    for (int it = blockIdx.x; it < NB * NCH * 4; it += gridDim.x) {
        const int h = it & 3, bn = it >> 2, b = bn / NCH, n = bn % NCH;
        float lb1[8], lb2[8];
#pragma unroll
        for (int i = 0; i < 8; ++i) { const int d = h * 128 + c8 * 8 + i; lb1[i] = sigmoidf_(lg[d] - lg[512 + d]); lb2[i] = sigmoidf_(lg[d + 64] - lg[512 + d + 64]); }
        const int r = chunk_row(b, n, row_l);
        const bool valid = r >= 0;
        u32x4 q1, q2, f1, f2;
        if (valid) { const bf16_t* zr = Z + (size_t)r * IN_CD;
            q1 = *(const u32x4*)(zr + 512 + h * 128 + c8 * 8); q2 = *(const u32x4*)(zr + 512 + h * 128 + 64 + c8 * 8);
            f1 = *(const u32x4*)(zr + 1024 + h * 128 + c8 * 8); f2 = *(const u32x4*)(zr + 1024 + h * 128 + 64 + c8 * 8);
        } else { q1 = q2 = f1 = f2 = (u32x4){0u, 0u, 0u, 0u}; }
        float qv1[8], qv2[8], kv1[8], kv2[8];
        {
            float fp1[8], fp2[8], lf1[8], lf2[8];
            UNPK8(qv1, q1); UNPK8(qv2, q2); UNPK8(fp1, f1); UNPK8(fp2, f2);
#pragma unroll
            for (int i = 0; i < 8; ++i) {
                const float ff1 = lb1[i] + (1.f - lb1[i]) * sigmoidf_(fp1[i]), ff2 = lb2[i] + (1.f - lb2[i]) * sigmoidf_(fp2[i]);
                if (valid) { lf1[i] = __logf(ff1); lf2[i] = __logf(ff2); kv1[i] = 1.f - ff1; kv2[i] = 1.f - ff2; }
                else { lf1[i] = 0.f; lf2[i] = 0.f; kv1[i] = 0.f; kv2[i] = 0.f; qv1[i] = 0.f; qv2[i] = 0.f; }
            }
            LAS float* cr = (LAS float*)(L + LA_CUM) + row_l * 128;
            *(LAS f32x4*)(cr + c8 * 8) = (f32x4){lf1[0], lf1[1], lf1[2], lf1[3]}; *(LAS f32x4*)(cr + c8 * 8 + 4) = (f32x4){lf1[4], lf1[5], lf1[6], lf1[7]};
            *(LAS f32x4*)(cr + 64 + c8 * 8) = (f32x4){lf2[0], lf2[1], lf2[2], lf2[3]}; *(LAS f32x4*)(cr + 64 + c8 * 8 + 4) = (f32x4){lf2[4], lf2[5], lf2[6], lf2[7]};
        }
        __syncthreads();
        {
            const int d = tid & 127, sg = tid >> 7; LAS float* c = (LAS float*)(L + LA_CUM) + (sg * 16) * 128 + d; float run = 0.f;
#pragma unroll
            for (int rr = 0; rr < 16; ++rr) { run += c[rr * 128]; c[rr * 128] = run; }
        }
        __syncthreads();
        {
            const LAS float* C = (const LAS float*)(L + LA_CUM);
            const int sg = row_l >> 4;
            float qi[16], ki[16], qd[16], kd[16];
#pragma unroll
            for (int i = 0; i < 16; ++i) {
                const int d = (i < 8) ? c8 * 8 + i : 64 + c8 * 8 + (i - 8);
                const float t0 = C[15 * 128 + d], t1 = C[31 * 128 + d], t2 = C[47 * 128 + d], t3 = C[63 * 128 + d];
                float cum = C[row_l * 128 + d];
                cum += (sg > 0 ? t0 : 0.f) + (sg > 1 ? t1 : 0.f) + (sg > 2 ? t2 : 0.f);
                const float cmid = t0 + t1, total = (t0 + t1) + (t2 + t3);
                const float q = (i < 8) ? qv1[i & 7] : qv2[i & 7], k = (i < 8) ? kv1[i & 7] : kv2[i & 7];
                qi[i] = q * __expf(fminf(cum - cmid, 80.f)); ki[i] = k * __expf(fminf(cmid - cum, 80.f));
                qd[i] = q * __expf(cum); kd[i] = k * __expf(total - cum);
                if (row_l == 0) *(LAS float*)(L + 70656 + d * 4) = __expf(total);
            }
            u32x4 w1, w2;
            PK8(w1, qi); { const float* sp = qi + 8; PK8(w2, sp); }
            *(LAS u32x4*)(L + LA_QS + row_l * 272 + c8 * 16) = w1; *(LAS u32x4*)(L + LA_QS + row_l * 272 + 128 + c8 * 16) = w2;
            PK8(w1, ki); { const float* sp = ki + 8; PK8(w2, sp); }
            *(LAS u32x4*)(L + LA_KS + row_l * 272 + c8 * 16) = w1; *(LAS u32x4*)(L + LA_KS + row_l * 272 + 128 + c8 * 16) = w2;
            PK8(w1, qd); { const float* sp = qd + 8; PK8(w2, sp); }
            *(LAS u32x4*)(L + LA_QD + row_l * 272 + c8 * 16) = w1; *(LAS u32x4*)(L + LA_QD + row_l * 272 + 128 + c8 * 16) = w2;
#pragma unroll
            for (int i = 0; i < 8; ++i) {
                *(LAS bf16_t*)(L + LA_KT + kt_off(c8 * 8 + i, row_l)) = f2bf(kd[i]);
                *(LAS bf16_t*)(L + LA_KT + kt_off(64 + c8 * 8 + i, row_l)) = f2bf(kd[8 + i]);
            }
        }
        __syncthreads();
        {
            unsigned char* dst = a.ws + HGT_OFF + (size_t)it * HGT_ITEM;
#pragma unroll
            for (int k = 0; k < 9; ++k) { const int idx = tid + k * NTHREADS; if (idx < 4448) *(u32x4*)(dst + (size_t)idx * 16) = *(const LAS u32x4*)(L + idx * 16); }
        }
        __syncthreads();
    }
}

__device__ __forceinline__ void hgrn_unit(const Args& a, LAS unsigned char* L, int unit, bool dry) {
    int tid_ = threadIdx.x; asm volatile("" : "+v"(tid_));
    const int tid = tid_, b = unit >> 4, h = (unit >> 2) & 3, sl = unit & 3;
    const bf16_t* Z = (const bf16_t*)(a.ws + Z_OFF); bf16_t* OB = (bf16_t*)(a.ws + HN_OFF);
    const int vrow = (tid >> 2) & 63, vp = tid & 3;
    f32x4 st[2] = {{0.f, 0.f, 0.f, 0.f}, {0.f, 0.f, 0.f, 0.f}};
    for (int i = tid; i < 32 * 272 / 4; i += NTHREADS) ((LAS unsigned*)(L + LA_ST))[i] = 0u;
    u32x4 pfA[9], pfB[9], vvA, vvB;
#define HG_LOAD(PF, VV, n_) do { const unsigned char* src_ = a.ws + HGT_OFF + (size_t)(((b * NCH + (n_)) * 4) + h) * HGT_ITEM; \
        _Pragma("unroll") for (int k = 0; k < 9; ++k) { const int idx = tid + k * NTHREADS; PF[k] = (u32x4){0u, 0u, 0u, 0u}; if (idx < 4448) PF[k] = *(const u32x4*)(src_ + (size_t)idx * 16); } \
        VV = (u32x4){0u, 0u, 0u, 0u}; \
        if (tid < 256) { const int rv = chunk_row(b, (n_), vrow); if (rv >= 0) VV = *(const u32x4*)(Z + (size_t)rv * IN_CD + 1536 + h * 128 + sl * 32 + vp * 8); } } while (0)
#define HG_STEP(PF, VV, n_) do { \
        _Pragma("unroll") for (int k = 0; k < 9; ++k) { const int idx = tid + k * NTHREADS; \
            if (idx < 4416) *(LAS u32x4*)(L + idx * 16) = PF[k]; \
            else if (idx < 4448) *(LAS u32x4*)(L + LA_DEC + (idx - 4416) * 16) = PF[k]; } \
        if (tid < 256) { const unsigned va[4] = {VV.x, VV.y, VV.z, VV.w}; \
            _Pragma("unroll") for (int i = 0; i < 8; ++i) *(LAS bf16_t*)(L + LA_VT + (vp * 8 + i) * 144 + vrow * 2) = (bf16_t)((i & 1) ? (va[i >> 1] >> 16) : (va[i >> 1] & 0xffffu)); } \
        if ((n_) + 2 < NCH) HG_LOAD(PF, VV, (n_) + 2); \
        LBAR(); \
        la_core<true>(L, st, 0.f, OB, 512, h * 128 + sl * 32, b, (n_), dry); \
        LBAR(); } while (0)
    HG_LOAD(pfA, vvA, 0);
    HG_LOAD(pfB, vvB, 1);
    for (int n = 0; n < NCH; n += 2) {
        HG_STEP(pfA, vvA, n);
        if (n + 1 < NCH) HG_STEP(pfB, vvB, n + 1);
    }
#undef HG_STEP
#undef HG_LOAD
}

constexpr int LR_XB = 0, LR_XC = 32768, LR_XA = 49152, LR_RG = 58368, RGS = 68  , LR_SEG = LR_RG + 64 * RGS * 4  , LR_END = LR_SEG + 16 * 64 * 4;
__device__ __forceinline__ void lru_unit(const Args& a, LAS unsigned char* L, int unit, bool dry) {
    int tid_ = threadIdx.x; asm volatile("" : "+v"(tid_));
    const int tid = tid_, lane = tid & 63, w = __builtin_amdgcn_readfirstlane(tid >> 6), fr = lane & 15, fq = lane >> 4;
    const int b = unit >> 5, cb = (unit >> 1) & 15, hf = unit & 1;
    bf16_t* Z = (bf16_t*)(a.ws + Z_OFF);
    const int row_l = tid >> 3, c8 = tid & 7;
    const int oc = cb * 64 + hf * 32 + c8 * 4;
    LAS float* XB = (LAS float*)(L + LR_XB); LAS float* XC = (LAS float*)(L + LR_XC); LAS float* RG = (LAS float*)(L + LR_RG);
    float cw[4][8], cbs[8];
#pragma unroll
    for (int i = 0; i < 8; ++i) { const int c = cb * 64 + c8 * 8 + i; cbs[i] = a.in[11][c];
#pragma unroll
        for (int ww = 0; ww < 4; ++ww) cw[ww][i] = a.in[10][ww * 1024 + c]; }
    const int mg = w >> 1, ct = w & 1;
    const int gch = cb * 64 + hf * 32 + ct * 16 + 4 * fq;
    const bf16_t* WG = (const bf16_t*)(a.ws + LRUW_OFF) + (size_t)cb * 128 * 64;
    const int nr_ = hf * 32 + ct * 16 + fr;
    const bf16x8 wr0 = *(const bf16x8*)(WG + nr_ * 64 + fq * 8), wr1 = *(const bf16x8*)(WG + nr_ * 64 + 32 + fq * 8);
    const bf16x8 wi0 = *(const bf16x8*)(WG + (64 + nr_) * 64 + fq * 8), wi1 = *(const bf16x8*)(WG + (64 + nr_) * 64 + 32 + fq * 8);
    const f32x4 bra = *(const f32x4*)(a.in[6] + gch), bia = *(const f32x4*)(a.in[8] + gch);
    float sp[4];
#pragma unroll
    for (int i = 0; i < 4; ++i) sp[i] = log1pf(expf(-a.in[9][gch + i]));
    float hstate = 0.f;
    for (int i = tid; i < 64 * 64; i += NTHREADS) XB[64 * 64 + i] = 0.f;
    u32x4 xbv; u32x2 bgv;
#define LRU_LOAD(n_) do { const int r_ = chunk_row(b, (n_), row_l); \
        if (r_ >= 0) { const bf16_t* zr = Z + (size_t)r_ * IN_AB; xbv = *(const u32x4*)(zr + 2048 + cb * 64 + c8 * 8); bgv = *(const u32x2*)(zr + 4096 + oc); } \
        else { xbv = (u32x4){0u, 0u, 0u, 0u}; bgv = (u32x2){0u, 0u}; } } while (0)
    LRU_LOAD(0);
    for (int n = 0; n < NCH; ++n) {
        const int cur = (n & 1) * 4096, prv = 4096 - cur;
        {
            float xf[8]; UNPK8(xf, xbv);
            *(LAS f32x4*)(XB + cur + row_l * 64 + c8 * 8) = (f32x4){xf[0], xf[1], xf[2], xf[3]}; *(LAS f32x4*)(XB + cur + row_l * 64 + c8 * 8 + 4) = (f32x4){xf[4], xf[5], xf[6], xf[7]};
        }
        const u32x2 bgc = bgv;
        const int grow = chunk_row(b, n, row_l);
        if (n + 1 < NCH) LRU_LOAD(n + 1);
        LBAR();
        {
            float xc[8];
#pragma unroll
            for (int i = 0; i < 8; ++i) xc[i] = cbs[i];
#pragma unroll
            for (int ww = 0; ww < 4; ++ww) {
                const int rr = row_l + ww - 3;
                const LAS float* src = rr >= 0 ? XB + cur + rr * 64 + c8 * 8 : XB + prv + (64 + rr) * 64 + c8 * 8;
                const f32x4 x0 = *(const LAS f32x4*)src, x1 = *(const LAS f32x4*)(src + 4);
                xc[0] += cw[ww][0] * x0[0]; xc[1] += cw[ww][1] * x0[1]; xc[2] += cw[ww][2] * x0[2]; xc[3] += cw[ww][3] * x0[3];
                xc[4] += cw[ww][4] * x1[0]; xc[5] += cw[ww][5] * x1[1]; xc[6] += cw[ww][6] * x1[2]; xc[7] += cw[ww][7] * x1[3];
            }
            *(LAS f32x4*)(XC + row_l * 64 + c8 * 8) = (f32x4){xc[0], xc[1], xc[2], xc[3]}; *(LAS f32x4*)(XC + row_l * 64 + c8 * 8 + 4) = (f32x4){xc[4], xc[5], xc[6], xc[7]};
            u32x4 o; PK8(o, xc);
            *(LAS u32x4*)(L + LR_XA + row_l * 144 + c8 * 16) = o;
        }
        LBAR();
        {
            const bf16x8 x0 = ldsfrag(L + LR_XA + (mg * 16 + fr) * 144 + fq * 16), x1 = ldsfrag(L + LR_XA + (mg * 16 + fr) * 144 + 64 + fq * 16);
            f32x4 ra = {0.f, 0.f, 0.f, 0.f}, ia = {0.f, 0.f, 0.f, 0.f};
            ra = MFMA16(wr0, x0, ra); ia = MFMA16(wi0, x0, ia); ra = MFMA16(wr1, x1, ra); ia = MFMA16(wi1, x1, ia);
            const int jr = mg * 16 + fr;
            const f32x4 x4 = *(const LAS f32x4*)(XC + jr * 64 + hf * 32 + ct * 16 + 4 * fq);
            const bool rvalid = (n > 0) || (jr >= 48);
            f32x4 a4, b4;
#pragma unroll
            for (int i = 0; i < 4; ++i) {
                const float r = sigmoidf_(ra[i] + bra[i]), ig = sigmoidf_(ia[i] + bia[i]);
                const float log_a = -8.f * r * sp[i], x2 = 2.f * log_a, e2 = __expf(x2);
                const float ser = -x2 * (1.f + x2 * (0.5f + x2 * (0.16666667f + x2 * (0.041666668f + x2 * 0.0083333338f))));
                const float om = x2 > -0.25f ? ser : 1.f - e2;
                a4[i] = rvalid ? __expf(log_a) : 1.f; b4[i] = rvalid ? sqrtf(fmaxf(om, 0.f)) * (ig * x4[i]) : 0.f;
            }
            *(LAS f32x4*)(RG + jr * RGS + ct * 16 + 4 * fq) = a4; *(LAS f32x4*)(RG + jr * RGS + 32 + ct * 16 + 4 * fq) = b4;
        }
        LBAR();
        {
            LAS float* SEG = (LAS float*)(L + LR_SEG);
            const int sg = w * 2 + (lane >> 5), ch = lane & 31;
            float sa[4], sb[4];
            {
                float P = 1.f, hh = 0.f;
#pragma unroll
                for (int i = 0; i < 4; ++i) { sa[i] = RG[(sg * 4 + i) * RGS + ch]; sb[i] = RG[(sg * 4 + i) * RGS + 32 + ch]; hh = sa[i] * hh + sb[i]; P *= sa[i]; }
                SEG[sg * 64 + ch] = P; SEG[sg * 64 + 32 + ch] = hh;
            }
            LBAR();
            float c = hstate, mine = 0.f;
#pragma unroll
            for (int s2 = 0; s2 < 16; ++s2) { mine = (s2 == sg) ? c : mine; c = SEG[s2 * 64 + ch] * c + SEG[s2 * 64 + 32 + ch]; }
            hstate = c;
            float hh = mine;
#pragma unroll
            for (int i = 0; i < 4; ++i) { hh = sa[i] * hh + sb[i]; RG[(sg * 4 + i) * RGS + 32 + ch] = hh; }
        }
        LBAR();
        if (grow >= 0 && !dry) {
            const f32x4 h4 = *(const LAS f32x4*)(RG + row_l * RGS + 32 + c8 * 4);
            u32x2 o; o.x = cvt_pk_bf16(gelu_tanh(bf_lo(bgc.x)) * h4[0], gelu_tanh(bf_hi(bgc.x)) * h4[1]); o.y = cvt_pk_bf16(gelu_tanh(bf_lo(bgc.y)) * h4[2], gelu_tanh(bf_hi(bgc.y)) * h4[3]);
            if (grow < RM) *(u32x2*)(Z + (size_t)grow * IN_AB + 4096 + oc) = o;
            else if (b == 0) *(u32x2*)((bf16_t*)(a.ws + YAB_OFF) + (size_t)(grow - RM) * 2048 + 1024 + oc) = o;
        }
    }
    LBAR();
#undef LRU_LOAD
}

constexpr int S5_ROWS = 128, S5_NIT = 33;
constexpr int S5_BU = 0, BUS = 132  , S5_HS = S5_ROWS * BUS * 4, S5_EX = S5_HS + S5_ROWS * 272  , S5_END = S5_EX + 8 * 128 * 4;
static_assert(S5_END <= LDS_BYTES - 16, "S5 lds");
__device__ __forceinline__ int sc_row(int b, int s, int j) { const int n = 2 * s - 1 + (j >> 6); return n < 0 ? -1 : chunk_row(b, n, j & 63); }
__device__ __forceinline__ void s5_unit(const Args& a, LAS unsigned char* L, int unit, bool dry) {
    int tid_ = threadIdx.x; asm volatile("" : "+v"(tid_));
    const int tid = tid_, lane = tid & 63, w = __builtin_amdgcn_readfirstlane(tid >> 6), fr = lane & 15, fq = lane >> 4;
    const int b = unit >> 5, g = unit & 31;
    bf16_t* Z = (bf16_t*)(a.ws + Z_OFF);
    const bf16_t* BB = (const bf16_t*)(a.ws + S5BB_OFF) + (size_t)g * 128 * 32;
    const bf16_t* CM = (const bf16_t*)(a.ws + S5CM_OFF) + (size_t)g * 16 * 128;
    const float* AB = (const float*)(a.ws + S5AB_OFF) + (size_t)g * 128;
    const bf16x8 bbf = *(const bf16x8*)(BB + (w * 16 + fr) * 32 + fq * 8);
    bf16x8 cmf[4];
#pragma unroll
    for (int kk = 0; kk < 4; ++kk) cmf[kk] = *(const bf16x8*)(CM + fr * 128 + kk * 32 + fq * 8);
    const float ar = AB[2 * lane], ai = AB[2 * lane + 1];
    const f32x4 dv = *(const f32x4*)(a.in[20] + g * 16 + 4 * fq);
    float hr = 0.f, hi = 0.f;
    LAS float* BU = (LAS float*)(L + S5_BU); LAS float* EX = (LAS float*)(L + S5_EX);
    float p16r, p16i;
    { float pr = ar, pi = ai;
#pragma unroll
      for (int i = 0; i < 4; ++i) { const float nr = pr * pr - pi * pi, ni = 2.f * pr * pi; pr = nr; pi = ni; }
      p16r = pr; p16i = pi; }
    bf16x8 uf[8]; u32x2 uvn = {0u, 0u};
#define S5_LOAD(s_) do { _Pragma("unroll") for (int m = 0; m < 8; ++m) { const int r_ = sc_row(b, (s_), m * 16 + fr); \
            uf[m] = (bf16x8){0, 0, 0, 0, 0, 0, 0, 0}; \
            if (r_ >= 0 && fq < 2) uf[m] = *(const bf16x8*)(Z + (size_t)r_ * IN_CD + g * 16 + fq * 8); } \
        { const int r2_ = sc_row(b, (s_), w * 16 + fr); uvn = (u32x2){0u, 0u}; if (r2_ >= 0) uvn = *(const u32x2*)(Z + (size_t)r2_ * IN_CD + g * 16 + 4 * fq); } } while (0)
    S5_LOAD(0);
    for (int sI = 0; sI < S5_NIT; ++sI) {
#pragma unroll
        for (int m = 0; m < 8; ++m) { f32x4 acc = {0.f, 0.f, 0.f, 0.f}; acc = MFMA16(bbf, uf[m], acc);
            *(LAS f32x4*)(BU + (m * 16 + fr) * BUS + w * 16 + 4 * fq) = acc; }
        const u32x2 uv = uvn;
        if (sI + 1 < S5_NIT) S5_LOAD(sI + 1);
        LBAR();
        {
            float cr = 0.f, ci = 0.f;
#pragma unroll
            for (int i = 0; i < 16; ++i) {
                const float br = BU[(16 * w + i) * BUS + lane], bi = BU[(16 * w + i) * BUS + 64 + lane];
                const float nr = ar * cr - ai * ci + br, ni = ar * ci + ai * cr + bi;
                cr = nr; ci = ni;
            }
            EX[w * 128 + lane] = cr; EX[w * 128 + 64 + lane] = ci;
        }
        LBAR();
        {
            float cr = hr, ci = hi, mr = 0.f, mi = 0.f;
#pragma unroll
            for (int ww = 0; ww < 8; ++ww) {
                if (ww == w) { mr = cr; mi = ci; }
                const float er = EX[ww * 128 + lane], ei = EX[ww * 128 + 64 + lane];
                const float nr = p16r * cr - p16i * ci + er, ni = p16r * ci + p16i * cr + ei;
                cr = nr; ci = ni;
            }
            hr = cr; hi = ci;
#pragma unroll
            for (int i = 0; i < 16; ++i) {
                const float br = BU[(16 * w + i) * BUS + lane], bi = BU[(16 * w + i) * BUS + 64 + lane];
                const float nr = ar * mr - ai * mi + br, ni = ar * mi + ai * mr + bi;
                mr = nr; mi = ni;
                *(LAS bf16_t*)(L + S5_HS + (16 * w + i) * 272 + lane * 2) = f2bf(mr);
                *(LAS bf16_t*)(L + S5_HS + (16 * w + i) * 272 + 128 + lane * 2) = f2bf(mi);
            }
        }
        LBAR();
        {
            f32x4 acc = {0.f, 0.f, 0.f, 0.f};
#pragma unroll
            for (int kk = 0; kk < 4; ++kk) acc = MFMA16(cmf[kk], ldsfrag(L + S5_HS + (w * 16 + fr) * 272 + kk * 64 + fq * 16), acc);
            const int r = sc_row(b, sI, w * 16 + fr);
            if (r >= 0 && !dry) {
                bf16_t* up = Z + (size_t)r * IN_CD + g * 16 + 4 * fq;
                const float y0 = gelu_tanh(acc[0] + dv[0] * bf_lo(uv.x)), y1 = gelu_tanh(acc[1] + dv[1] * bf_hi(uv.x));
                const float y2 = gelu_tanh(acc[2] + dv[2] * bf_lo(uv.y)), y3 = gelu_tanh(acc[3] + dv[3] * bf_hi(uv.y));
                u32x2 o; o.x = cvt_pk_bf16(y0, y1); o.y = cvt_pk_bf16(y2, y3);
                if (r < RM) *(u32x2*)up = o; else if (b == 0) *(u32x2*)((bf16_t*)(a.ws + YM_OFF) + (size_t)(r - RM) * 512 + g * 16 + 4 * fq) = o;
            }
        }
    }
    LBAR();
#undef S5_LOAD
}

__device__ __forceinline__ void phase_ret_post(const Args& a) {
    int tid_ = threadIdx.x; asm volatile("" : "+v"(tid_));
    const int tid = tid_, lane = tid & 63, wave = tid >> 6;
    const int gw = blockIdx.x * 8 + wave, NGW = gridDim.x * 8;
    bf16_t* Z = (bf16_t*)(a.ws + Z_OFF); const bf16_t* OB = (const bf16_t*)(a.ws + HN_OFF); const float* gn = a.in[4];
    for (int row = gw; row < RVALID; row += NGW) {
        u32x2 ov[4], gv[4]; f32x4 gg[4];
#pragma unroll
        for (int h = 0; h < 4; ++h) {
            ov[h] = *(const u32x2*)(OB + (size_t)row * DM + h * 256 + 4 * lane);
            gv[h] = *(const u32x2*)(Z + (size_t)row * IN_AB + 3072 + h * 256 + 4 * lane);
            gg[h] = *(const f32x4*)(gn + h * 256 + 4 * lane);
        }
#pragma unroll
        for (int h = 0; h < 4; ++h) {
            float o0 = bf_lo(ov[h].x), o1 = bf_hi(ov[h].x), o2 = bf_lo(ov[h].y), o3 = bf_hi(ov[h].y);
            const float mean = wave_sum((o0 + o1) + (o2 + o3)) * (1.f / 256.f);
            o0 -= mean; o1 -= mean; o2 -= mean; o3 -= mean;
            const float inv = rsqrtf(wave_sum(o0 * o0 + o1 * o1 + o2 * o2 + o3 * o3) * (1.f / 256.f) + EPS);
            u32x2 y; y.x = cvt_pk_bf16(o0 * inv * gg[h][0] * silu_(bf_lo(gv[h].x)), o1 * inv * gg[h][1] * silu_(bf_hi(gv[h].x)));
            y.y = cvt_pk_bf16(o2 * inv * gg[h][2] * silu_(bf_lo(gv[h].y)), o3 * inv * gg[h][3] * silu_(bf_hi(gv[h].y)));
            if (row < RM) *(u32x2*)(Z + (size_t)row * IN_AB + 3072 + h * 256 + 4 * lane) = y;
            else *(u32x2*)((bf16_t*)(a.ws + YAB_OFF) + (size_t)(row - RM) * 2048 + h * 256 + 4 * lane) = y;
        }
    }
}
__device__ __forceinline__ void phase_hg_post(const Args& a) {
    int tid_ = threadIdx.x; asm volatile("" : "+v"(tid_));
    const int tid = tid_, lane = tid & 63, wave = tid >> 6;
    const int gw = blockIdx.x * 8 + wave, NGW = gridDim.x * 8;
    bf16_t* Z = (bf16_t*)(a.ws + Z_OFF); const bf16_t* OB = (const bf16_t*)(a.ws + HN_OFF); const float* gn = a.in[24];
    for (int row = gw; row < RVALID; row += NGW) {
        unsigned ov[4], gv[4]; f32x2 gg[4];
#pragma unroll
        for (int h = 0; h < 4; ++h) {
            ov[h] = *(const unsigned*)(OB + (size_t)row * 512 + h * 128 + 2 * lane);
            gv[h] = *(const unsigned*)(Z + (size_t)row * IN_CD + 2048 + h * 128 + 2 * lane);
            gg[h] = *(const f32x2*)(gn + h * 128 + 2 * lane);
        }
#pragma unroll
        for (int h = 0; h < 4; ++h) {
            const float o0 = bf_lo(ov[h]), o1 = bf_hi(ov[h]);
            const float inv = rsqrtf(wave_sum(o0 * o0 + o1 * o1) * (1.f / 128.f) + EPS);
            const unsigned yv = cvt_pk_bf16(o0 * inv * gg[h][0] * silu_(bf_lo(gv[h])), o1 * inv * gg[h][1] * silu_(bf_hi(gv[h])));
            if (row < RM) *(unsigned*)(Z + (size_t)row * IN_CD + 2048 + h * 128 + 2 * lane) = yv;
            else *(unsigned*)((bf16_t*)(a.ws + YCD_OFF) + (size_t)(row - RM) * 1024 + 512 + h * 128 + 2 * lane) = yv;
        }
    }
}

#define XB_TMO      128
#define XB_XCNT(j)  (256  + 64 * (j))
#define XB_XSUB(j)  (1280 + 64 * (j))
#define XB_XGEN(j)  (2304 + 64 * (j))
#define XB_TOP      3328
#define XB_TOPGEN   3392
#define XCD_BAR_WORDS 3456
#define XB_SPIN_CAP (1u << 18)

__device__ __forceinline__ unsigned xb_ld(unsigned* p)              { return __hip_atomic_load(p, __ATOMIC_RELAXED, __HIP_MEMORY_SCOPE_AGENT); }
__device__ __forceinline__ unsigned xb_add(unsigned* p, unsigned v) { return __hip_atomic_fetch_add(p, v, __ATOMIC_RELAXED, __HIP_MEMORY_SCOPE_AGENT); }
__device__ __forceinline__ unsigned xb_xcc_id() { return (unsigned)__builtin_amdgcn_s_getreg((3 << 11) | 20) & 0xFu; }
#define XB_SPIN(cond, bar) do { unsigned _sp = 0; while (cond) { __builtin_amdgcn_s_sleep(1); \
    if ((++_sp & 255u) == 0u) { if (xb_ld(&(bar)[XB_TMO])) break; if (_sp > XB_SPIN_CAP) { atomicAdd(&(bar)[XB_TMO], 1u); break; } } } } while (0)

struct XcdBarrier {
    unsigned* bar; unsigned x;
    volatile LAS unsigned* st;
};

__device__ __forceinline__ XcdBarrier xcd_barrier_post(unsigned* bar, volatile LAS unsigned* st) {
    XcdBarrier b; b.bar = bar; b.x = xb_xcc_id(); b.st = st;
    if (threadIdx.x == 0) (void)xb_add(&bar[XB_XCNT(b.x)], 1u);
    return b;
}
__device__ __forceinline__ void xcd_barrier_complete(unsigned* bar, unsigned x, unsigned& nloc, unsigned& nx) {
    const unsigned G = gridDim.x * gridDim.y * gridDim.z;
    unsigned sum, cnt, mine, sp = 0u;
    for (;;) {
        sum = 0u; cnt = 0u; mine = 0u;
#pragma unroll
        for (unsigned j = 0; j < 16; ++j) { const unsigned c = xb_ld(&bar[XB_XCNT(j)]); sum += c; cnt += (c > 0u) ? 1u : 0u; mine = (j == x) ? c : mine; }
        if (sum == G) break;
        __builtin_amdgcn_s_sleep(1);
        if ((++sp & 255u) == 0u) { if (xb_ld(&bar[XB_TMO])) break; if (sp > XB_SPIN_CAP) { atomicAdd(&bar[XB_TMO], 1u); break; } }
    }
    nloc = mine > 0u ? mine : 1u; nx = cnt > 0u ? cnt : 1u;
}

__device__ __forceinline__ void xcd_barrier(const XcdBarrier& b) {
    asm volatile("s_waitcnt vmcnt(0)" ::: "memory");
    __syncthreads();
    if (threadIdx.x == 0) {
        unsigned* bar = b.bar;
        __builtin_amdgcn_s_waitcnt(0);
        unsigned nloc = b.st[0], nx = b.st[1];
        if (nloc == 0u) { xcd_barrier_complete(bar, b.x, nloc, nx); b.st[0] = nloc; b.st[1] = nx; }
        const unsigned old = xb_add(&bar[XB_XSUB(b.x)], 1u);
        const unsigned gen = old / nloc;
        if (old + 1u == (gen + 1u) * nloc) {
            __builtin_amdgcn_fence(__ATOMIC_RELEASE, "agent");
            asm volatile("s_waitcnt vmcnt(0)" ::: "memory");
            const unsigned og = xb_add(&bar[XB_TOP], 1u);
            const unsigned tg = og / nx;
            if (og + 1u == (tg + 1u) * nx) xb_add(&bar[XB_TOPGEN], 1u);
            else XB_SPIN(xb_ld(&bar[XB_TOPGEN]) == tg, bar);
            __builtin_amdgcn_fence(__ATOMIC_ACQUIRE, "agent");
            xb_add(&bar[XB_XGEN(b.x)], 1u);
            asm volatile("s_waitcnt vmcnt(0)" ::: "memory");
        } else {
            XB_SPIN(xb_ld(&bar[XB_XGEN(b.x)]) == gen, bar);
            __builtin_amdgcn_fence(__ATOMIC_ACQUIRE, "agent");
            asm volatile("s_waitcnt vmcnt(0)" ::: "memory");
        }
    }
    __syncthreads();
}


#ifndef DBG_STOP
#define DBG_STOP 0
#endif
__device__ __forceinline__ void dbg_digest(const Args& a) {
    const size_t gt = (size_t)blockIdx.x * NTHREADS + threadIdx.x, NGT = (size_t)gridDim.x * NTHREADS;
    const bf16_t* zb = (const bf16_t*)(a.ws + Z_OFF);
    const size_t NE = ((size_t)R * 5120 + (size_t)R * 1024);
    const size_t ON = (size_t)RM * DM;
    for (size_t i = gt; i < ON; i += NGT) {
        float s = 0.f;
        for (size_t k = i; k < NE; k += ON) s += __uint_as_float((unsigned)zb[k] << 16);
        a.out[i] = a.out[i] * 1e-3f + s;
    }
}
#ifndef DBG_REP34
#define DBG_REP34 0
#endif
#ifndef DBG_REPG
#define DBG_REPG 0
#endif
#ifndef DBG_SYNC2
#define DBG_SYNC2 0
#endif
#ifndef DBG_TIME
#define DBG_TIME 0
#endif
#define GSYNC() xcd_barrier(xbar)
#define DBG_CHECK(k) do { if (DBG_STOP == (k)) { grid.sync(); dbg_digest(a); return; } \
    if (DBG_TIME) { if ((k) == DBG_TIME - 1) dbg_t0 = __builtin_amdgcn_s_memrealtime(); if ((k) == DBG_TIME) dbg_t1 = __builtin_amdgcn_s_memrealtime(); } } while (0)
__global__ void __launch_bounds__(NTHREADS, 2) fwd_megakernel(Args a) {
    extern __shared__ __attribute__((aligned(16))) unsigned char lds_raw[];
    LAS unsigned char* L = (LAS unsigned char*)lds_raw;
    cg::grid_group grid = cg::this_grid();
    unsigned char* ws = a.ws;
    const int G = gridDim.x, bx = blockIdx.x;
    bf16_t* Zb = (bf16_t*)(ws + Z_OFF); bf16_t* HNb = (bf16_t*)(ws + HN_OFF); float* ssq = (float*)(ws + SSQ_OFF);
    bf16_t* YABb = (bf16_t*)(ws + YAB_OFF); bf16_t* YCDb = (bf16_t*)(ws + YCD_OFF); bf16_t* YMb = (bf16_t*)(ws + YM_OFF);
    float* hmeta = (float*)(ws + HMETA_OFF);
    const float* ng = a.in[26];
    const bool fusedres = (G == 256);

    if (threadIdx.x < 4) ((LAS unsigned*)(L + LDS_BYTES - 16))[threadIdx.x] = 0u;
    __syncthreads();
    const XcdBarrier xbar = xcd_barrier_post((unsigned*)(ws + BAR_OFF), (volatile LAS unsigned*)(L + LDS_BYTES - 16));
    if (a.never) grid.sync();
    phase_prologue(a, L, !fusedres);
    GSYNC();

#define GEMM_PHASE(MODE, Ap, lda_, Wp, N_, K_, Op, ldo_, Yp, ldy_, biasp, AMp, ldam_, OMp, ldom_, YMp, ldym_) do { \
        pg8::Gemm g{(Ap), (Wp), RM, (N_), (K_), (lda_)}; pg8::StaticOrder S; S.init(RM, (N_), G, bx); \
        pg8::Epi<MODE> E{(Op), (ldo_), nullptr, (Yp), (ldy_), (biasp)}; \
        pg8::gemm_phase(L, g, S, E); \
        meta_gemm<MODE, 4, ((K_) >= 1024 ? 4 : 2)>(L, (AMp), (ldam_), (Wp), (N_), (K_), (OMp), (ldom_), nullptr, (YMp), (ldym_), (biasp)); } while (0)
#define RES_PHASE(P, HIN, Ap, lda_, Wp, K_, AMp, ldam_, g1_, g2_) do { \
        pg8::Gemm g{(Ap), (Wp), RM, DM, (K_), (lda_)}; pg8::StaticOrder S; S.init(RM, DM, G, bx); \
        if (fusedres) { \
            float* x1 = (float*)(ws + XB_OFF + (size_t)((P) * 2) * XB_STRIDE); float* x2 = (float*)(ws + XB_OFF + (size_t)((P) * 2 + 1) * XB_STRIDE); \
            unsigned* c1 = (unsigned*)(ws + CNT_OFF) + ((P) * 2) * 80 * 32; unsigned* c2 = (unsigned*)(ws + CNT_OFF) + ((P) * 2 + 1) * 80 * 32; \
            pg8::EpiRes E{(HIN), a.out, (g1_), (g2_), HNb, x1, x2, c1, c2}; \
            pg8::gemm_phase(L, g, S, E); \
            meta_gemm<4, 1, ((K_) >= 2048 ? 8 : 4)>(L, (AMp), (ldam_), (Wp), DM, (K_), HNb + (size_t)RM * DM, DM, nullptr, nullptr, 0, nullptr, hmeta, (g1_), (g2_), x1 + 64 * 256 * 4, x2 + 64 * 256 * 4, c1 + 64 * 32, c2 + 64 * 32); \
            GSYNC(); \
        } else { \
            pg8::Epi<1> E{HNb, DM, ssq, nullptr, 0, nullptr}; \
            pg8::gemm_phase(L, g, S, E); \
            meta_gemm<1, 4, 4>(L, (AMp), (ldam_), (Wp), DM, (K_), HNb + (size_t)RM * DM, DM, ssq + (size_t)RM * 16, nullptr, 0, nullptr); \
            GSYNC(); \
            phase_resnorm(a, (g1_), (g2_)); \
            GSYNC(); \
        } } while (0)

    {
        const bf16_t* W = (const bf16_t*)(ws + W_INAB);
        GEMM_PHASE(0, HNb, DM, W, IN_AB, DM, Zb, IN_AB, nullptr, 0, nullptr, HNb + (size_t)RM * DM, DM, Zb + (size_t)RM * IN_AB, IN_AB, nullptr, 0);
    }
    GSYNC();
    for (int u = bx; u < 128 + 128; u += G) { if (u < 128) retention_unit(a, L, u, false); else lru_unit(a, L, u - 128, false); }
    GSYNC();
    phase_ret_post(a);
    GSYNC();
    {
        const bf16_t* W = (const bf16_t*)(ws + W_OUTAB);
        RES_PHASE(0, (fusedres ? a.in[0] : (const float*)a.out), Zb + 3072, IN_AB, W, 2048, YABb, 2048, ng + 1 * DM, ng + 2 * DM);
    }
    {
        const bf16_t* W = (const bf16_t*)(ws + W_W1_0);
        GEMM_PHASE(2, HNb, DM, W, FF, DM, Zb, FF, nullptr, 0, nullptr, HNb + (size_t)RM * DM, DM, Zb + (size_t)RM * FF, FF, nullptr, 0);
    }
    GSYNC();
    {
        const bf16_t* W = (const bf16_t*)(ws + W_W2_0);
        RES_PHASE(1, (const float*)a.out, Zb, FF, W, FF, Zb + (size_t)RM * FF, FF, ng + 3 * DM, ng + 4 * DM);
    }

    {
        const bf16_t* W = (const bf16_t*)(ws + W_INCD);
        GEMM_PHASE(0, HNb, DM, W, IN_CD, DM, Zb, IN_CD, nullptr, 0, nullptr, HNb + (size_t)RM * DM, DM, Zb + (size_t)RM * IN_CD, IN_CD, nullptr, 0);
    }
    GSYNC();
    hgrn_prepass(a, L);
    GSYNC();
    for (int u = bx; u < 64 + 128; u += G) { if (u < 64) hgrn_unit(a, L, u, false); else s5_unit(a, L, u - 64, false); }
    if (G == 256) { if (bx >= 192) weight_convert(a, L, WC_C5, WC_C9, bx - 192, 64); }
    else weight_convert(a, L, WC_C5, WC_C9, bx, G);
    GSYNC();
    phase_hg_post(a);
    {
        const bf16_t* W = (const bf16_t*)(ws + W_GLU);
        GEMM_PHASE(3, Zb, IN_CD, W, 512, 512, Zb + 1536, IN_CD, Zb, IN_CD, a.in[23], YMb, 512, YCDb, 1024, YMb, 512);
    }
    GSYNC();
    {
        const bf16_t* W = (const bf16_t*)(ws + W_OUTCD);
        RES_PHASE(2, (const float*)a.out, Zb + 1536, IN_CD, W, DM, YCDb, 1024, ng + 5 * DM, ng + 6 * DM);
    }
    {
        const bf16_t* W = (const bf16_t*)(ws + W_W1_1);
        GEMM_PHASE(2, HNb, DM, W, FF, DM, Zb, FF, nullptr, 0, nullptr, HNb + (size_t)RM * DM, DM, Zb + (size_t)RM * FF, FF, nullptr, 0);
    }
    GSYNC();
    {
        const bf16_t* W = (const bf16_t*)(ws + W_W2_1);
        pg8::Gemm g{Zb, W, RM, DM, FF, FF}; pg8::StaticOrder S; S.init(RM, DM, G, bx);
        if (fusedres) {
            float* x1 = (float*)(ws + XB_OFF + (size_t)6 * XB_STRIDE); unsigned* c1 = (unsigned*)(ws + CNT_OFF) + 6 * 80 * 32;
            pg8::EpiRes E{(const float*)a.out, a.out, ng + 7 * DM, nullptr, HNb, x1, x1, c1, c1};
            pg8::gemm_phase(L, g, S, E);
            meta_gemm<4, 1, 8>(L, Zb + (size_t)RM * FF, FF, W, DM, FF, HNb + (size_t)RM * DM, DM, nullptr, nullptr, 0, nullptr, hmeta, ng + 7 * DM, nullptr, x1 + 64 * 256 * 4, x1 + 64 * 256 * 4, c1 + 64 * 32, c1 + 64 * 32);
        } else {
            pg8::Epi<1> E{HNb, DM, ssq, nullptr, 0, nullptr};
            pg8::gemm_phase(L, g, S, E);
            meta_gemm<1, 4, 4>(L, Zb + (size_t)RM * FF, FF, W, DM, FF, HNb + (size_t)RM * DM, DM, ssq + (size_t)RM * 16, nullptr, 0, nullptr);
            GSYNC();
            phase_resnorm(a, ng + 7 * DM, nullptr);
        }
    }
#undef GEMM_PHASE
#undef RES_PHASE
}

extern "C" void kernel_launch(void* const* d_in, const int* in_sizes, int n_in, void* d_out, int out_size, void* d_ws, size_t ws_size, hipStream_t stream) {
    static int grid = 0;
    if (!grid) {
        int dev = 0, cus = 0, per_cu = 0;
        (void)hipGetDevice(&dev);
        (void)hipDeviceGetAttribute(&cus, hipDeviceAttributeMultiprocessorCount, dev);
        (void)hipFuncSetAttribute((const void*)fwd_megakernel, hipFuncAttributeMaxDynamicSharedMemorySize, LDS_BYTES);
        (void)hipOccupancyMaxActiveBlocksPerMultiprocessor(&per_cu, (const void*)fwd_megakernel, NTHREADS, LDS_BYTES);
        if (per_cu < 1) per_cu = 1;
        grid = cus * per_cu;
        if (n_in != 29 || ws_size < WS_END) fprintf(stderr, "kernel_launch: unexpected n_in %d / ws %zu (need %zu)\n", n_in, ws_size, (size_t)WS_END);
    }
    Args a{};
    for (int i = 0; i < 29; ++i) a.in[i] = (const float*)d_in[i];
    a.out = (float*)d_out; a.ws = (unsigned char*)d_ws; a.never = 0;
    (void)hipMemsetAsync((unsigned char*)d_ws + BAR_OFF, 0, (size_t)(XB_OFF - BAR_OFF), stream);
    void* args[] = {&a};
    hipError_t e = hipLaunchCooperativeKernel((void*)fwd_megakernel, dim3(grid), dim3(NTHREADS), args, LDS_BYTES, stream);
    if (e != hipSuccess) fprintf(stderr, "cooperative launch failed: %s (grid %d)\n", hipGetErrorString(e), grid);
}
```

```cpp
#include <hip/hip_runtime.h>
#include <hip/hip_cooperative_groups.h>
#include <cstdio>
#include <cstdint>
namespace cg = cooperative_groups;

#define LAS __attribute__((address_space(3)))
typedef unsigned short bf16_t;
typedef short bf16x8 __attribute__((ext_vector_type(8)));
typedef float f32x4 __attribute__((ext_vector_type(4)));
typedef float f32x2 __attribute__((ext_vector_type(2)));
typedef unsigned u32x4 __attribute__((ext_vector_type(4)));
typedef unsigned u32x2 __attribute__((ext_vector_type(2)));

constexpr int DM = 1024, NB = 4, SEQ = 4096, NMETA = 16, FF = 4096;
constexpr int RM = NB * SEQ;
constexpr int RMETA = RM;
constexpr int RVALID = RM + NMETA;
constexpr int R = RVALID;
constexpr int NCH = 65;
constexpr int IN_AB = 5120, IN_CD = 2560;
constexpr float EPS = 1e-6f;
constexpr int NTHREADS = 512;
constexpr int LDS_BYTES = 147456;

constexpr size_t W_INAB = 0;
constexpr size_t W_OUTAB = W_INAB + (size_t)5120 * 1024 * 2;
constexpr size_t W_W1_0 = W_OUTAB + (size_t)1024 * 2048 * 2;
constexpr size_t W_W2_0 = W_W1_0 + (size_t)4096 * 1024 * 2;
constexpr size_t W_INCD = W_W2_0 + (size_t)4096 * 1024 * 2;
constexpr size_t W_OUTCD = W_INCD + (size_t)2560 * 1024 * 2;
constexpr size_t W_GLU = W_OUTCD + (size_t)1024 * 1024 * 2;
constexpr size_t W_W1_1 = W_GLU + (size_t)512 * 512 * 2;
constexpr size_t W_W2_1 = W_W1_1 + (size_t)4096 * 1024 * 2;
constexpr size_t W_END = W_W2_1 + (size_t)4096 * 1024 * 2;
constexpr size_t Z_OFF = W_END;
constexpr size_t HN_OFF = Z_OFF + (size_t)R * 5120 * 2;
constexpr size_t SM_OFF = HN_OFF + (size_t)R * 1024 * 2;
constexpr size_t HMETA_OFF = SM_OFF;
constexpr size_t YAB_OFF = HMETA_OFF + (size_t)16 * 1024 * 4;
constexpr size_t YCD_OFF = YAB_OFF + (size_t)16 * 2048 * 2;
constexpr size_t YM_OFF = YCD_OFF + (size_t)16 * 1024 * 2;
constexpr size_t SSQ_OFF = YM_OFF + (size_t)16 * 512 * 2;
constexpr size_t LRUW_OFF = SSQ_OFF + (size_t)R * 16 * 4;
constexpr size_t S5BB_OFF = LRUW_OFF + (size_t)16 * 128 * 64 * 2;
constexpr size_t S5CM_OFF = S5BB_OFF + (size_t)32 * 128 * 32 * 2;
constexpr size_t S5AB_OFF = S5CM_OFF + (size_t)32 * 16 * 128 * 2;
constexpr size_t BAR_OFF = S5AB_OFF + (size_t)32 * 64 * 2 * 4;
constexpr size_t CNT_OFF = BAR_OFF + 16384;
constexpr size_t XB_OFF = CNT_OFF + (size_t)8 * 80 * 32 * 4;
constexpr size_t XB_STRIDE = (size_t)64 * 256 * 4 * 4 + 4096;
constexpr size_t WS_END = XB_OFF + 8 * XB_STRIDE;
static_assert(WS_END <= (size_t)268435456, "workspace map");

struct Args {
    const float* in[29];
    float* out;
    unsigned char* ws;
    long long never;
};

typedef __bf16 bf16x2_t __attribute__((ext_vector_type(2)));
__device__ __forceinline__ unsigned cvt_pk_bf16(float lo, float hi) { f32x2 v = {lo, hi}; bf16x2_t b = __builtin_convertvector(v, bf16x2_t); return __builtin_bit_cast(unsigned, b); }
__device__ __forceinline__ float bf_lo(unsigned u) { return __uint_as_float(u << 16); }
__device__ __forceinline__ float bf_hi(unsigned u) { return __uint_as_float(u & 0xffff0000u); }
__device__ __forceinline__ bf16_t f2bf(float f) { return (bf16_t)(cvt_pk_bf16(f, 0.f) & 0xffffu); }
__device__ __forceinline__ float wave_sum(float v) {
#pragma unroll
    for (int o = 1; o < 64; o <<= 1) v += __shfl_xor(v, o);
    return v;
}
__device__ __forceinline__ float sigmoidf_(float x) { return 1.f / (1.f + __expf(-x)); }
__device__ __forceinline__ float gelu_tanh(float x) {
    const float u = 0.7978845608028654f * (x + 0.044715f * x * x * x);
    const float e = __expf(2.f * u);
    const float t = 1.f - 2.f / (e + 1.f);
    return 0.5f * x * (1.f + t);
}
__device__ __forceinline__ float silu_(float x) { return x * sigmoidf_(x); }
__device__ __forceinline__ void sincos_big(float ang, float& s, float& c) {
    double t = (double)ang * 0.15915494309189535;
    t -= rint(t);
    const float fr = (float)t;
    s = __builtin_amdgcn_sinf(fr); c = __builtin_amdgcn_cosf(fr);
}
__device__ __forceinline__ void st_agent(float* p, float v) { __hip_atomic_store(p, v, __ATOMIC_RELAXED, __HIP_MEMORY_SCOPE_AGENT); }
__device__ __forceinline__ float ld_agent(const float* p) { return __hip_atomic_load(p, __ATOMIC_RELAXED, __HIP_MEMORY_SCOPE_AGENT); }
__device__ __forceinline__ void cnt_arrive_wait(unsigned* c, unsigned target) {
    __hip_atomic_fetch_add(c, 1u, __ATOMIC_RELAXED, __HIP_MEMORY_SCOPE_AGENT);
    unsigned sp = 0;
    while (__hip_atomic_load(c, __ATOMIC_RELAXED, __HIP_MEMORY_SCOPE_AGENT) < target) { __builtin_amdgcn_s_sleep(1); if (++sp > (1u << 22)) break; }
}
__device__ __forceinline__ float* hrow(const Args& a, int row) {
    return row < RM ? a.out + (size_t)row * DM : (float*)(a.ws + HMETA_OFF) + (size_t)(row - RM) * DM;
}
__device__ __forceinline__ int chunk_row(int b, int n, int j) {
    if (n == 0) return j >= 48 ? RMETA + (j - 48) : -1;
    return b * SEQ + (n - 1) * 64 + j;
}

namespace pg8 {
constexpr int BM = 256, BK = 64, HALF = 128, HTB = HALF * BK * 2, NXCD = 8, WGM = 8;
__device__ __forceinline__ int lds_byte(int r, int c) { const int st = (r >> 4) * 2 + (c >> 5), rr = r & 15, cc = c & 31, ob = rr * 64 + cc * 2; return st * 1024 + (ob ^ (((ob >> 9) & 1) << 5)); }
__device__ __forceinline__ void stage_rc(int b, int& Rr, int& C) { const int st = b / 1024, sb = b % 1024, swz = sb ^ (((sb >> 9) & 1) << 5); Rr = (st >> 1) * 16 + swz / 64; C = (st & 1) * 32 + (swz % 64) / 2; }
__device__ __forceinline__ int perm32(int rho) { const int n = rho >> 4, i = rho & 15; return 8 * (i >> 2) + 4 * n + (i & 3); }
struct Unit { int pm, pn; };
struct Gemm { const bf16_t* A; const bf16_t* Bt; int M, N, K, lda; };
struct StaticOrder {
    int nM, nN, nwg, G, c;
    __device__ void init(int M, int N, int G_, int c_) { nM = M / BM; nN = N / BM; nwg = nM * nN; G = G_; c = c_; }
    __device__ bool next(int i, Unit& u) const {
        const long L = (long)i * G + c; if (L >= nwg) return false;
        int wgid = (int)L; { const int q = nwg / NXCD, r = nwg % NXCD, xcd = wgid % NXCD, off = wgid / NXCD; wgid = (xcd < r ? xcd * (q + 1) : r * (q + 1) + (xcd - r) * q) + off; }
        const int nig = WGM * nN, gid = wgid / nig, fm = gid * WGM, gsz = (nM - fm) < WGM ? (nM - fm) : WGM;
        u.pm = fm + ((wgid % nig) % gsz); u.pn = (wgid % nig) / gsz; return true;
    }
};
template <class Epi>
__device__ __forceinline__ void gemm_phase(LAS unsigned char* lds, const Gemm g, const StaticOrder& S, const Epi& E) {
    int tid_ = threadIdx.x; asm volatile("" : "+v"(tid_));
    const int tid = tid_, wid = __builtin_amdgcn_readfirstlane(tid >> 6), lane = tid & 63, wr = wid >> 2, wc = wid & 3, fr = lane & 15, fq = lane >> 4;
    const int K = g.K, nt = K / BK, lda = g.lda;
    unsigned voffA[2], voffB[2];
#pragma unroll
    for (int i = 0; i < 2; ++i) { int Rr, C; stage_rc(tid * 16 + i * 8192, Rr, C); const int Rb = (Rr & ~31) + perm32(Rr & 31);
        voffA[i] = (unsigned)(Rr * lda + C) * 2u; voffB[i] = (unsigned)(Rb * K + C) * 2u; }
    const size_t kstep = (size_t)(BK * 2);
    const size_t hstepA = (size_t)HALF * lda * 2, hstepB = (size_t)HALF * K * 2;
    const size_t tstepA = 2 * hstepA, tstepB = 2 * hstepB;
    const unsigned ldsw = (unsigned)wid * 1024u;
    const int aoff = lds_byte(wr * 64 + fr, fq * 8), boff = lds_byte(wc * 32 + fr, fq * 8);
#define PG8_SA(b, h) (((b) * 2 + (h)) * HTB)
#define PG8_SB(b, h) ((4 + (b) * 2 + (h)) * HTB)
#define PG8_STAGE(bufoff, gbase, voff) do { _Pragma("unroll") for (int _i = 0; _i < 2; ++_i) \
        __builtin_amdgcn_global_load_lds((const unsigned*)((const char*)(gbase) + (voff)[_i]), (LAS unsigned*)(lds + (bufoff) + ldsw + _i * 8192), 16, 0, 0); } while (0)
#define PG8_LDA(dst, b, h) do { _Pragma("unroll") for (int m = 0; m < 4; ++m) _Pragma("unroll") for (int k = 0; k < 2; ++k) dst[m][k] = *(const LAS bf16x8*)(lds + PG8_SA(b, h) + aoff + m * 2048 + k * 1024); } while (0)
#define PG8_LDB(dst, b, h) do { _Pragma("unroll") for (int n = 0; n < 2; ++n) _Pragma("unroll") for (int k = 0; k < 2; ++k) dst[n][k] = *(const LAS bf16x8*)(lds + PG8_SB(b, h) + boff + n * 2048 + k * 1024); } while (0)
#define PG8_MMA(ai, bj, At, Bt) do { __builtin_amdgcn_s_setprio(1); _Pragma("unroll") for (int m = 0; m < 4; ++m) _Pragma("unroll") for (int n = 0; n < 2; ++n) _Pragma("unroll") for (int k = 0; k < 2; ++k) \
        acc[ai][bj][m][n] = __builtin_amdgcn_mfma_f32_16x16x32_bf16(Bt[n][k], At[m][k], acc[ai][bj][m][n], 0, 0, 0); __builtin_amdgcn_s_setprio(0); } while (0)
#define PG8_WAIT_V(n) asm volatile("s_waitcnt vmcnt(" #n ")" ::: "memory")
#define PG8_WAIT_L(n) asm volatile("s_waitcnt lgkmcnt(" #n ")" ::: "memory")
#define PG8_BAR __builtin_amdgcn_s_barrier()
#define PG8_SCHED __builtin_amdgcn_sched_barrier(0)
    Unit cur, nxt; int ui = 0;
    if (!S.next(0, cur)) return;
    f32x4 acc[2][2][4][2];
#pragma unroll
    for (int a = 0; a < 2; ++a)
#pragma unroll
        for (int b = 0; b < 2; ++b)
#pragma unroll
            for (int m = 0; m < 4; ++m)
#pragma unroll
                for (int n = 0; n < 2; ++n) acc[a][b][m][n] = (f32x4){0.f, 0.f, 0.f, 0.f};
    bf16x8 At[4][2], B0[2][2], B1[2][2];
    const char* cA = (const char*)g.A + (size_t)cur.pm * tstepA; const char* cB = (const char*)g.Bt + (size_t)cur.pn * tstepB;
    PG8_STAGE(PG8_SB(0, 0), cB, voffB); PG8_STAGE(PG8_SB(0, 1), cB + hstepB, voffB); PG8_STAGE(PG8_SA(0, 0), cA, voffA); PG8_STAGE(PG8_SA(0, 1), cA + hstepA, voffA);
    if (wr == 1) PG8_BAR;
    PG8_WAIT_V(2); PG8_BAR;
    PG8_STAGE(PG8_SB(1, 0), cB + kstep, voffB); PG8_STAGE(PG8_SA(1, 0), cA + kstep, voffA); PG8_STAGE(PG8_SB(1, 1), cB + hstepB + kstep, voffB);
    PG8_WAIT_V(6); PG8_BAR;
    for (;;) {
        const bool has_next = S.next(ui + 1, nxt);
        const char* nA = has_next ? (const char*)g.A + (size_t)nxt.pm * tstepA : cA; const char* nB = has_next ? (const char*)g.Bt + (size_t)nxt.pn * tstepB : cB;
        for (int t = 0; t < nt; t += 2) {
            const bool last = (t == nt - 2);
            const char* a1 = cA + (size_t)(t + 1) * kstep;
            const char* a2 = last ? nA : cA + (size_t)(t + 2) * kstep; const char* b2 = last ? nB : cB + (size_t)(t + 2) * kstep;
            const char* a3 = a2 + kstep; const char* b3 = b2 + kstep;
            PG8_LDB(B0, 0, 0); PG8_LDB(B1, 0, 1); PG8_SCHED; PG8_LDA(At, 0, 0); PG8_STAGE(PG8_SA(1, 1), a1 + hstepA, voffA);
            PG8_WAIT_V(8); PG8_WAIT_L(0); PG8_BAR; PG8_MMA(0, 0, At, B0); PG8_MMA(0, 1, At, B1); PG8_BAR; PG8_SCHED;
            PG8_LDA(At, 0, 1); PG8_STAGE(PG8_SB(0, 0), b2, voffB); PG8_STAGE(PG8_SB(0, 1), b2 + hstepB, voffB); PG8_STAGE(PG8_SA(0, 0), a2, voffA);
            PG8_WAIT_V(8); PG8_WAIT_L(0); PG8_BAR; PG8_MMA(1, 0, At, B0); PG8_MMA(1, 1, At, B1); PG8_BAR; PG8_SCHED;
            PG8_LDB(B0, 1, 0); PG8_LDB(B1, 1, 1); PG8_SCHED; PG8_LDA(At, 1, 0); PG8_STAGE(PG8_SA(0, 1), a2 + hstepA, voffA);
            PG8_WAIT_V(8); PG8_WAIT_L(0); PG8_BAR; PG8_MMA(0, 0, At, B0); PG8_MMA(0, 1, At, B1); PG8_BAR; PG8_SCHED;
            PG8_LDA(At, 1, 1); PG8_STAGE(PG8_SB(1, 0), b3, voffB); PG8_STAGE(PG8_SB(1, 1), b3 + hstepB, voffB); PG8_STAGE(PG8_SA(1, 0), a3, voffA);
            PG8_WAIT_V(8); PG8_WAIT_L(0); PG8_BAR; PG8_MMA(1, 0, At, B0); PG8_MMA(1, 1, At, B1); PG8_BAR; PG8_SCHED;
        }
        if (wr == 0) PG8_BAR;
        if constexpr (!Epi::AFTER_DRAIN) E(acc, cur, wr, wc, fr, fq);
        if (!has_next) break;
#pragma unroll
        for (int a = 0; a < 2; ++a)
#pragma unroll
            for (int b = 0; b < 2; ++b)
#pragma unroll
                for (int m = 0; m < 4; ++m)
#pragma unroll
                    for (int n = 0; n < 2; ++n) acc[a][b][m][n] = (f32x4){0.f, 0.f, 0.f, 0.f};
        cur = nxt; cA = nA; cB = nB; ++ui;
        if (wr == 1) PG8_BAR;
    }
    PG8_WAIT_V(0);
    PG8_BAR;
    if constexpr (Epi::AFTER_DRAIN) E.fused(acc, cur, wr, wc, fr, fq, lds);
#undef PG8_SA
#undef PG8_SB
#undef PG8_STAGE
#undef PG8_LDA
#undef PG8_LDB
#undef PG8_MMA
#undef PG8_WAIT_V
#undef PG8_WAIT_L
#undef PG8_BAR
#undef PG8_SCHED
}

template <int MODE> struct Epi {
    static constexpr bool AFTER_DRAIN = false;
    bf16_t* O; int ldo;
    float* ssq;
    const bf16_t* Y; int ldy;
    const float* bias;
    __device__ __forceinline__ void operator()(const f32x4 (&acc)[2][2][4][2], const Unit& u, int wr, int wc, int fr, int fq) const {
#pragma unroll
        for (int ai = 0; ai < 2; ++ai)
#pragma unroll
            for (int m = 0; m < 4; ++m) {
                const int row = u.pm * BM + ai * HALF + wr * 64 + m * 16 + fr;
                float ss = 0.f;
#pragma unroll
                for (int bj = 0; bj < 2; ++bj) {
                    const int col0 = u.pn * BM + bj * HALF + wc * 32 + 8 * fq;
                    f32x4 v0 = acc[ai][bj][m][0], v1 = acc[ai][bj][m][1];
                    if (MODE == 1) { ss += v0[0] * v0[0] + v0[1] * v0[1] + v0[2] * v0[2] + v0[3] * v0[3] + v1[0] * v1[0] + v1[1] * v1[1] + v1[2] * v1[2] + v1[3] * v1[3]; }
                    if (MODE == 2) {
#pragma unroll
                        for (int j = 0; j < 4; ++j) { float a = fmaxf(v0[j], 0.f); v0[j] = a * a; float b = fmaxf(v1[j], 0.f); v1[j] = b * b; }
                    }
                    if (MODE == 3) {
                        const u32x4 yv = *(const u32x4*)(Y + (size_t)row * ldy + col0);
                        const f32x4 b0 = *(const f32x4*)(bias + col0), b1 = *(const f32x4*)(bias + col0 + 4);
                        v0[0] = bf_lo(yv.x) * sigmoidf_(v0[0] + b0[0]); v0[1] = bf_hi(yv.x) * sigmoidf_(v0[1] + b0[1]);
                        v0[2] = bf_lo(yv.y) * sigmoidf_(v0[2] + b0[2]); v0[3] = bf_hi(yv.y) * sigmoidf_(v0[3] + b0[3]);
                        v1[0] = bf_lo(yv.z) * sigmoidf_(v1[0] + b1[0]); v1[1] = bf_hi(yv.z) * sigmoidf_(v1[1] + b1[1]);
                        v1[2] = bf_lo(yv.w) * sigmoidf_(v1[2] + b1[2]); v1[3] = bf_hi(yv.w) * sigmoidf_(v1[3] + b1[3]);
                    }
                    u32x4 w; w.x = cvt_pk_bf16(v0[0], v0[1]); w.y = cvt_pk_bf16(v0[2], v0[3]); w.z = cvt_pk_bf16(v1[0], v1[1]); w.w = cvt_pk_bf16(v1[2], v1[3]);
                    *(u32x4*)(O + (size_t)row * ldo + col0) = w;
                }
                if (MODE == 1) {
                    ss += __shfl_xor(ss, 16); ss += __shfl_xor(ss, 32);
                    if (fq == 0) ssq[(size_t)row * 16 + u.pn * 4 + wc] = ss;
                }
            }
    }
};

struct EpiRes {
    static constexpr bool AFTER_DRAIN = true;
    const float* hin; float* h;
    const float* g1; const float* g2;
    bf16_t* HN;
    float* xb1; float* xb2;
    unsigned* c1; unsigned* c2;
    __device__ __forceinline__ void exchange(const f32x4 (&acc)[2][2][4][2], const Unit& u, int wr, int wc, int fr, int fq, LAS unsigned char* lds, float* xb, unsigned* cnt) const {
        LAS float* P = (LAS float*)lds; LAS float* S = (LAS float*)(lds + 4096);
        const int tid = threadIdx.x;
#pragma unroll
        for (int ai = 0; ai < 2; ++ai)
#pragma unroll
            for (int m = 0; m < 4; ++m) {
                float ss = 0.f;
#pragma unroll
                for (int bj = 0; bj < 2; ++bj)
#pragma unroll
                    for (int n = 0; n < 2; ++n) { const f32x4 v = acc[ai][bj][m][n]; ss += v[0] * v[0] + v[1] * v[1] + v[2] * v[2] + v[3] * v[3]; }
                ss += __shfl_xor(ss, 16); ss += __shfl_xor(ss, 32);
                if (fq == 0) P[(ai * HALF + wr * 64 + m * 16 + fr) * 4 + wc] = ss;
            }
        __syncthreads();
        if (tid < 256) { const f32x4 p = *(const LAS f32x4*)(P + tid * 4); st_agent(xb + ((size_t)u.pm * 256 + tid) * 4 + u.pn, (p[0] + p[1]) + (p[2] + p[3])); }
        asm volatile("s_waitcnt vmcnt(0)" ::: "memory");
        __syncthreads();
        if (tid == 0) cnt_arrive_wait(cnt + u.pm * 32, 4u);
        __syncthreads();
        if (tid < 256) { const float* q = xb + ((size_t)u.pm * 256 + tid) * 4; const float t = (ld_agent(q) + ld_agent(q + 1)) + (ld_agent(q + 2) + ld_agent(q + 3));
            S[tid] = rsqrtf(t * (1.f / 1024.f) + EPS); }
        __syncthreads();
    }
    __device__ __forceinline__ void fused(f32x4 (&acc)[2][2][4][2], const Unit& u, int wr, int wc, int fr, int fq, LAS unsigned char* lds) const {
        const LAS float* S = (const LAS float*)(lds + 4096);
        exchange(acc, u, wr, wc, fr, fq, lds, xb1, c1);
#pragma unroll
        for (int bj = 0; bj < 2; ++bj) {
            const int col0 = u.pn * BM + bj * HALF + wc * 32 + 8 * fq;
            const f32x4 ga = *(const f32x4*)(g1 + col0), gb = *(const f32x4*)(g1 + col0 + 4);
#pragma unroll
            for (int ai = 0; ai < 2; ++ai)
#pragma unroll
                for (int m = 0; m < 4; ++m) {
                    const int rl = ai * HALF + wr * 64 + m * 16 + fr; const float inv = S[rl];
                    float* hp = h + (size_t)(u.pm * BM + rl) * 1024 + col0;
                    const float* hq = hin + (size_t)(u.pm * BM + rl) * 1024 + col0;
                    const f32x4 h0 = *(const f32x4*)hq, h1 = *(const f32x4*)(hq + 4);
                    f32x4 v0 = acc[ai][bj][m][0], v1 = acc[ai][bj][m][1];
                    v0 = h0 + v0 * inv * ga; v1 = h1 + v1 * inv * gb;
                    *(f32x4*)hp = v0; *(f32x4*)(hp + 4) = v1;
                    acc[ai][bj][m][0] = v0; acc[ai][bj][m][1] = v1;
                }
        }
        if (g2 == nullptr) return;
        __syncthreads();
        exchange(acc, u, wr, wc, fr, fq, lds, xb2, c2);
#pragma unroll
        for (int bj = 0; bj < 2; ++bj) {
            const int col0 = u.pn * BM + bj * HALF + wc * 32 + 8 * fq;
            const f32x4 ga = *(const f32x4*)(g2 + col0), gb = *(const f32x4*)(g2 + col0 + 4);
#pragma unroll
            for (int ai = 0; ai < 2; ++ai)
#pragma unroll
                for (int m = 0; m < 4; ++m) {
                    const int rl = ai * HALF + wr * 64 + m * 16 + fr; const float inv = S[rl];
                    const f32x4 v0 = acc[ai][bj][m][0] * inv * ga, v1 = acc[ai][bj][m][1] * inv * gb;
                    u32x4 w; w.x = cvt_pk_bf16(v0[0], v0[1]); w.y = cvt_pk_bf16(v0[2], v0[3]); w.z = cvt_pk_bf16(v1[0], v1[1]); w.w = cvt_pk_bf16(v1[2], v1[3]);
                    *(u32x4*)(HN + (size_t)(u.pm * BM + rl) * 1024 + col0) = w;
                }
        }
    }
};
}

__device__ __forceinline__ bf16x8 ldsfrag(const LAS unsigned char* p) { return *(const LAS bf16x8*)p; }
#define LBAR() do { asm volatile("s_waitcnt lgkmcnt(0)" ::: "memory"); __builtin_amdgcn_s_barrier(); asm volatile("" ::: "memory"); } while (0)
#define MFMA16(X, Y, ACC) __builtin_amdgcn_mfma_f32_16x16x32_bf16((X), (Y), (ACC), 0, 0, 0)


template <int MODE, int NT, int STEPS>
__device__ __forceinline__ void meta_gemm(LAS unsigned char* L, const bf16_t* A, int lda, const bf16_t* Bt, int N, int K,
                                          bf16_t* O, int ldo, float* ssq, const bf16_t* Y, int ldy, const float* bias,
                                          float* hm = nullptr, const float* g1 = nullptr, const float* g2 = nullptr, float* xm1 = nullptr, float* xm2 = nullptr, unsigned* cm1 = nullptr, unsigned* cm2 = nullptr) {
    int tid_ = threadIdx.x; asm volatile("" : "+v"(tid_));
    const int tid = tid_, lane = tid & 63, w = __builtin_amdgcn_readfirstlane(tid >> 6), fr = lane & 15, fq = lane >> 4;
    const int t = (int)gridDim.x - 1 - (int)blockIdx.x;
    if (t >= N / (16 * NT)) return;
    const int n0 = t * 16 * NT, kw = K / 8, k0 = w * kw;
    f32x4 acc[NT];
#pragma unroll
    for (int nt = 0; nt < NT; ++nt) acc[nt] = (f32x4){0.f, 0.f, 0.f, 0.f};
    const bf16_t* ap = A + (size_t)fr * lda + k0 + fq * 8;
    const bf16_t* bp = Bt + (size_t)(n0 + fr) * K + k0 + fq * 8;
    for (int k = 0; k < kw; k += 32 * STEPS) {
        bf16x8 af[STEPS], bfr[STEPS][NT];
#pragma unroll
        for (int st = 0; st < STEPS; ++st) { af[st] = *(const bf16x8*)(ap + k + 32 * st);
#pragma unroll
            for (int nt = 0; nt < NT; ++nt) bfr[st][nt] = *(const bf16x8*)(bp + (size_t)nt * 16 * K + k + 32 * st); }
#pragma unroll
        for (int st = 0; st < STEPS; ++st)
#pragma unroll
            for (int nt = 0; nt < NT; ++nt) acc[nt] = MFMA16(bfr[st][nt], af[st], acc[nt]);
    }
    LAS f32x4* P = (LAS f32x4*)L;
#pragma unroll
    for (int nt = 0; nt < NT; ++nt) P[(w * NT + nt) * 64 + lane] = acc[nt];
    __syncthreads();
    if (MODE == 4) {
        if (w == 0) {
            const int np = N / 16;
            f32x4 v = P[lane];
#pragma unroll
            for (int ww = 1; ww < 8; ++ww) v += P[ww * NT * 64 + lane];
            float ss = v[0] * v[0] + v[1] * v[1] + v[2] * v[2] + v[3] * v[3];
            ss += __shfl_xor(ss, 16); ss += __shfl_xor(ss, 32);
            if (fq == 0) st_agent(xm1 + fr * np + t, ss);
            asm volatile("s_waitcnt vmcnt(0)" ::: "memory");
            if (lane == 0) cnt_arrive_wait(cm1, (unsigned)np);
            __builtin_amdgcn_wave_barrier();
            float tot = 0.f;
#pragma unroll
            for (int q = 0; q < 16; ++q) tot += ld_agent(xm1 + fr * np + fq * 16 + q);
            tot += __shfl_xor(tot, 16); tot += __shfl_xor(tot, 32);
            const float inv = rsqrtf(tot * (1.f / 1024.f) + EPS);
            const int col = n0 + 4 * fq; float* hp = hm + fr * 1024 + col;
            { const f32x4 gg = *(const f32x4*)(g1 + col); const f32x4 h0 = *(const f32x4*)hp; v = h0 + v * inv * gg; *(f32x4*)hp = v; }
            if (g2 != nullptr) {
                float ss2 = v[0] * v[0] + v[1] * v[1] + v[2] * v[2] + v[3] * v[3];
                ss2 += __shfl_xor(ss2, 16); ss2 += __shfl_xor(ss2, 32);
                if (fq == 0) st_agent(xm2 + fr * np + t, ss2);
                asm volatile("s_waitcnt vmcnt(0)" ::: "memory");
                if (lane == 0) cnt_arrive_wait(cm2, (unsigned)np);
                __builtin_amdgcn_wave_barrier();
                float tot2 = 0.f;
#pragma unroll
                for (int q = 0; q < 16; ++q) tot2 += ld_agent(xm2 + fr * np + fq * 16 + q);
                tot2 += __shfl_xor(tot2, 16); tot2 += __shfl_xor(tot2, 32);
                const float inv2 = rsqrtf(tot2 * (1.f / 1024.f) + EPS);
                const f32x4 gg = *(const f32x4*)(g2 + col); const f32x4 y = v * inv2 * gg;
                u32x2 o; o.x = cvt_pk_bf16(y[0], y[1]); o.y = cvt_pk_bf16(y[2], y[3]);
                *(u32x2*)(O + (size_t)fr * ldo + col) = o;
            }
        }
    } else if (w == 0) {
        float ss = 0.f;
#pragma unroll
        for (int nt = 0; nt < NT; ++nt) {
            f32x4 v = P[nt * 64 + lane];
#pragma unroll
            for (int ww = 1; ww < 8; ++ww) v += P[(ww * NT + nt) * 64 + lane];
            const int col = n0 + nt * 16 + 4 * fq;
            if (MODE == 1) ss += v[0] * v[0] + v[1] * v[1] + v[2] * v[2] + v[3] * v[3];
            if (MODE == 2) {
#pragma unroll
                for (int j = 0; j < 4; ++j) { const float r = fmaxf(v[j], 0.f); v[j] = r * r; }
            }
            if (MODE == 3) {
                const u32x2 yv = *(const u32x2*)(Y + (size_t)fr * ldy + col);
                const f32x4 bb = *(const f32x4*)(bias + col);
                v[0] = bf_lo(yv.x) * sigmoidf_(v[0] + bb[0]); v[1] = bf_hi(yv.x) * sigmoidf_(v[1] + bb[1]);
                v[2] = bf_lo(yv.y) * sigmoidf_(v[2] + bb[2]); v[3] = bf_hi(yv.y) * sigmoidf_(v[3] + bb[3]);
            }
            u32x2 o; o.x = cvt_pk_bf16(v[0], v[1]); o.y = cvt_pk_bf16(v[2], v[3]);
            *(u32x2*)(O + (size_t)fr * ldo + col) = o;
        }
        if (MODE == 1) {
            ss += __shfl_xor(ss, 16); ss += __shfl_xor(ss, 32);
            if (fq == 0) ssq[fr * 16 + t] = ss;
        }
    }
    __syncthreads();
}

__device__ __forceinline__ void transpose_item(const float* W, int K, int N, bf16_t* WT, int dst_row0, LAS float* scr, int k0, int n0, int lane) {
#pragma unroll 8
    for (int i = 0; i < 32; ++i) { const int kk = 2 * i + (lane >> 5); scr[kk * 33 + (lane & 31)] = W[(size_t)(k0 + kk) * N + n0 + (lane & 31)]; }
    asm volatile("s_waitcnt lgkmcnt(0)" ::: "memory");
    const int c = lane & 7;
#pragma unroll
    for (int j = 0; j < 4; ++j) { const int n = (lane >> 3) + 8 * j; const LAS float* s = scr + (8 * c) * 33 + n;
        u32x4 o; o.x = cvt_pk_bf16(s[0 * 33], s[1 * 33]); o.y = cvt_pk_bf16(s[2 * 33], s[3 * 33]); o.z = cvt_pk_bf16(s[4 * 33], s[5 * 33]); o.w = cvt_pk_bf16(s[6 * 33], s[7 * 33]);
        *(u32x4*)(WT + (size_t)(dst_row0 + n) * K + k0 + 8 * c) = o; }
    asm volatile("s_waitcnt lgkmcnt(0)" ::: "memory");
}


constexpr int WC_I0 = 16 * 160, WC_I1 = 32 * 32, WC_I2 = 16 * 128, WC_I3 = 64 * 32, WC_I4 = 16 * 80, WC_I5 = 16 * 32, WC_I6 = 8 * 16, WC_I7 = WC_I2, WC_I8 = WC_I3;
constexpr int WC_C0 = 0, WC_C1 = WC_I0, WC_C5 = WC_I0 + WC_I1 + WC_I2 + WC_I3 + WC_I4, WC_C9 = WC_C5 + WC_I5 + WC_I6 + WC_I7 + WC_I8;
__device__ __forceinline__ void weight_convert(const Args& a, LAS unsigned char* lds, int it0, int it1, int vb, int nvb) {
    int tid_ = threadIdx.x; asm volatile("" : "+v"(tid_));
    const int tid = tid_, lane = tid & 63, wave = tid >> 6;
    unsigned char* ws = a.ws;
    LAS float* scr = (LAS float*)(lds + wave * 16384);
    constexpr int I0 = WC_I0, I1 = WC_I1, I2 = WC_I2, I3 = WC_I3, I4 = WC_I4, I5 = WC_I5, I6 = WC_I6, I7 = WC_I7;
    for (int it = it0 + vb * 8 + wave; it < it1; it += nvb * 8) {
        int r = it; const float* W; int K, N; bf16_t* WT; bool perm = false;
        if (r < I0) { W = a.in[2]; K = 1024; N = 5120; WT = (bf16_t*)(ws + W_INAB); perm = true; }
        else if ((r -= I0) < I1) { W = a.in[3]; K = 2048; N = 1024; WT = (bf16_t*)(ws + W_OUTAB); }
        else if ((r -= I1) < I2) { W = a.in[27]; K = 1024; N = 4096; WT = (bf16_t*)(ws + W_W1_0); }
        else if ((r -= I2) < I3) { W = a.in[28]; K = 4096; N = 1024; WT = (bf16_t*)(ws + W_W2_0); }
        else if ((r -= I3) < I4) { W = a.in[12]; K = 1024; N = 2560; WT = (bf16_t*)(ws + W_INCD); }
        else if ((r -= I4) < I5) { W = a.in[13]; K = 1024; N = 1024; WT = (bf16_t*)(ws + W_OUTCD); }
        else if ((r -= I5) < I6) { W = a.in[22]; K = 512; N = 512; WT = (bf16_t*)(ws + W_GLU); }
        else if ((r -= I6) < I7) { W = a.in[27] + (size_t)1024 * 4096; K = 1024; N = 4096; WT = (bf16_t*)(ws + W_W1_1); }
        else { r -= I7; W = a.in[28] + (size_t)1024 * 4096; K = 4096; N = 1024; WT = (bf16_t*)(ws + W_W2_1); }
        const int nblk = N / 32, kb = r / nblk, nb = r % nblk, n0 = nb * 32;
        int d0 = n0;
        if (perm) { if (n0 >= 2048 && n0 < 3072) d0 = n0 + 1024; else if (n0 >= 3072 && n0 < 4096) d0 = n0 - 1024; }
        transpose_item(W, K, N, WT, d0, scr, kb * 64, n0, lane);
    }
}

__device__ __forceinline__ void phase_prologue(const Args& a, LAS unsigned char* lds, bool copy_x) {
    int tid_ = threadIdx.x; asm volatile("" : "+v"(tid_));
    const int tid = tid_, lane = tid & 63, wave = tid >> 6;
    const int gw = blockIdx.x * 8 + wave, NGW = gridDim.x * 8;
    unsigned char* ws = a.ws;
    LAS float* scr = (LAS float*)(lds + wave * 16384);
    weight_convert(a, lds, WC_C0, WC_C5, blockIdx.x, gridDim.x);
    {
        const float* x = a.in[0]; const float* meta = a.in[1]; const float* g = a.in[26];
        bf16_t* HN = (bf16_t*)(ws + HN_OFF);
        f32x4 gg[4];
#pragma unroll
        for (int j = 0; j < 4; ++j) gg[j] = *(const f32x4*)(g + 4 * lane + 256 * j);
        for (int row0 = gw; row0 < R; row0 += 4 * NGW) {
            f32x4 v[4][4];
#pragma unroll
            for (int q = 0; q < 4; ++q) { const int row = row0 + q * NGW;
                if (row < R) { const float* src = row < RM ? x + (size_t)row * DM : meta + (size_t)(row - RM) * DM;
#pragma unroll
                    for (int j = 0; j < 4; ++j) v[q][j] = *(const f32x4*)(src + 4 * lane + 256 * j); }
                else {
#pragma unroll
                    for (int j = 0; j < 4; ++j) v[q][j] = (f32x4){0.f, 0.f, 0.f, 0.f}; } }
#pragma unroll
            for (int q = 0; q < 4; ++q) { const int row = row0 + q * NGW;
                if (row < R) {
                    float s = 0.f;
#pragma unroll
                    for (int j = 0; j < 4; ++j) s += v[q][j][0] * v[q][j][0] + v[q][j][1] * v[q][j][1] + v[q][j][2] * v[q][j][2] + v[q][j][3] * v[q][j][3];
                    const float inv = rsqrtf(wave_sum(s) * (1.f / DM) + EPS);
                    if (copy_x || row >= RM) { float* hr = hrow(a, row);
#pragma unroll
                        for (int j = 0; j < 4; ++j) *(f32x4*)(hr + 4 * lane + 256 * j) = v[q][j]; }
#pragma unroll
                    for (int j = 0; j < 4; ++j) { u32x2 o; o.x = cvt_pk_bf16(v[q][j][0] * inv * gg[j][0], v[q][j][1] * inv * gg[j][1]); o.y = cvt_pk_bf16(v[q][j][2] * inv * gg[j][2], v[q][j][3] * inv * gg[j][3]);
                        *(u32x2*)(HN + (size_t)row * DM + 4 * lane + 256 * j) = o; }
                } }
        }
    }
    const int gt = blockIdx.x * NTHREADS + tid, NGT = gridDim.x * NTHREADS;
    {
        bf16_t* WG = (bf16_t*)(ws + LRUW_OFF);
        for (int i = gt; i < 16 * 128 * 64; i += NGT) { const int k = i & 63, n = (i >> 6) & 127, blk = i >> 13;
            const float v = n < 64 ? a.in[5][(size_t)blk * 4096 + k * 64 + n] : a.in[7][(size_t)blk * 4096 + k * 64 + (n - 64)];
            WG[i] = f2bf(v); }
    }
    {
        bf16_t* BB = (bf16_t*)(ws + S5BB_OFF); bf16_t* CM = (bf16_t*)(ws + S5CM_OFF); float* AB = (float*)(ws + S5AB_OFF);
        const float* are_log = a.in[14]; const float* aim = a.in[15]; const float* bre = a.in[16]; const float* bim = a.in[17];
        const float* cre = a.in[18]; const float* cim = a.in[19]; const float* ldt = a.in[21];
        for (int i = gt; i < 32 * 64; i += NGT) {
            const int g = i >> 6, p = i & 63;
            const float dt = expf(ldt[g]); const float a_re = -expf(are_log[i]); const float a_im = aim[i];
            const float mag = expf(dt * a_re); float sn, cs; sincos_big(dt * a_im, sn, cs);
            const float ab_re = mag * cs, ab_im = mag * sn;
            AB[2 * i] = ab_re; AB[2 * i + 1] = ab_im;
            const float n_re = ab_re - 1.f, n_im = ab_im, den = a_re * a_re + a_im * a_im;
            const float z_re = (n_re * a_re + n_im * a_im) / den, z_im = (n_im * a_re - n_re * a_im) / den;
            for (int c = 0; c < 32; ++c) {
                float vr = 0.f, vi = 0.f;
                if (c < 16) { const float br = bre[(size_t)i * 16 + c], bi = bim[(size_t)i * 16 + c]; vr = z_re * br - z_im * bi; vi = z_re * bi + z_im * br; }
                BB[((size_t)g * 128 + p) * 32 + c] = f2bf(vr);
                BB[((size_t)g * 128 + 64 + p) * 32 + c] = f2bf(vi);
            }
            for (int c = 0; c < 16; ++c) {
                CM[((size_t)g * 16 + c) * 128 + p] = f2bf(cre[((size_t)g * 16 + c) * 64 + p]);
                CM[((size_t)g * 16 + c) * 128 + 64 + p] = f2bf(-cim[((size_t)g * 16 + c) * 64 + p]);
            }
        }
    }
}

__device__ __forceinline__ void phase_resnorm(const Args& a, const float* g1, const float* g2) {
    int tid_ = threadIdx.x; asm volatile("" : "+v"(tid_));
    const int tid = tid_, lane = tid & 63, wave = tid >> 6;
    const int gw = blockIdx.x * 8 + wave, NGW = gridDim.x * 8;
    bf16_t* HN = (bf16_t*)(a.ws + HN_OFF); const float* ssq = (const float*)(a.ws + SSQ_OFF);
    for (int row = gw; row < R; row += NGW) {
        bf16_t* mrow = HN + (size_t)row * DM;
        float s = 0.f;
        { const f32x4* sp = (const f32x4*)(ssq + (size_t)row * 16); const f32x4 s0 = sp[0], s1 = sp[1], s2 = sp[2], s3 = sp[3];
          s = ((s0[0] + s0[1]) + (s0[2] + s0[3])) + ((s1[0] + s1[1]) + (s1[2] + s1[3])) + ((s2[0] + s2[1]) + (s2[2] + s2[3])) + ((s3[0] + s3[1]) + (s3[2] + s3[3])); }
        const float inv = rsqrtf(s * (1.f / DM) + EPS);
        float* hr = hrow(a, row);
        f32x4 v[4]; float s2 = 0.f;
#pragma unroll
        for (int j = 0; j < 4; ++j) {
            const u32x2 mv = *(const u32x2*)(mrow + 4 * lane + 256 * j);
            const f32x4 gg = *(const f32x4*)(g1 + 4 * lane + 256 * j);
            v[j] = *(const f32x4*)(hr + 4 * lane + 256 * j);
            v[j][0] += bf_lo(mv.x) * inv * gg[0]; v[j][1] += bf_hi(mv.x) * inv * gg[1]; v[j][2] += bf_lo(mv.y) * inv * gg[2]; v[j][3] += bf_hi(mv.y) * inv * gg[3];
            *(f32x4*)(hr + 4 * lane + 256 * j) = v[j];
            s2 += v[j][0] * v[j][0] + v[j][1] * v[j][1] + v[j][2] * v[j][2] + v[j][3] * v[j][3];
        }
        if (g2) {
            const float inv2 = rsqrtf(wave_sum(s2) * (1.f / DM) + EPS);
#pragma unroll
            for (int j = 0; j < 4; ++j) { const f32x4 gg = *(const f32x4*)(g2 + 4 * lane + 256 * j);
                u32x2 o; o.x = cvt_pk_bf16(v[j][0] * inv2 * gg[0], v[j][1] * inv2 * gg[1]); o.y = cvt_pk_bf16(v[j][2] * inv2 * gg[2], v[j][3] * inv2 * gg[3]);
                *(u32x2*)(mrow + 4 * lane + 256 * j) = o; }
        }
    }
}

constexpr int LA_QS = 0, LA_KS = 17408, LA_QD = 34816, LA_KT = 52224, LA_VT = 70656, LA_PS = 75264, LA_ST = 84480, LA_CUM = 93184, LA_DEC = 125952, LA_CM = 126464  , LA_END = 126976;
static_assert(LA_END <= LDS_BYTES, "LA lds");
__device__ __forceinline__ int kt_off(int d, int s) { return d * 144 + ((((s >> 3) ^ (d >> 3)) & 7) << 4) + (s & 7) * 2; }

template <bool HG>
__device__ __forceinline__ void la_core(LAS unsigned char* L, f32x4 (&st)[2], float l2g, bf16_t* obuf, int ldo, int ocol, int b, int n, bool dry) {
    int tid_ = threadIdx.x; asm volatile("" : "+v"(tid_));
    const int tid = tid_, lane = tid & 63, w = __builtin_amdgcn_readfirstlane(tid >> 6), fr = lane & 15, fq = lane >> 4;
    const int mt = w >> 1, nh = w & 1;
    bf16x8 qf[4];
#pragma unroll
    for (int kk = 0; kk < 4; ++kk) qf[kk] = ldsfrag(L + LA_QS + (mt * 16 + fr) * 272 + kk * 64 + fq * 16);
    f32x4 s0 = {0.f, 0.f, 0.f, 0.f}, s1 = {0.f, 0.f, 0.f, 0.f};
#pragma unroll
    for (int kk = 0; kk < 4; ++kk) {
        const bf16x8 k0 = ldsfrag(L + LA_KS + ((nh * 2) * 16 + fr) * 272 + kk * 64 + fq * 16);
        const bf16x8 k1 = ldsfrag(L + LA_KS + ((nh * 2 + 1) * 16 + fr) * 272 + kk * 64 + fq * 16);
        s0 = MFMA16(k0, qf[kk], s0); s1 = MFMA16(k1, qf[kk], s1);
    }
    const int t = mt * 16 + fr;
    {
        float p0[4], p1[4];
#pragma unroll
        for (int jj = 0; jj < 4; ++jj) {
            const int sa = (nh * 2) * 16 + 4 * fq + jj, sb = sa + 16;
            if (HG) { p0[jj] = sa <= t ? s0[jj] : 0.f; p1[jj] = sb <= t ? s1[jj] : 0.f; }
            else { p0[jj] = s0[jj] * exp2f(l2g * fabsf((float)(t - sa))); p1[jj] = s1[jj] * exp2f(l2g * fabsf((float)(t - sb))); }
        }
        u32x2 o0, o1; o0.x = cvt_pk_bf16(p0[0], p0[1]); o0.y = cvt_pk_bf16(p0[2], p0[3]); o1.x = cvt_pk_bf16(p1[0], p1[1]); o1.y = cvt_pk_bf16(p1[2], p1[3]);
        *(LAS u32x2*)(L + LA_PS + t * 144 + ((nh * 2) * 16 + 4 * fq) * 2) = o0;
        *(LAS u32x2*)(L + LA_PS + t * 144 + ((nh * 2 + 1) * 16 + 4 * fq) * 2) = o1;
    }
    f32x4 o = {0.f, 0.f, 0.f, 0.f};
#pragma unroll
    for (int kk = 0; kk < 4; ++kk) {
        bf16x8 sf = ldsfrag(L + LA_ST + (nh * 16 + fr) * 272 + kk * 64 + fq * 16);
        if (HG) {
            const f32x4 c0 = *(const LAS f32x4*)(L + LA_CM + (kk * 32 + fq * 8) * 4), c1 = *(const LAS f32x4*)(L + LA_CM + (kk * 32 + fq * 8 + 4) * 4);
            const u32x4 su = __builtin_bit_cast(u32x4, sf);
            u32x4 r; r.x = cvt_pk_bf16(bf_lo(su.x) * c0[0], bf_hi(su.x) * c0[1]); r.y = cvt_pk_bf16(bf_lo(su.y) * c0[2], bf_hi(su.y) * c0[3]);
            r.z = cvt_pk_bf16(bf_lo(su.z) * c1[0], bf_hi(su.z) * c1[1]); r.w = cvt_pk_bf16(bf_lo(su.w) * c1[2], bf_hi(su.w) * c1[3]);
            sf = __builtin_bit_cast(bf16x8, r);
        }
        o = MFMA16(sf, qf[kk], o);
    }
    if (!HG) { const float sc = exp2f(l2g * (float)(t + 1)); o[0] *= sc; o[1] *= sc; o[2] *= sc; o[3] *= sc; }
    LBAR();
#pragma unroll
    for (int kk = 0; kk < 2; ++kk) {
        const bf16x8 vf = ldsfrag(L + LA_VT + (nh * 16 + fr) * 144 + kk * 64 + fq * 16);
        const bf16x8 pf = ldsfrag(L + LA_PS + (mt * 16 + fr) * 144 + kk * 64 + fq * 16);
        o = MFMA16(vf, pf, o);
    }
    {
        const int row = chunk_row(b, n, t);
        if (row >= 0 && (row < RM || b == 0) && !dry) { u32x2 ov; ov.x = cvt_pk_bf16(o[0], o[1]); ov.y = cvt_pk_bf16(o[2], o[3]);
            *(u32x2*)(obuf + (size_t)row * ldo + ocol + nh * 16 + 4 * fq) = ov; }
    }
    float dc[4];
    if (HG) { const f32x4 dv = *(const LAS f32x4*)(L + LA_DEC + (w * 16 + 4 * fq) * 4); dc[0] = dv[0]; dc[1] = dv[1]; dc[2] = dv[2]; dc[3] = dv[3]; }
    else { const float g64 = exp2f(l2g * 64.f); dc[0] = dc[1] = dc[2] = dc[3] = g64; }
    const int ktd = w * 16 + fr, ktx = (ktd >> 3) & 7;
    const bf16x8 kt0 = ldsfrag(L + LA_KT + ktd * 144 + ((fq ^ ktx) << 4)), kt1 = ldsfrag(L + LA_KT + ktd * 144 + (((4 + fq) ^ ktx) << 4));
#pragma unroll
    for (int et = 0; et < 2; ++et) {
#pragma unroll
        for (int jj = 0; jj < 4; ++jj) st[et][jj] *= dc[jj];
        const bf16x8 v0 = ldsfrag(L + LA_VT + (et * 16 + fr) * 144 + fq * 16), v1 = ldsfrag(L + LA_VT + (et * 16 + fr) * 144 + 64 + fq * 16);
        st[et] = MFMA16(kt0, v0, st[et]); st[et] = MFMA16(kt1, v1, st[et]);
        u32x2 sv; sv.x = cvt_pk_bf16(st[et][0], st[et][1]); sv.y = cvt_pk_bf16(st[et][2], st[et][3]);
        *(LAS u32x2*)(L + LA_ST + (et * 16 + fr) * 272 + (w * 16 + 4 * fq) * 2) = sv;
    }
}

#define UNPK8(dst, v) do { dst[0] = bf_lo((v).x); dst[1] = bf_hi((v).x); dst[2] = bf_lo((v).y); dst[3] = bf_hi((v).y); dst[4] = bf_lo((v).z); dst[5] = bf_hi((v).z); dst[6] = bf_lo((v).w); dst[7] = bf_hi((v).w); } while (0)
#define PK8(v, src) do { (v).x = cvt_pk_bf16(src[0], src[1]); (v).y = cvt_pk_bf16(src[2], src[3]); (v).z = cvt_pk_bf16(src[4], src[5]); (v).w = cvt_pk_bf16(src[6], src[7]); } while (0)

__device__ __forceinline__ void retention_unit(const Args& a, LAS unsigned char* L, int unit, bool dry) {
    int tid_ = threadIdx.x; asm volatile("" : "+v"(tid_));
    const int tid = tid_, b = unit >> 5, h = (unit >> 3) & 3, sl = unit & 7;
    const bf16_t* Z = (const bf16_t*)(a.ws + Z_OFF); bf16_t* OB = (bf16_t*)(a.ws + HN_OFF);
    const float l2g = log2f(1.f - exp2f(-5.f - (float)h));
    const int row_l = tid >> 3, c8 = tid & 7;
    const int vrow = (tid >> 2) & 63, vp = tid & 3;
    float rc[8], rs[8], stc[8], sts[8];
#pragma unroll
    for (int i = 0; i < 8; ++i) { const float invf = exp2f(-(float)(c8 * 8 + i) * (13.287712379549449f / 64.f));
        sincos_big((float)(row_l - 48) * invf, rs[i], rc[i]); sincos_big(64.f * invf, sts[i], stc[i]); }
    f32x4 st[2] = {{0.f, 0.f, 0.f, 0.f}, {0.f, 0.f, 0.f, 0.f}};
    for (int i = tid; i < 32 * 272 / 4; i += NTHREADS) ((LAS unsigned*)(L + LA_ST))[i] = 0u;
    u32x4 qA1, qA2, kA1, kA2, vA, qB1, qB2, kB1, kB2, vB;
#define RET_LOAD(q1, q2, k1, k2, vv, n_) do { const int r_ = chunk_row(b, (n_), row_l); \
        if (r_ >= 0) { const bf16_t* zr = Z + (size_t)r_ * IN_AB; \
            q1 = *(const u32x4*)(zr + h * 128 + c8 * 8); q2 = *(const u32x4*)(zr + h * 128 + 64 + c8 * 8); \
            k1 = *(const u32x4*)(zr + 512 + h * 128 + c8 * 8); k2 = *(const u32x4*)(zr + 512 + h * 128 + 64 + c8 * 8); \
        } else { q1 = q2 = k1 = k2 = (u32x4){0u, 0u, 0u, 0u}; } \
        vv = (u32x4){0u, 0u, 0u, 0u}; \
        if (tid < 256) { const int rv = chunk_row(b, (n_), vrow); if (rv >= 0) vv = *(const u32x4*)(Z + (size_t)rv * IN_AB + 1024 + h * 256 + sl * 32 + vp * 8); } } while (0)
#define RET_STEP(q1, q2, k1, k2, vv, n_) do { \
        { \
            float x1[8], x2[8], y1[8], y2[8], qo1[8], qo2[8], ko1[8], ko2[8]; \
            UNPK8(x1, q1); UNPK8(x2, q2); UNPK8(y1, k1); UNPK8(y2, k2); \
            _Pragma("unroll") for (int i = 0; i < 8; ++i) { \
                const float sn = rs[i], cs = rc[i]; \
                rc[i] = cs * stc[i] - sn * sts[i]; rs[i] = sn * stc[i] + cs * sts[i];       \
                qo1[i] = (x1[i] * cs - x2[i] * sn) * 0.08838834764831845f; qo2[i] = (x1[i] * sn + x2[i] * cs) * 0.08838834764831845f; \
                ko1[i] = y1[i] * cs - y2[i] * sn; ko2[i] = y1[i] * sn + y2[i] * cs; \
            } \
            u32x4 w1, w2; \
            PK8(w1, qo1); PK8(w2, qo2); \
            *(LAS u32x4*)(L + LA_QS + row_l * 272 + c8 * 16) = w1; *(LAS u32x4*)(L + LA_QS + row_l * 272 + 128 + c8 * 16) = w2; \
            PK8(w1, ko1); PK8(w2, ko2); \
            *(LAS u32x4*)(L + LA_KS + row_l * 272 + c8 * 16) = w1; *(LAS u32x4*)(L + LA_KS + row_l * 272 + 128 + c8 * 16) = w2; \
            _Pragma("unroll") for (int i = 0; i < 8; ++i) { \
                *(LAS bf16_t*)(L + LA_KT + kt_off(c8 * 8 + i, row_l)) = f2bf(ko1[i] * kdec); \
                *(LAS bf16_t*)(L + LA_KT + kt_off(64 + c8 * 8 + i, row_l)) = f2bf(ko2[i] * kdec); \
            } \
            if (tid < 256) { \
                const unsigned va[4] = {vv.x, vv.y, vv.z, vv.w}; \
                _Pragma("unroll") for (int i = 0; i < 8; ++i) *(LAS bf16_t*)(L + LA_VT + (vp * 8 + i) * 144 + vrow * 2) = (bf16_t)((i & 1) ? (va[i >> 1] >> 16) : (va[i >> 1] & 0xffffu)); \
            } \
        } \
        if ((n_) + 2 < NCH) RET_LOAD(q1, q2, k1, k2, vv, (n_) + 2); \
        LBAR(); \
        la_core<false>(L, st, l2g, OB, DM, h * 256 + sl * 32, b, (n_), dry); \
        LBAR(); } while (0)
    const float kdec = exp2f(l2g * (float)(63 - row_l));
    RET_LOAD(qA1, qA2, kA1, kA2, vA, 0);
    RET_LOAD(qB1, qB2, kB1, kB2, vB, 1);
    for (int n = 0; n < NCH; n += 2) {
        RET_STEP(qA1, qA2, kA1, kA2, vA, n);
        if (n + 1 < NCH) RET_STEP(qB1, qB2, kB1, kB2, vB, n + 1);
    }
#undef RET_STEP
#undef RET_LOAD
}

constexpr size_t HGT_OFF = Z_OFF + (size_t)R * IN_CD * 2;
constexpr size_t HGT_ITEM = 54272;
static_assert(HGT_OFF + (size_t)NB * NCH * 4 * HGT_ITEM <= HN_OFF, "HGRN tile images fit behind z_cd");
__device__ __forceinline__ void hgrn_prepass(const Args& a, LAS unsigned char* L) {
    int tid_ = threadIdx.x; asm volatile("" : "+v"(tid_));
    const int tid = tid_;
    const bf16_t* Z = (const bf16_t*)(a.ws + Z_OFF);
    const int row_l = tid >> 3, c8 = tid & 7;
    const float* lg = a.in[25];
    for (int it = blockIdx.x; it < NB * NCH * 4; it += gridDim.x) {
        const int h = it & 3, bn = it >> 2, b = bn / NCH, n = bn % NCH;
        float lb1[8], lb2[8];
#pragma unroll
        for (int i = 0; i < 8; ++i) { const int d = h * 128 + c8 * 8 + i; lb1[i] = sigmoidf_(lg[d] - lg[512 + d]); lb2[i] = sigmoidf_(lg[d + 64] - lg[512 + d + 64]); }
        const int r = chunk_row(b, n, row_l);
        const bool valid = r >= 0;
        u32x4 q1, q2, f1, f2;
        if (valid) { const bf16_t* zr = Z + (size_t)r * IN_CD;
            q1 = *(const u32x4*)(zr + 512 + h * 128 + c8 * 8); q2 = *(const u32x4*)(zr + 512 + h * 128 + 64 + c8 * 8);
            f1 = *(const u32x4*)(zr + 1024 + h * 128 + c8 * 8); f2 = *(const u32x4*)(zr + 1024 + h * 128 + 64 + c8 * 8);
        } else { q1 = q2 = f1 = f2 = (u32x4){0u, 0u, 0u, 0u}; }
        float qv1[8], qv2[8], kv1[8], kv2[8];
        {
            float fp1[8], fp2[8], lf1[8], lf2[8];
            UNPK8(qv1, q1); UNPK8(qv2, q2); UNPK8(fp1, f1); UNPK8(fp2, f2);
#pragma unroll
            for (int i = 0; i < 8; ++i) {
                const float ff1 = lb1[i] + (1.f - lb1[i]) * sigmoidf_(fp1[i]), ff2 = lb2[i] + (1.f - lb2[i]) * sigmoidf_(fp2[i]);
                if (valid) { lf1[i] = __logf(ff1); lf2[i] = __logf(ff2); kv1[i] = 1.f - ff1; kv2[i] = 1.f - ff2; }
                else { lf1[i] = 0.f; lf2[i] = 0.f; kv1[i] = 0.f; kv2[i] = 0.f; qv1[i] = 0.f; qv2[i] = 0.f; }
            }
            LAS float* cr = (LAS float*)(L + LA_CUM) + row_l * 128;
            *(LAS f32x4*)(cr + c8 * 8) = (f32x4){lf1[0], lf1[1], lf1[2], lf1[3]}; *(LAS f32x4*)(cr + c8 * 8 + 4) = (f32x4){lf1[4], lf1[5], lf1[6], lf1[7]};
            *(LAS f32x4*)(cr + 64 + c8 * 8) = (f32x4){lf2[0], lf2[1], lf2[2], lf2[3]}; *(LAS f32x4*)(cr + 64 + c8 * 8 + 4) = (f32x4){lf2[4], lf2[5], lf2[6], lf2[7]};
        }
        __syncthreads();
        {
            const int d = tid & 127, sg = tid >> 7; LAS float* c = (LAS float*)(L + LA_CUM) + (sg * 16) * 128 + d; float run = 0.f;
#pragma unroll
            for (int rr = 0; rr < 16; ++rr) { run += c[rr * 128]; c[rr * 128] = run; }
        }
        __syncthreads();
        {
            const LAS float* C = (const LAS float*)(L + LA_CUM);
            const int sg = row_l >> 4;
            float qi[16], ki[16], kd[16];
#pragma unroll
            for (int i = 0; i < 16; ++i) {
                const int d = (i < 8) ? c8 * 8 + i : 64 + c8 * 8 + (i - 8);
                const float t0 = C[15 * 128 + d], t1 = C[31 * 128 + d], t2 = C[47 * 128 + d], t3 = C[63 * 128 + d];
                float cum = C[row_l * 128 + d];
                cum += (sg > 0 ? t0 : 0.f) + (sg > 1 ? t1 : 0.f) + (sg > 2 ? t2 : 0.f);
                const float cmid = t0 + t1, total = (t0 + t1) + (t2 + t3);
                const float q = (i < 8) ? qv1[i & 7] : qv2[i & 7], k = (i < 8) ? kv1[i & 7] : kv2[i & 7];
                qi[i] = q * __expf(fminf(cum - cmid, 80.f)); ki[i] = k * __expf(fminf(cmid - cum, 80.f));
                kd[i] = k * __expf(total - cum);
                if (row_l == 0) { *(LAS float*)(L + 70656 + d * 4) = __expf(total); *(LAS float*)(L + 71168 + d * 4) = __expf(cmid); }
            }
            u32x4 w1, w2;
            PK8(w1, qi); { const float* sp = qi + 8; PK8(w2, sp); }
            *(LAS u32x4*)(L + LA_QS + row_l * 272 + c8 * 16) = w1; *(LAS u32x4*)(L + LA_QS + row_l * 272 + 128 + c8 * 16) = w2;
            PK8(w1, ki); { const float* sp = ki + 8; PK8(w2, sp); }
            *(LAS u32x4*)(L + LA_KS + row_l * 272 + c8 * 16) = w1; *(LAS u32x4*)(L + LA_KS + row_l * 272 + 128 + c8 * 16) = w2;
#pragma unroll
            for (int i = 0; i < 8; ++i) {
                *(LAS bf16_t*)(L + LA_KT + kt_off(c8 * 8 + i, row_l)) = f2bf(kd[i]);
                *(LAS bf16_t*)(L + LA_KT + kt_off(64 + c8 * 8 + i, row_l)) = f2bf(kd[8 + i]);
            }
        }
        __syncthreads();
        {
            unsigned char* dst = a.ws + HGT_OFF + (size_t)it * HGT_ITEM;
#pragma unroll
            for (int k = 0; k < 7; ++k) { const int idx = tid + k * NTHREADS; if (idx < 3392) *(u32x4*)(dst + (size_t)idx * 16) = *(const LAS u32x4*)(L + (idx < 2176 ? idx * 16 : LA_KT + (idx - 2176) * 16)); }
        }
        __syncthreads();
    }
}

__device__ __forceinline__ void hgrn_unit(const Args& a, LAS unsigned char* L, int unit, bool dry) {
    int tid_ = threadIdx.x; asm volatile("" : "+v"(tid_));
    const int tid = tid_, b = unit >> 4, h = (unit >> 2) & 3, sl = unit & 3;
    const bf16_t* Z = (const bf16_t*)(a.ws + Z_OFF); bf16_t* OB = (bf16_t*)(a.ws + HN_OFF);
    const int vrow = (tid >> 2) & 63, vp = tid & 3;
    f32x4 st[2] = {{0.f, 0.f, 0.f, 0.f}, {0.f, 0.f, 0.f, 0.f}};
    for (int i = tid; i < 32 * 272 / 4; i += NTHREADS) ((LAS unsigned*)(L + LA_ST))[i] = 0u;
    u32x4 pfA[7], pfB[7], vvA, vvB;
#define HG_LOAD(PF, VV, n_) do { const unsigned char* src_ = a.ws + HGT_OFF + (size_t)(((b * NCH + (n_)) * 4) + h) * HGT_ITEM; \
        _Pragma("unroll") for (int k = 0; k < 7; ++k) { const int idx = tid + k * NTHREADS; PF[k] = (u32x4){0u, 0u, 0u, 0u}; if (idx < 3392) PF[k] = *(const u32x4*)(src_ + (size_t)idx * 16); } \
        VV = (u32x4){0u, 0u, 0u, 0u}; \
        if (tid < 256) { const int rv = chunk_row(b, (n_), vrow); if (rv >= 0) VV = *(const u32x4*)(Z + (size_t)rv * IN_CD + 1536 + h * 128 + sl * 32 + vp * 8); } } while (0)
#define HG_STEP(PF, VV, n_) do { \
        _Pragma("unroll") for (int k = 0; k < 7; ++k) { const int idx = tid + k * NTHREADS; \
            if (idx < 2176) *(LAS u32x4*)(L + idx * 16) = PF[k];                                     \
            else if (idx < 3328) *(LAS u32x4*)(L + LA_KT + (idx - 2176) * 16) = PF[k];              \
            else if (idx < 3392) *(LAS u32x4*)(L + LA_DEC + (idx - 3328) * 16) = PF[k]; }           \
        if (tid < 256) { const unsigned va[4] = {VV.x, VV.y, VV.z, VV.w}; \
            _Pragma("unroll") for (int i = 0; i < 8; ++i) *(LAS bf16_t*)(L + LA_VT + (vp * 8 + i) * 144 + vrow * 2) = (bf16_t)((i & 1) ? (va[i >> 1] >> 16) : (va[i >> 1] & 0xffffu)); } \
        if ((n_) + 2 < NCH) HG_LOAD(PF, VV, (n_) + 2); \
        LBAR(); \
        la_core<true>(L, st, 0.f, OB, 512, h * 128 + sl * 32, b, (n_), dry); \
        LBAR(); } while (0)
    HG_LOAD(pfA, vvA, 0);
    HG_LOAD(pfB, vvB, 1);
    for (int n = 0; n < NCH; n += 2) {
        HG_STEP(pfA, vvA, n);
        if (n + 1 < NCH) HG_STEP(pfB, vvB, n + 1);
    }
#undef HG_STEP
#undef HG_LOAD
}

constexpr int LR_XB = 0, LR_XC = 32768, LR_XA = 49152, LR_RG = 58368, RGS = 68  , LR_SEG = LR_RG + 64 * RGS * 4  , LR_END = LR_SEG + 16 * 64 * 4;
__device__ __forceinline__ void lru_unit(const Args& a, LAS unsigned char* L, int unit, bool dry) {
    int tid_ = threadIdx.x; asm volatile("" : "+v"(tid_));
    const int tid = tid_, lane = tid & 63, w = __builtin_amdgcn_readfirstlane(tid >> 6), fr = lane & 15, fq = lane >> 4;
    const int b = unit >> 5, cb = (unit >> 1) & 15, hf = unit & 1;
    bf16_t* Z = (bf16_t*)(a.ws + Z_OFF);
    const int row_l = tid >> 3, c8 = tid & 7;
    const int oc = cb * 64 + hf * 32 + c8 * 4;
    LAS float* XB = (LAS float*)(L + LR_XB); LAS float* XC = (LAS float*)(L + LR_XC); LAS float* RG = (LAS float*)(L + LR_RG);
    float cw[4][8], cbs[8];
#pragma unroll
    for (int i = 0; i < 8; ++i) { const int c = cb * 64 + c8 * 8 + i; cbs[i] = a.in[11][c];
#pragma unroll
        for (int ww = 0; ww < 4; ++ww) cw[ww][i] = a.in[10][ww * 1024 + c]; }
    const int mg = w >> 1, ct = w & 1;
    const int gch = cb * 64 + hf * 32 + ct * 16 + 4 * fq;
    const bf16_t* WG = (const bf16_t*)(a.ws + LRUW_OFF) + (size_t)cb * 128 * 64;
    const int nr_ = hf * 32 + ct * 16 + fr;
    const bf16x8 wr0 = *(const bf16x8*)(WG + nr_ * 64 + fq * 8), wr1 = *(const bf16x8*)(WG + nr_ * 64 + 32 + fq * 8);
    const bf16x8 wi0 = *(const bf16x8*)(WG + (64 + nr_) * 64 + fq * 8), wi1 = *(const bf16x8*)(WG + (64 + nr_) * 64 + 32 + fq * 8);
    const f32x4 bra = *(const f32x4*)(a.in[6] + gch), bia = *(const f32x4*)(a.in[8] + gch);
    float sp[4];
#pragma unroll
    for (int i = 0; i < 4; ++i) sp[i] = log1pf(expf(-a.in[9][gch + i]));
    float hstate = 0.f;
    for (int i = tid; i < 64 * 64; i += NTHREADS) XB[64 * 64 + i] = 0.f;
    u32x4 xbv; u32x2 bgv;
#define LRU_LOAD(n_) do { const int r_ = chunk_row(b, (n_), row_l); \
        if (r_ >= 0) { const bf16_t* zr = Z + (size_t)r_ * IN_AB; xbv = *(const u32x4*)(zr + 2048 + cb * 64 + c8 * 8); bgv = *(const u32x2*)(zr + 4096 + oc); } \
        else { xbv = (u32x4){0u, 0u, 0u, 0u}; bgv = (u32x2){0u, 0u}; } } while (0)
    LRU_LOAD(0);
    for (int n = 0; n < NCH; ++n) {
        const int cur = (n & 1) * 4096, prv = 4096 - cur;
        {
            float xf[8]; UNPK8(xf, xbv);
            *(LAS f32x4*)(XB + cur + row_l * 64 + c8 * 8) = (f32x4){xf[0], xf[1], xf[2], xf[3]}; *(LAS f32x4*)(XB + cur + row_l * 64 + c8 * 8 + 4) = (f32x4){xf[4], xf[5], xf[6], xf[7]};
        }
        const u32x2 bgc = bgv;
        const int grow = chunk_row(b, n, row_l);
        if (n + 1 < NCH) LRU_LOAD(n + 1);
        LBAR();
        {
            float xc[8];
#pragma unroll
            for (int i = 0; i < 8; ++i) xc[i] = cbs[i];
#pragma unroll
            for (int ww = 0; ww < 4; ++ww) {
                const int rr = row_l + ww - 3;
                const LAS float* src = rr >= 0 ? XB + cur + rr * 64 + c8 * 8 : XB + prv + (64 + rr) * 64 + c8 * 8;
                const f32x4 x0 = *(const LAS f32x4*)src, x1 = *(const LAS f32x4*)(src + 4);
                xc[0] += cw[ww][0] * x0[0]; xc[1] += cw[ww][1] * x0[1]; xc[2] += cw[ww][2] * x0[2]; xc[3] += cw[ww][3] * x0[3];
                xc[4] += cw[ww][4] * x1[0]; xc[5] += cw[ww][5] * x1[1]; xc[6] += cw[ww][6] * x1[2]; xc[7] += cw[ww][7] * x1[3];
            }
            *(LAS f32x4*)(XC + row_l * 64 + c8 * 8) = (f32x4){xc[0], xc[1], xc[2], xc[3]}; *(LAS f32x4*)(XC + row_l * 64 + c8 * 8 + 4) = (f32x4){xc[4], xc[5], xc[6], xc[7]};
            u32x4 o; PK8(o, xc);
            *(LAS u32x4*)(L + LR_XA + row_l * 144 + c8 * 16) = o;
        }
        LBAR();
        {
            const bf16x8 x0 = ldsfrag(L + LR_XA + (mg * 16 + fr) * 144 + fq * 16), x1 = ldsfrag(L + LR_XA + (mg * 16 + fr) * 144 + 64 + fq * 16);
            f32x4 ra = {0.f, 0.f, 0.f, 0.f}, ia = {0.f, 0.f, 0.f, 0.f};
            ra = MFMA16(wr0, x0, ra); ia = MFMA16(wi0, x0, ia); ra = MFMA16(wr1, x1, ra); ia = MFMA16(wi1, x1, ia);
            const int jr = mg * 16 + fr;
            const f32x4 x4 = *(const LAS f32x4*)(XC + jr * 64 + hf * 32 + ct * 16 + 4 * fq);
            const bool rvalid = (n > 0) || (jr >= 48);
            f32x4 a4, b4;
#pragma unroll
            for (int i = 0; i < 4; ++i) {
                const float r = sigmoidf_(ra[i] + bra[i]), ig = sigmoidf_(ia[i] + bia[i]);
                const float log_a = -8.f * r * sp[i], x2 = 2.f * log_a, e2 = __expf(x2);
                const float ser = -x2 * (1.f + x2 * (0.5f + x2 * (0.16666667f + x2 * (0.041666668f + x2 * 0.0083333338f))));
                const float om = x2 > -0.25f ? ser : 1.f - e2;
                a4[i] = rvalid ? __expf(log_a) : 1.f; b4[i] = rvalid ? sqrtf(fmaxf(om, 0.f)) * (ig * x4[i]) : 0.f;
            }
            *(LAS f32x4*)(RG + jr * RGS + ct * 16 + 4 * fq) = a4; *(LAS f32x4*)(RG + jr * RGS + 32 + ct * 16 + 4 * fq) = b4;
        }
        LBAR();
        {
            LAS float* SEG = (LAS float*)(L + LR_SEG);
            const int sg = w * 2 + (lane >> 5), ch = lane & 31;
            float sa[4], sb[4];
            {
                float P = 1.f, hh = 0.f;
#pragma unroll
                for (int i = 0; i < 4; ++i) { sa[i] = RG[(sg * 4 + i) * RGS + ch]; sb[i] = RG[(sg * 4 + i) * RGS + 32 + ch]; hh = sa[i] * hh + sb[i]; P *= sa[i]; }
                SEG[sg * 64 + ch] = P; SEG[sg * 64 + 32 + ch] = hh;
            }
            LBAR();
            float c = hstate, mine = 0.f;
#pragma unroll
            for (int s2 = 0; s2 < 16; ++s2) { mine = (s2 == sg) ? c : mine; c = SEG[s2 * 64 + ch] * c + SEG[s2 * 64 + 32 + ch]; }
            hstate = c;
            float hh = mine;
#pragma unroll
            for (int i = 0; i < 4; ++i) { hh = sa[i] * hh + sb[i]; RG[(sg * 4 + i) * RGS + 32 + ch] = hh; }
        }
        LBAR();
        if (grow >= 0 && !dry) {
            const f32x4 h4 = *(const LAS f32x4*)(RG + row_l * RGS + 32 + c8 * 4);
            u32x2 o; o.x = cvt_pk_bf16(gelu_tanh(bf_lo(bgc.x)) * h4[0], gelu_tanh(bf_hi(bgc.x)) * h4[1]); o.y = cvt_pk_bf16(gelu_tanh(bf_lo(bgc.y)) * h4[2], gelu_tanh(bf_hi(bgc.y)) * h4[3]);
            if (grow < RM) *(u32x2*)(Z + (size_t)grow * IN_AB + 4096 + oc) = o;
            else if (b == 0) *(u32x2*)((bf16_t*)(a.ws + YAB_OFF) + (size_t)(grow - RM) * 2048 + 1024 + oc) = o;
        }
    }
    LBAR();
#undef LRU_LOAD
}

constexpr int S5_ROWS = 128, S5_NIT = 33;
constexpr int S5_BU = 0, BUS = 132  , S5_HS = S5_ROWS * BUS * 4, S5_EX = S5_HS + S5_ROWS * 272  , S5_END = S5_EX + 8 * 128 * 4;
static_assert(S5_END <= LDS_BYTES - 16, "S5 lds");
__device__ __forceinline__ int sc_row(int b, int s, int j) { const int n = 2 * s - 1 + (j >> 6); return n < 0 ? -1 : chunk_row(b, n, j & 63); }
__device__ __forceinline__ void s5_unit(const Args& a, LAS unsigned char* L, int unit, bool dry) {
    int tid_ = threadIdx.x; asm volatile("" : "+v"(tid_));
    const int tid = tid_, lane = tid & 63, w = __builtin_amdgcn_readfirstlane(tid >> 6), fr = lane & 15, fq = lane >> 4;
    const int b = unit >> 5, g = unit & 31;
    bf16_t* Z = (bf16_t*)(a.ws + Z_OFF);
    const bf16_t* BB = (const bf16_t*)(a.ws + S5BB_OFF) + (size_t)g * 128 * 32;
    const bf16_t* CM = (const bf16_t*)(a.ws + S5CM_OFF) + (size_t)g * 16 * 128;
    const float* AB = (const float*)(a.ws + S5AB_OFF) + (size_t)g * 128;
    const bf16x8 bbf = *(const bf16x8*)(BB + (w * 16 + fr) * 32 + fq * 8);
    bf16x8 cmf[4];
#pragma unroll
    for (int kk = 0; kk < 4; ++kk) cmf[kk] = *(const bf16x8*)(CM + fr * 128 + kk * 32 + fq * 8);
    const float ar = AB[2 * lane], ai = AB[2 * lane + 1];
    const f32x4 dv = *(const f32x4*)(a.in[20] + g * 16 + 4 * fq);
    float hr = 0.f, hi = 0.f;
    LAS float* BU = (LAS float*)(L + S5_BU); LAS float* EX = (LAS float*)(L + S5_EX);
    float p16r, p16i;
    { float pr = ar, pi = ai;
#pragma unroll
      for (int i = 0; i < 4; ++i) { const float nr = pr * pr - pi * pi, ni = 2.f * pr * pi; pr = nr; pi = ni; }
      p16r = pr; p16i = pi; }
    bf16x8 uf[8]; u32x2 uvn = {0u, 0u};
#define S5_LOAD(s_) do { _Pragma("unroll") for (int m = 0; m < 8; ++m) { const int r_ = sc_row(b, (s_), m * 16 + fr); \
            uf[m] = (bf16x8){0, 0, 0, 0, 0, 0, 0, 0}; \
            if (r_ >= 0 && fq < 2) uf[m] = *(const bf16x8*)(Z + (size_t)r_ * IN_CD + g * 16 + fq * 8); } \
        { const int r2_ = sc_row(b, (s_), w * 16 + fr); uvn = (u32x2){0u, 0u}; if (r2_ >= 0) uvn = *(const u32x2*)(Z + (size_t)r2_ * IN_CD + g * 16 + 4 * fq); } } while (0)
    S5_LOAD(0);
    for (int sI = 0; sI < S5_NIT; ++sI) {
#pragma unroll
        for (int m = 0; m < 8; ++m) { f32x4 acc = {0.f, 0.f, 0.f, 0.f}; acc = MFMA16(bbf, uf[m], acc);
            *(LAS f32x4*)(BU + (m * 16 + fr) * BUS + w * 16 + 4 * fq) = acc; }
        const u32x2 uv = uvn;
        if (sI + 1 < S5_NIT) S5_LOAD(sI + 1);
        LBAR();
        {
            float cr = 0.f, ci = 0.f;
#pragma unroll
            for (int i = 0; i < 16; ++i) {
                const float br = BU[(16 * w + i) * BUS + lane], bi = BU[(16 * w + i) * BUS + 64 + lane];
                const float nr = ar * cr - ai * ci + br, ni = ar * ci + ai * cr + bi;
                cr = nr; ci = ni;
            }
            EX[w * 128 + lane] = cr; EX[w * 128 + 64 + lane] = ci;
        }
        LBAR();
        {
            float cr = hr, ci = hi, mr = 0.f, mi = 0.f;
#pragma unroll
            for (int ww = 0; ww < 8; ++ww) {
                if (ww == w) { mr = cr; mi = ci; }
                const float er = EX[ww * 128 + lane], ei = EX[ww * 128 + 64 + lane];
                const float nr = p16r * cr - p16i * ci + er, ni = p16r * ci + p16i * cr + ei;
                cr = nr; ci = ni;
            }
            hr = cr; hi = ci;
#pragma unroll
            for (int i = 0; i < 16; ++i) {
                const float br = BU[(16 * w + i) * BUS + lane], bi = BU[(16 * w + i) * BUS + 64 + lane];
                const float nr = ar * mr - ai * mi + br, ni = ar * mi + ai * mr + bi;
                mr = nr; mi = ni;
                *(LAS bf16_t*)(L + S5_HS + (16 * w + i) * 272 + lane * 2) = f2bf(mr);
                *(LAS bf16_t*)(L + S5_HS + (16 * w + i) * 272 + 128 + lane * 2) = f2bf(mi);
            }
        }
        LBAR();
        {
            f32x4 acc = {0.f, 0.f, 0.f, 0.f};
#pragma unroll
            for (int kk = 0; kk < 4; ++kk) acc = MFMA16(cmf[kk], ldsfrag(L + S5_HS + (w * 16 + fr) * 272 + kk * 64 + fq * 16), acc);
            const int r = sc_row(b, sI, w * 16 + fr);
            if (r >= 0 && !dry) {
                bf16_t* up = Z + (size_t)r * IN_CD + g * 16 + 4 * fq;
                const float y0 = gelu_tanh(acc[0] + dv[0] * bf_lo(uv.x)), y1 = gelu_tanh(acc[1] + dv[1] * bf_hi(uv.x));
                const float y2 = gelu_tanh(acc[2] + dv[2] * bf_lo(uv.y)), y3 = gelu_tanh(acc[3] + dv[3] * bf_hi(uv.y));
                u32x2 o; o.x = cvt_pk_bf16(y0, y1); o.y = cvt_pk_bf16(y2, y3);
                if (r < RM) *(u32x2*)up = o; else if (b == 0) *(u32x2*)((bf16_t*)(a.ws + YM_OFF) + (size_t)(r - RM) * 512 + g * 16 + 4 * fq) = o;
            }
        }
    }
    LBAR();
#undef S5_LOAD
}

__device__ __forceinline__ void phase_ret_post(const Args& a) {
    int tid_ = threadIdx.x; asm volatile("" : "+v"(tid_));
    const int tid = tid_, lane = tid & 63, wave = tid >> 6;
    const int gw = blockIdx.x * 8 + wave, NGW = gridDim.x * 8;
    bf16_t* Z = (bf16_t*)(a.ws + Z_OFF); const bf16_t* OB = (const bf16_t*)(a.ws + HN_OFF); const float* gn = a.in[4];
    for (int row = gw; row < RVALID; row += NGW) {
        u32x2 ov[4], gv[4]; f32x4 gg[4];
#pragma unroll
        for (int h = 0; h < 4; ++h) {
            ov[h] = *(const u32x2*)(OB + (size_t)row * DM + h * 256 + 4 * lane);
            gv[h] = *(const u32x2*)(Z + (size_t)row * IN_AB + 3072 + h * 256 + 4 * lane);
            gg[h] = *(const f32x4*)(gn + h * 256 + 4 * lane);
        }
#pragma unroll
        for (int h = 0; h < 4; ++h) {
            float o0 = bf_lo(ov[h].x), o1 = bf_hi(ov[h].x), o2 = bf_lo(ov[h].y), o3 = bf_hi(ov[h].y);
            const float mean = wave_sum((o0 + o1) + (o2 + o3)) * (1.f / 256.f);
            o0 -= mean; o1 -= mean; o2 -= mean; o3 -= mean;
            const float inv = rsqrtf(wave_sum(o0 * o0 + o1 * o1 + o2 * o2 + o3 * o3) * (1.f / 256.f) + EPS);
            u32x2 y; y.x = cvt_pk_bf16(o0 * inv * gg[h][0] * silu_(bf_lo(gv[h].x)), o1 * inv * gg[h][1] * silu_(bf_hi(gv[h].x)));
            y.y = cvt_pk_bf16(o2 * inv * gg[h][2] * silu_(bf_lo(gv[h].y)), o3 * inv * gg[h][3] * silu_(bf_hi(gv[h].y)));
            if (row < RM) *(u32x2*)(Z + (size_t)row * IN_AB + 3072 + h * 256 + 4 * lane) = y;
            else *(u32x2*)((bf16_t*)(a.ws + YAB_OFF) + (size_t)(row - RM) * 2048 + h * 256 + 4 * lane) = y;
        }
    }
}
__device__ __forceinline__ void phase_hg_post(const Args& a) {
    int tid_ = threadIdx.x; asm volatile("" : "+v"(tid_));
    const int tid = tid_, lane = tid & 63, wave = tid >> 6;
    const int gw = blockIdx.x * 8 + wave, NGW = gridDim.x * 8;
    bf16_t* Z = (bf16_t*)(a.ws + Z_OFF); const bf16_t* OB = (const bf16_t*)(a.ws + HN_OFF); const float* gn = a.in[24];
    for (int row = gw; row < RVALID; row += NGW) {
        unsigned ov[4], gv[4]; f32x2 gg[4];
#pragma unroll
        for (int h = 0; h < 4; ++h) {
            ov[h] = *(const unsigned*)(OB + (size_t)row * 512 + h * 128 + 2 * lane);
            gv[h] = *(const unsigned*)(Z + (size_t)row * IN_CD + 2048 + h * 128 + 2 * lane);
            gg[h] = *(const f32x2*)(gn + h * 128 + 2 * lane);
        }
#pragma unroll
        for (int h = 0; h < 4; ++h) {
            const float o0 = bf_lo(ov[h]), o1 = bf_hi(ov[h]);
            const float inv = rsqrtf(wave_sum(o0 * o0 + o1 * o1) * (1.f / 128.f) + EPS);
            const unsigned yv = cvt_pk_bf16(o0 * inv * gg[h][0] * silu_(bf_lo(gv[h])), o1 * inv * gg[h][1] * silu_(bf_hi(gv[h])));
            if (row < RM) *(unsigned*)(Z + (size_t)row * IN_CD + 2048 + h * 128 + 2 * lane) = yv;
            else *(unsigned*)((bf16_t*)(a.ws + YCD_OFF) + (size_t)(row - RM) * 1024 + 512 + h * 128 + 2 * lane) = yv;
        }
    }
}

#define XB_TMO      128
#define XB_XCNT(j)  (256  + 64 * (j))
#define XB_XSUB(j)  (1280 + 64 * (j))
#define XB_XGEN(j)  (2304 + 64 * (j))
#define XB_TOP      3328
#define XB_TOPGEN   3392
#define XCD_BAR_WORDS 3456
#define XB_SPIN_CAP (1u << 18)

__device__ __forceinline__ unsigned xb_ld(unsigned* p)              { return __hip_atomic_load(p, __ATOMIC_RELAXED, __HIP_MEMORY_SCOPE_AGENT); }
__device__ __forceinline__ unsigned xb_add(unsigned* p, unsigned v) { return __hip_atomic_fetch_add(p, v, __ATOMIC_RELAXED, __HIP_MEMORY_SCOPE_AGENT); }
__device__ __forceinline__ unsigned xb_xcc_id() { return (unsigned)__builtin_amdgcn_s_getreg((3 << 11) | 20) & 0xFu; }
#define XB_SPIN(cond, bar) do { unsigned _sp = 0; while (cond) { __builtin_amdgcn_s_sleep(1); \
    if ((++_sp & 255u) == 0u) { if (xb_ld(&(bar)[XB_TMO])) break; if (_sp > XB_SPIN_CAP) { atomicAdd(&(bar)[XB_TMO], 1u); break; } } } } while (0)

struct XcdBarrier {
    unsigned* bar; unsigned x;
    volatile LAS unsigned* st;
};

__device__ __forceinline__ XcdBarrier xcd_barrier_post(unsigned* bar, volatile LAS unsigned* st) {
    XcdBarrier b; b.bar = bar; b.x = xb_xcc_id(); b.st = st;
    if (threadIdx.x == 0) (void)xb_add(&bar[XB_XCNT(b.x)], 1u);
    return b;
}
__device__ __forceinline__ void xcd_barrier_complete(unsigned* bar, unsigned x, unsigned& nloc, unsigned& nx) {
    const unsigned G = gridDim.x * gridDim.y * gridDim.z;
    unsigned sum, cnt, mine, sp = 0u;
    for (;;) {
        sum = 0u; cnt = 0u; mine = 0u;
#pragma unroll
        for (unsigned j = 0; j < 16; ++j) { const unsigned c = xb_ld(&bar[XB_XCNT(j)]); sum += c; cnt += (c > 0u) ? 1u : 0u; mine = (j == x) ? c : mine; }
        if (sum == G) break;
        __builtin_amdgcn_s_sleep(1);
        if ((++sp & 255u) == 0u) { if (xb_ld(&bar[XB_TMO])) break; if (sp > XB_SPIN_CAP) { atomicAdd(&bar[XB_TMO], 1u); break; } }
    }
    nloc = mine > 0u ? mine : 1u; nx = cnt > 0u ? cnt : 1u;
}

__device__ __forceinline__ void xcd_barrier(const XcdBarrier& b) {
    asm volatile("s_waitcnt vmcnt(0)" ::: "memory");
    __syncthreads();
    if (threadIdx.x == 0) {
        unsigned* bar = b.bar;
        __builtin_amdgcn_s_waitcnt(0);
        unsigned nloc = b.st[0], nx = b.st[1];
        if (nloc == 0u) { xcd_barrier_complete(bar, b.x, nloc, nx); b.st[0] = nloc; b.st[1] = nx; }
        const unsigned old = xb_add(&bar[XB_XSUB(b.x)], 1u);
        const unsigned gen = old / nloc;
        if (old + 1u == (gen + 1u) * nloc) {
            __builtin_amdgcn_fence(__ATOMIC_RELEASE, "agent");
            asm volatile("s_waitcnt vmcnt(0)" ::: "memory");
            const unsigned og = xb_add(&bar[XB_TOP], 1u);
            const unsigned tg = og / nx;
            if (og + 1u == (tg + 1u) * nx) xb_add(&bar[XB_TOPGEN], 1u);
            else XB_SPIN(xb_ld(&bar[XB_TOPGEN]) == tg, bar);
            __builtin_amdgcn_fence(__ATOMIC_ACQUIRE, "agent");
            xb_add(&bar[XB_XGEN(b.x)], 1u);
            asm volatile("s_waitcnt vmcnt(0)" ::: "memory");
        } else {
            XB_SPIN(xb_ld(&bar[XB_XGEN(b.x)]) == gen, bar);
            __builtin_amdgcn_fence(__ATOMIC_ACQUIRE, "agent");
            asm volatile("s_waitcnt vmcnt(0)" ::: "memory");
        }
    }
    __syncthreads();
}


#ifndef DBG_STOP
#define DBG_STOP 0
#endif
__device__ __forceinline__ void dbg_digest(const Args& a) {
    const size_t gt = (size_t)blockIdx.x * NTHREADS + threadIdx.x, NGT = (size_t)gridDim.x * NTHREADS;
    const bf16_t* zb = (const bf16_t*)(a.ws + Z_OFF);
    const size_t NE = ((size_t)R * 5120 + (size_t)R * 1024);
    const size_t ON = (size_t)RM * DM;
    for (size_t i = gt; i < ON; i += NGT) {
        float s = 0.f;
        for (size_t k = i; k < NE; k += ON) s += __uint_as_float((unsigned)zb[k] << 16);
        a.out[i] = a.out[i] * 1e-3f + s;
    }
}
#ifndef DBG_REP34
#define DBG_REP34 0
#endif
#ifndef DBG_REPG
#define DBG_REPG 0
#endif
#ifndef DBG_SYNC2
#define DBG_SYNC2 0
#endif
#ifndef DBG_TIME
#define DBG_TIME 0
#endif
#define GSYNC() xcd_barrier(xbar)
#define DBG_CHECK(k) do { if (DBG_STOP == (k)) { grid.sync(); dbg_digest(a); return; } \
    if (DBG_TIME) { if ((k) == DBG_TIME - 1) dbg_t0 = __builtin_amdgcn_s_memrealtime(); if ((k) == DBG_TIME) dbg_t1 = __builtin_amdgcn_s_memrealtime(); } } while (0)
__global__ void __launch_bounds__(NTHREADS, 2) fwd_megakernel(Args a) {
    extern __shared__ __attribute__((aligned(16))) unsigned char lds_raw[];
    LAS unsigned char* L = (LAS unsigned char*)lds_raw;
    cg::grid_group grid = cg::this_grid();
    unsigned char* ws = a.ws;
    const int G = gridDim.x, bx = blockIdx.x;
    bf16_t* Zb = (bf16_t*)(ws + Z_OFF); bf16_t* HNb = (bf16_t*)(ws + HN_OFF); float* ssq = (float*)(ws + SSQ_OFF);
    bf16_t* YABb = (bf16_t*)(ws + YAB_OFF); bf16_t* YCDb = (bf16_t*)(ws + YCD_OFF); bf16_t* YMb = (bf16_t*)(ws + YM_OFF);
    float* hmeta = (float*)(ws + HMETA_OFF);
    const float* ng = a.in[26];
    const bool fusedres = (G == 256);

    if (threadIdx.x < 4) ((LAS unsigned*)(L + LDS_BYTES - 16))[threadIdx.x] = 0u;
    __syncthreads();
    const XcdBarrier xbar = xcd_barrier_post((unsigned*)(ws + BAR_OFF), (volatile LAS unsigned*)(L + LDS_BYTES - 16));
    if (a.never) grid.sync();
    phase_prologue(a, L, !fusedres);
    GSYNC();

#define GEMM_PHASE(MODE, Ap, lda_, Wp, N_, K_, Op, ldo_, Yp, ldy_, biasp, AMp, ldam_, OMp, ldom_, YMp, ldym_) do { \
        pg8::Gemm g{(Ap), (Wp), RM, (N_), (K_), (lda_)}; pg8::StaticOrder S; S.init(RM, (N_), G, bx); \
        pg8::Epi<MODE> E{(Op), (ldo_), nullptr, (Yp), (ldy_), (biasp)}; \
        pg8::gemm_phase(L, g, S, E); \
        meta_gemm<MODE, 4, ((K_) >= 1024 ? 4 : 2)>(L, (AMp), (ldam_), (Wp), (N_), (K_), (OMp), (ldom_), nullptr, (YMp), (ldym_), (biasp)); } while (0)
#define RES_PHASE(P, HIN, Ap, lda_, Wp, K_, AMp, ldam_, g1_, g2_) do { \
        pg8::Gemm g{(Ap), (Wp), RM, DM, (K_), (lda_)}; pg8::StaticOrder S; S.init(RM, DM, G, bx); \
        if (fusedres) { \
            float* x1 = (float*)(ws + XB_OFF + (size_t)((P) * 2) * XB_STRIDE); float* x2 = (float*)(ws + XB_OFF + (size_t)((P) * 2 + 1) * XB_STRIDE); \
            unsigned* c1 = (unsigned*)(ws + CNT_OFF) + ((P) * 2) * 80 * 32; unsigned* c2 = (unsigned*)(ws + CNT_OFF) + ((P) * 2 + 1) * 80 * 32; \
            pg8::EpiRes E{(HIN), a.out, (g1_), (g2_), HNb, x1, x2, c1, c2}; \
            pg8::gemm_phase(L, g, S, E); \
            meta_gemm<4, 1, ((K_) >= 2048 ? 8 : 4)>(L, (AMp), (ldam_), (Wp), DM, (K_), HNb + (size_t)RM * DM, DM, nullptr, nullptr, 0, nullptr, hmeta, (g1_), (g2_), x1 + 64 * 256 * 4, x2 + 64 * 256 * 4, c1 + 64 * 32, c2 + 64 * 32); \
            GSYNC(); \
        } else { \
            pg8::Epi<1> E{HNb, DM, ssq, nullptr, 0, nullptr}; \
            pg8::gemm_phase(L, g, S, E); \
            meta_gemm<1, 4, 4>(L, (AMp), (ldam_), (Wp), DM, (K_), HNb + (size_t)RM * DM, DM, ssq + (size_t)RM * 16, nullptr, 0, nullptr); \
            GSYNC(); \
            phase_resnorm(a, (g1_), (g2_)); \
            GSYNC(); \
        } } while (0)

    {
        const bf16_t* W = (const bf16_t*)(ws + W_INAB);
        GEMM_PHASE(0, HNb, DM, W, IN_AB, DM, Zb, IN_AB, nullptr, 0, nullptr, HNb + (size_t)RM * DM, DM, Zb + (size_t)RM * IN_AB, IN_AB, nullptr, 0);
    }
    GSYNC();
    for (int u = bx; u < 128 + 128; u += G) { if (u < 128) retention_unit(a, L, u, false); else lru_unit(a, L, u - 128, false); }
    GSYNC();
    phase_ret_post(a);
    GSYNC();
    {
        const bf16_t* W = (const bf16_t*)(ws + W_OUTAB);
        RES_PHASE(0, (fusedres ? a.in[0] : (const float*)a.out), Zb + 3072, IN_AB, W, 2048, YABb, 2048, ng + 1 * DM, ng + 2 * DM);
    }
    {
        const bf16_t* W = (const bf16_t*)(ws + W_W1_0);
        GEMM_PHASE(2, HNb, DM, W, FF, DM, Zb, FF, nullptr, 0, nullptr, HNb + (size_t)RM * DM, DM, Zb + (size_t)RM * FF, FF, nullptr, 0);
    }
    GSYNC();
    {
        const bf16_t* W = (const bf16_t*)(ws + W_W2_0);
        RES_PHASE(1, (const float*)a.out, Zb, FF, W, FF, Zb + (size_t)RM * FF, FF, ng + 3 * DM, ng + 4 * DM);
    }

    {
        const bf16_t* W = (const bf16_t*)(ws + W_INCD);
        GEMM_PHASE(0, HNb, DM, W, IN_CD, DM, Zb, IN_CD, nullptr, 0, nullptr, HNb + (size_t)RM * DM, DM, Zb + (size_t)RM * IN_CD, IN_CD, nullptr, 0);
    }
    GSYNC();
    hgrn_prepass(a, L);
    GSYNC();
    for (int u = bx; u < 64 + 128; u += G) { if (u < 64) hgrn_unit(a, L, u, false); else s5_unit(a, L, u - 64, false); }
    if (G == 256) { if (bx >= 192) weight_convert(a, L, WC_C5, WC_C9, bx - 192, 64); }
    else weight_convert(a, L, WC_C5, WC_C9, bx, G);
    GSYNC();
    phase_hg_post(a);
    {
        const bf16_t* W = (const bf16_t*)(ws + W_GLU);
        GEMM_PHASE(3, Zb, IN_CD, W, 512, 512, Zb + 1536, IN_CD, Zb, IN_CD, a.in[23], YMb, 512, YCDb, 1024, YMb, 512);
    }
    GSYNC();
    {
        const bf16_t* W = (const bf16_t*)(ws + W_OUTCD);
        RES_PHASE(2, (const float*)a.out, Zb + 1536, IN_CD, W, DM, YCDb, 1024, ng + 5 * DM, ng + 6 * DM);
    }
    {
        const bf16_t* W = (const bf16_t*)(ws + W_W1_1);
        GEMM_PHASE(2, HNb, DM, W, FF, DM, Zb, FF, nullptr, 0, nullptr, HNb + (size_t)RM * DM, DM, Zb + (size_t)RM * FF, FF, nullptr, 0);
    }
    GSYNC();
    {
        const bf16_t* W = (const bf16_t*)(ws + W_W2_1);
        pg8::Gemm g{Zb, W, RM, DM, FF, FF}; pg8::StaticOrder S; S.init(RM, DM, G, bx);
        if (fusedres) {
            float* x1 = (float*)(ws + XB_OFF + (size_t)6 * XB_STRIDE); unsigned* c1 = (unsigned*)(ws + CNT_OFF) + 6 * 80 * 32;
            pg8::EpiRes E{(const float*)a.out, a.out, ng + 7 * DM, nullptr, HNb, x1, x1, c1, c1};
            pg8::gemm_phase(L, g, S, E);
            meta_gemm<4, 1, 8>(L, Zb + (size_t)RM * FF, FF, W, DM, FF, HNb + (size_t)RM * DM, DM, nullptr, nullptr, 0, nullptr, hmeta, ng + 7 * DM, nullptr, x1 + 64 * 256 * 4, x1 + 64 * 256 * 4, c1 + 64 * 32, c1 + 64 * 32);
        } else {
            pg8::Epi<1> E{HNb, DM, ssq, nullptr, 0, nullptr};
            pg8::gemm_phase(L, g, S, E);
            meta_gemm<1, 4, 4>(L, Zb + (size_t)RM * FF, FF, W, DM, FF, HNb + (size_t)RM * DM, DM, ssq + (size_t)RM * 16, nullptr, 0, nullptr);
            GSYNC();
            phase_resnorm(a, ng + 7 * DM, nullptr);
        }
    }
#undef GEMM_PHASE
#undef RES_PHASE
}

extern "C" void kernel_launch(void* const* d_in, const int* in_sizes, int n_in, void* d_out, int out_size, void* d_ws, size_t ws_size, hipStream_t stream) {
    static int grid = 0;
    if (!grid) {
        int dev = 0, cus = 0, per_cu = 0;
        (void)hipGetDevice(&dev);
        (void)hipDeviceGetAttribute(&cus, hipDeviceAttributeMultiprocessorCount, dev);
        (void)hipFuncSetAttribute((const void*)fwd_megakernel, hipFuncAttributeMaxDynamicSharedMemorySize, LDS_BYTES);
        (void)hipOccupancyMaxActiveBlocksPerMultiprocessor(&per_cu, (const void*)fwd_megakernel, NTHREADS, LDS_BYTES);
        if (per_cu < 1) per_cu = 1;
        grid = cus * per_cu;
        if (n_in != 29 || ws_size < WS_END) fprintf(stderr, "kernel_launch: unexpected n_in %d / ws %zu (need %zu)\n", n_in, ws_size, (size_t)WS_END);
    }
    Args a{};
    for (int i = 0; i < 29; ++i) a.in[i] = (const float*)d_in[i];
    a.out = (float*)d_out; a.ws = (unsigned char*)d_ws; a.never = 0;
    (void)hipMemsetAsync((unsigned char*)d_ws + BAR_OFF, 0, (size_t)(XB_OFF - BAR_OFF), stream);
    void* args[] = {&a};
    hipError_t e = hipLaunchCooperativeKernel((void*)fwd_megakernel, dim3(grid), dim3(NTHREADS), args, LDS_BYTES, stream);
    if (e != hipSuccess) fprintf(stderr, "cooperative launch failed: %s (grid %d)\n", hipGetErrorString(e), grid);
}
```

```cpp
#include <hip/hip_runtime.h>
#include <hip/hip_cooperative_groups.h>
#include <cstdio>
#include <cstdint>
namespace cg = cooperative_groups;

#define LAS __attribute__((address_space(3)))
typedef unsigned short bf16_t;
typedef short bf16x8 __attribute__((ext_vector_type(8)));
typedef float f32x4 __attribute__((ext_vector_type(4)));
typedef float f32x2 __attribute__((ext_vector_type(2)));
typedef unsigned u32x4 __attribute__((ext_vector_type(4)));
typedef unsigned u32x2 __attribute__((ext_vector_type(2)));

constexpr int DM = 1024, NB = 4, SEQ = 4096, NMETA = 16, FF = 4096;
constexpr int RM = NB * SEQ;
constexpr int RMETA = RM;
constexpr int RVALID = RM + NMETA;
constexpr int R = RVALID;
constexpr int NCH = 65;
constexpr int IN_AB = 5120, IN_CD = 2560;
constexpr float EPS = 1e-6f;
constexpr int NTHREADS = 512;
constexpr int LDS_BYTES = 147456;

constexpr size_t W_INAB = 0;
constexpr size_t W_OUTAB = W_INAB + (size_t)5120 * 1024 * 2;
constexpr size_t W_W1_0 = W_OUTAB + (size_t)1024 * 2048 * 2;
constexpr size_t W_W2_0 = W_W1_0 + (size_t)4096 * 1024 * 2;
constexpr size_t W_INCD = W_W2_0 + (size_t)4096 * 1024 * 2;
constexpr size_t W_OUTCD = W_INCD + (size_t)2560 * 1024 * 2;
constexpr size_t W_GLU = W_OUTCD + (size_t)1024 * 1024 * 2;
constexpr size_t W_W1_1 = W_GLU + (size_t)512 * 512 * 2;
constexpr size_t W_W2_1 = W_W1_1 + (size_t)4096 * 1024 * 2;
constexpr size_t W_END = W_W2_1 + (size_t)4096 * 1024 * 2;
constexpr size_t Z_OFF = W_END;
constexpr size_t HN_OFF = Z_OFF + (size_t)R * 5120 * 2;
constexpr size_t SM_OFF = HN_OFF + (size_t)R * 1024 * 2;
constexpr size_t HMETA_OFF = SM_OFF;
constexpr size_t YAB_OFF = HMETA_OFF + (size_t)16 * 1024 * 4;
constexpr size_t YCD_OFF = YAB_OFF + (size_t)16 * 2048 * 2;
constexpr size_t YM_OFF = YCD_OFF + (size_t)16 * 1024 * 2;
constexpr size_t SSQ_OFF = YM_OFF + (size_t)16 * 512 * 2;
constexpr size_t LRUW_OFF = SSQ_OFF + (size_t)R * 16 * 4;
constexpr size_t S5BB_OFF = LRUW_OFF + (size_t)16 * 128 * 64 * 2;
constexpr size_t S5CM_OFF = S5BB_OFF + (size_t)32 * 128 * 32 * 2;
constexpr size_t S5AB_OFF = S5CM_OFF + (size_t)32 * 16 * 128 * 2;
constexpr size_t BAR_OFF = S5AB_OFF + (size_t)32 * 64 * 2 * 4;
constexpr size_t CNT_OFF = BAR_OFF + 16384;
constexpr size_t XB_OFF = CNT_OFF + (size_t)8 * 80 * 32 * 4;
constexpr size_t XB_STRIDE = (size_t)64 * 256 * 4 * 4 + 4096;
constexpr size_t WS_END = XB_OFF + 8 * XB_STRIDE;
static_assert(WS_END <= (size_t)268435456, "workspace map");

struct Args {
    const float* in[29];
    float* out;
    unsigned char* ws;
    long long never;
};

typedef __bf16 bf16x2_t __attribute__((ext_vector_type(2)));
__device__ __forceinline__ unsigned cvt_pk_bf16(float lo, float hi) { f32x2 v = {lo, hi}; bf16x2_t b = __builtin_convertvector(v, bf16x2_t); return __builtin_bit_cast(unsigned, b); }
__device__ __forceinline__ float bf_lo(unsigned u) { return __uint_as_float(u << 16); }
__device__ __forceinline__ float bf_hi(unsigned u) { return __uint_as_float(u & 0xffff0000u); }
__device__ __forceinline__ bf16_t f2bf(float f) { return (bf16_t)(cvt_pk_bf16(f, 0.f) & 0xffffu); }
__device__ __forceinline__ float wave_sum(float v) {
#pragma unroll
    for (int o = 1; o < 64; o <<= 1) v += __shfl_xor(v, o);
    return v;
}
__device__ __forceinline__ float sigmoidf_(float x) { return 1.f / (1.f + __expf(-x)); }
__device__ __forceinline__ float gelu_tanh(float x) {
    const float u = 0.7978845608028654f * (x + 0.044715f * x * x * x);
    const float e = __expf(2.f * u);
    const float t = 1.f - 2.f / (e + 1.f);
    return 0.5f * x * (1.f + t);
}
__device__ __forceinline__ float silu_(float x) { return x * sigmoidf_(x); }
__device__ __forceinline__ void sincos_big(float ang, float& s, float& c) {
    double t = (double)ang * 0.15915494309189535;
    t -= rint(t);
    const float fr = (float)t;
    s = __builtin_amdgcn_sinf(fr); c = __builtin_amdgcn_cosf(fr);
}
__device__ __forceinline__ void st_agent(float* p, float v) { __hip_atomic_store(p, v, __ATOMIC_RELAXED, __HIP_MEMORY_SCOPE_AGENT); }
__device__ __forceinline__ float ld_agent(const float* p) { return __hip_atomic_load(p, __ATOMIC_RELAXED, __HIP_MEMORY_SCOPE_AGENT); }
__device__ __forceinline__ void cnt_arrive_wait(unsigned* c, unsigned target) {
    __hip_atomic_fetch_add(c, 1u, __ATOMIC_RELAXED, __HIP_MEMORY_SCOPE_AGENT);
    unsigned sp = 0;
    while (__hip_atomic_load(c, __ATOMIC_RELAXED, __HIP_MEMORY_SCOPE_AGENT) < target) { __builtin_amdgcn_s_sleep(1); if (++sp > (1u << 22)) break; }
}
__device__ __forceinline__ float* hrow(const Args& a, int row) {
    return row < RM ? a.out + (size_t)row * DM : (float*)(a.ws + HMETA_OFF) + (size_t)(row - RM) * DM;
}
__device__ __forceinline__ int chunk_row(int b, int n, int j) {
    if (n == 0) return j >= 48 ? RMETA + (j - 48) : -1;
    return b * SEQ + (n - 1) * 64 + j;
}

namespace pg8 {
constexpr int BM = 256, BK = 64, HALF = 128, HTB = HALF * BK * 2, NXCD = 8, WGM = 8;
__device__ __forceinline__ int lds_byte(int r, int c) { const int st = (r >> 4) * 2 + (c >> 5), rr = r & 15, cc = c & 31, ob = rr * 64 + cc * 2; return st * 1024 + (ob ^ (((ob >> 9) & 1) << 5)); }
__device__ __forceinline__ void stage_rc(int b, int& Rr, int& C) { const int st = b / 1024, sb = b % 1024, swz = sb ^ (((sb >> 9) & 1) << 5); Rr = (st >> 1) * 16 + swz / 64; C = (st & 1) * 32 + (swz % 64) / 2; }
__device__ __forceinline__ int perm32(int rho) { const int n = rho >> 4, i = rho & 15; return 8 * (i >> 2) + 4 * n + (i & 3); }
struct Unit { int pm, pn; };
struct Gemm { const bf16_t* A; const bf16_t* Bt; int M, N, K, lda; };
struct StaticOrder {
    int nM, nN, nwg, G, c;
    __device__ void init(int M, int N, int G_, int c_) { nM = M / BM; nN = N / BM; nwg = nM * nN; G = G_; c = c_; }
    __device__ bool next(int i, Unit& u) const {
        const long L = (long)i * G + c; if (L >= nwg) return false;
        int wgid = (int)L; { const int q = nwg / NXCD, r = nwg % NXCD, xcd = wgid % NXCD, off = wgid / NXCD; wgid = (xcd < r ? xcd * (q + 1) : r * (q + 1) + (xcd - r) * q) + off; }
        const int nig = WGM * nN, gid = wgid / nig, fm = gid * WGM, gsz = (nM - fm) < WGM ? (nM - fm) : WGM;
        u.pm = fm + ((wgid % nig) % gsz); u.pn = (wgid % nig) / gsz; return true;
    }
};
template <class Epi>
__device__ __forceinline__ void gemm_phase(LAS unsigned char* lds, const Gemm g, const StaticOrder& S, const Epi& E) {
    int tid_ = threadIdx.x; asm volatile("" : "+v"(tid_));
    const int tid = tid_, wid = __builtin_amdgcn_readfirstlane(tid >> 6), lane = tid & 63, wr = wid >> 2, wc = wid & 3, fr = lane & 15, fq = lane >> 4;
    const int K = g.K, nt = K / BK, lda = g.lda;
    unsigned voffA[2], voffB[2];
#pragma unroll
    for (int i = 0; i < 2; ++i) { int Rr, C; stage_rc(tid * 16 + i * 8192, Rr, C); const int Rb = (Rr & ~31) + perm32(Rr & 31);
        voffA[i] = (unsigned)(Rr * lda + C) * 2u; voffB[i] = (unsigned)(Rb * K + C) * 2u; }
    const size_t kstep = (size_t)(BK * 2);
    const size_t hstepA = (size_t)HALF * lda * 2, hstepB = (size_t)HALF * K * 2;
    const size_t tstepA = 2 * hstepA, tstepB = 2 * hstepB;
    const unsigned ldsw = (unsigned)wid * 1024u;
    const int aoff = lds_byte(wr * 64 + fr, fq * 8), boff = lds_byte(wc * 32 + fr, fq * 8);
#define PG8_SA(b, h) (((b) * 2 + (h)) * HTB)
#define PG8_SB(b, h) ((4 + (b) * 2 + (h)) * HTB)
#define PG8_STAGE(bufoff, gbase, voff) do { _Pragma("unroll") for (int _i = 0; _i < 2; ++_i) \
        __builtin_amdgcn_global_load_lds((const unsigned*)((const char*)(gbase) + (voff)[_i]), (LAS unsigned*)(lds + (bufoff) + ldsw + _i * 8192), 16, 0, 0); } while (0)
#define PG8_LDA(dst, b, h) do { _Pragma("unroll") for (int m = 0; m < 4; ++m) _Pragma("unroll") for (int k = 0; k < 2; ++k) dst[m][k] = *(const LAS bf16x8*)(lds + PG8_SA(b, h) + aoff + m * 2048 + k * 1024); } while (0)
#define PG8_LDB(dst, b, h) do { _Pragma("unroll") for (int n = 0; n < 2; ++n) _Pragma("unroll") for (int k = 0; k < 2; ++k) dst[n][k] = *(const LAS bf16x8*)(lds + PG8_SB(b, h) + boff + n * 2048 + k * 1024); } while (0)
#define PG8_MMA(ai, bj, At, Bt) do { __builtin_amdgcn_s_setprio(1); _Pragma("unroll") for (int m = 0; m < 4; ++m) _Pragma("unroll") for (int n = 0; n < 2; ++n) _Pragma("unroll") for (int k = 0; k < 2; ++k) \
        acc[ai][bj][m][n] = __builtin_amdgcn_mfma_f32_16x16x32_bf16(Bt[n][k], At[m][k], acc[ai][bj][m][n], 0, 0, 0); __builtin_amdgcn_s_setprio(0); } while (0)
#define PG8_WAIT_V(n) asm volatile("s_waitcnt vmcnt(" #n ")" ::: "memory")
#define PG8_WAIT_L(n) asm volatile("s_waitcnt lgkmcnt(" #n ")" ::: "memory")
#define PG8_BAR __builtin_amdgcn_s_barrier()
#define PG8_SCHED __builtin_amdgcn_sched_barrier(0)
    Unit cur, nxt; int ui = 0;
    if (!S.next(0, cur)) return;
    f32x4 acc[2][2][4][2];
#pragma unroll
    for (int a = 0; a < 2; ++a)
#pragma unroll
        for (int b = 0; b < 2; ++b)
#pragma unroll
            for (int m = 0; m < 4; ++m)
#pragma unroll
                for (int n = 0; n < 2; ++n) acc[a][b][m][n] = (f32x4){0.f, 0.f, 0.f, 0.f};
    bf16x8 At[4][2], B0[2][2], B1[2][2];
    const char* cA = (const char*)g.A + (size_t)cur.pm * tstepA; const char* cB = (const char*)g.Bt + (size_t)cur.pn * tstepB;
    PG8_STAGE(PG8_SB(0, 0), cB, voffB); PG8_STAGE(PG8_SB(0, 1), cB + hstepB, voffB); PG8_STAGE(PG8_SA(0, 0), cA, voffA); PG8_STAGE(PG8_SA(0, 1), cA + hstepA, voffA);
    if (wr == 1) PG8_BAR;
    PG8_WAIT_V(2); PG8_BAR;
    PG8_STAGE(PG8_SB(1, 0), cB + kstep, voffB); PG8_STAGE(PG8_SA(1, 0), cA + kstep, voffA); PG8_STAGE(PG8_SB(1, 1), cB + hstepB + kstep, voffB);
    PG8_WAIT_V(6); PG8_BAR;
    for (;;) {
        const bool has_next = S.next(ui + 1, nxt);
        const char* nA = has_next ? (const char*)g.A + (size_t)nxt.pm * tstepA : cA; const char* nB = has_next ? (const char*)g.Bt + (size_t)nxt.pn * tstepB : cB;
        for (int t = 0; t < nt; t += 2) {
            const bool last = (t == nt - 2);
            const char* a1 = cA + (size_t)(t + 1) * kstep;
            const char* a2 = last ? nA : cA + (size_t)(t + 2) * kstep; const char* b2 = last ? nB : cB + (size_t)(t + 2) * kstep;
            const char* a3 = a2 + kstep; const char* b3 = b2 + kstep;
            PG8_LDB(B0, 0, 0); PG8_LDB(B1, 0, 1); PG8_SCHED; PG8_LDA(At, 0, 0); PG8_STAGE(PG8_SA(1, 1), a1 + hstepA, voffA);
            PG8_WAIT_V(8); PG8_WAIT_L(0); PG8_BAR; PG8_MMA(0, 0, At, B0); PG8_MMA(0, 1, At, B1); PG8_BAR; PG8_SCHED;
            PG8_LDA(At, 0, 1); PG8_STAGE(PG8_SB(0, 0), b2, voffB); PG8_STAGE(PG8_SB(0, 1), b2 + hstepB, voffB); PG8_STAGE(PG8_SA(0, 0), a2, voffA);
            PG8_WAIT_V(8); PG8_WAIT_L(0); PG8_BAR; PG8_MMA(1, 0, At, B0); PG8_MMA(1, 1, At, B1); PG8_BAR; PG8_SCHED;
            PG8_LDB(B0, 1, 0); PG8_LDB(B1, 1, 1); PG8_SCHED; PG8_LDA(At, 1, 0); PG8_STAGE(PG8_SA(0, 1), a2 + hstepA, voffA);
            PG8_WAIT_V(8); PG8_WAIT_L(0); PG8_BAR; PG8_MMA(0, 0, At, B0); PG8_MMA(0, 1, At, B1); PG8_BAR; PG8_SCHED;
            PG8_LDA(At, 1, 1); PG8_STAGE(PG8_SB(1, 0), b3, voffB); PG8_STAGE(PG8_SB(1, 1), b3 + hstepB, voffB); PG8_STAGE(PG8_SA(1, 0), a3, voffA);
            PG8_WAIT_V(8); PG8_WAIT_L(0); PG8_BAR; PG8_MMA(1, 0, At, B0); PG8_MMA(1, 1, At, B1); PG8_BAR; PG8_SCHED;
        }
        if (wr == 0) PG8_BAR;
        if constexpr (!Epi::AFTER_DRAIN) E(acc, cur, wr, wc, fr, fq);
        if (!has_next) break;
#pragma unroll
        for (int a = 0; a < 2; ++a)
#pragma unroll
            for (int b = 0; b < 2; ++b)
#pragma unroll
                for (int m = 0; m < 4; ++m)
#pragma unroll
                    for (int n = 0; n < 2; ++n) acc[a][b][m][n] = (f32x4){0.f, 0.f, 0.f, 0.f};
        cur = nxt; cA = nA; cB = nB; ++ui;
        if (wr == 1) PG8_BAR;
    }
    PG8_WAIT_V(0);
    PG8_BAR;
    if constexpr (Epi::AFTER_DRAIN) E.fused(acc, cur, wr, wc, fr, fq, lds);
#undef PG8_SA
#undef PG8_SB
#undef PG8_STAGE
#undef PG8_LDA
#undef PG8_LDB
#undef PG8_MMA
#undef PG8_WAIT_V
#undef PG8_WAIT_L
#undef PG8_BAR
#undef PG8_SCHED
}

template <int MODE> struct Epi {
    static constexpr bool AFTER_DRAIN = false;
    bf16_t* O; int ldo;
    float* ssq;
    const bf16_t* Y; int ldy;
    const float* bias;
    __device__ __forceinline__ void operator()(const f32x4 (&acc)[2][2][4][2], const Unit& u, int wr, int wc, int fr, int fq) const {
#pragma unroll
        for (int ai = 0; ai < 2; ++ai)
#pragma unroll
            for (int m = 0; m < 4; ++m) {
                const int row = u.pm * BM + ai * HALF + wr * 64 + m * 16 + fr;
                float ss = 0.f;
#pragma unroll
                for (int bj = 0; bj < 2; ++bj) {
                    const int col0 = u.pn * BM + bj * HALF + wc * 32 + 8 * fq;
                    f32x4 v0 = acc[ai][bj][m][0], v1 = acc[ai][bj][m][1];
                    if (MODE == 1) { ss += v0[0] * v0[0] + v0[1] * v0[1] + v0[2] * v0[2] + v0[3] * v0[3] + v1[0] * v1[0] + v1[1] * v1[1] + v1[2] * v1[2] + v1[3] * v1[3]; }
                    if (MODE == 2) {
#pragma unroll
                        for (int j = 0; j < 4; ++j) { float a = fmaxf(v0[j], 0.f); v0[j] = a * a; float b = fmaxf(v1[j], 0.f); v1[j] = b * b; }
                    }
                    if (MODE == 3) {
                        const u32x4 yv = *(const u32x4*)(Y + (size_t)row * ldy + col0);
                        const f32x4 b0 = *(const f32x4*)(bias + col0), b1 = *(const f32x4*)(bias + col0 + 4);
                        v0[0] = bf_lo(yv.x) * sigmoidf_(v0[0] + b0[0]); v0[1] = bf_hi(yv.x) * sigmoidf_(v0[1] + b0[1]);
                        v0[2] = bf_lo(yv.y) * sigmoidf_(v0[2] + b0[2]); v0[3] = bf_hi(yv.y) * sigmoidf_(v0[3] + b0[3]);
                        v1[0] = bf_lo(yv.z) * sigmoidf_(v1[0] + b1[0]); v1[1] = bf_hi(yv.z) * sigmoidf_(v1[1] + b1[1]);
                        v1[2] = bf_lo(yv.w) * sigmoidf_(v1[2] + b1[2]); v1[3] = bf_hi(yv.w) * sigmoidf_(v1[3] + b1[3]);
                    }
                    u32x4 w; w.x = cvt_pk_bf16(v0[0], v0[1]); w.y = cvt_pk_bf16(v0[2], v0[3]); w.z = cvt_pk_bf16(v1[0], v1[1]); w.w = cvt_pk_bf16(v1[2], v1[3]);
                    *(u32x4*)(O + (size_t)row * ldo + col0) = w;
                }
                if (MODE == 1) {
                    ss += __shfl_xor(ss, 16); ss += __shfl_xor(ss, 32);
                    if (fq == 0) ssq[(size_t)row * 16 + u.pn * 4 + wc] = ss;
                }
            }
    }
};

struct EpiRes {
    static constexpr bool AFTER_DRAIN = true;
    const float* hin; float* h;
    const float* g1; const float* g2;
    bf16_t* HN;
    float* xb1; float* xb2;
    unsigned* c1; unsigned* c2;
    __device__ __forceinline__ void exchange(const f32x4 (&acc)[2][2][4][2], const Unit& u, int wr, int wc, int fr, int fq, LAS unsigned char* lds, float* xb, unsigned* cnt) const {
        LAS float* P = (LAS float*)lds; LAS float* S = (LAS float*)(lds + 4096);
        const int tid = threadIdx.x;
#pragma unroll
        for (int ai = 0; ai < 2; ++ai)
#pragma unroll
            for (int m = 0; m < 4; ++m) {
                float ss = 0.f;
#pragma unroll
                for (int bj = 0; bj < 2; ++bj)
#pragma unroll
                    for (int n = 0; n < 2; ++n) { const f32x4 v = acc[ai][bj][m][n]; ss += v[0] * v[0] + v[1] * v[1] + v[2] * v[2] + v[3] * v[3]; }
                ss += __shfl_xor(ss, 16); ss += __shfl_xor(ss, 32);
                if (fq == 0) P[(ai * HALF + wr * 64 + m * 16 + fr) * 4 + wc] = ss;
            }
        __syncthreads();
        if (tid < 256) { const f32x4 p = *(const LAS f32x4*)(P + tid * 4); st_agent(xb + ((size_t)u.pm * 256 + tid) * 4 + u.pn, (p[0] + p[1]) + (p[2] + p[3])); }
        asm volatile("s_waitcnt vmcnt(0)" ::: "memory");
        __syncthreads();
        if (tid == 0) cnt_arrive_wait(cnt + u.pm * 32, 4u);
        __syncthreads();
        if (tid < 256) { const float* q = xb + ((size_t)u.pm * 256 + tid) * 4; const float t = (ld_agent(q) + ld_agent(q + 1)) + (ld_agent(q + 2) + ld_agent(q + 3));
            S[tid] = rsqrtf(t * (1.f / 1024.f) + EPS); }
        __syncthreads();
    }
    __device__ __forceinline__ void fused(f32x4 (&acc)[2][2][4][2], const Unit& u, int wr, int wc, int fr, int fq, LAS unsigned char* lds) const {
        const LAS float* S = (const LAS float*)(lds + 4096);
        exchange(acc, u, wr, wc, fr, fq, lds, xb1, c1);
#pragma unroll
        for (int bj = 0; bj < 2; ++bj) {
            const int col0 = u.pn * BM + bj * HALF + wc * 32 + 8 * fq;
            const f32x4 ga = *(const f32x4*)(g1 + col0), gb = *(const f32x4*)(g1 + col0 + 4);
#pragma unroll
            for (int ai = 0; ai < 2; ++ai)
#pragma unroll
                for (int m = 0; m < 4; ++m) {
                    const int rl = ai * HALF + wr * 64 + m * 16 + fr; const float inv = S[rl];
                    float* hp = h + (size_t)(u.pm * BM + rl) * 1024 + col0;
                    const float* hq = hin + (size_t)(u.pm * BM + rl) * 1024 + col0;
                    const f32x4 h0 = *(const f32x4*)hq, h1 = *(const f32x4*)(hq + 4);
                    f32x4 v0 = acc[ai][bj][m][0], v1 = acc[ai][bj][m][1];
                    v0 = h0 + v0 * inv * ga; v1 = h1 + v1 * inv * gb;
                    *(f32x4*)hp = v0; *(f32x4*)(hp + 4) = v1;
                    acc[ai][bj][m][0] = v0; acc[ai][bj][m][1] = v1;
                }
        }
        if (g2 == nullptr) return;
        __syncthreads();
        exchange(acc, u, wr, wc, fr, fq, lds, xb2, c2);
#pragma unroll
        for (int bj = 0; bj < 2; ++bj) {
            const int col0 = u.pn * BM + bj * HALF + wc * 32 + 8 * fq;
            const f32x4 ga = *(const f32x4*)(g2 + col0), gb = *(const f32x4*)(g2 + col0 + 4);
#pragma unroll
            for (int ai = 0; ai < 2; ++ai)
#pragma unroll
                for (int m = 0; m < 4; ++m) {
                    const int rl = ai * HALF + wr * 64 + m * 16 + fr; const float inv = S[rl];
                    const f32x4 v0 = acc[ai][bj][m][0] * inv * ga, v1 = acc[ai][bj][m][1] * inv * gb;
                    u32x4 w; w.x = cvt_pk_bf16(v0[0], v0[1]); w.y = cvt_pk_bf16(v0[2], v0[3]); w.z = cvt_pk_bf16(v1[0], v1[1]); w.w = cvt_pk_bf16(v1[2], v1[3]);
                    *(u32x4*)(HN + (size_t)(u.pm * BM + rl) * 1024 + col0) = w;
                }
        }
    }
};
}

__device__ __forceinline__ bf16x8 ldsfrag(const LAS unsigned char* p) { return *(const LAS bf16x8*)p; }
#define LBAR() do { asm volatile("s_waitcnt lgkmcnt(0)" ::: "memory"); __builtin_amdgcn_s_barrier(); asm volatile("" ::: "memory"); } while (0)
#define MFMA16(X, Y, ACC) __builtin_amdgcn_mfma_f32_16x16x32_bf16((X), (Y), (ACC), 0, 0, 0)


template <int MODE, int NT, int STEPS>
__device__ __forceinline__ void meta_gemm(LAS unsigned char* L, const bf16_t* A, int lda, const bf16_t* Bt, int N, int K,
                                          bf16_t* O, int ldo, float* ssq, const bf16_t* Y, int ldy, const float* bias,
                                          float* hm = nullptr, const float* g1 = nullptr, const float* g2 = nullptr, float* xm1 = nullptr, float* xm2 = nullptr, unsigned* cm1 = nullptr, unsigned* cm2 = nullptr) {
    int tid_ = threadIdx.x; asm volatile("" : "+v"(tid_));
    const int tid = tid_, lane = tid & 63, w = __builtin_amdgcn_readfirstlane(tid >> 6), fr = lane & 15, fq = lane >> 4;
    const int t = (int)gridDim.x - 1 - (int)blockIdx.x;
    if (t >= N / (16 * NT)) return;
    const int n0 = t * 16 * NT, kw = K / 8, k0 = w * kw;
    f32x4 acc[NT];
#pragma unroll
    for (int nt = 0; nt < NT; ++nt) acc[nt] = (f32x4){0.f, 0.f, 0.f, 0.f};
    const bf16_t* ap = A + (size_t)fr * lda + k0 + fq * 8;
    const bf16_t* bp = Bt + (size_t)(n0 + fr) * K + k0 + fq * 8;
    for (int k = 0; k < kw; k += 32 * STEPS) {
        bf16x8 af[STEPS], bfr[STEPS][NT];
#pragma unroll
        for (int st = 0; st < STEPS; ++st) { af[st] = *(const bf16x8*)(ap + k + 32 * st);
#pragma unroll
            for (int nt = 0; nt < NT; ++nt) bfr[st][nt] = *(const bf16x8*)(bp + (size_t)nt * 16 * K + k + 32 * st); }
#pragma unroll
        for (int st = 0; st < STEPS; ++st)
#pragma unroll
            for (int nt = 0; nt < NT; ++nt) acc[nt] = MFMA16(bfr[st][nt], af[st], acc[nt]);
    }
    LAS f32x4* P = (LAS f32x4*)L;
#pragma unroll
    for (int nt = 0; nt < NT; ++nt) P[(w * NT + nt) * 64 + lane] = acc[nt];
    __syncthreads();
    if (MODE == 4) {
        if (w == 0) {
            const int np = N / 16;
            f32x4 v = P[lane];
#pragma unroll
            for (int ww = 1; ww < 8; ++ww) v += P[ww * NT * 64 + lane];
            float ss = v[0] * v[0] + v[1] * v[1] + v[2] * v[2] + v[3] * v[3];
            ss += __shfl_xor(ss, 16); ss += __shfl_xor(ss, 32);
            if (fq == 0) st_agent(xm1 + fr * np + t, ss);
            asm volatile("s_waitcnt vmcnt(0)" ::: "memory");
            if (lane == 0) cnt_arrive_wait(cm1, (unsigned)np);
            __builtin_amdgcn_wave_barrier();
            float tot = 0.f;
#pragma unroll
            for (int q = 0; q < 16; ++q) tot += ld_agent(xm1 + fr * np + fq * 16 + q);
            tot += __shfl_xor(tot, 16); tot += __shfl_xor(tot, 32);
            const float inv = rsqrtf(tot * (1.f / 1024.f) + EPS);
            const int col = n0 + 4 * fq; float* hp = hm + fr * 1024 + col;
            { const f32x4 gg = *(const f32x4*)(g1 + col); const f32x4 h0 = *(const f32x4*)hp; v = h0 + v * inv * gg; *(f32x4*)hp = v; }
            if (g2 != nullptr) {
                float ss2 = v[0] * v[0] + v[1] * v[1] + v[2] * v[2] + v[3] * v[3];
                ss2 += __shfl_xor(ss2, 16); ss2 += __shfl_xor(ss2, 32);
                if (fq == 0) st_agent(xm2 + fr * np + t, ss2);
                asm volatile("s_waitcnt vmcnt(0)" ::: "memory");
                if (lane == 0) cnt_arrive_wait(cm2, (unsigned)np);
                __builtin_amdgcn_wave_barrier();
                float tot2 = 0.f;
#pragma unroll
                for (int q = 0; q < 16; ++q) tot2 += ld_agent(xm2 + fr * np + fq * 16 + q);
                tot2 += __shfl_xor(tot2, 16); tot2 += __shfl_xor(tot2, 32);
                const float inv2 = rsqrtf(tot2 * (1.f / 1024.f) + EPS);
                const f32x4 gg = *(const f32x4*)(g2 + col); const f32x4 y = v * inv2 * gg;
                u32x2 o; o.x = cvt_pk_bf16(y[0], y[1]); o.y = cvt_pk_bf16(y[2], y[3]);
                *(u32x2*)(O + (size_t)fr * ldo + col) = o;
            }
        }
    } else if (w == 0) {
        float ss = 0.f;
#pragma unroll
        for (int nt = 0; nt < NT; ++nt) {
            f32x4 v = P[nt * 64 + lane];
#pragma unroll
            for (int ww = 1; ww < 8; ++ww) v += P[(ww * NT + nt) * 64 + lane];
            const int col = n0 + nt * 16 + 4 * fq;
            if (MODE == 1) ss += v[0] * v[0] + v[1] * v[1] + v[2] * v[2] + v[3] * v[3];
            if (MODE == 2) {
#pragma unroll
                for (int j = 0; j < 4; ++j) { const float r = fmaxf(v[j], 0.f); v[j] = r * r; }
            }
            if (MODE == 3) {
                const u32x2 yv = *(const u32x2*)(Y + (size_t)fr * ldy + col);
                const f32x4 bb = *(const f32x4*)(bias + col);
                v[0] = bf_lo(yv.x) * sigmoidf_(v[0] + bb[0]); v[1] = bf_hi(yv.x) * sigmoidf_(v[1] + bb[1]);
                v[2] = bf_lo(yv.y) * sigmoidf_(v[2] + bb[2]); v[3] = bf_hi(yv.y) * sigmoidf_(v[3] + bb[3]);
            }
            u32x2 o; o.x = cvt_pk_bf16(v[0], v[1]); o.y = cvt_pk_bf16(v[2], v[3]);
            *(u32x2*)(O + (size_t)fr * ldo + col) = o;
        }
        if (MODE == 1) {
            ss += __shfl_xor(ss, 16); ss += __shfl_xor(ss, 32);
            if (fq == 0) ssq[fr * 16 + t] = ss;
        }
    }
    __syncthreads();
}

__device__ __forceinline__ void transpose_item(const float* W, int K, int N, bf16_t* WT, int dst_row0, LAS float* scr, int k0, int n0, int lane) {
#pragma unroll 8
    for (int i = 0; i < 32; ++i) { const int kk = 2 * i + (lane >> 5); scr[kk * 33 + (lane & 31)] = W[(size_t)(k0 + kk) * N + n0 + (lane & 31)]; }
    asm volatile("s_waitcnt lgkmcnt(0)" ::: "memory");
    const int c = lane & 7;
#pragma unroll
    for (int j = 0; j < 4; ++j) { const int n = (lane >> 3) + 8 * j; const LAS float* s = scr + (8 * c) * 33 + n;
        u32x4 o; o.x = cvt_pk_bf16(s[0 * 33], s[1 * 33]); o.y = cvt_pk_bf16(s[2 * 33], s[3 * 33]); o.z = cvt_pk_bf16(s[4 * 33], s[5 * 33]); o.w = cvt_pk_bf16(s[6 * 33], s[7 * 33]);
        *(u32x4*)(WT + (size_t)(dst_row0 + n) * K + k0 + 8 * c) = o; }
    asm volatile("s_waitcnt lgkmcnt(0)" ::: "memory");
}


constexpr int WC_I0 = 16 * 160, WC_I1 = 32 * 32, WC_I2 = 16 * 128, WC_I3 = 64 * 32, WC_I4 = 16 * 80, WC_I5 = 16 * 32, WC_I6 = 8 * 16, WC_I7 = WC_I2, WC_I8 = WC_I3;
constexpr int WC_C0 = 0, WC_C1 = WC_I0, WC_C5 = WC_I0 + WC_I1 + WC_I2 + WC_I3 + WC_I4, WC_C9 = WC_C5 + WC_I5 + WC_I6 + WC_I7 + WC_I8;
__device__ __forceinline__ void weight_convert(const Args& a, LAS unsigned char* lds, int it0, int it1, int vb, int nvb) {
    int tid_ = threadIdx.x; asm volatile("" : "+v"(tid_));
    const int tid = tid_, lane = tid & 63, wave = tid >> 6;
    unsigned char* ws = a.ws;
    LAS float* scr = (LAS float*)(lds + wave * 16384);
    constexpr int I0 = WC_I0, I1 = WC_I1, I2 = WC_I2, I3 = WC_I3, I4 = WC_I4, I5 = WC_I5, I6 = WC_I6, I7 = WC_I7;
    for (int it = it0 + vb * 8 + wave; it < it1; it += nvb * 8) {
        int r = it; const float* W; int K, N; bf16_t* WT; bool perm = false;
        if (r < I0) { W = a.in[2]; K = 1024; N = 5120; WT = (bf16_t*)(ws + W_INAB); perm = true; }
        else if ((r -= I0) < I1) { W = a.in[3]; K = 2048; N = 1024; WT = (bf16_t*)(ws + W_OUTAB); }
        else if ((r -= I1) < I2) { W = a.in[27]; K = 1024; N = 4096; WT = (bf16_t*)(ws + W_W1_0); }
        else if ((r -= I2) < I3) { W = a.in[28]; K = 4096; N = 1024; WT = (bf16_t*)(ws + W_W2_0); }
        else if ((r -= I3) < I4) { W = a.in[12]; K = 1024; N = 2560; WT = (bf16_t*)(ws + W_INCD); }
        else if ((r -= I4) < I5) { W = a.in[13]; K = 1024; N = 1024; WT = (bf16_t*)(ws + W_OUTCD); }
        else if ((r -= I5) < I6) { W = a.in[22]; K = 512; N = 512; WT = (bf16_t*)(ws + W_GLU); }
        else if ((r -= I6) < I7) { W = a.in[27] + (size_t)1024 * 4096; K = 1024; N = 4096; WT = (bf16_t*)(ws + W_W1_1); }
        else { r -= I7; W = a.in[28] + (size_t)1024 * 4096; K = 4096; N = 1024; WT = (bf16_t*)(ws + W_W2_1); }
        const int nblk = N / 32, kb = r / nblk, nb = r % nblk, n0 = nb * 32;
        int d0 = n0;
        if (perm) { if (n0 >= 2048 && n0 < 3072) d0 = n0 + 1024; else if (n0 >= 3072 && n0 < 4096) d0 = n0 - 1024; }
        transpose_item(W, K, N, WT, d0, scr, kb * 64, n0, lane);
    }
}

__device__ __forceinline__ void phase_prologue(const Args& a, LAS unsigned char* lds, bool copy_x) {
    int tid_ = threadIdx.x; asm volatile("" : "+v"(tid_));
    const int tid = tid_, lane = tid & 63, wave = tid >> 6;
    const int gw = blockIdx.x * 8 + wave, NGW = gridDim.x * 8;
    unsigned char* ws = a.ws;
    LAS float* scr = (LAS float*)(lds + wave * 16384);
    weight_convert(a, lds, WC_C0, WC_C5, blockIdx.x, gridDim.x);
    {
        const float* x = a.in[0]; const float* meta = a.in[1]; const float* g = a.in[26];
        bf16_t* HN = (bf16_t*)(ws + HN_OFF);
        f32x4 gg[4];
#pragma unroll
        for (int j = 0; j < 4; ++j) gg[j] = *(const f32x4*)(g + 4 * lane + 256 * j);
        for (int row0 = gw; row0 < R; row0 += 4 * NGW) {
            f32x4 v[4][4];
#pragma unroll
            for (int q = 0; q < 4; ++q) { const int row = row0 + q * NGW;
                if (row < R) { const float* src = row < RM ? x + (size_t)row * DM : meta + (size_t)(row - RM) * DM;
#pragma unroll
                    for (int j = 0; j < 4; ++j) v[q][j] = *(const f32x4*)(src + 4 * lane + 256 * j); }
                else {
#pragma unroll
                    for (int j = 0; j < 4; ++j) v[q][j] = (f32x4){0.f, 0.f, 0.f, 0.f}; } }
#pragma unroll
            for (int q = 0; q < 4; ++q) { const int row = row0 + q * NGW;
                if (row < R) {
                    float s = 0.f;
#pragma unroll
                    for (int j = 0; j < 4; ++j) s += v[q][j][0] * v[q][j][0] + v[q][j][1] * v[q][j][1] + v[q][j][2] * v[q][j][2] + v[q][j][3] * v[q][j][3];
                    const float inv = rsqrtf(wave_sum(s) * (1.f / DM) + EPS);
                    if (copy_x || row >= RM) { float* hr = hrow(a, row);
#pragma unroll
                        for (int j = 0; j < 4; ++j) *(f32x4*)(hr + 4 * lane + 256 * j) = v[q][j]; }
#pragma unroll
                    for (int j = 0; j < 4; ++j) { u32x2 o; o.x = cvt_pk_bf16(v[q][j][0] * inv * gg[j][0], v[q][j][1] * inv * gg[j][1]); o.y = cvt_pk_bf16(v[q][j][2] * inv * gg[j][2], v[q][j][3] * inv * gg[j][3]);
                        *(u32x2*)(HN + (size_t)row * DM + 4 * lane + 256 * j) = o; }
                } }
        }
    }
    const int gt = blockIdx.x * NTHREADS + tid, NGT = gridDim.x * NTHREADS;
    {
        bf16_t* WG = (bf16_t*)(ws + LRUW_OFF);
        for (int i = gt; i < 16 * 128 * 64; i += NGT) { const int k = i & 63, n = (i >> 6) & 127, blk = i >> 13;
            const float v = n < 64 ? a.in[5][(size_t)blk * 4096 + k * 64 + n] : a.in[7][(size_t)blk * 4096 + k * 64 + (n - 64)];
            WG[i] = f2bf(v); }
    }
    {
        bf16_t* BB = (bf16_t*)(ws + S5BB_OFF); bf16_t* CM = (bf16_t*)(ws + S5CM_OFF); float* AB = (float*)(ws + S5AB_OFF);
        const float* are_log = a.in[14]; const float* aim = a.in[15]; const float* bre = a.in[16]; const float* bim = a.in[17];
        const float* cre = a.in[18]; const float* cim = a.in[19]; const float* ldt = a.in[21];
        for (int i = gt; i < 32 * 64; i += NGT) {
            const int g = i >> 6, p = i & 63;
            const float dt = expf(ldt[g]); const float a_re = -expf(are_log[i]); const float a_im = aim[i];
            const float mag = expf(dt * a_re); float sn, cs; sincos_big(dt * a_im, sn, cs);
            const float ab_re = mag * cs, ab_im = mag * sn;
            AB[2 * i] = ab_re; AB[2 * i + 1] = ab_im;
            const float n_re = ab_re - 1.f, n_im = ab_im, den = a_re * a_re + a_im * a_im;
            const float z_re = (n_re * a_re + n_im * a_im) / den, z_im = (n_im * a_re - n_re * a_im) / den;
            for (int c = 0; c < 32; ++c) {
                float vr = 0.f, vi = 0.f;
                if (c < 16) { const float br = bre[(size_t)i * 16 + c], bi = bim[(size_t)i * 16 + c]; vr = z_re * br - z_im * bi; vi = z_re * bi + z_im * br; }
                BB[((size_t)g * 128 + p) * 32 + c] = f2bf(vr);
                BB[((size_t)g * 128 + 64 + p) * 32 + c] = f2bf(vi);
            }
            for (int c = 0; c < 16; ++c) {
                CM[((size_t)g * 16 + c) * 128 + p] = f2bf(cre[((size_t)g * 16 + c) * 64 + p]);
                CM[((size_t)g * 16 + c) * 128 + 64 + p] = f2bf(-cim[((size_t)g * 16 + c) * 64 + p]);
            }
        }
    }
}

__device__ __forceinline__ void phase_resnorm(const Args& a, const float* g1, const float* g2) {
    int tid_ = threadIdx.x; asm volatile("" : "+v"(tid_));
    const int tid = tid_, lane = tid & 63, wave = tid >> 6;
    const int gw = blockIdx.x * 8 + wave, NGW = gridDim.x * 8;
    bf16_t* HN = (bf16_t*)(a.ws + HN_OFF); const float* ssq = (const float*)(a.ws + SSQ_OFF);
    for (int row = gw; row < R; row += NGW) {
        bf16_t* mrow = HN + (size_t)row * DM;
        float s = 0.f;
        { const f32x4* sp = (const f32x4*)(ssq + (size_t)row * 16); const f32x4 s0 = sp[0], s1 = sp[1], s2 = sp[2], s3 = sp[3];
          s = ((s0[0] + s0[1]) + (s0[2] + s0[3])) + ((s1[0] + s1[1]) + (s1[2] + s1[3])) + ((s2[0] + s2[1]) + (s2[2] + s2[3])) + ((s3[0] + s3[1]) + (s3[2] + s3[3])); }
        const float inv = rsqrtf(s * (1.f / DM) + EPS);
        float* hr = hrow(a, row);
        f32x4 v[4]; float s2 = 0.f;
#pragma unroll
        for (int j = 0; j < 4; ++j) {
            const u32x2 mv = *(const u32x2*)(mrow + 4 * lane + 256 * j);
            const f32x4 gg = *(const f32x4*)(g1 + 4 * lane + 256 * j);
            v[j] = *(const f32x4*)(hr + 4 * lane + 256 * j);
            v[j][0] += bf_lo(mv.x) * inv * gg[0]; v[j][1] += bf_hi(mv.x) * inv * gg[1]; v[j][2] += bf_lo(mv.y) * inv * gg[2]; v[j][3] += bf_hi(mv.y) * inv * gg[3];
            *(f32x4*)(hr + 4 * lane + 256 * j) = v[j];
            s2 += v[j][0] * v[j][0] + v[j][1] * v[j][1] + v[j][2] * v[j][2] + v[j][3] * v[j][3];
        }
        if (g2) {
            const float inv2 = rsqrtf(wave_sum(s2) * (1.f / DM) + EPS);
#pragma unroll
            for (int j = 0; j < 4; ++j) { const f32x4 gg = *(const f32x4*)(g2 + 4 * lane + 256 * j);
                u32x2 o; o.x = cvt_pk_bf16(v[j][0] * inv2 * gg[0], v[j][1] * inv2 * gg[1]); o.y = cvt_pk_bf16(v[j][2] * inv2 * gg[2], v[j][3] * inv2 * gg[3]);
                *(u32x2*)(mrow + 4 * lane + 256 * j) = o; }
        }
    }
}

constexpr int LA_QS = 0, LA_KS = 17408, LA_QD = 34816, LA_KT = 52224, LA_VT = 70656, LA_PS = 75264, LA_ST = 84480, LA_CUM = 93184, LA_DEC = 125952, LA_CM = 126464  , LA_END = 126976;
static_assert(LA_END <= LDS_BYTES, "LA lds");
__device__ __forceinline__ int kt_off(int d, int s) { return d * 144 + ((((s >> 3) ^ (d >> 3)) & 7) << 4) + (s & 7) * 2; }

template <bool HG>
__device__ __forceinline__ void la_core(LAS unsigned char* L, f32x4 (&st)[2], float l2g, bf16_t* obuf, int ldo, int ocol, int b, int n, bool dry) {
    int tid_ = threadIdx.x; asm volatile("" : "+v"(tid_));
    const int tid = tid_, lane = tid & 63, w = __builtin_amdgcn_readfirstlane(tid >> 6), fr = lane & 15, fq = lane >> 4;
    const int mt = w >> 1, nh = w & 1;
    bf16x8 qf[4];
#pragma unroll
    for (int kk = 0; kk < 4; ++kk) qf[kk] = ldsfrag(L + LA_QS + (mt * 16 + fr) * 272 + kk * 64 + fq * 16);
    f32x4 s0 = {0.f, 0.f, 0.f, 0.f}, s1 = {0.f, 0.f, 0.f, 0.f};
#pragma unroll
    for (int kk = 0; kk < 4; ++kk) {
        const bf16x8 k0 = ldsfrag(L + LA_KS + ((nh * 2) * 16 + fr) * 272 + kk * 64 + fq * 16);
        const bf16x8 k1 = ldsfrag(L + LA_KS + ((nh * 2 + 1) * 16 + fr) * 272 + kk * 64 + fq * 16);
        s0 = MFMA16(k0, qf[kk], s0); s1 = MFMA16(k1, qf[kk], s1);
    }
    const int t = mt * 16 + fr;
    {
        float p0[4], p1[4];
#pragma unroll
        for (int jj = 0; jj < 4; ++jj) {
            const int sa = (nh * 2) * 16 + 4 * fq + jj, sb = sa + 16;
            if (HG) { p0[jj] = sa <= t ? s0[jj] : 0.f; p1[jj] = sb <= t ? s1[jj] : 0.f; }
            else { p0[jj] = s0[jj] * exp2f(l2g * fabsf((float)(t - sa))); p1[jj] = s1[jj] * exp2f(l2g * fabsf((float)(t - sb))); }
        }
        u32x2 o0, o1; o0.x = cvt_pk_bf16(p0[0], p0[1]); o0.y = cvt_pk_bf16(p0[2], p0[3]); o1.x = cvt_pk_bf16(p1[0], p1[1]); o1.y = cvt_pk_bf16(p1[2], p1[3]);
        *(LAS u32x2*)(L + LA_PS + t * 144 + ((nh * 2) * 16 + 4 * fq) * 2) = o0;
        *(LAS u32x2*)(L + LA_PS + t * 144 + ((nh * 2 + 1) * 16 + 4 * fq) * 2) = o1;
    }
    f32x4 o = {0.f, 0.f, 0.f, 0.f};
#pragma unroll
    for (int kk = 0; kk < 4; ++kk) {
        bf16x8 sf = ldsfrag(L + LA_ST + (nh * 16 + fr) * 272 + kk * 64 + fq * 16);
        if (HG) {
            const f32x4 c0 = *(const LAS f32x4*)(L + LA_CM + (kk * 32 + fq * 8) * 4), c1 = *(const LAS f32x4*)(L + LA_CM + (kk * 32 + fq * 8 + 4) * 4);
            const u32x4 su = __builtin_bit_cast(u32x4, sf);
            u32x4 r; r.x = cvt_pk_bf16(bf_lo(su.x) * c0[0], bf_hi(su.x) * c0[1]); r.y = cvt_pk_bf16(bf_lo(su.y) * c0[2], bf_hi(su.y) * c0[3]);
            r.z = cvt_pk_bf16(bf_lo(su.z) * c1[0], bf_hi(su.z) * c1[1]); r.w = cvt_pk_bf16(bf_lo(su.w) * c1[2], bf_hi(su.w) * c1[3]);
            sf = __builtin_bit_cast(bf16x8, r);
        }
        o = MFMA16(sf, qf[kk], o);
    }
    if (!HG) { const float sc = exp2f(l2g * (float)(t + 1)); o[0] *= sc; o[1] *= sc; o[2] *= sc; o[3] *= sc; }
    LBAR();
#pragma unroll
    for (int kk = 0; kk < 2; ++kk) {
        const bf16x8 vf = ldsfrag(L + LA_VT + (nh * 16 + fr) * 144 + kk * 64 + fq * 16);
        const bf16x8 pf = ldsfrag(L + LA_PS + (mt * 16 + fr) * 144 + kk * 64 + fq * 16);
        o = MFMA16(vf, pf, o);
    }
    {
        const int row = chunk_row(b, n, t);
        if (row >= 0 && (row < RM || b == 0) && !dry) { u32x2 ov; ov.x = cvt_pk_bf16(o[0], o[1]); ov.y = cvt_pk_bf16(o[2], o[3]);
            *(u32x2*)(obuf + (size_t)row * ldo + ocol + nh * 16 + 4 * fq) = ov; }
    }
    float dc[4];
    if (HG) { const f32x4 dv = *(const LAS f32x4*)(L + LA_DEC + (w * 16 + 4 * fq) * 4); dc[0] = dv[0]; dc[1] = dv[1]; dc[2] = dv[2]; dc[3] = dv[3]; }
    else { const float g64 = exp2f(l2g * 64.f); dc[0] = dc[1] = dc[2] = dc[3] = g64; }
    const int ktd = w * 16 + fr, ktx = (ktd >> 3) & 7;
    const bf16x8 kt0 = ldsfrag(L + LA_KT + ktd * 144 + ((fq ^ ktx) << 4)), kt1 = ldsfrag(L + LA_KT + ktd * 144 + (((4 + fq) ^ ktx) << 4));
#pragma unroll
    for (int et = 0; et < 2; ++et) {
#pragma unroll
        for (int jj = 0; jj < 4; ++jj) st[et][jj] *= dc[jj];
        const bf16x8 v0 = ldsfrag(L + LA_VT + (et * 16 + fr) * 144 + fq * 16), v1 = ldsfrag(L + LA_VT + (et * 16 + fr) * 144 + 64 + fq * 16);
        st[et] = MFMA16(kt0, v0, st[et]); st[et] = MFMA16(kt1, v1, st[et]);
        u32x2 sv; sv.x = cvt_pk_bf16(st[et][0], st[et][1]); sv.y = cvt_pk_bf16(st[et][2], st[et][3]);
        *(LAS u32x2*)(L + LA_ST + (et * 16 + fr) * 272 + (w * 16 + 4 * fq) * 2) = sv;
    }
}

#define UNPK8(dst, v) do { dst[0] = bf_lo((v).x); dst[1] = bf_hi((v).x); dst[2] = bf_lo((v).y); dst[3] = bf_hi((v).y); dst[4] = bf_lo((v).z); dst[5] = bf_hi((v).z); dst[6] = bf_lo((v).w); dst[7] = bf_hi((v).w); } while (0)
#define PK8(v, src) do { (v).x = cvt_pk_bf16(src[0], src[1]); (v).y = cvt_pk_bf16(src[2], src[3]); (v).z = cvt_pk_bf16(src[4], src[5]); (v).w = cvt_pk_bf16(src[6], src[7]); } while (0)

__device__ __forceinline__ void retention_unit(const Args& a, LAS unsigned char* L, int unit, bool dry) {
    int tid_ = threadIdx.x; asm volatile("" : "+v"(tid_));
    const int tid = tid_, b = unit >> 5, h = (unit >> 3) & 3, sl = unit & 7;
    const bf16_t* Z = (const bf16_t*)(a.ws + Z_OFF); bf16_t* OB = (bf16_t*)(a.ws + HN_OFF);
    const float l2g = log2f(1.f - exp2f(-5.f - (float)h));
    const int row_l = tid >> 3, c8 = tid & 7;
    const int vrow = (tid >> 2) & 63, vp = tid & 3;
    float rc[8], rs[8], stc[8], sts[8];
#pragma unroll
    for (int i = 0; i < 8; ++i) { const float invf = exp2f(-(float)(c8 * 8 + i) * (13.287712379549449f / 64.f));
        sincos_big((float)(row_l - 48) * invf, rs[i], rc[i]); sincos_big(64.f * invf, sts[i], stc[i]); }
    f32x4 st[2] = {{0.f, 0.f, 0.f, 0.f}, {0.f, 0.f, 0.f, 0.f}};
    for (int i = tid; i < 32 * 272 / 4; i += NTHREADS) ((LAS unsigned*)(L + LA_ST))[i] = 0u;
    u32x4 qA1, qA2, kA1, kA2, vA, qB1, qB2, kB1, kB2, vB;
#define RET_LOAD(q1, q2, k1, k2, vv, n_) do { const int r_ = chunk_row(b, (n_), row_l); \
        if (r_ >= 0) { const bf16_t* zr = Z + (size_t)r_ * IN_AB; \
            q1 = *(const u32x4*)(zr + h * 128 + c8 * 8); q2 = *(const u32x4*)(zr + h * 128 + 64 + c8 * 8); \
            k1 = *(const u32x4*)(zr + 512 + h * 128 + c8 * 8); k2 = *(const u32x4*)(zr + 512 + h * 128 + 64 + c8 * 8); \
        } else { q1 = q2 = k1 = k2 = (u32x4){0u, 0u, 0u, 0u}; } \
        vv = (u32x4){0u, 0u, 0u, 0u}; \
        if (tid < 256) { const int rv = chunk_row(b, (n_), vrow); if (rv >= 0) vv = *(const u32x4*)(Z + (size_t)rv * IN_AB + 1024 + h * 256 + sl * 32 + vp * 8); } } while (0)
#define RET_STEP(q1, q2, k1, k2, vv, n_) do { \
        { \
            float x1[8], x2[8], y1[8], y2[8], qo1[8], qo2[8], ko1[8], ko2[8]; \
            UNPK8(x1, q1); UNPK8(x2, q2); UNPK8(y1, k1); UNPK8(y2, k2); \
            _Pragma("unroll") for (int i = 0; i < 8; ++i) { \
                const float sn = rs[i], cs = rc[i]; \
                rc[i] = cs * stc[i] - sn * sts[i]; rs[i] = sn * stc[i] + cs * sts[i];       \
                qo1[i] = (x1[i] * cs - x2[i] * sn) * 0.08838834764831845f; qo2[i] = (x1[i] * sn + x2[i] * cs) * 0.08838834764831845f; \
                ko1[i] = y1[i] * cs - y2[i] * sn; ko2[i] = y1[i] * sn + y2[i] * cs; \
            } \
            u32x4 w1, w2; \
            PK8(w1, qo1); PK8(w2, qo2); \
            *(LAS u32x4*)(L + LA_QS + row_l * 272 + c8 * 16) = w1; *(LAS u32x4*)(L + LA_QS + row_l * 272 + 128 + c8 * 16) = w2; \
            PK8(w1, ko1); PK8(w2, ko2); \
            *(LAS u32x4*)(L + LA_KS + row_l * 272 + c8 * 16) = w1; *(LAS u32x4*)(L + LA_KS + row_l * 272 + 128 + c8 * 16) = w2; \
            _Pragma("unroll") for (int i = 0; i < 8; ++i) { \
                *(LAS bf16_t*)(L + LA_KT + kt_off(c8 * 8 + i, row_l)) = f2bf(ko1[i] * kdec); \
                *(LAS bf16_t*)(L + LA_KT + kt_off(64 + c8 * 8 + i, row_l)) = f2bf(ko2[i] * kdec); \
            } \
            if (tid < 256) { \
                const unsigned va[4] = {vv.x, vv.y, vv.z, vv.w}; \
                _Pragma("unroll") for (int i = 0; i < 8; ++i) *(LAS bf16_t*)(L + LA_VT + (vp * 8 + i) * 144 + vrow * 2) = (bf16_t)((i & 1) ? (va[i >> 1] >> 16) : (va[i >> 1] & 0xffffu)); \
            } \
        } \
        if ((n_) + 2 < NCH) RET_LOAD(q1, q2, k1, k2, vv, (n_) + 2); \
        LBAR(); \
        la_core<false>(L, st, l2g, OB, DM, h * 256 + sl * 32, b, (n_), dry); \
        LBAR(); } while (0)
    const float kdec = exp2f(l2g * (float)(63 - row_l));
    RET_LOAD(qA1, qA2, kA1, kA2, vA, 0);
    RET_LOAD(qB1, qB2, kB1, kB2, vB, 1);
    for (int n = 0; n < NCH; n += 2) {
        RET_STEP(qA1, qA2, kA1, kA2, vA, n);
        if (n + 1 < NCH) RET_STEP(qB1, qB2, kB1, kB2, vB, n + 1);
    }
#undef RET_STEP
#undef RET_LOAD
}

constexpr size_t HGT_OFF = Z_OFF + (size_t)R * IN_CD * 2;
constexpr size_t HGT_ITEM = 54272;
static_assert(HGT_OFF + (size_t)NB * NCH * 4 * HGT_ITEM <= HN_OFF, "HGRN tile images fit behind z_cd");
__device__ __forceinline__ void hgrn_prepass(const Args& a, LAS unsigned char* L, unsigned* qctr) {
    int tid_ = threadIdx.x; asm volatile("" : "+v"(tid_));
    const int tid = tid_;
    const bf16_t* Z = (const bf16_t*)(a.ws + Z_OFF);
    const int row_l = tid >> 3, c8 = tid & 7;
    const float* lg = a.in[25];
    LAS int* wq = (LAS int*)(L + LDS_BYTES - 32);
    for (;;) {
        if (tid == 0) *wq = (int)__hip_atomic_fetch_add(qctr, 1u, __ATOMIC_RELAXED, __HIP_MEMORY_SCOPE_AGENT);
        __syncthreads();
        const int it = *wq;
        if (it >= NB * NCH * 4) break;
        const int h = it & 3, bn = it >> 2, b = bn / NCH, n = bn % NCH;
        float lb1[8], lb2[8];
#pragma unroll
        for (int i = 0; i < 8; ++i) { const int d = h * 128 + c8 * 8 + i; lb1[i] = sigmoidf_(lg[d] - lg[512 + d]); lb2[i] = sigmoidf_(lg[d + 64] - lg[512 + d + 64]); }
        const int r = chunk_row(b, n, row_l);
        const bool valid = r >= 0;
        u32x4 q1, q2, f1, f2;
        if (valid) { const bf16_t* zr = Z + (size_t)r * IN_CD;
            q1 = *(const u32x4*)(zr + 512 + h * 128 + c8 * 8); q2 = *(const u32x4*)(zr + 512 + h * 128 + 64 + c8 * 8);
            f1 = *(const u32x4*)(zr + 1024 + h * 128 + c8 * 8); f2 = *(const u32x4*)(zr + 1024 + h * 128 + 64 + c8 * 8);
        } else { q1 = q2 = f1 = f2 = (u32x4){0u, 0u, 0u, 0u}; }
        float qv1[8], qv2[8], kv1[8], kv2[8];
        {
            float fp1[8], fp2[8], lf1[8], lf2[8];
            UNPK8(qv1, q1); UNPK8(qv2, q2); UNPK8(fp1, f1); UNPK8(fp2, f2);
#pragma unroll
            for (int i = 0; i < 8; ++i) {
                const float ff1 = lb1[i] + (1.f - lb1[i]) * sigmoidf_(fp1[i]), ff2 = lb2[i] + (1.f - lb2[i]) * sigmoidf_(fp2[i]);
                if (valid) { lf1[i] = __logf(ff1); lf2[i] = __logf(ff2); kv1[i] = 1.f - ff1; kv2[i] = 1.f - ff2; }
                else { lf1[i] = 0.f; lf2[i] = 0.f; kv1[i] = 0.f; kv2[i] = 0.f; qv1[i] = 0.f; qv2[i] = 0.f; }
            }
            LAS float* cr = (LAS float*)(L + LA_CUM) + row_l * 128;
            *(LAS f32x4*)(cr + c8 * 8) = (f32x4){lf1[0], lf1[1], lf1[2], lf1[3]}; *(LAS f32x4*)(cr + c8 * 8 + 4) = (f32x4){lf1[4], lf1[5], lf1[6], lf1[7]};
            *(LAS f32x4*)(cr + 64 + c8 * 8) = (f32x4){lf2[0], lf2[1], lf2[2], lf2[3]}; *(LAS f32x4*)(cr + 64 + c8 * 8 + 4) = (f32x4){lf2[4], lf2[5], lf2[6], lf2[7]};
        }
        __syncthreads();
        {
            const int d = tid & 127, sg = tid >> 7; LAS float* c = (LAS float*)(L + LA_CUM) + (sg * 16) * 128 + d; float run = 0.f;
#pragma unroll
            for (int rr = 0; rr < 16; ++rr) { run += c[rr * 128]; c[rr * 128] = run; }
        }
        __syncthreads();
        {
            const LAS float* C = (const LAS float*)(L + LA_CUM);
            const int sg = row_l >> 4;
            float qi[16], ki[16], kd[16];
#pragma unroll
            for (int i = 0; i < 16; ++i) {
                const int d = (i < 8) ? c8 * 8 + i : 64 + c8 * 8 + (i - 8);
                const float t0 = C[15 * 128 + d], t1 = C[31 * 128 + d], t2 = C[47 * 128 + d], t3 = C[63 * 128 + d];
                float cum = C[row_l * 128 + d];
                cum += (sg > 0 ? t0 : 0.f) + (sg > 1 ? t1 : 0.f) + (sg > 2 ? t2 : 0.f);
                const float cmid = t0 + t1, total = (t0 + t1) + (t2 + t3);
                const float q = (i < 8) ? qv1[i & 7] : qv2[i & 7], k = (i < 8) ? kv1[i & 7] : kv2[i & 7];
                qi[i] = q * __expf(fminf(cum - cmid, 80.f)); ki[i] = k * __expf(fminf(cmid - cum, 80.f));
                kd[i] = k * __expf(total - cum);
                if (row_l == 0) { *(LAS float*)(L + 70656 + d * 4) = __expf(total); *(LAS float*)(L + 71168 + d * 4) = __expf(cmid); }
            }
            u32x4 w1, w2;
            PK8(w1, qi); { const float* sp = qi + 8; PK8(w2, sp); }
            *(LAS u32x4*)(L + LA_QS + row_l * 272 + c8 * 16) = w1; *(LAS u32x4*)(L + LA_QS + row_l * 272 + 128 + c8 * 16) = w2;
            PK8(w1, ki); { const float* sp = ki + 8; PK8(w2, sp); }
            *(LAS u32x4*)(L + LA_KS + row_l * 272 + c8 * 16) = w1; *(LAS u32x4*)(L + LA_KS + row_l * 272 + 128 + c8 * 16) = w2;
#pragma unroll
            for (int i = 0; i < 8; ++i) {
                *(LAS bf16_t*)(L + LA_KT + kt_off(c8 * 8 + i, row_l)) = f2bf(kd[i]);
                *(LAS bf16_t*)(L + LA_KT + kt_off(64 + c8 * 8 + i, row_l)) = f2bf(kd[8 + i]);
            }
        }
        __syncthreads();
        {
            unsigned char* dst = a.ws + HGT_OFF + (size_t)it * HGT_ITEM;
#pragma unroll
            for (int k = 0; k < 7; ++k) { const int idx = tid + k * NTHREADS; if (idx < 3392) *(u32x4*)(dst + (size_t)idx * 16) = *(const LAS u32x4*)(L + (idx < 2176 ? idx * 16 : LA_KT + (idx - 2176) * 16)); }
        }
        __syncthreads();
    }
}

__device__ __forceinline__ void hgrn_unit(const Args& a, LAS unsigned char* L, int unit, bool dry) {
    int tid_ = threadIdx.x; asm volatile("" : "+v"(tid_));
    const int tid = tid_, b = unit >> 4, h = (unit >> 2) & 3, sl = unit & 3;
    const bf16_t* Z = (const bf16_t*)(a.ws + Z_OFF); bf16_t* OB = (bf16_t*)(a.ws + HN_OFF);
    const int vrow = (tid >> 2) & 63, vp = tid & 3;
    f32x4 st[2] = {{0.f, 0.f, 0.f, 0.f}, {0.f, 0.f, 0.f, 0.f}};
    for (int i = tid; i < 32 * 272 / 4; i += NTHREADS) ((LAS unsigned*)(L + LA_ST))[i] = 0u;
    u32x4 pfA[7], pfB[7], vvA, vvB;
#define HG_LOAD(PF, VV, n_) do { const unsigned char* src_ = a.ws + HGT_OFF + (size_t)(((b * NCH + (n_)) * 4) + h) * HGT_ITEM; \
        _Pragma("unroll") for (int k = 0; k < 7; ++k) { const int idx = tid + k * NTHREADS; PF[k] = (u32x4){0u, 0u, 0u, 0u}; if (idx < 3392) PF[k] = *(const u32x4*)(src_ + (size_t)idx * 16); } \
        VV = (u32x4){0u, 0u, 0u, 0u}; \
        if (tid < 256) { const int rv = chunk_row(b, (n_), vrow); if (rv >= 0) VV = *(const u32x4*)(Z + (size_t)rv * IN_CD + 1536 + h * 128 + sl * 32 + vp * 8); } } while (0)
#define HG_STEP(PF, VV, n_) do { \
        _Pragma("unroll") for (int k = 0; k < 7; ++k) { const int idx = tid + k * NTHREADS; \
            if (idx < 2176) *(LAS u32x4*)(L + idx * 16) = PF[k];                                     \
            else if (idx < 3328) *(LAS u32x4*)(L + LA_KT + (idx - 2176) * 16) = PF[k];              \
            else if (idx < 3392) *(LAS u32x4*)(L + LA_DEC + (idx - 3328) * 16) = PF[k]; }           \
        if (tid < 256) { const unsigned va[4] = {VV.x, VV.y, VV.z, VV.w}; \
            _Pragma("unroll") for (int i = 0; i < 8; ++i) *(LAS bf16_t*)(L + LA_VT + (vp * 8 + i) * 144 + vrow * 2) = (bf16_t)((i & 1) ? (va[i >> 1] >> 16) : (va[i >> 1] & 0xffffu)); } \
        if ((n_) + 2 < NCH) HG_LOAD(PF, VV, (n_) + 2); \
        LBAR(); \
        la_core<true>(L, st, 0.f, OB, 512, h * 128 + sl * 32, b, (n_), dry); \
        LBAR(); } while (0)
    HG_LOAD(pfA, vvA, 0);
    HG_LOAD(pfB, vvB, 1);
    for (int n = 0; n < NCH; n += 2) {
        HG_STEP(pfA, vvA, n);
        if (n + 1 < NCH) HG_STEP(pfB, vvB, n + 1);
    }
#undef HG_STEP
#undef HG_LOAD
}

constexpr int LR_XB = 0, LR_XC = 32768, LR_XA = 49152, LR_RG = 58368, RGS = 68  , LR_SEG = LR_RG + 64 * RGS * 4  , LR_END = LR_SEG + 16 * 64 * 4;
__device__ __forceinline__ void lru_unit(const Args& a, LAS unsigned char* L, int unit, bool dry) {
    int tid_ = threadIdx.x; asm volatile("" : "+v"(tid_));
    const int tid = tid_, lane = tid & 63, w = __builtin_amdgcn_readfirstlane(tid >> 6), fr = lane & 15, fq = lane >> 4;
    const int b = unit >> 5, cb = (unit >> 1) & 15, hf = unit & 1;
    bf16_t* Z = (bf16_t*)(a.ws + Z_OFF);
    const int row_l = tid >> 3, c8 = tid & 7;
    const int oc = cb * 64 + hf * 32 + c8 * 4;
    LAS float* XB = (LAS float*)(L + LR_XB); LAS float* XC = (LAS float*)(L + LR_XC); LAS float* RG = (LAS float*)(L + LR_RG);
    float cw[4][8], cbs[8];
#pragma unroll
    for (int i = 0; i < 8; ++i) { const int c = cb * 64 + c8 * 8 + i; cbs[i] = a.in[11][c];
#pragma unroll
        for (int ww = 0; ww < 4; ++ww) cw[ww][i] = a.in[10][ww * 1024 + c]; }
    const int mg = w >> 1, ct = w & 1;
    const int gch = cb * 64 + hf * 32 + ct * 16 + 4 * fq;
    const bf16_t* WG = (const bf16_t*)(a.ws + LRUW_OFF) + (size_t)cb * 128 * 64;
    const int nr_ = hf * 32 + ct * 16 + fr;
    const bf16x8 wr0 = *(const bf16x8*)(WG + nr_ * 64 + fq * 8), wr1 = *(const bf16x8*)(WG + nr_ * 64 + 32 + fq * 8);
    const bf16x8 wi0 = *(const bf16x8*)(WG + (64 + nr_) * 64 + fq * 8), wi1 = *(const bf16x8*)(WG + (64 + nr_) * 64 + 32 + fq * 8);
    const f32x4 bra = *(const f32x4*)(a.in[6] + gch), bia = *(const f32x4*)(a.in[8] + gch);
    float sp[4];
#pragma unroll
    for (int i = 0; i < 4; ++i) sp[i] = log1pf(expf(-a.in[9][gch + i]));
    float hstate = 0.f;
    for (int i = tid; i < 64 * 64; i += NTHREADS) XB[64 * 64 + i] = 0.f;
    u32x4 xbv; u32x2 bgv;
#define LRU_LOAD(n_) do { const int r_ = chunk_row(b, (n_), row_l); \
        if (r_ >= 0) { const bf16_t* zr = Z + (size_t)r_ * IN_AB; xbv = *(const u32x4*)(zr + 2048 + cb * 64 + c8 * 8); bgv = *(const u32x2*)(zr + 4096 + oc); } \
        else { xbv = (u32x4){0u, 0u, 0u, 0u}; bgv = (u32x2){0u, 0u}; } } while (0)
    LRU_LOAD(0);
    for (int n = 0; n < NCH; ++n) {
        const int cur = (n & 1) * 4096, prv = 4096 - cur;
        {
            float xf[8]; UNPK8(xf, xbv);
            *(LAS f32x4*)(XB + cur + row_l * 64 + c8 * 8) = (f32x4){xf[0], xf[1], xf[2], xf[3]}; *(LAS f32x4*)(XB + cur + row_l * 64 + c8 * 8 + 4) = (f32x4){xf[4], xf[5], xf[6], xf[7]};
        }
        const u32x2 bgc = bgv;
        const int grow = chunk_row(b, n, row_l);
        if (n + 1 < NCH) LRU_LOAD(n + 1);
        LBAR();
        {
            float xc[8];
#pragma unroll
            for (int i = 0; i < 8; ++i) xc[i] = cbs[i];
#pragma unroll
            for (int ww = 0; ww < 4; ++ww) {
                const int rr = row_l + ww - 3;
                const LAS float* src = rr >= 0 ? XB + cur + rr * 64 + c8 * 8 : XB + prv + (64 + rr) * 64 + c8 * 8;
                const f32x4 x0 = *(const LAS f32x4*)src, x1 = *(const LAS f32x4*)(src + 4);
                xc[0] += cw[ww][0] * x0[0]; xc[1] += cw[ww][1] * x0[1]; xc[2] += cw[ww][2] * x0[2]; xc[3] += cw[ww][3] * x0[3];
                xc[4] += cw[ww][4] * x1[0]; xc[5] += cw[ww][5] * x1[1]; xc[6] += cw[ww][6] * x1[2]; xc[7] += cw[ww][7] * x1[3];
            }
            *(LAS f32x4*)(XC + row_l * 64 + c8 * 8) = (f32x4){xc[0], xc[1], xc[2], xc[3]}; *(LAS f32x4*)(XC + row_l * 64 + c8 * 8 + 4) = (f32x4){xc[4], xc[5], xc[6], xc[7]};
            u32x4 o; PK8(o, xc);
            *(LAS u32x4*)(L + LR_XA + row_l * 144 + c8 * 16) = o;
        }
        LBAR();
        {
            const bf16x8 x0 = ldsfrag(L + LR_XA + (mg * 16 + fr) * 144 + fq * 16), x1 = ldsfrag(L + LR_XA + (mg * 16 + fr) * 144 + 64 + fq * 16);
            f32x4 ra = {0.f, 0.f, 0.f, 0.f}, ia = {0.f, 0.f, 0.f, 0.f};
            ra = MFMA16(wr0, x0, ra); ia = MFMA16(wi0, x0, ia); ra = MFMA16(wr1, x1, ra); ia = MFMA16(wi1, x1, ia);
            const int jr = mg * 16 + fr;
            const f32x4 x4 = *(const LAS f32x4*)(XC + jr * 64 + hf * 32 + ct * 16 + 4 * fq);
            const bool rvalid = (n > 0) || (jr >= 48);
            f32x4 a4, b4;
#pragma unroll
            for (int i = 0; i < 4; ++i) {
                const float r = sigmoidf_(ra[i] + bra[i]), ig = sigmoidf_(ia[i] + bia[i]);
                const float log_a = -8.f * r * sp[i], x2 = 2.f * log_a, e2 = __expf(x2);
                const float ser = -x2 * (1.f + x2 * (0.5f + x2 * (0.16666667f + x2 * (0.041666668f + x2 * 0.0083333338f))));
                const float om = x2 > -0.25f ? ser : 1.f - e2;
                a4[i] = rvalid ? __expf(log_a) : 1.f; b4[i] = rvalid ? sqrtf(fmaxf(om, 0.f)) * (ig * x4[i]) : 0.f;
            }
            *(LAS f32x4*)(RG + jr * RGS + ct * 16 + 4 * fq) = a4; *(LAS f32x4*)(RG + jr * RGS + 32 + ct * 16 + 4 * fq) = b4;
        }
        LBAR();
        {
            LAS float* SEG = (LAS float*)(L + LR_SEG);
            const int sg = w * 2 + (lane >> 5), ch = lane & 31;
            float sa[4], sb[4];
            {
                float P = 1.f, hh = 0.f;
#pragma unroll
                for (int i = 0; i < 4; ++i) { sa[i] = RG[(sg * 4 + i) * RGS + ch]; sb[i] = RG[(sg * 4 + i) * RGS + 32 + ch]; hh = sa[i] * hh + sb[i]; P *= sa[i]; }
                SEG[sg * 64 + ch] = P; SEG[sg * 64 + 32 + ch] = hh;
            }
            LBAR();
            float c = hstate, mine = 0.f;
#pragma unroll
            for (int s2 = 0; s2 < 16; ++s2) { mine = (s2 == sg) ? c : mine; c = SEG[s2 * 64 + ch] * c + SEG[s2 * 64 + 32 + ch]; }
            hstate = c;
            float hh = mine;
#pragma unroll
            for (int i = 0; i < 4; ++i) { hh = sa[i] * hh + sb[i]; RG[(sg * 4 + i) * RGS + 32 + ch] = hh; }
        }
        LBAR();
        if (grow >= 0 && !dry) {
            const f32x4 h4 = *(const LAS f32x4*)(RG + row_l * RGS + 32 + c8 * 4);
            u32x2 o; o.x = cvt_pk_bf16(gelu_tanh(bf_lo(bgc.x)) * h4[0], gelu_tanh(bf_hi(bgc.x)) * h4[1]); o.y = cvt_pk_bf16(gelu_tanh(bf_lo(bgc.y)) * h4[2], gelu_tanh(bf_hi(bgc.y)) * h4[3]);
            if (grow < RM) *(u32x2*)(Z + (size_t)grow * IN_AB + 4096 + oc) = o;
            else if (b == 0) *(u32x2*)((bf16_t*)(a.ws + YAB_OFF) + (size_t)(grow - RM) * 2048 + 1024 + oc) = o;
        }
    }
    LBAR();
#undef LRU_LOAD
}

constexpr int S5_ROWS = 128, S5_NIT = 33;
constexpr int S5_BU = 0, BUS = 132  , S5_HS = S5_ROWS * BUS * 4, S5_EX = S5_HS + S5_ROWS * 272  , S5_END = S5_EX + 8 * 128 * 4;
static_assert(S5_END <= LDS_BYTES - 16, "S5 lds");
__device__ __forceinline__ int sc_row(int b, int s, int j) { const int n = 2 * s - 1 + (j >> 6); return n < 0 ? -1 : chunk_row(b, n, j & 63); }
__device__ __forceinline__ void s5_unit(const Args& a, LAS unsigned char* L, int unit, bool dry) {
    int tid_ = threadIdx.x; asm volatile("" : "+v"(tid_));
    const int tid = tid_, lane = tid & 63, w = __builtin_amdgcn_readfirstlane(tid >> 6), fr = lane & 15, fq = lane >> 4;
    const int b = unit >> 5, g = unit & 31;
    bf16_t* Z = (bf16_t*)(a.ws + Z_OFF);
    const bf16_t* BB = (const bf16_t*)(a.ws + S5BB_OFF) + (size_t)g * 128 * 32;
    const bf16_t* CM = (const bf16_t*)(a.ws + S5CM_OFF) + (size_t)g * 16 * 128;
    const float* AB = (const float*)(a.ws + S5AB_OFF) + (size_t)g * 128;
    const bf16x8 bbf = *(const bf16x8*)(BB + (w * 16 + fr) * 32 + fq * 8);
    bf16x8 cmf[4];
#pragma unroll
    for (int kk = 0; kk < 4; ++kk) cmf[kk] = *(const bf16x8*)(CM + fr * 128 + kk * 32 + fq * 8);
    const float ar = AB[2 * lane], ai = AB[2 * lane + 1];
    const f32x4 dv = *(const f32x4*)(a.in[20] + g * 16 + 4 * fq);
    float hr = 0.f, hi = 0.f;
    LAS float* BU = (LAS float*)(L + S5_BU); LAS float* EX = (LAS float*)(L + S5_EX);
    float p16r, p16i;
    { float pr = ar, pi = ai;
#pragma unroll
      for (int i = 0; i < 4; ++i) { const float nr = pr * pr - pi * pi, ni = 2.f * pr * pi; pr = nr; pi = ni; }
      p16r = pr; p16i = pi; }
    bf16x8 uf[8]; u32x2 uvn = {0u, 0u};
#define S5_LOAD(s_) do { _Pragma("unroll") for (int m = 0; m < 8; ++m) { const int r_ = sc_row(b, (s_), m * 16 + fr); \
            uf[m] = (bf16x8){0, 0, 0, 0, 0, 0, 0, 0}; \
            if (r_ >= 0 && fq < 2) uf[m] = *(const bf16x8*)(Z + (size_t)r_ * IN_CD + g * 16 + fq * 8); } \
        { const int r2_ = sc_row(b, (s_), w * 16 + fr); uvn = (u32x2){0u, 0u}; if (r2_ >= 0) uvn = *(const u32x2*)(Z + (size_t)r2_ * IN_CD + g * 16 + 4 * fq); } } while (0)
    S5_LOAD(0);
    for (int sI = 0; sI < S5_NIT; ++sI) {
#pragma unroll
        for (int m = 0; m < 8; ++m) { f32x4 acc = {0.f, 0.f, 0.f, 0.f}; acc = MFMA16(bbf, uf[m], acc);
            *(LAS f32x4*)(BU + (m * 16 + fr) * BUS + w * 16 + 4 * fq) = acc; }
        const u32x2 uv = uvn;
        if (sI + 1 < S5_NIT) S5_LOAD(sI + 1);
        LBAR();
        {
            float cr = 0.f, ci = 0.f;
#pragma unroll
            for (int i = 0; i < 16; ++i) {
                const float br = BU[(16 * w + i) * BUS + lane], bi = BU[(16 * w + i) * BUS + 64 + lane];
                const float nr = ar * cr - ai * ci + br, ni = ar * ci + ai * cr + bi;
                cr = nr; ci = ni;
            }
            EX[w * 128 + lane] = cr; EX[w * 128 + 64 + lane] = ci;
        }
        LBAR();
        {
            float cr = hr, ci = hi, mr = 0.f, mi = 0.f;
#pragma unroll
            for (int ww = 0; ww < 8; ++ww) {
                if (ww == w) { mr = cr; mi = ci; }
                const float er = EX[ww * 128 + lane], ei = EX[ww * 128 + 64 + lane];
                const float nr = p16r * cr - p16i * ci + er, ni = p16r * ci + p16i * cr + ei;
                cr = nr; ci = ni;
            }
            hr = cr; hi = ci;
#pragma unroll
            for (int i = 0; i < 16; ++i) {
                const float br = BU[(16 * w + i) * BUS + lane], bi = BU[(16 * w + i) * BUS + 64 + lane];
                const float nr = ar * mr - ai * mi + br, ni = ar * mi + ai * mr + bi;
                mr = nr; mi = ni;
                *(LAS bf16_t*)(L + S5_HS + (16 * w + i) * 272 + lane * 2) = f2bf(mr);
                *(LAS bf16_t*)(L + S5_HS + (16 * w + i) * 272 + 128 + lane * 2) = f2bf(mi);
            }
        }
        LBAR();
        {
            f32x4 acc = {0.f, 0.f, 0.f, 0.f};
#pragma unroll
            for (int kk = 0; kk < 4; ++kk) acc = MFMA16(cmf[kk], ldsfrag(L + S5_HS + (w * 16 + fr) * 272 + kk * 64 + fq * 16), acc);
            const int r = sc_row(b, sI, w * 16 + fr);
            if (r >= 0 && !dry) {
                bf16_t* up = Z + (size_t)r * IN_CD + g * 16 + 4 * fq;
                const float y0 = gelu_tanh(acc[0] + dv[0] * bf_lo(uv.x)), y1 = gelu_tanh(acc[1] + dv[1] * bf_hi(uv.x));
                const float y2 = gelu_tanh(acc[2] + dv[2] * bf_lo(uv.y)), y3 = gelu_tanh(acc[3] + dv[3] * bf_hi(uv.y));
                u32x2 o; o.x = cvt_pk_bf16(y0, y1); o.y = cvt_pk_bf16(y2, y3);
                if (r < RM) *(u32x2*)up = o; else if (b == 0) *(u32x2*)((bf16_t*)(a.ws + YM_OFF) + (size_t)(r - RM) * 512 + g * 16 + 4 * fq) = o;
            }
        }
    }
    LBAR();
#undef S5_LOAD
}

__device__ __forceinline__ void phase_ret_post(const Args& a) {
    int tid_ = threadIdx.x; asm volatile("" : "+v"(tid_));
    const int tid = tid_, lane = tid & 63, wave = tid >> 6;
    const int gw = blockIdx.x * 8 + wave, NGW = gridDim.x * 8;
    bf16_t* Z = (bf16_t*)(a.ws + Z_OFF); const bf16_t* OB = (const bf16_t*)(a.ws + HN_OFF); const float* gn = a.in[4];
    for (int row = gw; row < RVALID; row += NGW) {
        u32x2 ov[4], gv[4]; f32x4 gg[4];
#pragma unroll
        for (int h = 0; h < 4; ++h) {
            ov[h] = *(const u32x2*)(OB + (size_t)row * DM + h * 256 + 4 * lane);
            gv[h] = *(const u32x2*)(Z + (size_t)row * IN_AB + 3072 + h * 256 + 4 * lane);
            gg[h] = *(const f32x4*)(gn + h * 256 + 4 * lane);
        }
#pragma unroll
        for (int h = 0; h < 4; ++h) {
            float o0 = bf_lo(ov[h].x), o1 = bf_hi(ov[h].x), o2 = bf_lo(ov[h].y), o3 = bf_hi(ov[h].y);
            const float mean = wave_sum((o0 + o1) + (o2 + o3)) * (1.f / 256.f);
            o0 -= mean; o1 -= mean; o2 -= mean; o3 -= mean;
            const float inv = rsqrtf(wave_sum(o0 * o0 + o1 * o1 + o2 * o2 + o3 * o3) * (1.f / 256.f) + EPS);
            u32x2 y; y.x = cvt_pk_bf16(o0 * inv * gg[h][0] * silu_(bf_lo(gv[h].x)), o1 * inv * gg[h][1] * silu_(bf_hi(gv[h].x)));
            y.y = cvt_pk_bf16(o2 * inv * gg[h][2] * silu_(bf_lo(gv[h].y)), o3 * inv * gg[h][3] * silu_(bf_hi(gv[h].y)));
            if (row < RM) *(u32x2*)(Z + (size_t)row * IN_AB + 3072 + h * 256 + 4 * lane) = y;
            else *(u32x2*)((bf16_t*)(a.ws + YAB_OFF) + (size_t)(row - RM) * 2048 + h * 256 + 4 * lane) = y;
        }
    }
}
__device__ __forceinline__ void phase_hg_post(const Args& a) {
    int tid_ = threadIdx.x; asm volatile("" : "+v"(tid_));
    const int tid = tid_, lane = tid & 63, wave = tid >> 6;
    const int gw = blockIdx.x * 8 + wave, NGW = gridDim.x * 8;
    bf16_t* Z = (bf16_t*)(a.ws + Z_OFF); const bf16_t* OB = (const bf16_t*)(a.ws + HN_OFF); const float* gn = a.in[24];
    for (int row = gw; row < RVALID; row += NGW) {
        unsigned ov[4], gv[4]; f32x2 gg[4];
#pragma unroll
        for (int h = 0; h < 4; ++h) {
            ov[h] = *(const unsigned*)(OB + (size_t)row * 512 + h * 128 + 2 * lane);
            gv[h] = *(const unsigned*)(Z + (size_t)row * IN_CD + 2048 + h * 128 + 2 * lane);
            gg[h] = *(const f32x2*)(gn + h * 128 + 2 * lane);
        }
#pragma unroll
        for (int h = 0; h < 4; ++h) {
            const float o0 = bf_lo(ov[h]), o1 = bf_hi(ov[h]);
            const float inv = rsqrtf(wave_sum(o0 * o0 + o1 * o1) * (1.f / 128.f) + EPS);
            const unsigned yv = cvt_pk_bf16(o0 * inv * gg[h][0] * silu_(bf_lo(gv[h])), o1 * inv * gg[h][1] * silu_(bf_hi(gv[h])));
            if (row < RM) *(unsigned*)(Z + (size_t)row * IN_CD + 2048 + h * 128 + 2 * lane) = yv;
            else *(unsigned*)((bf16_t*)(a.ws + YCD_OFF) + (size_t)(row - RM) * 1024 + 512 + h * 128 + 2 * lane) = yv;
        }
    }
}

#define XB_TMO      128
#define XB_XCNT(j)  (256  + 64 * (j))
#define XB_XSUB(j)  (1280 + 64 * (j))
#define XB_XGEN(j)  (2304 + 64 * (j))
#define XB_TOP      3328
#define XB_TOPGEN   3392
#define XCD_BAR_WORDS 3456
#define XB_SPIN_CAP (1u << 18)

__device__ __forceinline__ unsigned xb_ld(unsigned* p)              { return __hip_atomic_load(p, __ATOMIC_RELAXED, __HIP_MEMORY_SCOPE_AGENT); }
__device__ __forceinline__ unsigned xb_add(unsigned* p, unsigned v) { return __hip_atomic_fetch_add(p, v, __ATOMIC_RELAXED, __HIP_MEMORY_SCOPE_AGENT); }
__device__ __forceinline__ unsigned xb_xcc_id() { return (unsigned)__builtin_amdgcn_s_getreg((3 << 11) | 20) & 0xFu; }
#define XB_SPIN(cond, bar) do { unsigned _sp = 0; while (cond) { __builtin_amdgcn_s_sleep(1); \
    if ((++_sp & 255u) == 0u) { if (xb_ld(&(bar)[XB_TMO])) break; if (_sp > XB_SPIN_CAP) { atomicAdd(&(bar)[XB_TMO], 1u); break; } } } } while (0)

struct XcdBarrier {
    unsigned* bar; unsigned x;
    volatile LAS unsigned* st;
};

__device__ __forceinline__ XcdBarrier xcd_barrier_post(unsigned* bar, volatile LAS unsigned* st) {
    XcdBarrier b; b.bar = bar; b.x = xb_xcc_id(); b.st = st;
    if (threadIdx.x == 0) (void)xb_add(&bar[XB_XCNT(b.x)], 1u);
    return b;
}
__device__ __forceinline__ void xcd_barrier_complete(unsigned* bar, unsigned x, unsigned& nloc, unsigned& nx) {
    const unsigned G = gridDim.x * gridDim.y * gridDim.z;
    unsigned sum, cnt, mine, sp = 0u;
    for (;;) {
        sum = 0u; cnt = 0u; mine = 0u;
#pragma unroll
        for (unsigned j = 0; j < 16; ++j) { const unsigned c = xb_ld(&bar[XB_XCNT(j)]); sum += c; cnt += (c > 0u) ? 1u : 0u; mine = (j == x) ? c : mine; }
        if (sum == G) break;
        __builtin_amdgcn_s_sleep(1);
        if ((++sp & 255u) == 0u) { if (xb_ld(&bar[XB_TMO])) break; if (sp > XB_SPIN_CAP) { atomicAdd(&bar[XB_TMO], 1u); break; } }
    }
    nloc = mine > 0u ? mine : 1u; nx = cnt > 0u ? cnt : 1u;
}

__device__ __forceinline__ void xcd_barrier(const XcdBarrier& b) {
    asm volatile("s_waitcnt vmcnt(0)" ::: "memory");
    __syncthreads();
    if (threadIdx.x == 0) {
        unsigned* bar = b.bar;
        __builtin_amdgcn_s_waitcnt(0);
        unsigned nloc = b.st[0], nx = b.st[1];
        if (nloc == 0u) { xcd_barrier_complete(bar, b.x, nloc, nx); b.st[0] = nloc; b.st[1] = nx; }
        const unsigned old = xb_add(&bar[XB_XSUB(b.x)], 1u);
        const unsigned gen = old / nloc;
        if (old + 1u == (gen + 1u) * nloc) {
            __builtin_amdgcn_fence(__ATOMIC_RELEASE, "agent");
            asm volatile("s_waitcnt vmcnt(0)" ::: "memory");
            const unsigned og = xb_add(&bar[XB_TOP], 1u);
            const unsigned tg = og / nx;
            if (og + 1u == (tg + 1u) * nx) xb_add(&bar[XB_TOPGEN], 1u);
            else XB_SPIN(xb_ld(&bar[XB_TOPGEN]) == tg, bar);
            __builtin_amdgcn_fence(__ATOMIC_ACQUIRE, "agent");
            xb_add(&bar[XB_XGEN(b.x)], 1u);
            asm volatile("s_waitcnt vmcnt(0)" ::: "memory");
        } else {
            XB_SPIN(xb_ld(&bar[XB_XGEN(b.x)]) == gen, bar);
            __builtin_amdgcn_fence(__ATOMIC_ACQUIRE, "agent");
            asm volatile("s_waitcnt vmcnt(0)" ::: "memory");
        }
    }
    __syncthreads();
}


#ifndef DBG_STOP
#define DBG_STOP 0
#endif
__device__ __forceinline__ void dbg_digest(const Args& a) {
    const size_t gt = (size_t)blockIdx.x * NTHREADS + threadIdx.x, NGT = (size_t)gridDim.x * NTHREADS;
    const bf16_t* zb = (const bf16_t*)(a.ws + Z_OFF);
    const size_t NE = ((size_t)R * 5120 + (size_t)R * 1024);
    const size_t ON = (size_t)RM * DM;
    for (size_t i = gt; i < ON; i += NGT) {
        float s = 0.f;
        for (size_t k = i; k < NE; k += ON) s += __uint_as_float((unsigned)zb[k] << 16);
        a.out[i] = a.out[i] * 1e-3f + s;
    }
}
#ifndef DBG_REP34
#define DBG_REP34 0
#endif
#ifndef DBG_REPG
#define DBG_REPG 0
#endif
#ifndef DBG_SYNC2
#define DBG_SYNC2 0
#endif
#ifndef DBG_TIME
#define DBG_TIME 0
#endif
#define GSYNC() xcd_barrier(xbar)
#define DBG_CHECK(k) do { if (DBG_STOP == (k)) { grid.sync(); dbg_digest(a); return; } \
    if (DBG_TIME) { if ((k) == DBG_TIME - 1) dbg_t0 = __builtin_amdgcn_s_memrealtime(); if ((k) == DBG_TIME) dbg_t1 = __builtin_amdgcn_s_memrealtime(); } } while (0)
__global__ void __launch_bounds__(NTHREADS, 2) fwd_megakernel(Args a) {
    extern __shared__ __attribute__((aligned(16))) unsigned char lds_raw[];
    LAS unsigned char* L = (LAS unsigned char*)lds_raw;
    cg::grid_group grid = cg::this_grid();
    unsigned char* ws = a.ws;
    const int G = gridDim.x, bx = blockIdx.x;
    bf16_t* Zb = (bf16_t*)(ws + Z_OFF); bf16_t* HNb = (bf16_t*)(ws + HN_OFF); float* ssq = (float*)(ws + SSQ_OFF);
    bf16_t* YABb = (bf16_t*)(ws + YAB_OFF); bf16_t* YCDb = (bf16_t*)(ws + YCD_OFF); bf16_t* YMb = (bf16_t*)(ws + YM_OFF);
    float* hmeta = (float*)(ws + HMETA_OFF);
    const float* ng = a.in[26];
    const bool fusedres = (G == 256);

    if (threadIdx.x < 4) ((LAS unsigned*)(L + LDS_BYTES - 16))[threadIdx.x] = 0u;
    __syncthreads();
    const XcdBarrier xbar = xcd_barrier_post((unsigned*)(ws + BAR_OFF), (volatile LAS unsigned*)(L + LDS_BYTES - 16));
    if (a.never) grid.sync();
    phase_prologue(a, L, !fusedres);
    GSYNC();

#define GEMM_PHASE(MODE, Ap, lda_, Wp, N_, K_, Op, ldo_, Yp, ldy_, biasp, AMp, ldam_, OMp, ldom_, YMp, ldym_) do { \
        pg8::Gemm g{(Ap), (Wp), RM, (N_), (K_), (lda_)}; pg8::StaticOrder S; S.init(RM, (N_), G, bx); \
        pg8::Epi<MODE> E{(Op), (ldo_), nullptr, (Yp), (ldy_), (biasp)}; \
        pg8::gemm_phase(L, g, S, E); \
        meta_gemm<MODE, 4, ((K_) >= 1024 ? 4 : 2)>(L, (AMp), (ldam_), (Wp), (N_), (K_), (OMp), (ldom_), nullptr, (YMp), (ldym_), (biasp)); } while (0)
#define RES_PHASE(P, HIN, Ap, lda_, Wp, K_, AMp, ldam_, g1_, g2_) do { \
        pg8::Gemm g{(Ap), (Wp), RM, DM, (K_), (lda_)}; pg8::StaticOrder S; S.init(RM, DM, G, bx); \
        if (fusedres) { \
            float* x1 = (float*)(ws + XB_OFF + (size_t)((P) * 2) * XB_STRIDE); float* x2 = (float*)(ws + XB_OFF + (size_t)((P) * 2 + 1) * XB_STRIDE); \
            unsigned* c1 = (unsigned*)(ws + CNT_OFF) + ((P) * 2) * 80 * 32; unsigned* c2 = (unsigned*)(ws + CNT_OFF) + ((P) * 2 + 1) * 80 * 32; \
            pg8::EpiRes E{(HIN), a.out, (g1_), (g2_), HNb, x1, x2, c1, c2}; \
            pg8::gemm_phase(L, g, S, E); \
            meta_gemm<4, 1, ((K_) >= 2048 ? 8 : 4)>(L, (AMp), (ldam_), (Wp), DM, (K_), HNb + (size_t)RM * DM, DM, nullptr, nullptr, 0, nullptr, hmeta, (g1_), (g2_), x1 + 64 * 256 * 4, x2 + 64 * 256 * 4, c1 + 64 * 32, c2 + 64 * 32); \
            GSYNC(); \
        } else { \
            pg8::Epi<1> E{HNb, DM, ssq, nullptr, 0, nullptr}; \
            pg8::gemm_phase(L, g, S, E); \
            meta_gemm<1, 4, 4>(L, (AMp), (ldam_), (Wp), DM, (K_), HNb + (size_t)RM * DM, DM, ssq + (size_t)RM * 16, nullptr, 0, nullptr); \
            GSYNC(); \
            phase_resnorm(a, (g1_), (g2_)); \
            GSYNC(); \
        } } while (0)

    {
        const bf16_t* W = (const bf16_t*)(ws + W_INAB);
        GEMM_PHASE(0, HNb, DM, W, IN_AB, DM, Zb, IN_AB, nullptr, 0, nullptr, HNb + (size_t)RM * DM, DM, Zb + (size_t)RM * IN_AB, IN_AB, nullptr, 0);
    }
    GSYNC();
    for (int u = bx; u < 128 + 128; u += G) { if (u < 128) retention_unit(a, L, u, false); else lru_unit(a, L, u - 128, false); }
    GSYNC();
    phase_ret_post(a);
    GSYNC();
    {
        const bf16_t* W = (const bf16_t*)(ws + W_OUTAB);
        RES_PHASE(0, (fusedres ? a.in[0] : (const float*)a.out), Zb + 3072, IN_AB, W, 2048, YABb, 2048, ng + 1 * DM, ng + 2 * DM);
    }
    {
        const bf16_t* W = (const bf16_t*)(ws + W_W1_0);
        GEMM_PHASE(2, HNb, DM, W, FF, DM, Zb, FF, nullptr, 0, nullptr, HNb + (size_t)RM * DM, DM, Zb + (size_t)RM * FF, FF, nullptr, 0);
    }
    GSYNC();
    {
        const bf16_t* W = (const bf16_t*)(ws + W_W2_0);
        RES_PHASE(1, (const float*)a.out, Zb, FF, W, FF, Zb + (size_t)RM * FF, FF, ng + 3 * DM, ng + 4 * DM);
    }

    {
        const bf16_t* W = (const bf16_t*)(ws + W_INCD);
        GEMM_PHASE(0, HNb, DM, W, 2048, DM, Zb, IN_CD, nullptr, 0, nullptr, HNb + (size_t)RM * DM, DM, Zb + (size_t)RM * IN_CD, IN_CD, nullptr, 0);
    }
    GSYNC();
    {
        const bf16_t* Wg = (const bf16_t*)(ws + W_INCD) + (size_t)2048 * DM;
        GEMM_PHASE(0, HNb, DM, Wg, 512, DM, Zb + 2048, IN_CD, nullptr, 0, nullptr, HNb + (size_t)RM * DM, DM, Zb + (size_t)RM * IN_CD + 2048, IN_CD, nullptr, 0);
    }
    hgrn_prepass(a, L, (unsigned*)(ws + CNT_OFF) + 7 * 80 * 32 + 70 * 32);
    GSYNC();
    for (int u = bx; u < 64 + 128; u += G) { if (u < 64) hgrn_unit(a, L, u, false); else s5_unit(a, L, u - 64, false); }
    if (G == 256) { if (bx >= 192) weight_convert(a, L, WC_C5, WC_C9, bx - 192, 64); }
    else weight_convert(a, L, WC_C5, WC_C9, bx, G);
    GSYNC();
    phase_hg_post(a);
    {
        const bf16_t* W = (const bf16_t*)(ws + W_GLU);
        GEMM_PHASE(3, Zb, IN_CD, W, 512, 512, Zb + 1536, IN_CD, Zb, IN_CD, a.in[23], YMb, 512, YCDb, 1024, YMb, 512);
    }
    GSYNC();
    {
        const bf16_t* W = (const bf16_t*)(ws + W_OUTCD);
        RES_PHASE(2, (const float*)a.out, Zb + 1536, IN_CD, W, DM, YCDb, 1024, ng + 5 * DM, ng + 6 * DM);
    }
    {
        const bf16_t* W = (const bf16_t*)(ws + W_W1_1);
        GEMM_PHASE(2, HNb, DM, W, FF, DM, Zb, FF, nullptr, 0, nullptr, HNb + (size_t)RM * DM, DM, Zb + (size_t)RM * FF, FF, nullptr, 0);
    }
    GSYNC();
    {
        const bf16_t* W = (const bf16_t*)(ws + W_W2_1);
        pg8::Gemm g{Zb, W, RM, DM, FF, FF}; pg8::StaticOrder S; S.init(RM, DM, G, bx);
        if (fusedres) {
            float* x1 = (float*)(ws + XB_OFF + (size_t)6 * XB_STRIDE); unsigned* c1 = (unsigned*)(ws + CNT_OFF) + 6 * 80 * 32;
            pg8::EpiRes E{(const float*)a.out, a.out, ng + 7 * DM, nullptr, HNb, x1, x1, c1, c1};
            pg8::gemm_phase(L, g, S, E);
            meta_gemm<4, 1, 8>(L, Zb + (size_t)RM * FF, FF, W, DM, FF, HNb + (size_t)RM * DM, DM, nullptr, nullptr, 0, nullptr, hmeta, ng + 7 * DM, nullptr, x1 + 64 * 256 * 4, x1 + 64 * 256 * 4, c1 + 64 * 32, c1 + 64 * 32);
        } else {
            pg8::Epi<1> E{HNb, DM, ssq, nullptr, 0, nullptr};
            pg8::gemm_phase(L, g, S, E);
            meta_gemm<1, 4, 4>(L, Zb + (size_t)RM * FF, FF, W, DM, FF, HNb + (size_t)RM * DM, DM, ssq + (size_t)RM * 16, nullptr, 0, nullptr);
            GSYNC();
            phase_resnorm(a, ng + 7 * DM, nullptr);
        }
    }
#undef GEMM_PHASE
#undef RES_PHASE
}

extern "C" void kernel_launch(void* const* d_in, const int* in_sizes, int n_in, void* d_out, int out_size, void* d_ws, size_t ws_size, hipStream_t stream) {
    static int grid = 0;
    if (!grid) {
        int dev = 0, cus = 0, per_cu = 0;
        (void)hipGetDevice(&dev);
        (void)hipDeviceGetAttribute(&cus, hipDeviceAttributeMultiprocessorCount, dev);
        (void)hipFuncSetAttribute((const void*)fwd_megakernel, hipFuncAttributeMaxDynamicSharedMemorySize, LDS_BYTES);
        (void)hipOccupancyMaxActiveBlocksPerMultiprocessor(&per_cu, (const void*)fwd_megakernel, NTHREADS, LDS_BYTES);
        if (per_cu < 1) per_cu = 1;
        grid = cus * per_cu;
        if (n_in != 29 || ws_size < WS_END) fprintf(stderr, "kernel_launch: unexpected n_in %d / ws %zu (need %zu)\n", n_in, ws_size, (size_t)WS_END);
    }
    Args a{};
    for (int i = 0; i < 29; ++i) a.in[i] = (const float*)d_in[i];
    a.out = (float*)d_out; a.ws = (unsigned char*)d_ws; a.never = 0;
    (void)hipMemsetAsync((unsigned char*)d_ws + BAR_OFF, 0, (size_t)(XB_OFF - BAR_OFF), stream);
    void* args[] = {&a};
    hipError_t e = hipLaunchCooperativeKernel((void*)fwd_megakernel, dim3(grid), dim3(NTHREADS), args, LDS_BYTES, stream);
    if (e != hipSuccess) fprintf(stderr, "cooperative launch failed: %s (grid %d)\n", hipGetErrorString(e), grid);
}
```

```cpp
#include <hip/hip_runtime.h>
#include <hip/hip_cooperative_groups.h>
#include <cstdio>
#include <cstdint>
namespace cg = cooperative_groups;

#define LAS __attribute__((address_space(3)))
typedef unsigned short bf16_t;
typedef short bf16x8 __attribute__((ext_vector_type(8)));
typedef float f32x4 __attribute__((ext_vector_type(4)));
typedef float f32x2 __attribute__((ext_vector_type(2)));
typedef unsigned u32x4 __attribute__((ext_vector_type(4)));
typedef unsigned u32x2 __attribute__((ext_vector_type(2)));

constexpr int DM = 1024, NB = 4, SEQ = 4096, NMETA = 16, FF = 4096;
constexpr int RM = NB * SEQ;
constexpr int RMETA = RM;
constexpr int RVALID = RM + NMETA;
constexpr int R = RVALID;
constexpr int NCH = 65;
constexpr int IN_AB = 5120, IN_CD = 2560;
constexpr float EPS = 1e-6f;
constexpr int NTHREADS = 512;
constexpr int LDS_BYTES = 147456;

constexpr size_t W_INAB = 0;
constexpr size_t W_OUTAB = W_INAB + (size_t)5120 * 1024 * 2;
constexpr size_t W_W1_0 = W_OUTAB + (size_t)1024 * 2048 * 2;
constexpr size_t W_W2_0 = W_W1_0 + (size_t)4096 * 1024 * 2;
constexpr size_t W_INCD = W_W2_0 + (size_t)4096 * 1024 * 2;
constexpr size_t W_OUTCD = W_INCD + (size_t)2560 * 1024 * 2;
constexpr size_t W_GLU = W_OUTCD + (size_t)1024 * 1024 * 2;
constexpr size_t W_W1_1 = W_GLU + (size_t)512 * 512 * 2;
constexpr size_t W_W2_1 = W_W1_1 + (size_t)4096 * 1024 * 2;
constexpr size_t W_END = W_W2_1 + (size_t)4096 * 1024 * 2;
constexpr size_t Z_OFF = W_END;
constexpr size_t HN_OFF = Z_OFF + (size_t)R * 5120 * 2;
constexpr size_t SM_OFF = HN_OFF + (size_t)R * 1024 * 2;
constexpr size_t HMETA_OFF = SM_OFF;
constexpr size_t YAB_OFF = HMETA_OFF + (size_t)16 * 1024 * 4;
constexpr size_t YCD_OFF = YAB_OFF + (size_t)16 * 2048 * 2;
constexpr size_t YM_OFF = YCD_OFF + (size_t)16 * 1024 * 2;
constexpr size_t SSQ_OFF = YM_OFF + (size_t)16 * 512 * 2;
constexpr size_t LRUW_OFF = SSQ_OFF + (size_t)R * 16 * 4;
constexpr size_t S5BB_OFF = LRUW_OFF + (size_t)16 * 128 * 64 * 2;
constexpr size_t S5CM_OFF = S5BB_OFF + (size_t)32 * 128 * 32 * 2;
constexpr size_t S5AB_OFF = S5CM_OFF + (size_t)32 * 16 * 128 * 2;
constexpr size_t BAR_OFF = S5AB_OFF + (size_t)32 * 64 * 2 * 4;
constexpr size_t CNT_OFF = BAR_OFF + 16384;
constexpr size_t XB_OFF = CNT_OFF + (size_t)8 * 80 * 32 * 4;
constexpr size_t XB_STRIDE = (size_t)64 * 256 * 4 * 4 + 4096;
constexpr size_t WS_END = XB_OFF + 8 * XB_STRIDE;
static_assert(WS_END <= (size_t)268435456, "workspace map");

struct Args {
    const float* in[29];
    float* out;
    unsigned char* ws;
    long long never;
};

typedef __bf16 bf16x2_t __attribute__((ext_vector_type(2)));
__device__ __forceinline__ unsigned cvt_pk_bf16(float lo, float hi) { f32x2 v = {lo, hi}; bf16x2_t b = __builtin_convertvector(v, bf16x2_t); return __builtin_bit_cast(unsigned, b); }
__device__ __forceinline__ float bf_lo(unsigned u) { return __uint_as_float(u << 16); }
__device__ __forceinline__ float bf_hi(unsigned u) { return __uint_as_float(u & 0xffff0000u); }
__device__ __forceinline__ bf16_t f2bf(float f) { return (bf16_t)(cvt_pk_bf16(f, 0.f) & 0xffffu); }
__device__ __forceinline__ float wave_sum(float v) {
#pragma unroll
    for (int o = 1; o < 64; o <<= 1) v += __shfl_xor(v, o);
    return v;
}
__device__ __forceinline__ float sigmoidf_(float x) { return 1.f / (1.f + __expf(-x)); }
__device__ __forceinline__ float gelu_tanh(float x) {
    const float u = 0.7978845608028654f * (x + 0.044715f * x * x * x);
    const float e = __expf(2.f * u);
    const float t = 1.f - 2.f / (e + 1.f);
    return 0.5f * x * (1.f + t);
}
__device__ __forceinline__ float silu_(float x) { return x * sigmoidf_(x); }
__device__ __forceinline__ void sincos_big(float ang, float& s, float& c) {
    double t = (double)ang * 0.15915494309189535;
    t -= rint(t);
    const float fr = (float)t;
    s = __builtin_amdgcn_sinf(fr); c = __builtin_amdgcn_cosf(fr);
}
__device__ __forceinline__ void st_agent(float* p, float v) { __hip_atomic_store(p, v, __ATOMIC_RELAXED, __HIP_MEMORY_SCOPE_AGENT); }
__device__ __forceinline__ float ld_agent(const float* p) { return __hip_atomic_load(p, __ATOMIC_RELAXED, __HIP_MEMORY_SCOPE_AGENT); }
__device__ __forceinline__ void cnt_arrive_wait(unsigned* c, unsigned target) {
    __hip_atomic_fetch_add(c, 1u, __ATOMIC_RELAXED, __HIP_MEMORY_SCOPE_AGENT);
    unsigned sp = 0;
    while (__hip_atomic_load(c, __ATOMIC_RELAXED, __HIP_MEMORY_SCOPE_AGENT) < target) { __builtin_amdgcn_s_sleep(1); if (++sp > (1u << 22)) break; }
}
__device__ __forceinline__ float* hrow(const Args& a, int row) {
    return row < RM ? a.out + (size_t)row * DM : (float*)(a.ws + HMETA_OFF) + (size_t)(row - RM) * DM;
}
__device__ __forceinline__ int chunk_row(int b, int n, int j) {
    if (n == 0) return j >= 48 ? RMETA + (j - 48) : -1;
    return b * SEQ + (n - 1) * 64 + j;
}

namespace pg8 {
constexpr int BM = 256, BK = 64, HALF = 128, HTB = HALF * BK * 2, NXCD = 8, WGM = 4;
__device__ __forceinline__ int lds_byte(int r, int c) { const int st = (r >> 4) * 2 + (c >> 5), rr = r & 15, cc = c & 31, ob = rr * 64 + cc * 2; return st * 1024 + (ob ^ (((ob >> 9) & 1) << 5)); }
__device__ __forceinline__ void stage_rc(int b, int& Rr, int& C) { const int st = b / 1024, sb = b % 1024, swz = sb ^ (((sb >> 9) & 1) << 5); Rr = (st >> 1) * 16 + swz / 64; C = (st & 1) * 32 + (swz % 64) / 2; }
__device__ __forceinline__ int perm32(int rho) { const int n = rho >> 4, i = rho & 15; return 8 * (i >> 2) + 4 * n + (i & 3); }
struct Unit { int pm, pn; };
struct Gemm { const bf16_t* A; const bf16_t* Bt; int M, N, K, lda; };
struct StaticOrder {
    int nM, nN, nwg, G, c;
    __device__ void init(int M, int N, int G_, int c_) { nM = M / BM; nN = N / BM; nwg = nM * nN; G = G_; c = c_; }
    __device__ bool next(int i, Unit& u) const {
        const long L = (long)i * G + c; if (L >= nwg) return false;
        int wgid = (int)L; { const int q = nwg / NXCD, r = nwg % NXCD, xcd = wgid % NXCD, off = wgid / NXCD; wgid = (xcd < r ? xcd * (q + 1) : r * (q + 1) + (xcd - r) * q) + off; }
        const int nig = WGM * nN, gid = wgid / nig, fm = gid * WGM, gsz = (nM - fm) < WGM ? (nM - fm) : WGM;
        u.pm = fm + ((wgid % nig) % gsz); u.pn = (wgid % nig) / gsz; return true;
    }
};
template <class Epi>
__device__ __forceinline__ void gemm_phase(LAS unsigned char* lds, const Gemm g, const StaticOrder& S, const Epi& E) {
    int tid_ = threadIdx.x; asm volatile("" : "+v"(tid_));
    const int tid = tid_, wid = __builtin_amdgcn_readfirstlane(tid >> 6), lane = tid & 63, wr = wid >> 2, wc = wid & 3, fr = lane & 15, fq = lane >> 4;
    const int K = g.K, nt = K / BK, lda = g.lda;
    unsigned voffA[2], voffB[2];
#pragma unroll
    for (int i = 0; i < 2; ++i) { int Rr, C; stage_rc(tid * 16 + i * 8192, Rr, C); const int Rb = (Rr & ~31) + perm32(Rr & 31);
        voffA[i] = (unsigned)(Rr * lda + C) * 2u; voffB[i] = (unsigned)(Rb * K + C) * 2u; }
    const size_t kstep = (size_t)(BK * 2);
    const size_t hstepA = (size_t)HALF * lda * 2, hstepB = (size_t)HALF * K * 2;
    const size_t tstepA = 2 * hstepA, tstepB = 2 * hstepB;
    const unsigned ldsw = (unsigned)wid * 1024u;
    const int aoff = lds_byte(wr * 64 + fr, fq * 8), boff = lds_byte(wc * 32 + fr, fq * 8);
#define PG8_SA(b, h) (((b) * 2 + (h)) * HTB)
#define PG8_SB(b, h) ((4 + (b) * 2 + (h)) * HTB)
#define PG8_STAGE(bufoff, gbase, voff) do { _Pragma("unroll") for (int _i = 0; _i < 2; ++_i) \
        __builtin_amdgcn_global_load_lds((const unsigned*)((const char*)(gbase) + (voff)[_i]), (LAS unsigned*)(lds + (bufoff) + ldsw + _i * 8192), 16, 0, 0); } while (0)
#define PG8_LDA(dst, b, h) do { _Pragma("unroll") for (int m = 0; m < 4; ++m) _Pragma("unroll") for (int k = 0; k < 2; ++k) dst[m][k] = *(const LAS bf16x8*)(lds + PG8_SA(b, h) + aoff + m * 2048 + k * 1024); } while (0)
#define PG8_LDB(dst, b, h) do { _Pragma("unroll") for (int n = 0; n < 2; ++n) _Pragma("unroll") for (int k = 0; k < 2; ++k) dst[n][k] = *(const LAS bf16x8*)(lds + PG8_SB(b, h) + boff + n * 2048 + k * 1024); } while (0)
#define PG8_MMA(ai, bj, At, Bt) do { __builtin_amdgcn_s_setprio(1); _Pragma("unroll") for (int m = 0; m < 4; ++m) _Pragma("unroll") for (int n = 0; n < 2; ++n) _Pragma("unroll") for (int k = 0; k < 2; ++k) \
        acc[ai][bj][m][n] = __builtin_amdgcn_mfma_f32_16x16x32_bf16(Bt[n][k], At[m][k], acc[ai][bj][m][n], 0, 0, 0); __builtin_amdgcn_s_setprio(0); } while (0)
#define PG8_WAIT_V(n) asm volatile("s_waitcnt vmcnt(" #n ")" ::: "memory")
#define PG8_WAIT_L(n) asm volatile("s_waitcnt lgkmcnt(" #n ")" ::: "memory")
#define PG8_BAR __builtin_amdgcn_s_barrier()
#define PG8_SCHED __builtin_amdgcn_sched_barrier(0)
    Unit cur, nxt; int ui = 0;
    if (!S.next(0, cur)) return;
    f32x4 acc[2][2][4][2];
#pragma unroll
    for (int a = 0; a < 2; ++a)
#pragma unroll
        for (int b = 0; b < 2; ++b)
#pragma unroll
            for (int m = 0; m < 4; ++m)
#pragma unroll
                for (int n = 0; n < 2; ++n) acc[a][b][m][n] = (f32x4){0.f, 0.f, 0.f, 0.f};
    bf16x8 At[4][2], B0[2][2], B1[2][2];
    const char* cA = (const char*)g.A + (size_t)cur.pm * tstepA; const char* cB = (const char*)g.Bt + (size_t)cur.pn * tstepB;
    PG8_STAGE(PG8_SB(0, 0), cB, voffB); PG8_STAGE(PG8_SB(0, 1), cB + hstepB, voffB); PG8_STAGE(PG8_SA(0, 0), cA, voffA); PG8_STAGE(PG8_SA(0, 1), cA + hstepA, voffA);
    if (wr == 1) PG8_BAR;
    PG8_WAIT_V(2); PG8_BAR;
    PG8_STAGE(PG8_SB(1, 0), cB + kstep, voffB); PG8_STAGE(PG8_SA(1, 0), cA + kstep, voffA); PG8_STAGE(PG8_SB(1, 1), cB + hstepB + kstep, voffB);
    PG8_WAIT_V(6); PG8_BAR;
    for (;;) {
        const bool has_next = S.next(ui + 1, nxt);
        const char* nA = has_next ? (const char*)g.A + (size_t)nxt.pm * tstepA : cA; const char* nB = has_next ? (const char*)g.Bt + (size_t)nxt.pn * tstepB : cB;
        for (int t = 0; t < nt; t += 2) {
            const bool last = (t == nt - 2);
            const char* a1 = cA + (size_t)(t + 1) * kstep;
            const char* a2 = last ? nA : cA + (size_t)(t + 2) * kstep; const char* b2 = last ? nB : cB + (size_t)(t + 2) * kstep;
            const char* a3 = a2 + kstep; const char* b3 = b2 + kstep;
            PG8_LDB(B0, 0, 0); PG8_LDB(B1, 0, 1); PG8_SCHED; PG8_LDA(At, 0, 0); PG8_STAGE(PG8_SA(1, 1), a1 + hstepA, voffA);
            PG8_WAIT_V(8); PG8_WAIT_L(0); PG8_BAR; PG8_MMA(0, 0, At, B0); PG8_MMA(0, 1, At, B1); PG8_BAR; PG8_SCHED;
            PG8_LDA(At, 0, 1); PG8_STAGE(PG8_SB(0, 0), b2, voffB); PG8_STAGE(PG8_SB(0, 1), b2 + hstepB, voffB); PG8_STAGE(PG8_SA(0, 0), a2, voffA);
            PG8_WAIT_V(8); PG8_WAIT_L(0); PG8_BAR; PG8_MMA(1, 0, At, B0); PG8_MMA(1, 1, At, B1); PG8_BAR; PG8_SCHED;
            PG8_LDB(B0, 1, 0); PG8_LDB(B1, 1, 1); PG8_SCHED; PG8_LDA(At, 1, 0); PG8_STAGE(PG8_SA(0, 1), a2 + hstepA, voffA);
            PG8_WAIT_V(8); PG8_WAIT_L(0); PG8_BAR; PG8_MMA(0, 0, At, B0); PG8_MMA(0, 1, At, B1); PG8_BAR; PG8_SCHED;
            PG8_LDA(At, 1, 1); PG8_STAGE(PG8_SB(1, 0), b3, voffB); PG8_STAGE(PG8_SB(1, 1), b3 + hstepB, voffB); PG8_STAGE(PG8_SA(1, 0), a3, voffA);
            PG8_WAIT_V(8); PG8_WAIT_L(0); PG8_BAR; PG8_MMA(1, 0, At, B0); PG8_MMA(1, 1, At, B1); PG8_BAR; PG8_SCHED;
        }
        if (wr == 0) PG8_BAR;
        if constexpr (!Epi::AFTER_DRAIN) E(acc, cur, wr, wc, fr, fq);
        if (!has_next) break;
#pragma unroll
        for (int a = 0; a < 2; ++a)
#pragma unroll
            for (int b = 0; b < 2; ++b)
#pragma unroll
                for (int m = 0; m < 4; ++m)
#pragma unroll
                    for (int n = 0; n < 2; ++n) acc[a][b][m][n] = (f32x4){0.f, 0.f, 0.f, 0.f};
        cur = nxt; cA = nA; cB = nB; ++ui;
        if (wr == 1) PG8_BAR;
    }
    PG8_WAIT_V(0);
    PG8_BAR;
    if constexpr (Epi::AFTER_DRAIN) E.fused(acc, cur, wr, wc, fr, fq, lds);
#undef PG8_SA
#undef PG8_SB
#undef PG8_STAGE
#undef PG8_LDA
#undef PG8_LDB
#undef PG8_MMA
#undef PG8_WAIT_V
#undef PG8_WAIT_L
#undef PG8_BAR
#undef PG8_SCHED
}

template <int MODE> struct Epi {
    static constexpr bool AFTER_DRAIN = false;
    bf16_t* O; int ldo;
    float* ssq;
    const bf16_t* Y; int ldy;
    const float* bias;
    __device__ __forceinline__ void operator()(const f32x4 (&acc)[2][2][4][2], const Unit& u, int wr, int wc, int fr, int fq) const {
#pragma unroll
        for (int ai = 0; ai < 2; ++ai)
#pragma unroll
            for (int m = 0; m < 4; ++m) {
                const int row = u.pm * BM + ai * HALF + wr * 64 + m * 16 + fr;
                float ss = 0.f;
#pragma unroll
                for (int bj = 0; bj < 2; ++bj) {
                    const int col0 = u.pn * BM + bj * HALF + wc * 32 + 8 * fq;
                    f32x4 v0 = acc[ai][bj][m][0], v1 = acc[ai][bj][m][1];
                    if (MODE == 1) { ss += v0[0] * v0[0] + v0[1] * v0[1] + v0[2] * v0[2] + v0[3] * v0[3] + v1[0] * v1[0] + v1[1] * v1[1] + v1[2] * v1[2] + v1[3] * v1[3]; }
                    if (MODE == 2) {
#pragma unroll
                        for (int j = 0; j < 4; ++j) { float a = fmaxf(v0[j], 0.f); v0[j] = a * a; float b = fmaxf(v1[j], 0.f); v1[j] = b * b; }
                    }
                    if (MODE == 3) {
                        const u32x4 yv = *(const u32x4*)(Y + (size_t)row * ldy + col0);
                        const f32x4 b0 = *(const f32x4*)(bias + col0), b1 = *(const f32x4*)(bias + col0 + 4);
                        v0[0] = bf_lo(yv.x) * sigmoidf_(v0[0] + b0[0]); v0[1] = bf_hi(yv.x) * sigmoidf_(v0[1] + b0[1]);
                        v0[2] = bf_lo(yv.y) * sigmoidf_(v0[2] + b0[2]); v0[3] = bf_hi(yv.y) * sigmoidf_(v0[3] + b0[3]);
                        v1[0] = bf_lo(yv.z) * sigmoidf_(v1[0] + b1[0]); v1[1] = bf_hi(yv.z) * sigmoidf_(v1[1] + b1[1]);
                        v1[2] = bf_lo(yv.w) * sigmoidf_(v1[2] + b1[2]); v1[3] = bf_hi(yv.w) * sigmoidf_(v1[3] + b1[3]);
                    }
                    u32x4 w; w.x = cvt_pk_bf16(v0[0], v0[1]); w.y = cvt_pk_bf16(v0[2], v0[3]); w.z = cvt_pk_bf16(v1[0], v1[1]); w.w = cvt_pk_bf16(v1[2], v1[3]);
                    *(u32x4*)(O + (size_t)row * ldo + col0) = w;
                }
                if (MODE == 1) {
                    ss += __shfl_xor(ss, 16); ss += __shfl_xor(ss, 32);
                    if (fq == 0) ssq[(size_t)row * 16 + u.pn * 4 + wc] = ss;
                }
            }
    }
};

struct EpiRes {
    static constexpr bool AFTER_DRAIN = true;
    const float* hin; float* h;
    const float* g1; const float* g2;
    bf16_t* HN;
    float* xb1; float* xb2;
    unsigned* c1; unsigned* c2;
    __device__ __forceinline__ void exchange(const f32x4 (&acc)[2][2][4][2], const Unit& u, int wr, int wc, int fr, int fq, LAS unsigned char* lds, float* xb, unsigned* cnt) const {
        LAS float* P = (LAS float*)lds; LAS float* S = (LAS float*)(lds + 4096);
        const int tid = threadIdx.x;
#pragma unroll
        for (int ai = 0; ai < 2; ++ai)
#pragma unroll
            for (int m = 0; m < 4; ++m) {
                float ss = 0.f;
#pragma unroll
                for (int bj = 0; bj < 2; ++bj)
#pragma unroll
                    for (int n = 0; n < 2; ++n) { const f32x4 v = acc[ai][bj][m][n]; ss += v[0] * v[0] + v[1] * v[1] + v[2] * v[2] + v[3] * v[3]; }
                ss += __shfl_xor(ss, 16); ss += __shfl_xor(ss, 32);
                if (fq == 0) P[(ai * HALF + wr * 64 + m * 16 + fr) * 4 + wc] = ss;
            }
        __syncthreads();
        if (tid < 256) { const f32x4 p = *(const LAS f32x4*)(P + tid * 4); st_agent(xb + ((size_t)u.pm * 256 + tid) * 4 + u.pn, (p[0] + p[1]) + (p[2] + p[3])); }
        asm volatile("s_waitcnt vmcnt(0)" ::: "memory");
        __syncthreads();
        if (tid == 0) cnt_arrive_wait(cnt + u.pm * 32, 4u);
        __syncthreads();
        if (tid < 256) { const float* q = xb + ((size_t)u.pm * 256 + tid) * 4; const float t = (ld_agent(q) + ld_agent(q + 1)) + (ld_agent(q + 2) + ld_agent(q + 3));
            S[tid] = rsqrtf(t * (1.f / 1024.f) + EPS); }
        __syncthreads();
    }
    __device__ __forceinline__ void fused(f32x4 (&acc)[2][2][4][2], const Unit& u, int wr, int wc, int fr, int fq, LAS unsigned char* lds) const {
        const LAS float* S = (const LAS float*)(lds + 4096);
        exchange(acc, u, wr, wc, fr, fq, lds, xb1, c1);
#pragma unroll
        for (int bj = 0; bj < 2; ++bj) {
            const int col0 = u.pn * BM + bj * HALF + wc * 32 + 8 * fq;
            const f32x4 ga = *(const f32x4*)(g1 + col0), gb = *(const f32x4*)(g1 + col0 + 4);
#pragma unroll
            for (int ai = 0; ai < 2; ++ai)
#pragma unroll
                for (int m = 0; m < 4; ++m) {
                    const int rl = ai * HALF + wr * 64 + m * 16 + fr; const float inv = S[rl];
                    float* hp = h + (size_t)(u.pm * BM + rl) * 1024 + col0;
                    const float* hq = hin + (size_t)(u.pm * BM + rl) * 1024 + col0;
                    const f32x4 h0 = *(const f32x4*)hq, h1 = *(const f32x4*)(hq + 4);
                    f32x4 v0 = acc[ai][bj][m][0], v1 = acc[ai][bj][m][1];
                    v0 = h0 + v0 * inv * ga; v1 = h1 + v1 * inv * gb;
                    *(f32x4*)hp = v0; *(f32x4*)(hp + 4) = v1;
                    acc[ai][bj][m][0] = v0; acc[ai][bj][m][1] = v1;
                }
        }
        if (g2 == nullptr) return;
        __syncthreads();
        exchange(acc, u, wr, wc, fr, fq, lds, xb2, c2);
#pragma unroll
        for (int bj = 0; bj < 2; ++bj) {
            const int col0 = u.pn * BM + bj * HALF + wc * 32 + 8 * fq;
            const f32x4 ga = *(const f32x4*)(g2 + col0), gb = *(const f32x4*)(g2 + col0 + 4);
#pragma unroll
            for (int ai = 0; ai < 2; ++ai)
#pragma unroll
                for (int m = 0; m < 4; ++m) {
                    const int rl = ai * HALF + wr * 64 + m * 16 + fr; const float inv = S[rl];
                    const f32x4 v0 = acc[ai][bj][m][0] * inv * ga, v1 = acc[ai][bj][m][1] * inv * gb;
                    u32x4 w; w.x = cvt_pk_bf16(v0[0], v0[1]); w.y = cvt_pk_bf16(v0[2], v0[3]); w.z = cvt_pk_bf16(v1[0], v1[1]); w.w = cvt_pk_bf16(v1[2], v1[3]);
                    *(u32x4*)(HN + (size_t)(u.pm * BM + rl) * 1024 + col0) = w;
                }
        }
    }
};
}

__device__ __forceinline__ bf16x8 ldsfrag(const LAS unsigned char* p) { return *(const LAS bf16x8*)p; }
#define LBAR() do { asm volatile("s_waitcnt lgkmcnt(0)" ::: "memory"); __builtin_amdgcn_s_barrier(); asm volatile("" ::: "memory"); } while (0)
#define MFMA16(X, Y, ACC) __builtin_amdgcn_mfma_f32_16x16x32_bf16((X), (Y), (ACC), 0, 0, 0)


template <int MODE, int NT, int STEPS>
__device__ __forceinline__ void meta_gemm(LAS unsigned char* L, const bf16_t* A, int lda, const bf16_t* Bt, int N, int K,
                                          bf16_t* O, int ldo, float* ssq, const bf16_t* Y, int ldy, const float* bias,
                                          float* hm = nullptr, const float* g1 = nullptr, const float* g2 = nullptr, float* xm1 = nullptr, float* xm2 = nullptr, unsigned* cm1 = nullptr, unsigned* cm2 = nullptr) {
    int tid_ = threadIdx.x; asm volatile("" : "+v"(tid_));
    const int tid = tid_, lane = tid & 63, w = __builtin_amdgcn_readfirstlane(tid >> 6), fr = lane & 15, fq = lane >> 4;
    const int t = (int)gridDim.x - 1 - (int)blockIdx.x;
    if (t >= N / (16 * NT)) return;
    const int n0 = t * 16 * NT, kw = K / 8, k0 = w * kw;
    f32x4 acc[NT];
#pragma unroll
    for (int nt = 0; nt < NT; ++nt) acc[nt] = (f32x4){0.f, 0.f, 0.f, 0.f};
    const bf16_t* ap = A + (size_t)fr * lda + k0 + fq * 8;
    const bf16_t* bp = Bt + (size_t)(n0 + fr) * K + k0 + fq * 8;
    for (int k = 0; k < kw; k += 32 * STEPS) {
        bf16x8 af[STEPS], bfr[STEPS][NT];
#pragma unroll
        for (int st = 0; st < STEPS; ++st) { af[st] = *(const bf16x8*)(ap + k + 32 * st);
#pragma unroll
            for (int nt = 0; nt < NT; ++nt) bfr[st][nt] = *(const bf16x8*)(bp + (size_t)nt * 16 * K + k + 32 * st); }
#pragma unroll
        for (int st = 0; st < STEPS; ++st)
#pragma unroll
            for (int nt = 0; nt < NT; ++nt) acc[nt] = MFMA16(bfr[st][nt], af[st], acc[nt]);
    }
    LAS f32x4* P = (LAS f32x4*)L;
#pragma unroll
    for (int nt = 0; nt < NT; ++nt) P[(w * NT + nt) * 64 + lane] = acc[nt];
    __syncthreads();
    if (MODE == 4) {
        if (w == 0) {
            const int np = N / 16;
            f32x4 v = P[lane];
#pragma unroll
            for (int ww = 1; ww < 8; ++ww) v += P[ww * NT * 64 + lane];
            float ss = v[0] * v[0] + v[1] * v[1] + v[2] * v[2] + v[3] * v[3];
            ss += __shfl_xor(ss, 16); ss += __shfl_xor(ss, 32);
            if (fq == 0) st_agent(xm1 + fr * np + t, ss);
            asm volatile("s_waitcnt vmcnt(0)" ::: "memory");
            if (lane == 0) cnt_arrive_wait(cm1, (unsigned)np);
            __builtin_amdgcn_wave_barrier();
            float tot = 0.f;
#pragma unroll
            for (int q = 0; q < 16; ++q) tot += ld_agent(xm1 + fr * np + fq * 16 + q);
            tot += __shfl_xor(tot, 16); tot += __shfl_xor(tot, 32);
            const float inv = rsqrtf(tot * (1.f / 1024.f) + EPS);
            const int col = n0 + 4 * fq; float* hp = hm + fr * 1024 + col;
            { const f32x4 gg = *(const f32x4*)(g1 + col); const f32x4 h0 = *(const f32x4*)hp; v = h0 + v * inv * gg; *(f32x4*)hp = v; }
            if (g2 != nullptr) {
                float ss2 = v[0] * v[0] + v[1] * v[1] + v[2] * v[2] + v[3] * v[3];
                ss2 += __shfl_xor(ss2, 16); ss2 += __shfl_xor(ss2, 32);
                if (fq == 0) st_agent(xm2 + fr * np + t, ss2);
                asm volatile("s_waitcnt vmcnt(0)" ::: "memory");
                if (lane == 0) cnt_arrive_wait(cm2, (unsigned)np);
                __builtin_amdgcn_wave_barrier();
                float tot2 = 0.f;
#pragma unroll
                for (int q = 0; q < 16; ++q) tot2 += ld_agent(xm2 + fr * np + fq * 16 + q);
                tot2 += __shfl_xor(tot2, 16); tot2 += __shfl_xor(tot2, 32);
                const float inv2 = rsqrtf(tot2 * (1.f / 1024.f) + EPS);
                const f32x4 gg = *(const f32x4*)(g2 + col); const f32x4 y = v * inv2 * gg;
                u32x2 o; o.x = cvt_pk_bf16(y[0], y[1]); o.y = cvt_pk_bf16(y[2], y[3]);
                *(u32x2*)(O + (size_t)fr * ldo + col) = o;
            }
        }
    } else if (w == 0) {
        float ss = 0.f;
#pragma unroll
        for (int nt = 0; nt < NT; ++nt) {
            f32x4 v = P[nt * 64 + lane];
#pragma unroll
            for (int ww = 1; ww < 8; ++ww) v += P[(ww * NT + nt) * 64 + lane];
            const int col = n0 + nt * 16 + 4 * fq;
            if (MODE == 1) ss += v[0] * v[0] + v[1] * v[1] + v[2] * v[2] + v[3] * v[3];
            if (MODE == 2) {
#pragma unroll
                for (int j = 0; j < 4; ++j) { const float r = fmaxf(v[j], 0.f); v[j] = r * r; }
            }
            if (MODE == 3) {
                const u32x2 yv = *(const u32x2*)(Y + (size_t)fr * ldy + col);
                const f32x4 bb = *(const f32x4*)(bias + col);
                v[0] = bf_lo(yv.x) * sigmoidf_(v[0] + bb[0]); v[1] = bf_hi(yv.x) * sigmoidf_(v[1] + bb[1]);
                v[2] = bf_lo(yv.y) * sigmoidf_(v[2] + bb[2]); v[3] = bf_hi(yv.y) * sigmoidf_(v[3] + bb[3]);
            }
            u32x2 o; o.x = cvt_pk_bf16(v[0], v[1]); o.y = cvt_pk_bf16(v[2], v[3]);
            *(u32x2*)(O + (size_t)fr * ldo + col) = o;
        }
        if (MODE == 1) {
            ss += __shfl_xor(ss, 16); ss += __shfl_xor(ss, 32);
            if (fq == 0) ssq[fr * 16 + t] = ss;
        }
    }
    __syncthreads();
}

__device__ __forceinline__ void transpose_item(const float* W, int K, int N, bf16_t* WT, int dst_row0, LAS float* scr, int k0, int n0, int lane) {
#pragma unroll 8
    for (int i = 0; i < 32; ++i) { const int kk = 2 * i + (lane >> 5); scr[kk * 33 + (lane & 31)] = W[(size_t)(k0 + kk) * N + n0 + (lane & 31)]; }
    asm volatile("s_waitcnt lgkmcnt(0)" ::: "memory");
    const int c = lane & 7;
#pragma unroll
    for (int j = 0; j < 4; ++j) { const int n = (lane >> 3) + 8 * j; const LAS float* s = scr + (8 * c) * 33 + n;
        u32x4 o; o.x = cvt_pk_bf16(s[0 * 33], s[1 * 33]); o.y = cvt_pk_bf16(s[2 * 33], s[3 * 33]); o.z = cvt_pk_bf16(s[4 * 33], s[5 * 33]); o.w = cvt_pk_bf16(s[6 * 33], s[7 * 33]);
        *(u32x4*)(WT + (size_t)(dst_row0 + n) * K + k0 + 8 * c) = o; }
    asm volatile("s_waitcnt lgkmcnt(0)" ::: "memory");
}


constexpr int WC_I0 = 16 * 160, WC_I1 = 32 * 32, WC_I2 = 16 * 128, WC_I3 = 64 * 32, WC_I4 = 16 * 80, WC_I5 = 16 * 32, WC_I6 = 8 * 16, WC_I7 = WC_I2, WC_I8 = WC_I3;
constexpr int WC_C0 = 0, WC_C1 = WC_I0, WC_C5 = WC_I0 + WC_I1 + WC_I2 + WC_I3 + WC_I4, WC_C9 = WC_C5 + WC_I5 + WC_I6 + WC_I7 + WC_I8;
__device__ __forceinline__ void weight_convert(const Args& a, LAS unsigned char* lds, int it0, int it1, int vb, int nvb) {
    int tid_ = threadIdx.x; asm volatile("" : "+v"(tid_));
    const int tid = tid_, lane = tid & 63, wave = tid >> 6;
    unsigned char* ws = a.ws;
    LAS float* scr = (LAS float*)(lds + wave * 16384);
    constexpr int I0 = WC_I0, I1 = WC_I1, I2 = WC_I2, I3 = WC_I3, I4 = WC_I4, I5 = WC_I5, I6 = WC_I6, I7 = WC_I7;
    for (int it = it0 + vb * 8 + wave; it < it1; it += nvb * 8) {
        int r = it; const float* W; int K, N; bf16_t* WT; bool perm = false;
        if (r < I0) { W = a.in[2]; K = 1024; N = 5120; WT = (bf16_t*)(ws + W_INAB); perm = true; }
        else if ((r -= I0) < I1) { W = a.in[3]; K = 2048; N = 1024; WT = (bf16_t*)(ws + W_OUTAB); }
        else if ((r -= I1) < I2) { W = a.in[27]; K = 1024; N = 4096; WT = (bf16_t*)(ws + W_W1_0); }
        else if ((r -= I2) < I3) { W = a.in[28]; K = 4096; N = 1024; WT = (bf16_t*)(ws + W_W2_0); }
        else if ((r -= I3) < I4) { W = a.in[12]; K = 1024; N = 2560; WT = (bf16_t*)(ws + W_INCD); }
        else if ((r -= I4) < I5) { W = a.in[13]; K = 1024; N = 1024; WT = (bf16_t*)(ws + W_OUTCD); }
        else if ((r -= I5) < I6) { W = a.in[22]; K = 512; N = 512; WT = (bf16_t*)(ws + W_GLU); }
        else if ((r -= I6) < I7) { W = a.in[27] + (size_t)1024 * 4096; K = 1024; N = 4096; WT = (bf16_t*)(ws + W_W1_1); }
        else { r -= I7; W = a.in[28] + (size_t)1024 * 4096; K = 4096; N = 1024; WT = (bf16_t*)(ws + W_W2_1); }
        const int nblk = N / 32, kb = r / nblk, nb = r % nblk, n0 = nb * 32;
        int d0 = n0;
        if (perm) { if (n0 >= 2048 && n0 < 3072) d0 = n0 + 1024; else if (n0 >= 3072 && n0 < 4096) d0 = n0 - 1024; }
        transpose_item(W, K, N, WT, d0, scr, kb * 64, n0, lane);
    }
}

__device__ __forceinline__ void phase_prologue(const Args& a, LAS unsigned char* lds, bool copy_x) {
    int tid_ = threadIdx.x; asm volatile("" : "+v"(tid_));
    const int tid = tid_, lane = tid & 63, wave = tid >> 6;
    const int gw = blockIdx.x * 8 + wave, NGW = gridDim.x * 8;
    unsigned char* ws = a.ws;
    LAS float* scr = (LAS float*)(lds + wave * 16384);
    weight_convert(a, lds, WC_C0, WC_C5, blockIdx.x, gridDim.x);
    {
        const float* x = a.in[0]; const float* meta = a.in[1]; const float* g = a.in[26];
        bf16_t* HN = (bf16_t*)(ws + HN_OFF);
        f32x4 gg[4];
#pragma unroll
        for (int j = 0; j < 4; ++j) gg[j] = *(const f32x4*)(g + 4 * lane + 256 * j);
        for (int row0 = gw; row0 < R; row0 += 4 * NGW) {
            f32x4 v[4][4];
#pragma unroll
            for (int q = 0; q < 4; ++q) { const int row = row0 + q * NGW;
                if (row < R) { const float* src = row < RM ? x + (size_t)row * DM : meta + (size_t)(row - RM) * DM;
#pragma unroll
                    for (int j = 0; j < 4; ++j) v[q][j] = *(const f32x4*)(src + 4 * lane + 256 * j); }
                else {
#pragma unroll
                    for (int j = 0; j < 4; ++j) v[q][j] = (f32x4){0.f, 0.f, 0.f, 0.f}; } }
#pragma unroll
            for (int q = 0; q < 4; ++q) { const int row = row0 + q * NGW;
                if (row < R) {
                    float s = 0.f;
#pragma unroll
                    for (int j = 0; j < 4; ++j) s += v[q][j][0] * v[q][j][0] + v[q][j][1] * v[q][j][1] + v[q][j][2] * v[q][j][2] + v[q][j][3] * v[q][j][3];
                    const float inv = rsqrtf(wave_sum(s) * (1.f / DM) + EPS);
                    if (copy_x || row >= RM) { float* hr = hrow(a, row);
#pragma unroll
                        for (int j = 0; j < 4; ++j) *(f32x4*)(hr + 4 * lane + 256 * j) = v[q][j]; }
#pragma unroll
                    for (int j = 0; j < 4; ++j) { u32x2 o; o.x = cvt_pk_bf16(v[q][j][0] * inv * gg[j][0], v[q][j][1] * inv * gg[j][1]); o.y = cvt_pk_bf16(v[q][j][2] * inv * gg[j][2], v[q][j][3] * inv * gg[j][3]);
                        *(u32x2*)(HN + (size_t)row * DM + 4 * lane + 256 * j) = o; }
                } }
        }
    }
    const int gt = blockIdx.x * NTHREADS + tid, NGT = gridDim.x * NTHREADS;
    {
        bf16_t* WG = (bf16_t*)(ws + LRUW_OFF);
        for (int i = gt; i < 16 * 128 * 64; i += NGT) { const int k = i & 63, n = (i >> 6) & 127, blk = i >> 13;
            const float v = n < 64 ? a.in[5][(size_t)blk * 4096 + k * 64 + n] : a.in[7][(size_t)blk * 4096 + k * 64 + (n - 64)];
            WG[i] = f2bf(v); }
    }
    {
        bf16_t* BB = (bf16_t*)(ws + S5BB_OFF); bf16_t* CM = (bf16_t*)(ws + S5CM_OFF); float* AB = (float*)(ws + S5AB_OFF);
        const float* are_log = a.in[14]; const float* aim = a.in[15]; const float* bre = a.in[16]; const float* bim = a.in[17];
        const float* cre = a.in[18]; const float* cim = a.in[19]; const float* ldt = a.in[21];
        for (int i = gt; i < 32 * 64; i += NGT) {
            const int g = i >> 6, p = i & 63;
            const float dt = expf(ldt[g]); const float a_re = -expf(are_log[i]); const float a_im = aim[i];
            const float mag = expf(dt * a_re); float sn, cs; sincos_big(dt * a_im, sn, cs);
            const float ab_re = mag * cs, ab_im = mag * sn;
            AB[2 * i] = ab_re; AB[2 * i + 1] = ab_im;
            const float n_re = ab_re - 1.f, n_im = ab_im, den = a_re * a_re + a_im * a_im;
            const float z_re = (n_re * a_re + n_im * a_im) / den, z_im = (n_im * a_re - n_re * a_im) / den;
            for (int c = 0; c < 32; ++c) {
                float vr = 0.f, vi = 0.f;
                if (c < 16) { const float br = bre[(size_t)i * 16 + c], bi = bim[(size_t)i * 16 + c]; vr = z_re * br - z_im * bi; vi = z_re * bi + z_im * br; }
                BB[((size_t)g * 128 + p) * 32 + c] = f2bf(vr);
                BB[((size_t)g * 128 + 64 + p) * 32 + c] = f2bf(vi);
            }
            for (int c = 0; c < 16; ++c) {
                CM[((size_t)g * 16 + c) * 128 + p] = f2bf(cre[((size_t)g * 16 + c) * 64 + p]);
                CM[((size_t)g * 16 + c) * 128 + 64 + p] = f2bf(-cim[((size_t)g * 16 + c) * 64 + p]);
            }
        }
    }
}

__device__ __forceinline__ void phase_resnorm(const Args& a, const float* g1, const float* g2) {
    int tid_ = threadIdx.x; asm volatile("" : "+v"(tid_));
    const int tid = tid_, lane = tid & 63, wave = tid >> 6;
    const int gw = blockIdx.x * 8 + wave, NGW = gridDim.x * 8;
    bf16_t* HN = (bf16_t*)(a.ws + HN_OFF); const float* ssq = (const float*)(a.ws + SSQ_OFF);
    for (int row = gw; row < R; row += NGW) {
        bf16_t* mrow = HN + (size_t)row * DM;
        float s = 0.f;
        { const f32x4* sp = (const f32x4*)(ssq + (size_t)row * 16); const f32x4 s0 = sp[0], s1 = sp[1], s2 = sp[2], s3 = sp[3];
          s = ((s0[0] + s0[1]) + (s0[2] + s0[3])) + ((s1[0] + s1[1]) + (s1[2] + s1[3])) + ((s2[0] + s2[1]) + (s2[2] + s2[3])) + ((s3[0] + s3[1]) + (s3[2] + s3[3])); }
        const float inv = rsqrtf(s * (1.f / DM) + EPS);
        float* hr = hrow(a, row);
        f32x4 v[4]; float s2 = 0.f;
#pragma unroll
        for (int j = 0; j < 4; ++j) {
            const u32x2 mv = *(const u32x2*)(mrow + 4 * lane + 256 * j);
            const f32x4 gg = *(const f32x4*)(g1 + 4 * lane + 256 * j);
            v[j] = *(const f32x4*)(hr + 4 * lane + 256 * j);
            v[j][0] += bf_lo(mv.x) * inv * gg[0]; v[j][1] += bf_hi(mv.x) * inv * gg[1]; v[j][2] += bf_lo(mv.y) * inv * gg[2]; v[j][3] += bf_hi(mv.y) * inv * gg[3];
            *(f32x4*)(hr + 4 * lane + 256 * j) = v[j];
            s2 += v[j][0] * v[j][0] + v[j][1] * v[j][1] + v[j][2] * v[j][2] + v[j][3] * v[j][3];
        }
        if (g2) {
            const float inv2 = rsqrtf(wave_sum(s2) * (1.f / DM) + EPS);
#pragma unroll
            for (int j = 0; j < 4; ++j) { const f32x4 gg = *(const f32x4*)(g2 + 4 * lane + 256 * j);
                u32x2 o; o.x = cvt_pk_bf16(v[j][0] * inv2 * gg[0], v[j][1] * inv2 * gg[1]); o.y = cvt_pk_bf16(v[j][2] * inv2 * gg[2], v[j][3] * inv2 * gg[3]);
                *(u32x2*)(mrow + 4 * lane + 256 * j) = o; }
        }
    }
}

constexpr int LA_QS = 0, LA_KS = 17408, LA_QD = 34816, LA_KT = 52224, LA_VT = 70656, LA_PS = 75264, LA_ST = 84480, LA_CUM = 93184, LA_DEC = 125952, LA_CM = 126464  , LA_END = 126976;
static_assert(LA_END <= LDS_BYTES, "LA lds");
__device__ __forceinline__ int kt_off(int d, int s) { return d * 144 + ((((s >> 3) ^ (d >> 3)) & 7) << 4) + (s & 7) * 2; }

template <bool HG>
__device__ __forceinline__ void la_core(LAS unsigned char* L, f32x4 (&st)[2], float l2g, bf16_t* obuf, int ldo, int ocol, int b, int n, bool dry) {
    int tid_ = threadIdx.x; asm volatile("" : "+v"(tid_));
    const int tid = tid_, lane = tid & 63, w = __builtin_amdgcn_readfirstlane(tid >> 6), fr = lane & 15, fq = lane >> 4;
    const int mt = w >> 1, nh = w & 1;
    bf16x8 qf[4];
#pragma unroll
    for (int kk = 0; kk < 4; ++kk) qf[kk] = ldsfrag(L + LA_QS + (mt * 16 + fr) * 272 + kk * 64 + fq * 16);
    f32x4 s0 = {0.f, 0.f, 0.f, 0.f}, s1 = {0.f, 0.f, 0.f, 0.f};
#pragma unroll
    for (int kk = 0; kk < 4; ++kk) {
        const bf16x8 k0 = ldsfrag(L + LA_KS + ((nh * 2) * 16 + fr) * 272 + kk * 64 + fq * 16);
        const bf16x8 k1 = ldsfrag(L + LA_KS + ((nh * 2 + 1) * 16 + fr) * 272 + kk * 64 + fq * 16);
        s0 = MFMA16(k0, qf[kk], s0); s1 = MFMA16(k1, qf[kk], s1);
    }
    const int t = mt * 16 + fr;
    {
        float p0[4], p1[4];
#pragma unroll
        for (int jj = 0; jj < 4; ++jj) {
            const int sa = (nh * 2) * 16 + 4 * fq + jj, sb = sa + 16;
            if (HG) { p0[jj] = sa <= t ? s0[jj] : 0.f; p1[jj] = sb <= t ? s1[jj] : 0.f; }
            else { p0[jj] = s0[jj] * exp2f(l2g * fabsf((float)(t - sa))); p1[jj] = s1[jj] * exp2f(l2g * fabsf((float)(t - sb))); }
        }
        u32x2 o0, o1; o0.x = cvt_pk_bf16(p0[0], p0[1]); o0.y = cvt_pk_bf16(p0[2], p0[3]); o1.x = cvt_pk_bf16(p1[0], p1[1]); o1.y = cvt_pk_bf16(p1[2], p1[3]);
        *(LAS u32x2*)(L + LA_PS + t * 144 + ((nh * 2) * 16 + 4 * fq) * 2) = o0;
        *(LAS u32x2*)(L + LA_PS + t * 144 + ((nh * 2 + 1) * 16 + 4 * fq) * 2) = o1;
    }
    f32x4 o = {0.f, 0.f, 0.f, 0.f};
#pragma unroll
    for (int kk = 0; kk < 4; ++kk) {
        bf16x8 sf = ldsfrag(L + LA_ST + (nh * 16 + fr) * 272 + kk * 64 + fq * 16);
        if (HG) {
            const f32x4 c0 = *(const LAS f32x4*)(L + LA_CM + (kk * 32 + fq * 8) * 4), c1 = *(const LAS f32x4*)(L + LA_CM + (kk * 32 + fq * 8 + 4) * 4);
            const u32x4 su = __builtin_bit_cast(u32x4, sf);
            u32x4 r; r.x = cvt_pk_bf16(bf_lo(su.x) * c0[0], bf_hi(su.x) * c0[1]); r.y = cvt_pk_bf16(bf_lo(su.y) * c0[2], bf_hi(su.y) * c0[3]);
            r.z = cvt_pk_bf16(bf_lo(su.z) * c1[0], bf_hi(su.z) * c1[1]); r.w = cvt_pk_bf16(bf_lo(su.w) * c1[2], bf_hi(su.w) * c1[3]);
            sf = __builtin_bit_cast(bf16x8, r);
        }
        o = MFMA16(sf, qf[kk], o);
    }
    if (!HG) { const float sc = exp2f(l2g * (float)(t + 1)); o[0] *= sc; o[1] *= sc; o[2] *= sc; o[3] *= sc; }
    LBAR();
#pragma unroll
    for (int kk = 0; kk < 2; ++kk) {
        const bf16x8 vf = ldsfrag(L + LA_VT + (nh * 16 + fr) * 144 + kk * 64 + fq * 16);
        const bf16x8 pf = ldsfrag(L + LA_PS + (mt * 16 + fr) * 144 + kk * 64 + fq * 16);
        o = MFMA16(vf, pf, o);
    }
    {
        const int row = chunk_row(b, n, t);
        if (row >= 0 && (row < RM || b == 0) && !dry) { u32x2 ov; ov.x = cvt_pk_bf16(o[0], o[1]); ov.y = cvt_pk_bf16(o[2], o[3]);
            *(u32x2*)(obuf + (size_t)row * ldo + ocol + nh * 16 + 4 * fq) = ov; }
    }
    float dc[4];
    if (HG) { const f32x4 dv = *(const LAS f32x4*)(L + LA_DEC + (w * 16 + 4 * fq) * 4); dc[0] = dv[0]; dc[1] = dv[1]; dc[2] = dv[2]; dc[3] = dv[3]; }
    else { const float g64 = exp2f(l2g * 64.f); dc[0] = dc[1] = dc[2] = dc[3] = g64; }
    const int ktd = w * 16 + fr, ktx = (ktd >> 3) & 7;
    const bf16x8 kt0 = ldsfrag(L + LA_KT + ktd * 144 + ((fq ^ ktx) << 4)), kt1 = ldsfrag(L + LA_KT + ktd * 144 + (((4 + fq) ^ ktx) << 4));
#pragma unroll
    for (int et = 0; et < 2; ++et) {
#pragma unroll
        for (int jj = 0; jj < 4; ++jj) st[et][jj] *= dc[jj];
        const bf16x8 v0 = ldsfrag(L + LA_VT + (et * 16 + fr) * 144 + fq * 16), v1 = ldsfrag(L + LA_VT + (et * 16 + fr) * 144 + 64 + fq * 16);
        st[et] = MFMA16(kt0, v0, st[et]); st[et] = MFMA16(kt1, v1, st[et]);
        u32x2 sv; sv.x = cvt_pk_bf16(st[et][0], st[et][1]); sv.y = cvt_pk_bf16(st[et][2], st[et][3]);
        *(LAS u32x2*)(L + LA_ST + (et * 16 + fr) * 272 + (w * 16 + 4 * fq) * 2) = sv;
    }
}

#define UNPK8(dst, v) do { dst[0] = bf_lo((v).x); dst[1] = bf_hi((v).x); dst[2] = bf_lo((v).y); dst[3] = bf_hi((v).y); dst[4] = bf_lo((v).z); dst[5] = bf_hi((v).z); dst[6] = bf_lo((v).w); dst[7] = bf_hi((v).w); } while (0)
#define PK8(v, src) do { (v).x = cvt_pk_bf16(src[0], src[1]); (v).y = cvt_pk_bf16(src[2], src[3]); (v).z = cvt_pk_bf16(src[4], src[5]); (v).w = cvt_pk_bf16(src[6], src[7]); } while (0)

__device__ __forceinline__ void retention_unit(const Args& a, LAS unsigned char* L, int unit, bool dry) {
    int tid_ = threadIdx.x; asm volatile("" : "+v"(tid_));
    const int tid = tid_, b = unit >> 5, h = (unit >> 3) & 3, sl = unit & 7;
    const bf16_t* Z = (const bf16_t*)(a.ws + Z_OFF); bf16_t* OB = (bf16_t*)(a.ws + HN_OFF);
    const float l2g = log2f(1.f - exp2f(-5.f - (float)h));
    const int row_l = tid >> 3, c8 = tid & 7;
    const int vrow = (tid >> 2) & 63, vp = tid & 3;
    float rc[8], rs[8], stc[8], sts[8];
#pragma unroll
    for (int i = 0; i < 8; ++i) { const float invf = exp2f(-(float)(c8 * 8 + i) * (13.287712379549449f / 64.f));
        sincos_big((float)(row_l - 48) * invf, rs[i], rc[i]); sincos_big(64.f * invf, sts[i], stc[i]); }
    f32x4 st[2] = {{0.f, 0.f, 0.f, 0.f}, {0.f, 0.f, 0.f, 0.f}};
    for (int i = tid; i < 32 * 272 / 4; i += NTHREADS) ((LAS unsigned*)(L + LA_ST))[i] = 0u;
    u32x4 qA1, qA2, kA1, kA2, vA, qB1, qB2, kB1, kB2, vB;
#define RET_LOAD(q1, q2, k1, k2, vv, n_) do { const int r_ = chunk_row(b, (n_), row_l); \
        if (r_ >= 0) { const bf16_t* zr = Z + (size_t)r_ * IN_AB; \
            q1 = *(const u32x4*)(zr + h * 128 + c8 * 8); q2 = *(const u32x4*)(zr + h * 128 + 64 + c8 * 8); \
            k1 = *(const u32x4*)(zr + 512 + h * 128 + c8 * 8); k2 = *(const u32x4*)(zr + 512 + h * 128 + 64 + c8 * 8); \
        } else { q1 = q2 = k1 = k2 = (u32x4){0u, 0u, 0u, 0u}; } \
        vv = (u32x4){0u, 0u, 0u, 0u}; \
        if (tid < 256) { const int rv = chunk_row(b, (n_), vrow); if (rv >= 0) vv = *(const u32x4*)(Z + (size_t)rv * IN_AB + 1024 + h * 256 + sl * 32 + vp * 8); } } while (0)
#define RET_STEP(q1, q2, k1, k2, vv, n_) do { \
        { \
            float x1[8], x2[8], y1[8], y2[8], qo1[8], qo2[8], ko1[8], ko2[8]; \
            UNPK8(x1, q1); UNPK8(x2, q2); UNPK8(y1, k1); UNPK8(y2, k2); \
            _Pragma("unroll") for (int i = 0; i < 8; ++i) { \
                const float sn = rs[i], cs = rc[i]; \
                rc[i] = cs * stc[i] - sn * sts[i]; rs[i] = sn * stc[i] + cs * sts[i];       \
                qo1[i] = (x1[i] * cs - x2[i] * sn) * 0.08838834764831845f; qo2[i] = (x1[i] * sn + x2[i] * cs) * 0.08838834764831845f; \
                ko1[i] = y1[i] * cs - y2[i] * sn; ko2[i] = y1[i] * sn + y2[i] * cs; \
            } \
            u32x4 w1, w2; \
            PK8(w1, qo1); PK8(w2, qo2); \
            *(LAS u32x4*)(L + LA_QS + row_l * 272 + c8 * 16) = w1; *(LAS u32x4*)(L + LA_QS + row_l * 272 + 128 + c8 * 16) = w2; \
            PK8(w1, ko1); PK8(w2, ko2); \
            *(LAS u32x4*)(L + LA_KS + row_l * 272 + c8 * 16) = w1; *(LAS u32x4*)(L + LA_KS + row_l * 272 + 128 + c8 * 16) = w2; \
            _Pragma("unroll") for (int i = 0; i < 8; ++i) { \
                *(LAS bf16_t*)(L + LA_KT + kt_off(c8 * 8 + i, row_l)) = f2bf(ko1[i] * kdec); \
                *(LAS bf16_t*)(L + LA_KT + kt_off(64 + c8 * 8 + i, row_l)) = f2bf(ko2[i] * kdec); \
            } \
            if (tid < 256) { \
                const unsigned va[4] = {vv.x, vv.y, vv.z, vv.w}; \
                _Pragma("unroll") for (int i = 0; i < 8; ++i) *(LAS bf16_t*)(L + LA_VT + (vp * 8 + i) * 144 + vrow * 2) = (bf16_t)((i & 1) ? (va[i >> 1] >> 16) : (va[i >> 1] & 0xffffu)); \
            } \
        } \
        if ((n_) + 2 < NCH) RET_LOAD(q1, q2, k1, k2, vv, (n_) + 2); \
        LBAR(); \
        la_core<false>(L, st, l2g, OB, DM, h * 256 + sl * 32, b, (n_), dry); \
        LBAR(); } while (0)
    const float kdec = exp2f(l2g * (float)(63 - row_l));
    RET_LOAD(qA1, qA2, kA1, kA2, vA, 0);
    RET_LOAD(qB1, qB2, kB1, kB2, vB, 1);
    for (int n = 0; n < NCH; n += 2) {
        RET_STEP(qA1, qA2, kA1, kA2, vA, n);
        if (n + 1 < NCH) RET_STEP(qB1, qB2, kB1, kB2, vB, n + 1);
    }
#undef RET_STEP
#undef RET_LOAD
}

constexpr size_t HGT_OFF = Z_OFF + (size_t)R * IN_CD * 2;
constexpr size_t HGT_ITEM = 54272;
static_assert(HGT_OFF + (size_t)NB * NCH * 4 * HGT_ITEM <= HN_OFF, "HGRN tile images fit behind z_cd");
__device__ __forceinline__ void hgrn_prepass(const Args& a, LAS unsigned char* L, unsigned* qctr) {
    int tid_ = threadIdx.x; asm volatile("" : "+v"(tid_));
    const int tid = tid_;
    const bf16_t* Z = (const bf16_t*)(a.ws + Z_OFF);
    const int row_l = tid >> 3, c8 = tid & 7;
    const float* lg = a.in[25];
    LAS int* wq = (LAS int*)(L + LDS_BYTES - 32);
    for (;;) {
        if (tid == 0) *wq = (int)__hip_atomic_fetch_add(qctr, 1u, __ATOMIC_RELAXED, __HIP_MEMORY_SCOPE_AGENT);
        __syncthreads();
        const int it = *wq;
        if (it >= NB * NCH * 4) break;
        const int h = it & 3, bn = it >> 2, b = bn / NCH, n = bn % NCH;
        float lb1[8], lb2[8];
#pragma unroll
        for (int i = 0; i < 8; ++i) { const int d = h * 128 + c8 * 8 + i; lb1[i] = sigmoidf_(lg[d] - lg[512 + d]); lb2[i] = sigmoidf_(lg[d + 64] - lg[512 + d + 64]); }
        const int r = chunk_row(b, n, row_l);
        const bool valid = r >= 0;
        u32x4 q1, q2, f1, f2;
        if (valid) { const bf16_t* zr = Z + (size_t)r * IN_CD;
            q1 = *(const u32x4*)(zr + 512 + h * 128 + c8 * 8); q2 = *(const u32x4*)(zr + 512 + h * 128 + 64 + c8 * 8);
            f1 = *(const u32x4*)(zr + 1024 + h * 128 + c8 * 8); f2 = *(const u32x4*)(zr + 1024 + h * 128 + 64 + c8 * 8);
        } else { q1 = q2 = f1 = f2 = (u32x4){0u, 0u, 0u, 0u}; }
        float qv1[8], qv2[8], kv1[8], kv2[8];
        {
            float fp1[8], fp2[8], lf1[8], lf2[8];
            UNPK8(qv1, q1); UNPK8(qv2, q2); UNPK8(fp1, f1); UNPK8(fp2, f2);
#pragma unroll
            for (int i = 0; i < 8; ++i) {
                const float ff1 = lb1[i] + (1.f - lb1[i]) * sigmoidf_(fp1[i]), ff2 = lb2[i] + (1.f - lb2[i]) * sigmoidf_(fp2[i]);
                if (valid) { lf1[i] = __logf(ff1); lf2[i] = __logf(ff2); kv1[i] = 1.f - ff1; kv2[i] = 1.f - ff2; }
                else { lf1[i] = 0.f; lf2[i] = 0.f; kv1[i] = 0.f; kv2[i] = 0.f; qv1[i] = 0.f; qv2[i] = 0.f; }
            }
            LAS float* cr = (LAS float*)(L + LA_CUM) + row_l * 128;
            *(LAS f32x4*)(cr + c8 * 8) = (f32x4){lf1[0], lf1[1], lf1[2], lf1[3]}; *(LAS f32x4*)(cr + c8 * 8 + 4) = (f32x4){lf1[4], lf1[5], lf1[6], lf1[7]};
            *(LAS f32x4*)(cr + 64 + c8 * 8) = (f32x4){lf2[0], lf2[1], lf2[2], lf2[3]}; *(LAS f32x4*)(cr + 64 + c8 * 8 + 4) = (f32x4){lf2[4], lf2[5], lf2[6], lf2[7]};
        }
        __syncthreads();
        {
            const int d = tid & 127, sg = tid >> 7; LAS float* c = (LAS float*)(L + LA_CUM) + (sg * 16) * 128 + d; float run = 0.f;
#pragma unroll
            for (int rr = 0; rr < 16; ++rr) { run += c[rr * 128]; c[rr * 128] = run; }
        }
        __syncthreads();
        {
            const LAS float* C = (const LAS float*)(L + LA_CUM);
            const int sg = row_l >> 4;
            float qi[16], ki[16], kd[16];
#pragma unroll
            for (int i = 0; i < 16; ++i) {
                const int d = (i < 8) ? c8 * 8 + i : 64 + c8 * 8 + (i - 8);
                const float t0 = C[15 * 128 + d], t1 = C[31 * 128 + d], t2 = C[47 * 128 + d], t3 = C[63 * 128 + d];
                float cum = C[row_l * 128 + d];
                cum += (sg > 0 ? t0 : 0.f) + (sg > 1 ? t1 : 0.f) + (sg > 2 ? t2 : 0.f);
                const float cmid = t0 + t1, total = (t0 + t1) + (t2 + t3);
                const float q = (i < 8) ? qv1[i & 7] : qv2[i & 7], k = (i < 8) ? kv1[i & 7] : kv2[i & 7];
                qi[i] = q * __expf(fminf(cum - cmid, 80.f)); ki[i] = k * __expf(fminf(cmid - cum, 80.f));
                kd[i] = k * __expf(total - cum);
                if (row_l == 0) { *(LAS float*)(L + 70656 + d * 4) = __expf(total); *(LAS float*)(L + 71168 + d * 4) = __expf(cmid); }
            }
            u32x4 w1, w2;
            PK8(w1, qi); { const float* sp = qi + 8; PK8(w2, sp); }
            *(LAS u32x4*)(L + LA_QS + row_l * 272 + c8 * 16) = w1; *(LAS u32x4*)(L + LA_QS + row_l * 272 + 128 + c8 * 16) = w2;
            PK8(w1, ki); { const float* sp = ki + 8; PK8(w2, sp); }
            *(LAS u32x4*)(L + LA_KS + row_l * 272 + c8 * 16) = w1; *(LAS u32x4*)(L + LA_KS + row_l * 272 + 128 + c8 * 16) = w2;
#pragma unroll
            for (int i = 0; i < 8; ++i) {
                *(LAS bf16_t*)(L + LA_KT + kt_off(c8 * 8 + i, row_l)) = f2bf(kd[i]);
                *(LAS bf16_t*)(L + LA_KT + kt_off(64 + c8 * 8 + i, row_l)) = f2bf(kd[8 + i]);
            }
        }
        __syncthreads();
        {
            unsigned char* dst = a.ws + HGT_OFF + (size_t)it * HGT_ITEM;
#pragma unroll
            for (int k = 0; k < 7; ++k) { const int idx = tid + k * NTHREADS; if (idx < 3392) *(u32x4*)(dst + (size_t)idx * 16) = *(const LAS u32x4*)(L + (idx < 2176 ? idx * 16 : LA_KT + (idx - 2176) * 16)); }
        }
        __syncthreads();
    }
}

__device__ __forceinline__ void hgrn_unit(const Args& a, LAS unsigned char* L, int unit, bool dry) {
    int tid_ = threadIdx.x; asm volatile("" : "+v"(tid_));
    const int tid = tid_, b = unit >> 4, h = (unit >> 2) & 3, sl = unit & 3;
    const bf16_t* Z = (const bf16_t*)(a.ws + Z_OFF); bf16_t* OB = (bf16_t*)(a.ws + HN_OFF);
    const int vrow = (tid >> 2) & 63, vp = tid & 3;
    f32x4 st[2] = {{0.f, 0.f, 0.f, 0.f}, {0.f, 0.f, 0.f, 0.f}};
    for (int i = tid; i < 32 * 272 / 4; i += NTHREADS) ((LAS unsigned*)(L + LA_ST))[i] = 0u;
    u32x4 pfA[7], pfB[7], vvA, vvB;
#define HG_LOAD(PF, VV, n_) do { const unsigned char* src_ = a.ws + HGT_OFF + (size_t)(((b * NCH + (n_)) * 4) + h) * HGT_ITEM; \
        _Pragma("unroll") for (int k = 0; k < 7; ++k) { const int idx = tid + k * NTHREADS; PF[k] = (u32x4){0u, 0u, 0u, 0u}; if (idx < 3392) PF[k] = *(const u32x4*)(src_ + (size_t)idx * 16); } \
        VV = (u32x4){0u, 0u, 0u, 0u}; \
        if (tid < 256) { const int rv = chunk_row(b, (n_), vrow); if (rv >= 0) VV = *(const u32x4*)(Z + (size_t)rv * IN_CD + 1536 + h * 128 + sl * 32 + vp * 8); } } while (0)
#define HG_STEP(PF, VV, n_) do { \
        _Pragma("unroll") for (int k = 0; k < 7; ++k) { const int idx = tid + k * NTHREADS; \
            if (idx < 2176) *(LAS u32x4*)(L + idx * 16) = PF[k];                                     \
            else if (idx < 3328) *(LAS u32x4*)(L + LA_KT + (idx - 2176) * 16) = PF[k];              \
            else if (idx < 3392) *(LAS u32x4*)(L + LA_DEC + (idx - 3328) * 16) = PF[k]; }           \
        if (tid < 256) { const unsigned va[4] = {VV.x, VV.y, VV.z, VV.w}; \
            _Pragma("unroll") for (int i = 0; i < 8; ++i) *(LAS bf16_t*)(L + LA_VT + (vp * 8 + i) * 144 + vrow * 2) = (bf16_t)((i & 1) ? (va[i >> 1] >> 16) : (va[i >> 1] & 0xffffu)); } \
        if ((n_) + 2 < NCH) HG_LOAD(PF, VV, (n_) + 2); \
        LBAR(); \
        la_core<true>(L, st, 0.f, OB, 512, h * 128 + sl * 32, b, (n_), dry); \
        LBAR(); } while (0)
    HG_LOAD(pfA, vvA, 0);
    HG_LOAD(pfB, vvB, 1);
    for (int n = 0; n < NCH; n += 2) {
        HG_STEP(pfA, vvA, n);
        if (n + 1 < NCH) HG_STEP(pfB, vvB, n + 1);
    }
#undef HG_STEP
#undef HG_LOAD
}

constexpr int LR_XB = 0, LR_XC = 32768, LR_XA = 49152, LR_RG = 58368, RGS = 68  , LR_SEG = LR_RG + 64 * RGS * 4  , LR_END = LR_SEG + 16 * 64 * 4;
__device__ __forceinline__ void lru_unit(const Args& a, LAS unsigned char* L, int unit, bool dry) {
    int tid_ = threadIdx.x; asm volatile("" : "+v"(tid_));
    const int tid = tid_, lane = tid & 63, w = __builtin_amdgcn_readfirstlane(tid >> 6), fr = lane & 15, fq = lane >> 4;
    const int b = unit >> 5, cb = (unit >> 1) & 15, hf = unit & 1;
    bf16_t* Z = (bf16_t*)(a.ws + Z_OFF);
    const int row_l = tid >> 3, c8 = tid & 7;
    const int oc = cb * 64 + hf * 32 + c8 * 4;
    LAS float* XB = (LAS float*)(L + LR_XB); LAS float* XC = (LAS float*)(L + LR_XC); LAS float* RG = (LAS float*)(L + LR_RG);
    float cw[4][8], cbs[8];
#pragma unroll
    for (int i = 0; i < 8; ++i) { const int c = cb * 64 + c8 * 8 + i; cbs[i] = a.in[11][c];
#pragma unroll
        for (int ww = 0; ww < 4; ++ww) cw[ww][i] = a.in[10][ww * 1024 + c]; }
    const int mg = w >> 1, ct = w & 1;
    const int gch = cb * 64 + hf * 32 + ct * 16 + 4 * fq;
    const bf16_t* WG = (const bf16_t*)(a.ws + LRUW_OFF) + (size_t)cb * 128 * 64;
    const int nr_ = hf * 32 + ct * 16 + fr;
    const bf16x8 wr0 = *(const bf16x8*)(WG + nr_ * 64 + fq * 8), wr1 = *(const bf16x8*)(WG + nr_ * 64 + 32 + fq * 8);
    const bf16x8 wi0 = *(const bf16x8*)(WG + (64 + nr_) * 64 + fq * 8), wi1 = *(const bf16x8*)(WG + (64 + nr_) * 64 + 32 + fq * 8);
    const f32x4 bra = *(const f32x4*)(a.in[6] + gch), bia = *(const f32x4*)(a.in[8] + gch);
    float sp[4];
#pragma unroll
    for (int i = 0; i < 4; ++i) sp[i] = log1pf(expf(-a.in[9][gch + i]));
    float hstate = 0.f;
    for (int i = tid; i < 64 * 64; i += NTHREADS) XB[64 * 64 + i] = 0.f;
    u32x4 xbv; u32x2 bgv;
#define LRU_LOAD(n_) do { const int r_ = chunk_row(b, (n_), row_l); \
        if (r_ >= 0) { const bf16_t* zr = Z + (size_t)r_ * IN_AB; xbv = *(const u32x4*)(zr + 2048 + cb * 64 + c8 * 8); bgv = *(const u32x2*)(zr + 4096 + oc); } \
        else { xbv = (u32x4){0u, 0u, 0u, 0u}; bgv = (u32x2){0u, 0u}; } } while (0)
    LRU_LOAD(0);
    for (int n = 0; n < NCH; ++n) {
        const int cur = (n & 1) * 4096, prv = 4096 - cur;
        {
            float xf[8]; UNPK8(xf, xbv);
            *(LAS f32x4*)(XB + cur + row_l * 64 + c8 * 8) = (f32x4){xf[0], xf[1], xf[2], xf[3]}; *(LAS f32x4*)(XB + cur + row_l * 64 + c8 * 8 + 4) = (f32x4){xf[4], xf[5], xf[6], xf[7]};
        }
        const u32x2 bgc = bgv;
        const int grow = chunk_row(b, n, row_l);
        if (n + 1 < NCH) LRU_LOAD(n + 1);
        LBAR();
        {
            float xc[8];
#pragma unroll
            for (int i = 0; i < 8; ++i) xc[i] = cbs[i];
#pragma unroll
            for (int ww = 0; ww < 4; ++ww) {
                const int rr = row_l + ww - 3;
                const LAS float* src = rr >= 0 ? XB + cur + rr * 64 + c8 * 8 : XB + prv + (64 + rr) * 64 + c8 * 8;
                const f32x4 x0 = *(const LAS f32x4*)src, x1 = *(const LAS f32x4*)(src + 4);
                xc[0] += cw[ww][0] * x0[0]; xc[1] += cw[ww][1] * x0[1]; xc[2] += cw[ww][2] * x0[2]; xc[3] += cw[ww][3] * x0[3];
                xc[4] += cw[ww][4] * x1[0]; xc[5] += cw[ww][5] * x1[1]; xc[6] += cw[ww][6] * x1[2]; xc[7] += cw[ww][7] * x1[3];
            }
            *(LAS f32x4*)(XC + row_l * 64 + c8 * 8) = (f32x4){xc[0], xc[1], xc[2], xc[3]}; *(LAS f32x4*)(XC + row_l * 64 + c8 * 8 + 4) = (f32x4){xc[4], xc[5], xc[6], xc[7]};
            u32x4 o; PK8(o, xc);
            *(LAS u32x4*)(L + LR_XA + row_l * 144 + c8 * 16) = o;
        }
        LBAR();
        {
            const bf16x8 x0 = ldsfrag(L + LR_XA + (mg * 16 + fr) * 144 + fq * 16), x1 = ldsfrag(L + LR_XA + (mg * 16 + fr) * 144 + 64 + fq * 16);
            f32x4 ra = {0.f, 0.f, 0.f, 0.f}, ia = {0.f, 0.f, 0.f, 0.f};
            ra = MFMA16(wr0, x0, ra); ia = MFMA16(wi0, x0, ia); ra = MFMA16(wr1, x1, ra); ia = MFMA16(wi1, x1, ia);
            const int jr = mg * 16 + fr;
            const f32x4 x4 = *(const LAS f32x4*)(XC + jr * 64 + hf * 32 + ct * 16 + 4 * fq);
            const bool rvalid = (n > 0) || (jr >= 48);
            f32x4 a4, b4;
#pragma unroll
            for (int i = 0; i < 4; ++i) {
                const float r = sigmoidf_(ra[i] + bra[i]), ig = sigmoidf_(ia[i] + bia[i]);
                const float log_a = -8.f * r * sp[i], x2 = 2.f * log_a, e2 = __expf(x2);
                const float ser = -x2 * (1.f + x2 * (0.5f + x2 * (0.16666667f + x2 * (0.041666668f + x2 * 0.0083333338f))));
                const float om = x2 > -0.25f ? ser : 1.f - e2;
                a4[i] = rvalid ? __expf(log_a) : 1.f; b4[i] = rvalid ? sqrtf(fmaxf(om, 0.f)) * (ig * x4[i]) : 0.f;
            }
            *(LAS f32x4*)(RG + jr * RGS + ct * 16 + 4 * fq) = a4; *(LAS f32x4*)(RG + jr * RGS + 32 + ct * 16 + 4 * fq) = b4;
        }
        LBAR();
        {
            LAS float* SEG = (LAS float*)(L + LR_SEG);
            const int sg = w * 2 + (lane >> 5), ch = lane & 31;
            float sa[4], sb[4];
            {
                float P = 1.f, hh = 0.f;
#pragma unroll
                for (int i = 0; i < 4; ++i) { sa[i] = RG[(sg * 4 + i) * RGS + ch]; sb[i] = RG[(sg * 4 + i) * RGS + 32 + ch]; hh = sa[i] * hh + sb[i]; P *= sa[i]; }
                SEG[sg * 64 + ch] = P; SEG[sg * 64 + 32 + ch] = hh;
            }
            LBAR();
            float c = hstate, mine = 0.f;
#pragma unroll
            for (int s2 = 0; s2 < 16; ++s2) { mine = (s2 == sg) ? c : mine; c = SEG[s2 * 64 + ch] * c + SEG[s2 * 64 + 32 + ch]; }
            hstate = c;
            float hh = mine;
#pragma unroll
            for (int i = 0; i < 4; ++i) { hh = sa[i] * hh + sb[i]; RG[(sg * 4 + i) * RGS + 32 + ch] = hh; }
        }
        LBAR();
        if (grow >= 0 && !dry) {
            const f32x4 h4 = *(const LAS f32x4*)(RG + row_l * RGS + 32 + c8 * 4);
            u32x2 o; o.x = cvt_pk_bf16(gelu_tanh(bf_lo(bgc.x)) * h4[0], gelu_tanh(bf_hi(bgc.x)) * h4[1]); o.y = cvt_pk_bf16(gelu_tanh(bf_lo(bgc.y)) * h4[2], gelu_tanh(bf_hi(bgc.y)) * h4[3]);
            if (grow < RM) *(u32x2*)(Z + (size_t)grow * IN_AB + 4096 + oc) = o;
            else if (b == 0) *(u32x2*)((bf16_t*)(a.ws + YAB_OFF) + (size_t)(grow - RM) * 2048 + 1024 + oc) = o;
        }
    }
    LBAR();
#undef LRU_LOAD
}

constexpr int S5_ROWS = 128, S5_NIT = 33;
constexpr int S5_BU = 0, BUS = 132  , S5_HS = S5_ROWS * BUS * 4, S5_EX = S5_HS + S5_ROWS * 272  , S5_END = S5_EX + 8 * 128 * 4;
static_assert(S5_END <= LDS_BYTES - 16, "S5 lds");
__device__ __forceinline__ int sc_row(int b, int s, int j) { const int n = 2 * s - 1 + (j >> 6); return n < 0 ? -1 : chunk_row(b, n, j & 63); }
__device__ __forceinline__ void s5_unit(const Args& a, LAS unsigned char* L, int unit, bool dry) {
    int tid_ = threadIdx.x; asm volatile("" : "+v"(tid_));
    const int tid = tid_, lane = tid & 63, w = __builtin_amdgcn_readfirstlane(tid >> 6), fr = lane & 15, fq = lane >> 4;
    const int b = unit >> 5, g = unit & 31;
    bf16_t* Z = (bf16_t*)(a.ws + Z_OFF);
    const bf16_t* BB = (const bf16_t*)(a.ws + S5BB_OFF) + (size_t)g * 128 * 32;
    const bf16_t* CM = (const bf16_t*)(a.ws + S5CM_OFF) + (size_t)g * 16 * 128;
    const float* AB = (const float*)(a.ws + S5AB_OFF) + (size_t)g * 128;
    const bf16x8 bbf = *(const bf16x8*)(BB + (w * 16 + fr) * 32 + fq * 8);
    bf16x8 cmf[4];
#pragma unroll
    for (int kk = 0; kk < 4; ++kk) cmf[kk] = *(const bf16x8*)(CM + fr * 128 + kk * 32 + fq * 8);
    const float ar = AB[2 * lane], ai = AB[2 * lane + 1];
    const f32x4 dv = *(const f32x4*)(a.in[20] + g * 16 + 4 * fq);
    float hr = 0.f, hi = 0.f;
    LAS float* BU = (LAS float*)(L + S5_BU); LAS float* EX = (LAS float*)(L + S5_EX);
    float p16r, p16i;
    { float pr = ar, pi = ai;
#pragma unroll
      for (int i = 0; i < 4; ++i) { const float nr = pr * pr - pi * pi, ni = 2.f * pr * pi; pr = nr; pi = ni; }
      p16r = pr; p16i = pi; }
    bf16x8 uf[8]; u32x2 uvn = {0u, 0u};
#define S5_LOAD(s_) do { _Pragma("unroll") for (int m = 0; m < 8; ++m) { const int r_ = sc_row(b, (s_), m * 16 + fr); \
            uf[m] = (bf16x8){0, 0, 0, 0, 0, 0, 0, 0}; \
            if (r_ >= 0 && fq < 2) uf[m] = *(const bf16x8*)(Z + (size_t)r_ * IN_CD + g * 16 + fq * 8); } \
        { const int r2_ = sc_row(b, (s_), w * 16 + fr); uvn = (u32x2){0u, 0u}; if (r2_ >= 0) uvn = *(const u32x2*)(Z + (size_t)r2_ * IN_CD + g * 16 + 4 * fq); } } while (0)
    S5_LOAD(0);
    for (int sI = 0; sI < S5_NIT; ++sI) {
#pragma unroll
        for (int m = 0; m < 8; ++m) { f32x4 acc = {0.f, 0.f, 0.f, 0.f}; acc = MFMA16(bbf, uf[m], acc);
            *(LAS f32x4*)(BU + (m * 16 + fr) * BUS + w * 16 + 4 * fq) = acc; }
        const u32x2 uv = uvn;
        if (sI + 1 < S5_NIT) S5_LOAD(sI + 1);
        LBAR();
        {
            float cr = 0.f, ci = 0.f;
#pragma unroll
            for (int i = 0; i < 16; ++i) {
                const float br = BU[(16 * w + i) * BUS + lane], bi = BU[(16 * w + i) * BUS + 64 + lane];
                const float nr = ar * cr - ai * ci + br, ni = ar * ci + ai * cr + bi;
                cr = nr; ci = ni;
            }
            EX[w * 128 + lane] = cr; EX[w * 128 + 64 + lane] = ci;
        }
        LBAR();
        {
            float cr = hr, ci = hi, mr = 0.f, mi = 0.f;
#pragma unroll
            for (int ww = 0; ww < 8; ++ww) {
                if (ww == w) { mr = cr; mi = ci; }
                const float er = EX[ww * 128 + lane], ei = EX[ww * 128 + 64 + lane];
                const float nr = p16r * cr - p16i * ci + er, ni = p16r * ci + p16i * cr + ei;
                cr = nr; ci = ni;
            }
            hr = cr; hi = ci;
#pragma unroll
            for (int i = 0; i < 16; ++i) {
                const float br = BU[(16 * w + i) * BUS + lane], bi = BU[(16 * w + i) * BUS + 64 + lane];
                const float nr = ar * mr - ai * mi + br, ni = ar * mi + ai * mr + bi;
                mr = nr; mi = ni;
                *(LAS bf16_t*)(L + S5_HS + (16 * w + i) * 272 + lane * 2) = f2bf(mr);
                *(LAS bf16_t*)(L + S5_HS + (16 * w + i) * 272 + 128 + lane * 2) = f2bf(mi);
            }
        }
        LBAR();
        {
            f32x4 acc = {0.f, 0.f, 0.f, 0.f};
#pragma unroll
            for (int kk = 0; kk < 4; ++kk) acc = MFMA16(cmf[kk], ldsfrag(L + S5_HS + (w * 16 + fr) * 272 + kk * 64 + fq * 16), acc);
            const int r = sc_row(b, sI, w * 16 + fr);
            if (r >= 0 && !dry) {
                bf16_t* up = Z + (size_t)r * IN_CD + g * 16 + 4 * fq;
                const float y0 = gelu_tanh(acc[0] + dv[0] * bf_lo(uv.x)), y1 = gelu_tanh(acc[1] + dv[1] * bf_hi(uv.x));
                const float y2 = gelu_tanh(acc[2] + dv[2] * bf_lo(uv.y)), y3 = gelu_tanh(acc[3] + dv[3] * bf_hi(uv.y));
                u32x2 o; o.x = cvt_pk_bf16(y0, y1); o.y = cvt_pk_bf16(y2, y3);
                if (r < RM) *(u32x2*)up = o; else if (b == 0) *(u32x2*)((bf16_t*)(a.ws + YM_OFF) + (size_t)(r - RM) * 512 + g * 16 + 4 * fq) = o;
            }
        }
    }
    LBAR();
#undef S5_LOAD
}

__device__ __forceinline__ void phase_ret_post(const Args& a) {
    int tid_ = threadIdx.x; asm volatile("" : "+v"(tid_));
    const int tid = tid_, lane = tid & 63, wave = tid >> 6;
    const int gw = blockIdx.x * 8 + wave, NGW = gridDim.x * 8;
    bf16_t* Z = (bf16_t*)(a.ws + Z_OFF); const bf16_t* OB = (const bf16_t*)(a.ws + HN_OFF); const float* gn = a.in[4];
    for (int row = gw; row < RVALID; row += NGW) {
        u32x2 ov[4], gv[4]; f32x4 gg[4];
#pragma unroll
        for (int h = 0; h < 4; ++h) {
            ov[h] = *(const u32x2*)(OB + (size_t)row * DM + h * 256 + 4 * lane);
            gv[h] = *(const u32x2*)(Z + (size_t)row * IN_AB + 3072 + h * 256 + 4 * lane);
            gg[h] = *(const f32x4*)(gn + h * 256 + 4 * lane);
        }
#pragma unroll
        for (int h = 0; h < 4; ++h) {
            float o0 = bf_lo(ov[h].x), o1 = bf_hi(ov[h].x), o2 = bf_lo(ov[h].y), o3 = bf_hi(ov[h].y);
            const float mean = wave_sum((o0 + o1) + (o2 + o3)) * (1.f / 256.f);
            o0 -= mean; o1 -= mean; o2 -= mean; o3 -= mean;
            const float inv = rsqrtf(wave_sum(o0 * o0 + o1 * o1 + o2 * o2 + o3 * o3) * (1.f / 256.f) + EPS);
            u32x2 y; y.x = cvt_pk_bf16(o0 * inv * gg[h][0] * silu_(bf_lo(gv[h].x)), o1 * inv * gg[h][1] * silu_(bf_hi(gv[h].x)));
            y.y = cvt_pk_bf16(o2 * inv * gg[h][2] * silu_(bf_lo(gv[h].y)), o3 * inv * gg[h][3] * silu_(bf_hi(gv[h].y)));
            if (row < RM) *(u32x2*)(Z + (size_t)row * IN_AB + 3072 + h * 256 + 4 * lane) = y;
            else *(u32x2*)((bf16_t*)(a.ws + YAB_OFF) + (size_t)(row - RM) * 2048 + h * 256 + 4 * lane) = y;
        }
    }
}
__device__ __forceinline__ void phase_hg_post(const Args& a) {
    int tid_ = threadIdx.x; asm volatile("" : "+v"(tid_));
    const int tid = tid_, lane = tid & 63, wave = tid >> 6;
    const int gw = blockIdx.x * 8 + wave, NGW = gridDim.x * 8;
    bf16_t* Z = (bf16_t*)(a.ws + Z_OFF); const bf16_t* OB = (const bf16_t*)(a.ws + HN_OFF); const float* gn = a.in[24];
    for (int row = gw; row < RVALID; row += NGW) {
        unsigned ov[4], gv[4]; f32x2 gg[4];
#pragma unroll
        for (int h = 0; h < 4; ++h) {
            ov[h] = *(const unsigned*)(OB + (size_t)row * 512 + h * 128 + 2 * lane);
            gv[h] = *(const unsigned*)(Z + (size_t)row * IN_CD + 2048 + h * 128 + 2 * lane);
            gg[h] = *(const f32x2*)(gn + h * 128 + 2 * lane);
        }
#pragma unroll
        for (int h = 0; h < 4; ++h) {
            const float o0 = bf_lo(ov[h]), o1 = bf_hi(ov[h]);
            const float inv = rsqrtf(wave_sum(o0 * o0 + o1 * o1) * (1.f / 128.f) + EPS);
            const unsigned yv = cvt_pk_bf16(o0 * inv * gg[h][0] * silu_(bf_lo(gv[h])), o1 * inv * gg[h][1] * silu_(bf_hi(gv[h])));
            if (row < RM) *(unsigned*)(Z + (size_t)row * IN_CD + 2048 + h * 128 + 2 * lane) = yv;
            else *(unsigned*)((bf16_t*)(a.ws + YCD_OFF) + (size_t)(row - RM) * 1024 + 512 + h * 128 + 2 * lane) = yv;
        }
    }
}

#define XB_TMO      128
#define XB_XCNT(j)  (256  + 64 * (j))
#define XB_XSUB(j)  (1280 + 64 * (j))
#define XB_XGEN(j)  (2304 + 64 * (j))
#define XB_TOP      3328
#define XB_TOPGEN   3392
#define XCD_BAR_WORDS 3456
#define XB_SPIN_CAP (1u << 18)

__device__ __forceinline__ unsigned xb_ld(unsigned* p)              { return __hip_atomic_load(p, __ATOMIC_RELAXED, __HIP_MEMORY_SCOPE_AGENT); }
__device__ __forceinline__ unsigned xb_add(unsigned* p, unsigned v) { return __hip_atomic_fetch_add(p, v, __ATOMIC_RELAXED, __HIP_MEMORY_SCOPE_AGENT); }
__device__ __forceinline__ unsigned xb_xcc_id() { return (unsigned)__builtin_amdgcn_s_getreg((3 << 11) | 20) & 0xFu; }
#define XB_SPIN(cond, bar) do { unsigned _sp = 0; while (cond) { __builtin_amdgcn_s_sleep(1); \
    if ((++_sp & 255u) == 0u) { if (xb_ld(&(bar)[XB_TMO])) break; if (_sp > XB_SPIN_CAP) { atomicAdd(&(bar)[XB_TMO], 1u); break; } } } } while (0)

struct XcdBarrier {
    unsigned* bar; unsigned x;
    volatile LAS unsigned* st;
};

__device__ __forceinline__ XcdBarrier xcd_barrier_post(unsigned* bar, volatile LAS unsigned* st) {
    XcdBarrier b; b.bar = bar; b.x = xb_xcc_id(); b.st = st;
    if (threadIdx.x == 0) (void)xb_add(&bar[XB_XCNT(b.x)], 1u);
    return b;
}
__device__ __forceinline__ void xcd_barrier_complete(unsigned* bar, unsigned x, unsigned& nloc, unsigned& nx) {
    const unsigned G = gridDim.x * gridDim.y * gridDim.z;
    unsigned sum, cnt, mine, sp = 0u;
    for (;;) {
        sum = 0u; cnt = 0u; mine = 0u;
#pragma unroll
        for (unsigned j = 0; j < 16; ++j) { const unsigned c = xb_ld(&bar[XB_XCNT(j)]); sum += c; cnt += (c > 0u) ? 1u : 0u; mine = (j == x) ? c : mine; }
        if (sum == G) break;
        __builtin_amdgcn_s_sleep(1);
        if ((++sp & 255u) == 0u) { if (xb_ld(&bar[XB_TMO])) break; if (sp > XB_SPIN_CAP) { atomicAdd(&bar[XB_TMO], 1u); break; } }
    }
    nloc = mine > 0u ? mine : 1u; nx = cnt > 0u ? cnt : 1u;
}

__device__ __forceinline__ void xcd_barrier(const XcdBarrier& b) {
    asm volatile("s_waitcnt vmcnt(0)" ::: "memory");
    __syncthreads();
    if (threadIdx.x == 0) {
        unsigned* bar = b.bar;
        __builtin_amdgcn_s_waitcnt(0);
        unsigned nloc = b.st[0], nx = b.st[1];
        if (nloc == 0u) { xcd_barrier_complete(bar, b.x, nloc, nx); b.st[0] = nloc; b.st[1] = nx; }
        const unsigned old = xb_add(&bar[XB_XSUB(b.x)], 1u);
        const unsigned gen = old / nloc;
        if (old + 1u == (gen + 1u) * nloc) {
            __builtin_amdgcn_fence(__ATOMIC_RELEASE, "agent");
            asm volatile("s_waitcnt vmcnt(0)" ::: "memory");
            const unsigned og = xb_add(&bar[XB_TOP], 1u);
            const unsigned tg = og / nx;
            if (og + 1u == (tg + 1u) * nx) xb_add(&bar[XB_TOPGEN], 1u);
            else XB_SPIN(xb_ld(&bar[XB_TOPGEN]) == tg, bar);
            __builtin_amdgcn_fence(__ATOMIC_ACQUIRE, "agent");
            xb_add(&bar[XB_XGEN(b.x)], 1u);
            asm volatile("s_waitcnt vmcnt(0)" ::: "memory");
        } else {
            XB_SPIN(xb_ld(&bar[XB_XGEN(b.x)]) == gen, bar);
            __builtin_amdgcn_fence(__ATOMIC_ACQUIRE, "agent");
            asm volatile("s_waitcnt vmcnt(0)" ::: "memory");
        }
    }
    __syncthreads();
}


#ifndef DBG_STOP
#define DBG_STOP 0
#endif
__device__ __forceinline__ void dbg_digest(const Args& a) {
    const size_t gt = (size_t)blockIdx.x * NTHREADS + threadIdx.x, NGT = (size_t)gridDim.x * NTHREADS;
    const bf16_t* zb = (const bf16_t*)(a.ws + Z_OFF);
    const size_t NE = ((size_t)R * 5120 + (size_t)R * 1024);
    const size_t ON = (size_t)RM * DM;
    for (size_t i = gt; i < ON; i += NGT) {
        float s = 0.f;
        for (size_t k = i; k < NE; k += ON) s += __uint_as_float((unsigned)zb[k] << 16);
        a.out[i] = a.out[i] * 1e-3f + s;
    }
}
#ifndef DBG_REP34
#define DBG_REP34 0
#endif
#ifndef DBG_REPG
#define DBG_REPG 0
#endif
#ifndef DBG_SYNC2
#define DBG_SYNC2 0
#endif
#ifndef DBG_TIME
#define DBG_TIME 0
#endif
#define GSYNC() xcd_barrier(xbar)
#define DBG_CHECK(k) do { if (DBG_STOP == (k)) { grid.sync(); dbg_digest(a); return; } \
    if (DBG_TIME) { if ((k) == DBG_TIME - 1) dbg_t0 = __builtin_amdgcn_s_memrealtime(); if ((k) == DBG_TIME) dbg_t1 = __builtin_amdgcn_s_memrealtime(); } } while (0)
__global__ void __launch_bounds__(NTHREADS, 2) fwd_megakernel(Args a) {
    extern __shared__ __attribute__((aligned(16))) unsigned char lds_raw[];
    LAS unsigned char* L = (LAS unsigned char*)lds_raw;
    cg::grid_group grid = cg::this_grid();
    unsigned char* ws = a.ws;
    const int G = gridDim.x, bx = blockIdx.x;
    bf16_t* Zb = (bf16_t*)(ws + Z_OFF); bf16_t* HNb = (bf16_t*)(ws + HN_OFF); float* ssq = (float*)(ws + SSQ_OFF);
    bf16_t* YABb = (bf16_t*)(ws + YAB_OFF); bf16_t* YCDb = (bf16_t*)(ws + YCD_OFF); bf16_t* YMb = (bf16_t*)(ws + YM_OFF);
    float* hmeta = (float*)(ws + HMETA_OFF);
    const float* ng = a.in[26];
    const bool fusedres = (G == 256);

    if (threadIdx.x < 4) ((LAS unsigned*)(L + LDS_BYTES - 16))[threadIdx.x] = 0u;
    __syncthreads();
    const XcdBarrier xbar = xcd_barrier_post((unsigned*)(ws + BAR_OFF), (volatile LAS unsigned*)(L + LDS_BYTES - 16));
    if (a.never) grid.sync();
    phase_prologue(a, L, !fusedres);
    GSYNC();

#define GEMM_PHASE(MODE, Ap, lda_, Wp, N_, K_, Op, ldo_, Yp, ldy_, biasp, AMp, ldam_, OMp, ldom_, YMp, ldym_) do { \
        pg8::Gemm g{(Ap), (Wp), RM, (N_), (K_), (lda_)}; pg8::StaticOrder S; S.init(RM, (N_), G, bx); \
        pg8::Epi<MODE> E{(Op), (ldo_), nullptr, (Yp), (ldy_), (biasp)}; \
        pg8::gemm_phase(L, g, S, E); \
        meta_gemm<MODE, 4, ((K_) >= 1024 ? 4 : 2)>(L, (AMp), (ldam_), (Wp), (N_), (K_), (OMp), (ldom_), nullptr, (YMp), (ldym_), (biasp)); } while (0)
#define RES_PHASE(P, HIN, Ap, lda_, Wp, K_, AMp, ldam_, g1_, g2_) do { \
        pg8::Gemm g{(Ap), (Wp), RM, DM, (K_), (lda_)}; pg8::StaticOrder S; S.init(RM, DM, G, bx); \
        if (fusedres) { \
            float* x1 = (float*)(ws + XB_OFF + (size_t)((P) * 2) * XB_STRIDE); float* x2 = (float*)(ws + XB_OFF + (size_t)((P) * 2 + 1) * XB_STRIDE); \
            unsigned* c1 = (unsigned*)(ws + CNT_OFF) + ((P) * 2) * 80 * 32; unsigned* c2 = (unsigned*)(ws + CNT_OFF) + ((P) * 2 + 1) * 80 * 32; \
            pg8::EpiRes E{(HIN), a.out, (g1_), (g2_), HNb, x1, x2, c1, c2}; \
            pg8::gemm_phase(L, g, S, E); \
            meta_gemm<4, 1, ((K_) >= 2048 ? 8 : 4)>(L, (AMp), (ldam_), (Wp), DM, (K_), HNb + (size_t)RM * DM, DM, nullptr, nullptr, 0, nullptr, hmeta, (g1_), (g2_), x1 + 64 * 256 * 4, x2 + 64 * 256 * 4, c1 + 64 * 32, c2 + 64 * 32); \
            GSYNC(); \
        } else { \
            pg8::Epi<1> E{HNb, DM, ssq, nullptr, 0, nullptr}; \
            pg8::gemm_phase(L, g, S, E); \
            meta_gemm<1, 4, 4>(L, (AMp), (ldam_), (Wp), DM, (K_), HNb + (size_t)RM * DM, DM, ssq + (size_t)RM * 16, nullptr, 0, nullptr); \
            GSYNC(); \
            phase_resnorm(a, (g1_), (g2_)); \
            GSYNC(); \
        } } while (0)

    {
        const bf16_t* W = (const bf16_t*)(ws + W_INAB);
        GEMM_PHASE(0, HNb, DM, W, IN_AB, DM, Zb, IN_AB, nullptr, 0, nullptr, HNb + (size_t)RM * DM, DM, Zb + (size_t)RM * IN_AB, IN_AB, nullptr, 0);
    }
    GSYNC();
    for (int u = bx; u < 128 + 128; u += G) { if (u < 128) retention_unit(a, L, u, false); else lru_unit(a, L, u - 128, false); }
    GSYNC();
    phase_ret_post(a);
    GSYNC();
    {
        const bf16_t* W = (const bf16_t*)(ws + W_OUTAB);
        RES_PHASE(0, (fusedres ? a.in[0] : (const float*)a.out), Zb + 3072, IN_AB, W, 2048, YABb, 2048, ng + 1 * DM, ng + 2 * DM);
    }
    {
        const bf16_t* W = (const bf16_t*)(ws + W_W1_0);
        GEMM_PHASE(2, HNb, DM, W, FF, DM, Zb, FF, nullptr, 0, nullptr, HNb + (size_t)RM * DM, DM, Zb + (size_t)RM * FF, FF, nullptr, 0);
    }
    GSYNC();
    {
        const bf16_t* W = (const bf16_t*)(ws + W_W2_0);
        RES_PHASE(1, (const float*)a.out, Zb, FF, W, FF, Zb + (size_t)RM * FF, FF, ng + 3 * DM, ng + 4 * DM);
    }

    {
        const bf16_t* W = (const bf16_t*)(ws + W_INCD);
        GEMM_PHASE(0, HNb, DM, W, 2048, DM, Zb, IN_CD, nullptr, 0, nullptr, HNb + (size_t)RM * DM, DM, Zb + (size_t)RM * IN_CD, IN_CD, nullptr, 0);
    }
    GSYNC();
    {
        const bf16_t* Wg = (const bf16_t*)(ws + W_INCD) + (size_t)2048 * DM;
        GEMM_PHASE(0, HNb, DM, Wg, 512, DM, Zb + 2048, IN_CD, nullptr, 0, nullptr, HNb + (size_t)RM * DM, DM, Zb + (size_t)RM * IN_CD + 2048, IN_CD, nullptr, 0);
    }
    hgrn_prepass(a, L, (unsigned*)(ws + CNT_OFF) + 7 * 80 * 32 + 70 * 32);
    GSYNC();
    for (int u = bx; u < 64 + 128; u += G) { if (u < 64) hgrn_unit(a, L, u, false); else s5_unit(a, L, u - 64, false); }
    if (G == 256) { if (bx >= 192) weight_convert(a, L, WC_C5, WC_C9, bx - 192, 64); }
    else weight_convert(a, L, WC_C5, WC_C9, bx, G);
    GSYNC();
    phase_hg_post(a);
    {
        const bf16_t* W = (const bf16_t*)(ws + W_GLU);
        GEMM_PHASE(3, Zb, IN_CD, W, 512, 512, Zb + 1536, IN_CD, Zb, IN_CD, a.in[23], YMb, 512, YCDb, 1024, YMb, 512);
    }
    GSYNC();
    {
        const bf16_t* W = (const bf16_t*)(ws + W_OUTCD);
        RES_PHASE(2, (const float*)a.out, Zb + 1536, IN_CD, W, DM, YCDb, 1024, ng + 5 * DM, ng + 6 * DM);
    }
    {
        const bf16_t* W = (const bf16_t*)(ws + W_W1_1);
        GEMM_PHASE(2, HNb, DM, W, FF, DM, Zb, FF, nullptr, 0, nullptr, HNb + (size_t)RM * DM, DM, Zb + (size_t)RM * FF, FF, nullptr, 0);
    }
    GSYNC();
    {
        const bf16_t* W = (const bf16_t*)(ws + W_W2_1);
        pg8::Gemm g{Zb, W, RM, DM, FF, FF}; pg8::StaticOrder S; S.init(RM, DM, G, bx);
        if (fusedres) {
            float* x1 = (float*)(ws + XB_OFF + (size_t)6 * XB_STRIDE); unsigned* c1 = (unsigned*)(ws + CNT_OFF) + 6 * 80 * 32;
            pg8::EpiRes E{(const float*)a.out, a.out, ng + 7 * DM, nullptr, HNb, x1, x1, c1, c1};
            pg8::gemm_phase(L, g, S, E);
            meta_gemm<4, 1, 8>(L, Zb + (size_t)RM * FF, FF, W, DM, FF, HNb + (size_t)RM * DM, DM, nullptr, nullptr, 0, nullptr, hmeta, ng + 7 * DM, nullptr, x1 + 64 * 256 * 4, x1 + 64 * 256 * 4, c1 + 64 * 32, c1 + 64 * 32);
        } else {
            pg8::Epi<1> E{HNb, DM, ssq, nullptr, 0, nullptr};
            pg8::gemm_phase(L, g, S, E);
            meta_gemm<1, 4, 4>(L, Zb + (size_t)RM * FF, FF, W, DM, FF, HNb + (size_t)RM * DM, DM, ssq + (size_t)RM * 16, nullptr, 0, nullptr);
            GSYNC();
            phase_resnorm(a, ng + 7 * DM, nullptr);
        }
    }
#undef GEMM_PHASE
#undef RES_PHASE
}

extern "C" void kernel_launch(void* const* d_in, const int* in_sizes, int n_in, void* d_out, int out_size, void* d_ws, size_t ws_size, hipStream_t stream) {
    static int grid = 0;
    if (!grid) {
        int dev = 0, cus = 0, per_cu = 0;
        (void)hipGetDevice(&dev);
        (void)hipDeviceGetAttribute(&cus, hipDeviceAttributeMultiprocessorCount, dev);
        (void)hipFuncSetAttribute((const void*)fwd_megakernel, hipFuncAttributeMaxDynamicSharedMemorySize, LDS_BYTES);
        (void)hipOccupancyMaxActiveBlocksPerMultiprocessor(&per_cu, (const void*)fwd_megakernel, NTHREADS, LDS_BYTES);
        if (per_cu < 1) per_cu = 1;
        grid = cus * per_cu;
        if (n_in != 29 || ws_size < WS_END) fprintf(stderr, "kernel_launch: unexpected n_in %d / ws %zu (need %zu)\n", n_in, ws_size, (size_t)WS_END);
    }
    Args a{};
    for (int i = 0; i < 29; ++i) a.in[i] = (const float*)d_in[i];
    a.out = (float*)d_out; a.ws = (unsigned char*)d_ws; a.never = 0;
    (void)hipMemsetAsync((unsigned char*)d_ws + BAR_OFF, 0, (size_t)(XB_OFF - BAR_OFF), stream);
    void* args[] = {&a};
    hipError_t e = hipLaunchCooperativeKernel((void*)fwd_megakernel, dim3(grid), dim3(NTHREADS), args, LDS_BYTES, stream);
    if (e != hipSuccess) fprintf(stderr, "cooperative launch failed: %s (grid %d)\n", hipGetErrorString(e), grid);
}
```
